# Optimizing an MI355X kernel written in HIP

```python
import jax, jax.numpy as jnp
from jax import lax
import numpy as np

D_MODEL = 2048
BATCH = 1
SEQ = 8192
DEPTH = 2

GRID_W = 64
CTX_LEN = 256
HEAD_DIM = 128
N_BRANCH = 4
BRANCH_W = D_MODEL // N_BRANCH
A_HEADS = BRANCH_W // HEAD_DIM
A_KV_HEADS = A_HEADS // 2
KV_W = A_KV_HEADS * HEAD_DIM
ROPE_THETA = 10000.0
ROPE_HALF = HEAD_DIM // 4
Q_BLOCK = 128
B_GROUPS = 4
B_GROUP_W = BRANCH_W // B_GROUPS
POOL_WINDOWS = (2, 4, 8, 16)
C_GROUPS = 4
C_GROUP_W = BRANCH_W // C_GROUPS
C_CHUNK = 128
D_HEADS = BRANCH_W // HEAD_DIM
NA_WIN_H = 8
NA_WIN_W = 16
FFN_HIDDEN = -(-(8 * D_MODEL) // (3 * 256)) * 256
EPS = 1e-6

A_Q0 = 0
A_K0 = A_Q0 + A_HEADS * HEAD_DIM
A_V0 = A_K0 + KV_W
A_END = A_V0 + KV_W
B0 = A_END
B_END = B0 + BRANCH_W
C_U0 = B_END
C_V0 = C_U0 + BRANCH_W
C_END = C_V0 + BRANCH_W
D_Q0 = C_END
D_K0 = D_Q0 + D_HEADS * HEAD_DIM
D_V0 = D_K0 + D_HEADS * HEAD_DIM
D_END = D_V0 + D_HEADS * HEAD_DIM
G0 = D_END
IN_COLS = G0 + N_BRANCH * D_MODEL

kernel_name = 'hybrid_dit_parallel_gated_mixers'


def _rms(x, g):
    xf = x.astype(jnp.float32)
    y = xf * lax.rsqrt(jnp.mean(xf * xf, axis=-1, keepdims=True) + EPS)
    return (y * g.astype(jnp.float32)).astype(x.dtype)


def _layernorm(x, g, b):
    xf = x.astype(jnp.float32)
    mu = jnp.mean(xf, axis=-1, keepdims=True)
    var = jnp.mean(jnp.square(xf - mu), axis=-1, keepdims=True)
    y = (xf - mu) * lax.rsqrt(var + EPS) * g.astype(jnp.float32) + b.astype(jnp.float32)
    return y.astype(x.dtype)


def _modulate(h, shift, scale):
    return h * (1.0 + scale) + shift


def _heads(a):
    return a.reshape(a.shape[:-1] + (-1, HEAD_DIM))


def _rope_tables(n):
    t = jnp.arange(n)
    row = (t // GRID_W).astype(jnp.float32)
    col = (t % GRID_W).astype(jnp.float32)
    inv = ROPE_THETA ** (-jnp.arange(ROPE_HALF, dtype=jnp.float32) / ROPE_HALF)
    ang = jnp.concatenate([row[:, None] * inv, col[:, None] * inv], axis=-1)
    return jnp.cos(ang), jnp.sin(ang)


def _apply_rope(x, cos, sin):
    b, n, h, d = x.shape
    xr = x.reshape(b, n, h, 2, 2, ROPE_HALF)
    x1, x2 = xr[..., 0, :], xr[..., 1, :]
    cs = cos.reshape(n, 2, ROPE_HALF)[None, :, None].astype(x.dtype)
    sn = sin.reshape(n, 2, ROPE_HALF)[None, :, None].astype(x.dtype)
    return jnp.stack([x1 * cs - x2 * sn, x2 * cs + x1 * sn], axis=-2).reshape(b, n, h, d)


def _block_attention(q, k, v):
    b, n, h, d = q.shape
    hkv = k.shape[2]
    g = h // hkv
    qb = q.reshape(b, n // Q_BLOCK, Q_BLOCK, hkv, g, d).transpose(1, 0, 2, 3, 4, 5)
    scale = d ** -0.5

    def one(qblk):
        s = jnp.einsum('bqkgd,bskd->bkgqs', qblk, k).astype(jnp.float32) * scale
        p = jax.nn.softmax(s, axis=-1).astype(v.dtype)
        return jnp.einsum('bkgqs,bskd->bqkgd', p, v)

    o = lax.map(one, qb)
    return o.transpose(1, 0, 2, 3, 4, 5).reshape(b, n, h * d)


def _pool_mix(p, w, scale):
    b, n, _ = p.shape
    pg = p.reshape(b, n, B_GROUPS, B_GROUP_W).astype(jnp.float32)
    cs = jnp.concatenate([jnp.zeros_like(pg[:, :1]), jnp.cumsum(pg, axis=1)], axis=1)
    t = jnp.arange(n)[:, None]
    half = jnp.array(POOL_WINDOWS, jnp.int32)[None, :] // 2
    lo = jnp.clip(t - half, 0, n)
    hi = jnp.clip(t + half, 0, n)
    gidx = jnp.arange(B_GROUPS)[None, :]
    win = cs[:, hi, gidx] - cs[:, lo, gidx]
    mean = win / (hi - lo).astype(jnp.float32)[None, :, :, None]
    dlt = (mean - pg).astype(p.dtype)
    y = jnp.einsum('bngc,gce->bnge', dlt, w).reshape(b, n, BRANCH_W)
    return y * scale


def _chunk_mlp(u, v, g, bn, ws, bs):
    b, n, _ = v.shape
    vn = _layernorm(v, g, bn).reshape(b, n // C_CHUNK, C_CHUNK, C_GROUPS, C_GROUP_W)
    mixed = jnp.einsum('gpq,bkqgc->bkpgc', ws, vn) + bs.T[None, None, :, :, None]
    return u * mixed.reshape(b, n, BRANCH_W)


def _neighbourhood_attention(q, k, v, k_ctx, v_ctx, rpb, rows):
    b, n, h, d = q.shape
    wh = min(NA_WIN_H, rows)
    qg = q.reshape(b, rows, GRID_W, h, d)
    kg = k.reshape(b, rows, GRID_W, h, d)
    vg = v.reshape(b, rows, GRID_W, h, d)
    r = jnp.arange(rows)
    r0 = jnp.clip(r - wh // 2, 0, rows - wh)
    dr_idx = r0[:, None] + jnp.arange(wh)[None, :] - r[:, None] + (NA_WIN_H - 1)
    cc = jnp.arange(GRID_W)
    c0 = jnp.clip(cc - NA_WIN_W // 2, 0, GRID_W - NA_WIN_W)
    col_idx = c0[:, None] + jnp.arange(NA_WIN_W)[None, :]
    dc_idx = col_idx - cc[:, None] + (NA_WIN_W - 1)
    rpb_cols = rpb[:, :, dc_idx]
    scale = d ** -0.5
    n_loc = wh * NA_WIN_W

    def one_row(args):
        q_row, start, dr = args
        k_rows = lax.dynamic_slice_in_dim(kg, start, wh, axis=1)
        v_rows = lax.dynamic_slice_in_dim(vg, start, wh, axis=1)
        k_win = k_rows[:, :, col_idx]
        v_win = v_rows[:, :, col_idx]
        bias = rpb_cols[:, dr].transpose(0, 2, 1, 3).astype(jnp.float32)
        s_loc = jnp.einsum('bchd,bicjhd->bhcij', q_row, k_win).astype(jnp.float32) * scale + bias
        s_ctx = jnp.einsum('bchd,blhd->bhcl', q_row, k_ctx).astype(jnp.float32) * scale
        s = jnp.concatenate([s_loc.reshape(b, h, GRID_W, n_loc), s_ctx], axis=-1)
        p = jax.nn.softmax(s, axis=-1).astype(v.dtype)
        p_loc = p[..., :n_loc].reshape(b, h, GRID_W, wh, NA_WIN_W)
        p_ctx = p[..., n_loc:]
        return (jnp.einsum('bhcij,bicjhd->bchd', p_loc, v_win)
                + jnp.einsum('bhcl,blhd->bchd', p_ctx, v_ctx))

    o = lax.map(one_row, (qg.transpose(1, 0, 2, 3, 4), r0, dr_idx))
    return o.transpose(1, 0, 2, 3, 4).reshape(b, n, h * d)


def _merge(outs, gate_logits, w_br, w_o):
    y = jnp.einsum('bnik,ikd->bnid', outs, w_br)
    gates = jax.nn.sigmoid(gate_logits.reshape(y.shape))
    return jnp.sum(gates * y, axis=2) @ w_o


def _swiglu(h, wg, wu, wd):
    return (jax.nn.silu(h @ wg) * (h @ wu)) @ wd


def setup_inputs(seed: int = 0) -> dict:
    key = jax.random.key(seed)
    ks = jax.random.split(key, 25)
    L, D = DEPTH, D_MODEL

    def nrm(k, shape, s):
        return jax.random.normal(k, shape, jnp.float32) * s

    def gain(k, shape):
        return 1.0 + 0.02 * jax.random.normal(k, shape, jnp.float32)

    return {
        'x': nrm(ks[0], (BATCH, SEQ, D), 1.0),
        'c': nrm(ks[1], (BATCH, D), 1.0),
        'ctx': nrm(ks[2], (BATCH, CTX_LEN, D), 1.0),
        'c_ctx': nrm(ks[3], (D,), 1.0),
        'ada_w': nrm(ks[4], (L, D, 6 * D), 0.5 * D ** -0.5),
        'ada_b': nrm(ks[5], (L, 6 * D), 0.01),
        'norm_pre_mix': gain(ks[6], (L, D)),
        'norm_post_mix': gain(ks[7], (L, D)),
        'norm_pre_ffn': gain(ks[8], (L, D)),
        'norm_post_ffn': gain(ks[9], (L, D)),
        'w_in': nrm(ks[10], (L, D, IN_COLS), D ** -0.5),
        'a_q_norm': gain(ks[11], (L, HEAD_DIM)),
        'a_k_norm': gain(ks[12], (L, HEAD_DIM)),
        'b_w': nrm(ks[13], (L, B_GROUPS, B_GROUP_W, B_GROUP_W), B_GROUP_W ** -0.5),
        'b_scale': gain(ks[14], (L, BRANCH_W)),
        'c_norm_g': gain(ks[15], (L, BRANCH_W)),
        'c_norm_b': nrm(ks[16], (L, BRANCH_W), 0.02),
        'c_ws': nrm(ks[17], (L, C_GROUPS, C_CHUNK, C_CHUNK), C_CHUNK ** -0.5),
        'c_bs': gain(ks[18], (L, C_GROUPS, C_CHUNK)),
        'd_rpb': nrm(ks[19], (L, D_HEADS, 2 * NA_WIN_H - 1, 2 * NA_WIN_W - 1), 0.1),
        'w_br': nrm(ks[20], (L, N_BRANCH, BRANCH_W, D), BRANCH_W ** -0.5),
        'w_o': nrm(ks[21], (L, D, D), D ** -0.5),
        'w_gate': nrm(ks[22], (L, D, FFN_HIDDEN), D ** -0.5),
        'w_up': nrm(ks[23], (L, D, FFN_HIDDEN), D ** -0.5),
        'w_down': nrm(ks[24], (L, FFN_HIDDEN, D), FFN_HIDDEN ** -0.5),
    }


def reference(x, c, ctx, c_ctx, ada_w, ada_b, norm_pre_mix, norm_post_mix, norm_pre_ffn,
              norm_post_ffn, w_in, a_q_norm, a_k_norm, b_w, b_scale, c_norm_g, c_norm_b,
              c_ws, c_bs, d_rpb, w_br, w_o, w_gate, w_up, w_down):
    n = x.shape[1]
    rows = n // GRID_W
    cos, sin = _rope_tables(n)
    xl, xc = x, ctx
    for layer in range(DEPTH):
        last = layer == DEPTH - 1
        w = w_in[layer]
        mod_l = (jax.nn.silu(c) @ ada_w[layer] + ada_b[layer])[:, None, :]
        mod_c = (jax.nn.silu(c_ctx) @ ada_w[layer] + ada_b[layer])[None, None, :]
        sh_l, sc_l, g_l, shf_l, scf_l, gf_l = jnp.split(mod_l, 6, axis=-1)
        sh_c, sc_c, g_c, shf_c, scf_c, gf_c = jnp.split(mod_c, 6, axis=-1)

        hl = _modulate(_rms(xl, norm_pre_mix[layer]), sh_l, sc_l)
        hc = _modulate(_rms(xc, norm_pre_mix[layer]), sh_c, sc_c)

        if last:
            pc_a = hc @ w[:, A_K0:A_END]
            pc_d = hc @ w[:, D_K0:D_END]
        else:
            pc = hc @ w
            pc_a = pc[..., A_K0:A_END]
            pc_d = pc[..., D_K0:D_END]
        ka_c = _rms(_heads(pc_a[..., :KV_W]), a_k_norm[layer])
        va_c = _heads(pc_a[..., KV_W:])
        kd_c = _heads(pc_d[..., :BRANCH_W])
        vd_c = _heads(pc_d[..., BRANCH_W:])

        pl = hl @ w
        qa = _apply_rope(_rms(_heads(pl[..., A_Q0:A_K0]), a_q_norm[layer]), cos, sin)
        ka = _apply_rope(_rms(_heads(pl[..., A_K0:A_V0]), a_k_norm[layer]), cos, sin)
        va = _heads(pl[..., A_V0:A_END])
        out_a = _block_attention(qa, jnp.concatenate([ka, ka_c], axis=1),
                                 jnp.concatenate([va, va_c], axis=1))
        out_b = _pool_mix(pl[..., B0:B_END], b_w[layer], b_scale[layer])
        out_c = _chunk_mlp(pl[..., C_U0:C_V0], pl[..., C_V0:C_END], c_norm_g[layer],
                           c_norm_b[layer], c_ws[layer], c_bs[layer])
        out_d = _neighbourhood_attention(_heads(pl[..., D_Q0:D_K0]), _heads(pl[..., D_K0:D_V0]),
                                         _heads(pl[..., D_V0:D_END]), kd_c, vd_c, d_rpb[layer], rows)
        y_l = _merge(jnp.stack([out_a, out_b, out_c, out_d], axis=2), pl[..., G0:],
                     w_br[layer], w_o[layer])
        xl = xl + g_l * _rms(y_l, norm_post_mix[layer])
        hf_l = _modulate(_rms(xl, norm_pre_ffn[layer]), shf_l, scf_l)
        xl = xl + gf_l * _rms(_swiglu(hf_l, w_gate[layer], w_up[layer], w_down[layer]),
                              norm_post_ffn[layer])

        if not last:
            qa_c = _rms(_heads(pc[..., A_Q0:A_K0]), a_q_norm[layer])
            oa_c = _block_attention(qa_c, ka_c, va_c)
            ob_c = _pool_mix(pc[..., B0:B_END], b_w[layer], b_scale[layer])
            oc_c = _chunk_mlp(pc[..., C_U0:C_V0], pc[..., C_V0:C_END], c_norm_g[layer],
                              c_norm_b[layer], c_ws[layer], c_bs[layer])
            od_c = _block_attention(_heads(pc[..., D_Q0:D_K0]), kd_c, vd_c)
            y_c = _merge(jnp.stack([oa_c, ob_c, oc_c, od_c], axis=2), pc[..., G0:],
                         w_br[layer], w_o[layer])
            xc = xc + g_c * _rms(y_c, norm_post_mix[layer])
            hf_c = _modulate(_rms(xc, norm_pre_ffn[layer]), shf_c, scf_c)
            xc = xc + gf_c * _rms(_swiglu(hf_c, w_gate[layer], w_up[layer], w_down[layer]),
                                  norm_post_ffn[layer])
    return xl
```

```cpp
#include <hip/hip_runtime.h>
#include <hip/hip_cooperative_groups.h>
#include <cstdio>
#include <cstdint>
namespace cg = cooperative_groups;

#ifndef MK_COOP
#define MK_COOP 1
#endif

typedef unsigned short bf16_t;
typedef short bf16x8 __attribute__((ext_vector_type(8)));
typedef float f32x4 __attribute__((ext_vector_type(4)));
typedef unsigned u32x4 __attribute__((ext_vector_type(4)));
typedef unsigned u32x2 __attribute__((ext_vector_type(2)));

constexpr int DM = 2048, SEQ = 8192, CTXL = 256, MR = SEQ + CTXL, NIN = 12288, FF = 5632, HD = 128, GW = 64;
constexpr int A_Q0 = 0, A_K0 = 512, A_V0 = 768, B0 = 1024, C_U0 = 1536, C_V0 = 2048, D_Q0 = 2560, D_K0 = 3072, D_V0 = 3584, G0 = 4096;
constexpr float EPS = 1e-6f;
constexpr int NTHR = 512, NWAVE = 8;
constexpr int LDS_BYTES = 147456;

enum { I_X = 0, I_C, I_CTX, I_CCTX, I_ADAW, I_ADAB, I_NPRE_MIX, I_NPOST_MIX, I_NPRE_FFN, I_NPOST_FFN, I_WIN, I_AQN, I_AKN, I_BW, I_BSCALE,
       I_CNG, I_CNB, I_CWS, I_CBS, I_RPB, I_WBR, I_WO, I_WG, I_WU, I_WD, N_IN };

constexpr size_t MiB = 1u << 20;
constexpr size_t WS_CTL = 0, CTL_BYTES = 1 * MiB;
constexpr size_t CTL_MOD = 256 * 1024;
constexpr size_t WS_W = 2 * MiB, WPL = 131 * MiB;
constexpr size_t W_IN = 0, W_BR = 48 * MiB, W_O = 56 * MiB, W_GU = 64 * MiB, W_D = 108 * MiB, W_B = 130 * MiB;
constexpr size_t WS_X = 264 * MiB;
constexpr size_t WS_XN = 330 * MiB;
constexpr size_t WS_PL = 363 * MiB;
constexpr size_t WS_H = WS_PL;
constexpr size_t WS_OUTS = 561 * MiB;
constexpr size_t WS_DLT = 594 * MiB;
constexpr size_t WS_MRG = 603 * MiB;
constexpr size_t WS_MRGB = 669 * MiB;
constexpr size_t WS_END = 702 * MiB;

struct Args { const float* in[N_IN]; float* out; unsigned char* ws; int ph_lo, ph_hi; };

__device__ __forceinline__ unsigned f2bf(float f) { unsigned u = __builtin_bit_cast(unsigned, f); return (u + 0x7fffu + ((u >> 16) & 1u)) >> 16; }
__device__ __forceinline__ unsigned pk2(float lo, float hi) { return f2bf(lo) | (f2bf(hi) << 16); }
__device__ __forceinline__ float bflo(unsigned w) { return __builtin_bit_cast(float, w << 16); }
__device__ __forceinline__ float bfhi(unsigned w) { return __builtin_bit_cast(float, w & 0xffff0000u); }
__device__ __forceinline__ float bf2f(bf16_t h) { return __builtin_bit_cast(float, (unsigned)h << 16); }
__device__ __forceinline__ float wave_sum(float v) {
#pragma unroll
    for (int o = 32; o >= 1; o >>= 1) v += __shfl_xor(v, o);
    return v;
}
__device__ __forceinline__ int otid() { int t = threadIdx.x; asm volatile("" : "+v"(t)); return t; }
__device__ __forceinline__ float sigmoidf_(float x) { return 1.f / (1.f + __expf(-x)); }
__device__ __forceinline__ float siluf_(float x) { return x / (1.f + __expf(-x)); }

struct Unit { int pm, pn; };
struct Gemm { const bf16_t* A; const bf16_t* Bt; int lda, ldb, K; };
constexpr int NXCD = 8, WGM = 8;
struct StaticOrder {
    int nM, nN, nwg, G, c;
    __device__ void init(int M, int N, int G_, int c_) { nM = M / 256; nN = N / 256; nwg = nM * nN; G = G_; c = c_; }
    __device__ bool next(int i, Unit& u) const {
        const long L = (long)i * G + c; if (L >= nwg) return false;
        int wgid = (int)L; { const int q = nwg / NXCD, r = nwg % NXCD, xcd = wgid % NXCD, off = wgid / NXCD; wgid = (xcd < r ? xcd * (q + 1) : r * (q + 1) + (xcd - r) * q) + off; }
        const int nig = WGM * nN, gid = wgid / nig, fm = gid * WGM, gsz = (nM - fm) < WGM ? (nM - fm) : WGM;
        u.pm = fm + ((wgid % nig) % gsz); u.pn = (wgid % nig) / gsz; return true;
    }
};
struct MergeOrder {
    StaticOrder base;
    __device__ bool next(int i, Unit& u) const { Unit t; if (!base.next(i >> 2, t)) return false; const int pass = i & 3; u.pm = pass * 33 + t.pm; u.pn = pass * 8 + t.pn; return true; }
};

template <class Epi, class Sched>
__device__ __forceinline__ void gemm_phase(const Gemm g, const Sched& S, const Epi& E) {
    const int tid = otid(), wid = tid >> 6, lane = tid & 63, wr = wid >> 2, wc = wid & 3, fr = lane & 15, fq = lane >> 4;
    Unit u;
    for (int ui = 0; S.next(ui, u); ++ui) {
        f32x4 acc[2][2][4][2];
#pragma unroll
        for (int a = 0; a < 2; ++a)
#pragma unroll
            for (int b = 0; b < 2; ++b)
#pragma unroll
                for (int m = 0; m < 4; ++m)
#pragma unroll
                    for (int n = 0; n < 2; ++n) acc[a][b][m][n] = (f32x4){0.f, 0.f, 0.f, 0.f};
        const bf16_t* Ap = g.A + (size_t)(u.pm * 256 + wr * 64 + fr) * g.lda + fq * 8;
        const bf16_t* Bp = g.Bt + (size_t)(u.pn * 256 + wc * 32 + 8 * (fr >> 2) + (fr & 3)) * g.ldb + fq * 8;
        for (int k0 = 0; k0 < g.K; k0 += 32) {
            bf16x8 av[2][4], bv[2][2];
#pragma unroll
            for (int ai = 0; ai < 2; ++ai)
#pragma unroll
                for (int m = 0; m < 4; ++m) av[ai][m] = *(const bf16x8*)(Ap + (size_t)(ai * 128 + m * 16) * g.lda + k0);
#pragma unroll
            for (int bj = 0; bj < 2; ++bj)
#pragma unroll
                for (int n = 0; n < 2; ++n) bv[bj][n] = *(const bf16x8*)(Bp + (size_t)(bj * 128 + 4 * n) * g.ldb + k0);
#pragma unroll
            for (int ai = 0; ai < 2; ++ai)
#pragma unroll
                for (int bj = 0; bj < 2; ++bj)
#pragma unroll
                    for (int m = 0; m < 4; ++m)
#pragma unroll
                        for (int n = 0; n < 2; ++n)
                            acc[ai][bj][m][n] = __builtin_amdgcn_mfma_f32_16x16x32_bf16(bv[bj][n], av[ai][m], acc[ai][bj][m][n], 0, 0, 0);
        }
        E(acc, u, wr, wc, fr, fq);
    }
}

struct EpiIn {
    bf16_t* PL;
    __device__ __forceinline__ void operator()(const f32x4 (&acc)[2][2][4][2], const Unit& u, int wr, int wc, int fr, int fq) const {
        const bool gate = u.pn >= (G0 / 256);
#pragma unroll
        for (int ai = 0; ai < 2; ++ai)
#pragma unroll
            for (int m = 0; m < 4; ++m) {
                const int row = u.pm * 256 + ai * 128 + wr * 64 + m * 16 + fr;
#pragma unroll
                for (int bj = 0; bj < 2; ++bj) {
                    const int col = u.pn * 256 + bj * 128 + wc * 32 + 8 * fq;
                    f32x4 v0 = acc[ai][bj][m][0], v1 = acc[ai][bj][m][1];
                    if (gate) {
#pragma unroll
                        for (int e = 0; e < 4; ++e) { v0[e] = sigmoidf_(v0[e]); v1[e] = sigmoidf_(v1[e]); }
                    }
                    u32x4 w; w.x = pk2(v0[0], v0[1]); w.y = pk2(v0[2], v0[3]); w.z = pk2(v1[0], v1[1]); w.w = pk2(v1[2], v1[3]);
                    *(u32x4*)(PL + (size_t)row * NIN + col) = w;
                }
            }
    }
};
struct EpiScale {
    bf16_t* O; int ldc; const float* scale;
    __device__ __forceinline__ void operator()(const f32x4 (&acc)[2][2][4][2], const Unit& u, int wr, int wc, int fr, int fq) const {
#pragma unroll
        for (int bj = 0; bj < 2; ++bj) {
            const int col = u.pn * 256 + bj * 128 + wc * 32 + 8 * fq;
            const f32x4 s0 = *(const f32x4*)(scale + col), s1 = *(const f32x4*)(scale + col + 4);
#pragma unroll
            for (int ai = 0; ai < 2; ++ai)
#pragma unroll
                for (int m = 0; m < 4; ++m) {
                    const int row = u.pm * 256 + ai * 128 + wr * 64 + m * 16 + fr;
                    const f32x4 v0 = acc[ai][bj][m][0] * s0, v1 = acc[ai][bj][m][1] * s1;
                    u32x4 w; w.x = pk2(v0[0], v0[1]); w.y = pk2(v0[2], v0[3]); w.z = pk2(v1[0], v1[1]); w.w = pk2(v1[2], v1[3]);
                    *(u32x4*)(O + (size_t)row * ldc + col) = w;
                }
        }
    }
};
struct EpiMerge {
    const bf16_t* PL; float* MRG; bf16_t* MRGB;
    __device__ __forceinline__ void operator()(const f32x4 (&acc)[2][2][4][2], const Unit& u, int wr, int wc, int fr, int fq) const {
        const int pass = u.pm / 33, pm = u.pm - pass * 33, pn = u.pn & 7;
#pragma unroll
        for (int ai = 0; ai < 2; ++ai)
#pragma unroll
            for (int m = 0; m < 4; ++m) {
                const int row = pm * 256 + ai * 128 + wr * 64 + m * 16 + fr;
#pragma unroll
                for (int bj = 0; bj < 2; ++bj) {
                    const int col = pn * 256 + bj * 128 + wc * 32 + 8 * fq;
                    const u32x4 gw = *(const u32x4*)(PL + (size_t)row * NIN + G0 + pass * DM + col);
                    f32x4 v0 = acc[ai][bj][m][0], v1 = acc[ai][bj][m][1];
                    v0[0] *= bflo(gw.x); v0[1] *= bfhi(gw.x); v0[2] *= bflo(gw.y); v0[3] *= bfhi(gw.y);
                    v1[0] *= bflo(gw.z); v1[1] *= bfhi(gw.z); v1[2] *= bflo(gw.w); v1[3] *= bfhi(gw.w);
                    float* mp = MRG + (size_t)row * DM + col;
                    if (pass > 0) { v0 += *(const f32x4*)mp; v1 += *(const f32x4*)(mp + 4); }
                    if (pass < 3) { *(f32x4*)mp = v0; *(f32x4*)(mp + 4) = v1; }
                    else { u32x4 w; w.x = pk2(v0[0], v0[1]); w.y = pk2(v0[2], v0[3]); w.z = pk2(v1[0], v1[1]); w.w = pk2(v1[2], v1[3]);
                           *(u32x4*)(MRGB + (size_t)row * DM + col) = w; }
                }
            }
    }
};
struct EpiF32 {
    float* Y; int ldc;
    __device__ __forceinline__ void operator()(const f32x4 (&acc)[2][2][4][2], const Unit& u, int wr, int wc, int fr, int fq) const {
#pragma unroll
        for (int ai = 0; ai < 2; ++ai)
#pragma unroll
            for (int m = 0; m < 4; ++m) {
                const int row = u.pm * 256 + ai * 128 + wr * 64 + m * 16 + fr;
#pragma unroll
                for (int bj = 0; bj < 2; ++bj) {
                    const int col = u.pn * 256 + bj * 128 + wc * 32 + 8 * fq;
                    float* yp = Y + (size_t)row * ldc + col;
                    *(f32x4*)yp = acc[ai][bj][m][0]; *(f32x4*)(yp + 4) = acc[ai][bj][m][1];
                }
            }
    }
};
struct EpiSwiglu {
    bf16_t* H;
    __device__ __forceinline__ void operator()(const f32x4 (&acc)[2][2][4][2], const Unit& u, int wr, int wc, int fr, int fq) const {
#pragma unroll
        for (int ai = 0; ai < 2; ++ai)
#pragma unroll
            for (int m = 0; m < 4; ++m) {
                const int row = u.pm * 256 + ai * 128 + wr * 64 + m * 16 + fr;
                const int col = u.pn * 128 + wc * 32 + 8 * fq;
                f32x4 h0, h1;
#pragma unroll
                for (int e = 0; e < 4; ++e) { h0[e] = siluf_(acc[ai][0][m][0][e]) * acc[ai][1][m][0][e]; h1[e] = siluf_(acc[ai][0][m][1][e]) * acc[ai][1][m][1][e]; }
                u32x4 w; w.x = pk2(h0[0], h0[1]); w.y = pk2(h0[2], h0[3]); w.z = pk2(h1[0], h1[1]); w.w = pk2(h1[2], h1[3]);
                *(u32x4*)(H + (size_t)row * FF + col) = w;
            }
    }
};

__device__ __forceinline__ void tr_item(const float* src, int ldn, int k0, int n0, bf16_t* dst, int dld, int drow0, int dk0, float* scr, int lane) {
    const float* sp = src + (size_t)k0 * ldn + n0 + lane;
#pragma unroll 16
    for (int i = 0; i < 64; ++i) scr[i * 65 + lane] = sp[(size_t)i * ldn];
    __builtin_amdgcn_s_waitcnt(0); asm volatile("" ::: "memory");
    const int c = lane & 7;
#pragma unroll
    for (int j = 0; j < 8; ++j) {
        const int n = (lane >> 3) + 8 * j; const float* s = scr + (8 * c) * 65 + n;
        u32x4 o; o.x = pk2(s[0], s[65]); o.y = pk2(s[2 * 65], s[3 * 65]); o.z = pk2(s[4 * 65], s[5 * 65]); o.w = pk2(s[6 * 65], s[7 * 65]);
        *(u32x4*)(dst + (size_t)(drow0 + n) * dld + dk0 + 8 * c) = o;
    }
    __builtin_amdgcn_s_waitcnt(0); asm volatile("" ::: "memory");
}

__device__ __forceinline__ void phase_prologue(const Args& a, unsigned char* lds, int vcu, int G) {
    const int tid = otid(), wave = tid >> 6, lane = tid & 63;
    const int gw = vcu * NWAVE + wave, NGW = G * NWAVE;
    float* scr = (float*)(lds + wave * 16640);
    constexpr int I_IN = 32 * 192, I_BR = 4 * 8 * 32, I_O = 32 * 32, I_G = 32 * 88, I_D = 88 * 32, I_B = 16;
    constexpr int PLI = I_IN + I_BR + I_O + 2 * I_G + I_D + I_B;
    for (int it = gw; it < 2 * PLI; it += NGW) {
        const int l = it / PLI; int r = it - l * PLI;
        unsigned char* wb = a.ws + WS_W + (size_t)l * WPL;
        if (r < I_IN) { const int kb = r / 192, nb = r % 192; tr_item(a.in[I_WIN] + (size_t)l * DM * NIN, NIN, kb * 64, nb * 64, (bf16_t*)(wb + W_IN), DM, nb * 64, kb * 64, scr, lane); continue; } r -= I_IN;
        if (r < I_BR) { const int i = r >> 8, rr = r & 255, kb = rr >> 5, nb = rr & 31;
            tr_item(a.in[I_WBR] + (size_t)(l * 4 + i) * 512 * DM, DM, kb * 64, nb * 64, (bf16_t*)(wb + W_BR) + (size_t)i * DM * 512, 512, nb * 64, kb * 64, scr, lane); continue; } r -= I_BR;
        if (r < I_O) { const int kb = r >> 5, nb = r & 31; tr_item(a.in[I_WO] + (size_t)l * DM * DM, DM, kb * 64, nb * 64, (bf16_t*)(wb + W_O), DM, nb * 64, kb * 64, scr, lane); continue; } r -= I_O;
        if (r < I_G) { const int kb = r / 88, nb = r % 88, n0 = nb * 64; tr_item(a.in[I_WG] + (size_t)l * DM * FF, FF, kb * 64, n0, (bf16_t*)(wb + W_GU), DM, (n0 >> 7) * 256 + (n0 & 127), kb * 64, scr, lane); continue; } r -= I_G;
        if (r < I_G) { const int kb = r / 88, nb = r % 88, n0 = nb * 64; tr_item(a.in[I_WU] + (size_t)l * DM * FF, FF, kb * 64, n0, (bf16_t*)(wb + W_GU), DM, (n0 >> 7) * 256 + 128 + (n0 & 127), kb * 64, scr, lane); continue; } r -= I_G;
        if (r < I_D) { const int kb = r >> 5, nb = r & 31; tr_item(a.in[I_WD] + (size_t)l * FF * DM, DM, kb * 64, nb * 64, (bf16_t*)(wb + W_D), FF, nb * 64, kb * 64, scr, lane); continue; } r -= I_D;
        { const int g = r >> 2, kb = (r >> 1) & 1, nb = r & 1;
          tr_item(a.in[I_BW] + (size_t)(l * 4 + g) * 128 * 128, 128, kb * 64, nb * 64, (bf16_t*)(wb + W_B), 512, g * 128 + nb * 64, g * 128 + kb * 64, scr, lane); }
    }
    for (int i = vcu * NTHR + tid; i < 2 * 32768; i += G * NTHR) {
        const int l = i >> 15, j = i & 32767, n = j >> 6, kc = j & 63;
        if ((n >> 7) != (kc >> 4)) *(u32x4*)((bf16_t*)(a.ws + WS_W + (size_t)l * WPL + W_B) + (size_t)n * 512 + kc * 8) = (u32x4){0u, 0u, 0u, 0u};
    }
    float* MOD = (float*)(a.ws + WS_CTL + CTL_MOD);
    for (int it = vcu; it < 768; it += G) {
        const int l = it / 384, r = it % 384, cb = r >> 6, kc = r & 63;
        const int col = cb * 2048 + tid * 4;
        f32x4 al = {0.f, 0.f, 0.f, 0.f}, ac = {0.f, 0.f, 0.f, 0.f};
        const float* wp = a.in[I_ADAW] + ((size_t)l * DM + kc * 32) * NIN + col;
#pragma unroll 8
        for (int k = 0; k < 32; ++k) {
            const float sl = siluf_(a.in[I_C][kc * 32 + k]), sc = siluf_(a.in[I_CCTX][kc * 32 + k]);
            const f32x4 w = *(const f32x4*)(wp + (size_t)k * NIN);
            al += sl * w; ac += sc * w;
        }
        if (kc == 0) { const f32x4 b = *(const f32x4*)(a.in[I_ADAB] + (size_t)l * NIN + col); al += b; ac += b; }
        float* ml = MOD + (size_t)(l * 2 + 0) * NIN + col; float* mc = MOD + (size_t)(l * 2 + 1) * NIN + col;
#pragma unroll
        for (int e = 0; e < 4; ++e) { unsafeAtomicAdd(ml + e, al[e]); unsafeAtomicAdd(mc + e, ac[e]); }
    }
}

template <int MODE>
__device__ __forceinline__ void phase_rows(const Args& a, int vcu, int G, int nrows, const float* gpost, const float* modcur, int gate_idx,
                                           const float* gnext, const float* modnext, int sh_idx) {
    const int tid = otid(), wave = tid >> 6, lane = tid & 63;
    const int gw = vcu * NWAVE + wave, NGW = G * NWAVE;
    float* X = (float*)(a.ws + WS_X); const float* Y = (const float*)(a.ws + WS_MRG); bf16_t* XN = (bf16_t*)(a.ws + WS_XN);
    for (int row = gw; row < nrows; row += NGW) {
        const int isctx = row >= SEQ ? 1 : 0;
        f32x4 x[8];
        if (MODE == 0) {
            const float* src = isctx ? a.in[I_CTX] + (size_t)(row - SEQ) * DM : a.in[I_X] + (size_t)row * DM;
#pragma unroll
            for (int j = 0; j < 8; ++j) x[j] = *(const f32x4*)(src + 4 * lane + 256 * j);
        } else {
            f32x4 y[8]; float ss = 0.f;
#pragma unroll
            for (int j = 0; j < 8; ++j) { x[j] = *(const f32x4*)(X + (size_t)row * DM + 4 * lane + 256 * j); y[j] = *(const f32x4*)(Y + (size_t)row * DM + 4 * lane + 256 * j);
                ss += (y[j][0] * y[j][0] + y[j][1] * y[j][1]) + (y[j][2] * y[j][2] + y[j][3] * y[j][3]); }
            const float rstd = 1.0f / sqrtf(wave_sum(ss) * (1.f / DM) + EPS);
            const float* gate = modcur + (size_t)isctx * NIN + gate_idx * DM;
#pragma unroll
            for (int j = 0; j < 8; ++j) { const int col = 4 * lane + 256 * j; const f32x4 gp = *(const f32x4*)(gpost + col), gt = *(const f32x4*)(gate + col);
                x[j] += gt * (y[j] * rstd * gp); }
        }
        if (MODE == 2) {
#pragma unroll
            for (int j = 0; j < 8; ++j) *(f32x4*)(a.out + (size_t)row * DM + 4 * lane + 256 * j) = x[j];
            continue;
        }
        float ss = 0.f;
#pragma unroll
        for (int j = 0; j < 8; ++j) { *(f32x4*)(X + (size_t)row * DM + 4 * lane + 256 * j) = x[j];
            ss += (x[j][0] * x[j][0] + x[j][1] * x[j][1]) + (x[j][2] * x[j][2] + x[j][3] * x[j][3]); }
        const float rstd = 1.0f / sqrtf(wave_sum(ss) * (1.f / DM) + EPS);
        const float* sh = modnext + (size_t)isctx * NIN + sh_idx * DM; const float* sc = sh + DM;
#pragma unroll
        for (int j = 0; j < 8; ++j) { const int col = 4 * lane + 256 * j; const f32x4 gn = *(const f32x4*)(gnext + col), s1 = *(const f32x4*)(sc + col), s0 = *(const f32x4*)(sh + col);
            const f32x4 h = (x[j] * rstd * gn) * (1.f + s1) + s0;
            u32x2 w; w.x = pk2(h[0], h[1]); w.y = pk2(h[2], h[3]); *(u32x2*)(XN + (size_t)row * DM + col) = w; }
    }
}

__device__ __forceinline__ void qk_prep_row(const Args& a, int layer, int row, int lane) {
    bf16_t* p = (bf16_t*)(a.ws + WS_PL) + (size_t)row * NIN;
    const int ax = lane >> 5, f = lane & 31, d1 = ax * 64 + f, d2 = d1 + 32;
    float cs = 1.f, sn = 0.f;
    if (row < SEQ) { const float pos = (float)(ax == 0 ? (row >> 6) : (row & 63)); const float inv = exp2f(-(float)f * (13.287712379549449f / 32.f)); const float ang = pos * inv; cs = cosf(ang); sn = sinf(ang); }
#pragma unroll
    for (int h = 0; h < 6; ++h) {
        const float* gn = (h < 4 ? a.in[I_AQN] : a.in[I_AKN]) + layer * HD;
        bf16_t* hp = p + h * HD;
        float x1 = bf2f(hp[d1]), x2 = bf2f(hp[d2]);
        const float rstd = 1.0f / sqrtf(wave_sum(x1 * x1 + x2 * x2) * (1.f / HD) + EPS);
        x1 = x1 * rstd * gn[d1]; x2 = x2 * rstd * gn[d2];
        hp[d1] = (bf16_t)f2bf(x1 * cs - x2 * sn); hp[d2] = (bf16_t)f2bf(x2 * cs + x1 * sn);
    }
}
__device__ __forceinline__ void dlt_row(const Args& a, int row, int lane) {
    const bf16_t* PL = (const bf16_t*)(a.ws + WS_PL); bf16_t* DLT = (bf16_t*)(a.ws + WS_DLT);
    const int base = row < SEQ ? 0 : SEQ, n = row < SEQ ? SEQ : CTXL, t = row - base, half = 1 << (lane >> 4);
    const int lo = max(t - half, 0), hi = min(t + half, n);
    float s[8];
#pragma unroll
    for (int e = 0; e < 8; ++e) s[e] = 0.f;
    for (int r = lo; r < hi; ++r) { const u32x4 w = *(const u32x4*)(PL + (size_t)(base + r) * NIN + B0 + lane * 8);
        s[0] += bflo(w.x); s[1] += bfhi(w.x); s[2] += bflo(w.y); s[3] += bfhi(w.y); s[4] += bflo(w.z); s[5] += bfhi(w.z); s[6] += bflo(w.w); s[7] += bfhi(w.w); }
    const float inv = 1.f / (float)(hi - lo);
    const u32x4 w = *(const u32x4*)(PL + (size_t)row * NIN + B0 + lane * 8);
    u32x4 o; o.x = pk2(s[0] * inv - bflo(w.x), s[1] * inv - bfhi(w.x)); o.y = pk2(s[2] * inv - bflo(w.y), s[3] * inv - bfhi(w.y));
    o.z = pk2(s[4] * inv - bflo(w.z), s[5] * inv - bfhi(w.z)); o.w = pk2(s[6] * inv - bflo(w.w), s[7] * inv - bfhi(w.w));
    *(u32x4*)(DLT + (size_t)row * 512 + lane * 8) = o;
}
constexpr int CP = 136;
__device__ __forceinline__ void cmix_unit(const Args& a, int layer, int unit, unsigned char* lds) {
    const int tid = otid(), wave = tid >> 6, lane = tid & 63, chunk = unit >> 2, g = unit & 3;
    const bf16_t* PL = (const bf16_t*)(a.ws + WS_PL); bf16_t* OUT = (bf16_t*)(a.ws + WS_OUTS) + (size_t)2 * MR * 512;
    bf16_t* vT = (bf16_t*)lds;
    bf16_t* wsL = (bf16_t*)(lds + 128 * CP * 2);
    float* st = (float*)(lds + 2 * 128 * CP * 2);
    const int t0 = chunk * 128;
    for (int i = 0; i < 16; ++i) {
        const int q = wave * 16 + i;
        const u32x4 w = *(const u32x4*)(PL + (size_t)(t0 + q) * NIN + C_V0 + lane * 8);
        float x[8] = {bflo(w.x), bfhi(w.x), bflo(w.y), bfhi(w.y), bflo(w.z), bfhi(w.z), bflo(w.w), bfhi(w.w)};
        float s = 0.f;
#pragma unroll
        for (int e = 0; e < 8; ++e) s += x[e];
        const float mean = wave_sum(s) * (1.f / 512.f); float q2 = 0.f;
#pragma unroll
        for (int e = 0; e < 8; ++e) { const float d = x[e] - mean; q2 += d * d; }
        const float rstd = 1.0f / sqrtf(wave_sum(q2) * (1.f / 512.f) + EPS);
        if (lane == 0) { st[2 * q] = mean; st[2 * q + 1] = rstd; }
    }
    __syncthreads();
    {
        const int q = tid & 127, cb = tid >> 7; const float mean = st[2 * q], rstd = st[2 * q + 1];
        const float* lg = a.in[I_CNG] + layer * 512 + g * 128 + cb * 32; const float* lb = a.in[I_CNB] + layer * 512 + g * 128 + cb * 32;
        const bf16_t* vp = PL + (size_t)(t0 + q) * NIN + C_V0 + g * 128 + cb * 32;
#pragma unroll
        for (int j = 0; j < 4; ++j) { const u32x4 w = *(const u32x4*)(vp + j * 8);
            const float x[8] = {bflo(w.x), bfhi(w.x), bflo(w.y), bfhi(w.y), bflo(w.z), bfhi(w.z), bflo(w.w), bfhi(w.w)};
#pragma unroll
            for (int e = 0; e < 8; ++e) { const int c = j * 8 + e; vT[(cb * 32 + c) * CP + q] = (bf16_t)f2bf((x[e] - mean) * rstd * lg[c] + lb[c]); } }
        const int p = tid >> 2, qb = (tid & 3) * 32; const float* wp = a.in[I_CWS] + ((size_t)(layer * 4 + g) * 128 + p) * 128 + qb;
#pragma unroll
        for (int j = 0; j < 8; ++j) { const f32x4 w = *(const f32x4*)(wp + j * 4); u32x2 o; o.x = pk2(w[0], w[1]); o.y = pk2(w[2], w[3]); *(u32x2*)(wsL + p * CP + qb + j * 4) = o; }
    }
    __syncthreads();
    {
        const int fr = lane & 15, fq = lane >> 4;
        f32x4 acc[8];
#pragma unroll
        for (int nb = 0; nb < 8; ++nb) acc[nb] = (f32x4){0.f, 0.f, 0.f, 0.f};
#pragma unroll
        for (int ks = 0; ks < 4; ++ks) {
            const bf16x8 wf = *(const bf16x8*)(wsL + (wave * 16 + fr) * CP + ks * 32 + fq * 8);
#pragma unroll
            for (int nb = 0; nb < 8; ++nb) { const bf16x8 vf = *(const bf16x8*)(vT + (nb * 16 + fr) * CP + ks * 32 + fq * 8);
                acc[nb] = __builtin_amdgcn_mfma_f32_16x16x32_bf16(vf, wf, acc[nb], 0, 0, 0); }
        }
        const int p = wave * 16 + fr; const float bs = a.in[I_CBS][(layer * 4 + g) * 128 + p];
        const bf16_t* up = PL + (size_t)(t0 + p) * NIN + C_U0 + g * 128; bf16_t* op = OUT + (size_t)(t0 + p) * 512 + g * 128;
#pragma unroll
        for (int nb = 0; nb < 8; ++nb) { const int c = nb * 16 + 4 * fq; const u32x2 uw = *(const u32x2*)(up + c);
            u32x2 o; o.x = pk2((acc[nb][0] + bs) * bflo(uw.x), (acc[nb][1] + bs) * bfhi(uw.x)); o.y = pk2((acc[nb][2] + bs) * bflo(uw.y), (acc[nb][3] + bs) * bfhi(uw.y));
            *(u32x2*)(op + c) = o; }
    }
    __syncthreads();
}

template <int MODE>
__device__ __forceinline__ void attn_simple_item(const bf16_t* PL, int qcol, int kcol, int vcol, bf16_t* O, int qrow, int h, int kvh, int kbeg, int kend, const float* rpb, int lane) {
    constexpr float C = 0.088388347648318440f * 1.4426950408889634f;
    const int part = lane & 3;
    float q[32], o[32];
    { const bf16_t* qp = PL + (size_t)qrow * NIN + qcol + h * HD + part * 32;
#pragma unroll
      for (int j = 0; j < 4; ++j) { const u32x4 w = *(const u32x4*)(qp + j * 8);
          q[j * 8 + 0] = bflo(w.x) * C; q[j * 8 + 1] = bfhi(w.x) * C; q[j * 8 + 2] = bflo(w.y) * C; q[j * 8 + 3] = bfhi(w.y) * C;
          q[j * 8 + 4] = bflo(w.z) * C; q[j * 8 + 5] = bfhi(w.z) * C; q[j * 8 + 6] = bflo(w.w) * C; q[j * 8 + 7] = bfhi(w.w) * C; } }
#pragma unroll
    for (int d = 0; d < 32; ++d) o[d] = 0.f;
    float mrun = -1e30f, l = 0.f;
    const int r = qrow >> 6, c = qrow & 63, r0 = min(max(r - 4, 0), 120), c0 = min(max(c - 8, 0), 48);
    const int nk = MODE == 0 ? (kend - kbeg) : 384;
    for (int idx = 0; idx < nk; ++idx) {
        int krow; float bias = 0.f;
        if (MODE == 0) krow = kbeg + idx;
        else if (idx < 128) { const int i = idx >> 4, j = idx & 15; krow = (r0 + i) * GW + c0 + j; bias = rpb[(h * 15 + (r0 + i - r + 7)) * 31 + (c0 + j - c + 15)] * 1.4426950408889634f; }
        else krow = SEQ + idx - 128;
        const bf16_t* kp = PL + (size_t)krow * NIN + kcol + kvh * HD + part * 32;
        float s = 0.f;
#pragma unroll
        for (int j = 0; j < 4; ++j) { const u32x4 w = *(const u32x4*)(kp + j * 8);
            s += q[j * 8 + 0] * bflo(w.x) + q[j * 8 + 1] * bfhi(w.x) + q[j * 8 + 2] * bflo(w.y) + q[j * 8 + 3] * bfhi(w.y)
               + q[j * 8 + 4] * bflo(w.z) + q[j * 8 + 5] * bfhi(w.z) + q[j * 8 + 6] * bflo(w.w) + q[j * 8 + 7] * bfhi(w.w); }
        s += __shfl_xor(s, 1); s += __shfl_xor(s, 2);
        s += bias;
        const float mn = fmaxf(mrun, s), alpha = exp2f(mrun - mn), p = exp2f(s - mn);
        l = l * alpha + p; mrun = mn;
        const bf16_t* vp = PL + (size_t)krow * NIN + vcol + kvh * HD + part * 32;
#pragma unroll
        for (int j = 0; j < 4; ++j) { const u32x4 w = *(const u32x4*)(vp + j * 8);
            o[j * 8 + 0] = o[j * 8 + 0] * alpha + p * bflo(w.x); o[j * 8 + 1] = o[j * 8 + 1] * alpha + p * bfhi(w.x);
            o[j * 8 + 2] = o[j * 8 + 2] * alpha + p * bflo(w.y); o[j * 8 + 3] = o[j * 8 + 3] * alpha + p * bfhi(w.y);
            o[j * 8 + 4] = o[j * 8 + 4] * alpha + p * bflo(w.z); o[j * 8 + 5] = o[j * 8 + 5] * alpha + p * bfhi(w.z);
            o[j * 8 + 6] = o[j * 8 + 6] * alpha + p * bflo(w.w); o[j * 8 + 7] = o[j * 8 + 7] * alpha + p * bfhi(w.w); }
    }
    const float il = 1.f / l;
    bf16_t* op = O + (size_t)qrow * 512 + h * HD + part * 32;
#pragma unroll
    for (int j = 0; j < 4; ++j) { u32x4 w; w.x = pk2(o[j * 8 + 0] * il, o[j * 8 + 1] * il); w.y = pk2(o[j * 8 + 2] * il, o[j * 8 + 3] * il);
        w.z = pk2(o[j * 8 + 4] * il, o[j * 8 + 5] * il); w.w = pk2(o[j * 8 + 6] * il, o[j * 8 + 7] * il); *(u32x4*)(op + j * 8) = w; }
}

__device__ __forceinline__ void phase_small(const Args& a, unsigned char* lds, int vcu, int G, int layer, bool last) {
    const int tid = otid(), wave = tid >> 6, lane = tid & 63;
    const int gw = vcu * NWAVE + wave, NGW = G * NWAVE;
    const int nrows = last ? SEQ : MR;
    for (int row = gw; row < MR; row += NGW) qk_prep_row(a, layer, row, lane);
    for (int row = gw; row < nrows; row += NGW) dlt_row(a, row, lane);
    const int nunits = (nrows / 128) * 4;
    for (int u = vcu; u < nunits; u += G) cmix_unit(a, layer, u, lds);
    const bf16_t* PL = (const bf16_t*)(a.ws + WS_PL); bf16_t* OD = (bf16_t*)(a.ws + WS_OUTS) + (size_t)3 * MR * 512;
    const float* rpb = a.in[I_RPB] + layer * 4 * 15 * 31;
    const int n_lat = (SEQ / 16) * 4, n_ctx = last ? 0 : (CTXL / 16) * 4;
    for (int it = gw; it < n_lat + n_ctx; it += NGW) {
        if (it < n_lat) { const int h = it & 3, qt = it >> 2; attn_simple_item<1>(PL, D_Q0, D_K0, D_V0, OD, qt * 16 + (lane >> 2), h, h, 0, 0, rpb, lane); }
        else { const int j = it - n_lat, h = j & 3, qt = j >> 2; attn_simple_item<0>(PL, D_Q0, D_K0, D_V0, OD, SEQ + qt * 16 + (lane >> 2), h, h, SEQ, MR, rpb, lane); }
    }
}
__device__ __forceinline__ void phase_attn_a(const Args& a, int vcu, int G, bool last) {
    const int tid = otid(), wave = tid >> 6, lane = tid & 63;
    const int gw = vcu * NWAVE + wave, NGW = G * NWAVE;
    const bf16_t* PL = (const bf16_t*)(a.ws + WS_PL); bf16_t* OA = (bf16_t*)(a.ws + WS_OUTS);
    const int n_lat = (SEQ / 16) * 4, n_ctx = last ? 0 : (CTXL / 16) * 4;
    for (int it = gw; it < n_lat + n_ctx; it += NGW) {
        if (it < n_lat) { const int h = it & 3, qt = it >> 2; attn_simple_item<0>(PL, A_Q0, A_K0, A_V0, OA, qt * 16 + (lane >> 2), h, h >> 1, 0, MR, nullptr, lane); }
        else { const int j = it - n_lat, h = j & 3, qt = j >> 2; attn_simple_item<0>(PL, A_Q0, A_K0, A_V0, OA, SEQ + qt * 16 + (lane >> 2), h, h >> 1, SEQ, MR, nullptr, lane); }
    }
}

constexpr int NPHASE = 22;
__global__ void __launch_bounds__(NTHR, 2) fwd(Args a) {
    extern __shared__ __attribute__((aligned(16))) unsigned char lds[];
    const int G = gridDim.x, bx = blockIdx.x;
    const int vcu = (G % 8 == 0) ? (bx % 8) * (G / 8) + bx / 8 : bx;
    unsigned char* ws = a.ws;
    const float* MOD = (const float*)(ws + WS_CTL + CTL_MOD);
#if MK_COOP
    cg::grid_group grid = cg::this_grid();
#define SEAM(p) do { if (lo <= (p) && (p) + 1 < hi) grid.sync(); } while (0)
#else
#define SEAM(p) do { } while (0)
#endif
    const int lo = a.ph_lo, hi = a.ph_hi;
#ifndef PHMASK
#define PHMASK 0xffffffu
#endif
#define IN(p) (lo <= (p) && (p) < hi && ((PHMASK >> ((p) < 2 ? (p) : 2 + ((p) - 2) % 10)) & 1u))
    if (IN(0)) { phase_prologue(a, lds, vcu, G); } SEAM(0);
    if (IN(1)) { phase_rows<0>(a, vcu, G, MR, nullptr, nullptr, 0, a.in[I_NPRE_MIX], MOD, 0); } SEAM(1);
#pragma nounroll
    for (int l = 0; l < 2; ++l) {
        const bool last = (l == 1);
        const int pb = 2 + l * 10;
        unsigned char* wb = ws + WS_W + (size_t)l * WPL;
        const float* modl = MOD + (size_t)l * 2 * NIN;
        const int Mrows = last ? SEQ : MR;
        if (IN(pb + 0)) {
            Gemm g{(const bf16_t*)(ws + WS_XN), (const bf16_t*)(wb + W_IN), DM, DM, DM}; StaticOrder S; S.init(MR, NIN, G, bx);
            EpiIn E{(bf16_t*)(ws + WS_PL)}; gemm_phase(g, S, E);
        } SEAM(pb + 0);
        if (IN(pb + 1)) { phase_small(a, lds, vcu, G, l, last); } SEAM(pb + 1);
        if (IN(pb + 2)) { phase_attn_a(a, vcu, G, last); } SEAM(pb + 2);
        if (IN(pb + 3)) {
            Gemm g{(const bf16_t*)(ws + WS_DLT), (const bf16_t*)(wb + W_B), 512, 512, 512}; StaticOrder S; S.init(Mrows, 512, G, bx);
            EpiScale E{(bf16_t*)(ws + WS_OUTS) + (size_t)1 * MR * 512, 512, a.in[I_BSCALE] + l * 512}; gemm_phase(g, S, E);
        } SEAM(pb + 3);
        if (IN(pb + 4)) {
            Gemm g{(const bf16_t*)(ws + WS_OUTS), (const bf16_t*)(wb + W_BR), 512, 512, 512}; MergeOrder S; S.base.init(Mrows, DM, G, bx);
            EpiMerge E{(const bf16_t*)(ws + WS_PL), (float*)(ws + WS_MRG), (bf16_t*)(ws + WS_MRGB)}; gemm_phase(g, S, E);
        } SEAM(pb + 4);
        if (IN(pb + 5)) {
            Gemm g{(const bf16_t*)(ws + WS_MRGB), (const bf16_t*)(wb + W_O), DM, DM, DM}; StaticOrder S; S.init(Mrows, DM, G, bx);
            EpiF32 E{(float*)(ws + WS_MRG), DM}; gemm_phase(g, S, E);
        } SEAM(pb + 5);
        if (IN(pb + 6)) { phase_rows<1>(a, vcu, G, Mrows, a.in[I_NPOST_MIX] + l * DM, modl, 2, a.in[I_NPRE_FFN] + l * DM, modl, 3); } SEAM(pb + 6);
        if (IN(pb + 7)) {
            Gemm g{(const bf16_t*)(ws + WS_XN), (const bf16_t*)(wb + W_GU), DM, DM, DM}; StaticOrder S; S.init(Mrows, 2 * FF, G, bx);
            EpiSwiglu E{(bf16_t*)(ws + WS_H)}; gemm_phase(g, S, E);
        } SEAM(pb + 7);
        if (IN(pb + 8)) {
            Gemm g{(const bf16_t*)(ws + WS_H), (const bf16_t*)(wb + W_D), FF, FF, FF}; StaticOrder S; S.init(Mrows, DM, G, bx);
            EpiF32 E{(float*)(ws + WS_MRG), DM}; gemm_phase(g, S, E);
        } SEAM(pb + 8);
        if (IN(pb + 9)) {
            if (!last) phase_rows<1>(a, vcu, G, MR, a.in[I_NPOST_FFN] + l * DM, modl, 5, a.in[I_NPRE_MIX] + (l + 1) * DM, MOD + (size_t)(l + 1) * 2 * NIN, 0);
            else phase_rows<2>(a, vcu, G, SEQ, a.in[I_NPOST_FFN] + l * DM, modl, 5, nullptr, nullptr, 0);
        }
        if (!last) SEAM(pb + 9);
    }
#undef IN
#undef SEAM
}

extern "C" void kernel_launch(void* const* d_in, const int* in_sizes, int n_in, void* d_out, int out_size, void* d_ws, size_t ws_size, hipStream_t stream) {
    static int grid = 0;
    if (grid == 0) {
        if (n_in != N_IN || out_size != SEQ * DM || ws_size < WS_END) { fprintf(stderr, "kernel_launch: unexpected shapes (n_in %d out %d ws %zu)\n", n_in, out_size, ws_size); grid = -1; return; }
        if (hipFuncSetAttribute((const void*)fwd, hipFuncAttributeMaxDynamicSharedMemorySize, LDS_BYTES) != hipSuccess) { fprintf(stderr, "kernel_launch: hipFuncSetAttribute failed\n"); grid = -1; return; }
        int dev = 0, cus = 0, per_cu = 0;
        hipGetDevice(&dev); hipDeviceGetAttribute(&cus, hipDeviceAttributeMultiprocessorCount, dev);
        hipOccupancyMaxActiveBlocksPerMultiprocessor(&per_cu, (const void*)fwd, NTHR, LDS_BYTES);
        if (per_cu < 1) { fprintf(stderr, "kernel_launch: occupancy query says %d blocks per CU\n", per_cu); per_cu = 1; }
        (void)hipGetLastError();
        grid = cus * per_cu;
        fprintf(stderr, "kernel_launch: grid %d (cus %d x %d)\n", grid, cus, per_cu);
    }
    if (grid < 0) return;
    hipMemsetAsync((char*)d_ws + WS_CTL, 0, CTL_BYTES, stream);
    Args a{};
    for (int i = 0; i < N_IN; ++i) a.in[i] = (const float*)d_in[i];
    a.out = (float*)d_out; a.ws = (unsigned char*)d_ws;
#if MK_COOP
    a.ph_lo = 0; a.ph_hi = NPHASE;
    void* params[] = {&a};
    hipError_t e = hipLaunchCooperativeKernel((const void*)fwd, dim3(grid), dim3(NTHR), params, LDS_BYTES, stream);
    if (e != hipSuccess) fprintf(stderr, "kernel_launch: cooperative launch failed: %s (grid %d)\n", hipGetErrorString(e), grid);
#else
    for (int p = 0; p < NPHASE; ++p) {
        a.ph_lo = p; a.ph_hi = p + 1;
        hipLaunchKernelGGL(fwd, dim3(grid), dim3(NTHR), LDS_BYTES, stream, a);
    }
#endif
}
```

```cpp
#include <hip/hip_runtime.h>
#include <hip/hip_cooperative_groups.h>
#include <cstdio>
#include <cstdint>
namespace cg = cooperative_groups;

#ifndef MK_COOP
#define MK_COOP 1
#endif

typedef unsigned short bf16_t;
typedef short bf16x8 __attribute__((ext_vector_type(8)));
typedef float f32x4 __attribute__((ext_vector_type(4)));
typedef unsigned u32x4 __attribute__((ext_vector_type(4)));
typedef unsigned u32x2 __attribute__((ext_vector_type(2)));

constexpr int DM = 2048, SEQ = 8192, CTXL = 256, MR = SEQ + CTXL, NIN = 12288, FF = 5632, HD = 128, GW = 64;
constexpr int A_Q0 = 0, A_K0 = 512, A_V0 = 768, B0 = 1024, C_U0 = 1536, C_V0 = 2048, D_Q0 = 2560, D_K0 = 3072, D_V0 = 3584, G0 = 4096;
constexpr float EPS = 1e-6f;
constexpr int NTHR = 512, NWAVE = 8;
constexpr int LDS_BYTES = 147456;

enum { I_X = 0, I_C, I_CTX, I_CCTX, I_ADAW, I_ADAB, I_NPRE_MIX, I_NPOST_MIX, I_NPRE_FFN, I_NPOST_FFN, I_WIN, I_AQN, I_AKN, I_BW, I_BSCALE,
       I_CNG, I_CNB, I_CWS, I_CBS, I_RPB, I_WBR, I_WO, I_WG, I_WU, I_WD, N_IN };

constexpr size_t MiB = 1u << 20;
constexpr size_t WS_CTL = 0, CTL_BYTES = 1 * MiB;
constexpr size_t CTL_MOD = 256 * 1024;
constexpr size_t WS_W = 2 * MiB, WPL = 131 * MiB;
constexpr size_t W_IN = 0, W_BR = 48 * MiB, W_O = 56 * MiB, W_GU = 64 * MiB, W_D = 108 * MiB, W_B = 130 * MiB;
constexpr size_t WS_X = 264 * MiB;
constexpr size_t WS_XN = 330 * MiB;
constexpr size_t WS_PL = 363 * MiB;
constexpr size_t WS_H = WS_PL;
constexpr size_t WS_OUTS = 561 * MiB;
constexpr size_t WS_DLT = 594 * MiB;
constexpr size_t WS_MRG = 603 * MiB;
constexpr size_t WS_MRGB = 669 * MiB;
constexpr size_t WS_END = 702 * MiB;

struct Args { const float* in[N_IN]; float* out; unsigned char* ws; int ph_lo, ph_hi; };

__device__ __forceinline__ unsigned f2bf(float f) { unsigned u = __builtin_bit_cast(unsigned, f); return (u + 0x7fffu + ((u >> 16) & 1u)) >> 16; }
__device__ __forceinline__ unsigned pk2(float lo, float hi) { return f2bf(lo) | (f2bf(hi) << 16); }
__device__ __forceinline__ float bflo(unsigned w) { return __builtin_bit_cast(float, w << 16); }
__device__ __forceinline__ float bfhi(unsigned w) { return __builtin_bit_cast(float, w & 0xffff0000u); }
__device__ __forceinline__ float bf2f(bf16_t h) { return __builtin_bit_cast(float, (unsigned)h << 16); }
__device__ __forceinline__ float wave_sum(float v) {
#pragma unroll
    for (int o = 32; o >= 1; o >>= 1) v += __shfl_xor(v, o);
    return v;
}
__device__ __forceinline__ int otid() { int t = threadIdx.x; asm volatile("" : "+v"(t)); return t; }
__device__ __forceinline__ float sigmoidf_(float x) { return 1.f / (1.f + __expf(-x)); }
__device__ __forceinline__ float siluf_(float x) { return x / (1.f + __expf(-x)); }

struct Unit { int pm, pn; };
struct Gemm { const bf16_t* A; const bf16_t* Bt; int lda, ldb, K; };
constexpr int NXCD = 8, WGM = 8;
struct StaticOrder {
    int nM, nN, nwg, G, c;
    __device__ void init(int M, int N, int G_, int c_) { nM = M / 256; nN = N / 256; nwg = nM * nN; G = G_; c = c_; }
    __device__ bool next(int i, Unit& u) const {
        const long L = (long)i * G + c; if (L >= nwg) return false;
        int wgid = (int)L; { const int q = nwg / NXCD, r = nwg % NXCD, xcd = wgid % NXCD, off = wgid / NXCD; wgid = (xcd < r ? xcd * (q + 1) : r * (q + 1) + (xcd - r) * q) + off; }
        const int nig = WGM * nN, gid = wgid / nig, fm = gid * WGM, gsz = (nM - fm) < WGM ? (nM - fm) : WGM;
        u.pm = fm + ((wgid % nig) % gsz); u.pn = (wgid % nig) / gsz; return true;
    }
    __device__ __forceinline__ void a_ready(const Unit&) const {}
    __device__ __forceinline__ void done(const Unit&) const {}
};
struct MergeOrder {
    StaticOrder base;
    __device__ bool next(int i, Unit& u) const { Unit t; if (!base.next(i >> 2, t)) return false; const int pass = i & 3; u.pm = pass * 33 + t.pm; u.pn = pass * 8 + t.pn; return true; }
    __device__ __forceinline__ void a_ready(const Unit&) const {}
    __device__ __forceinline__ void done(const Unit&) const {}
};

struct EpiIn {
    static constexpr bool PERM = true, AFTER_DRAIN = false;
    bf16_t* PL;
    __device__ __forceinline__ void operator()(const f32x4 (&acc)[2][2][4][2], const Unit& u, int wr, int wc, int fr, int fq) const {
        const bool gate = u.pn >= (G0 / 256);
#pragma unroll
        for (int ai = 0; ai < 2; ++ai)
#pragma unroll
            for (int m = 0; m < 4; ++m) {
                const int row = u.pm * 256 + ai * 128 + wr * 64 + m * 16 + fr;
#pragma unroll
                for (int bj = 0; bj < 2; ++bj) {
                    const int col = u.pn * 256 + bj * 128 + wc * 32 + 8 * fq;
                    f32x4 v0 = acc[ai][bj][m][0], v1 = acc[ai][bj][m][1];
                    if (gate) {
#pragma unroll
                        for (int e = 0; e < 4; ++e) { v0[e] = sigmoidf_(v0[e]); v1[e] = sigmoidf_(v1[e]); }
                    }
                    u32x4 w; w.x = pk2(v0[0], v0[1]); w.y = pk2(v0[2], v0[3]); w.z = pk2(v1[0], v1[1]); w.w = pk2(v1[2], v1[3]);
                    *(u32x4*)(PL + (size_t)row * NIN + col) = w;
                }
            }
    }
};
struct EpiScale {
    static constexpr bool PERM = true, AFTER_DRAIN = false;
    bf16_t* O; int ldc; const float* scale;
    __device__ __forceinline__ void operator()(const f32x4 (&acc)[2][2][4][2], const Unit& u, int wr, int wc, int fr, int fq) const {
#pragma unroll
        for (int bj = 0; bj < 2; ++bj) {
            const int col = u.pn * 256 + bj * 128 + wc * 32 + 8 * fq;
            const f32x4 s0 = *(const f32x4*)(scale + col), s1 = *(const f32x4*)(scale + col + 4);
#pragma unroll
            for (int ai = 0; ai < 2; ++ai)
#pragma unroll
                for (int m = 0; m < 4; ++m) {
                    const int row = u.pm * 256 + ai * 128 + wr * 64 + m * 16 + fr;
                    const f32x4 v0 = acc[ai][bj][m][0] * s0, v1 = acc[ai][bj][m][1] * s1;
                    u32x4 w; w.x = pk2(v0[0], v0[1]); w.y = pk2(v0[2], v0[3]); w.z = pk2(v1[0], v1[1]); w.w = pk2(v1[2], v1[3]);
                    *(u32x4*)(O + (size_t)row * ldc + col) = w;
                }
        }
    }
};
struct EpiMerge {
    static constexpr bool PERM = true, AFTER_DRAIN = false;
    const bf16_t* PL; float* MRG; bf16_t* MRGB;
    __device__ __forceinline__ void operator()(const f32x4 (&acc)[2][2][4][2], const Unit& u, int wr, int wc, int fr, int fq) const {
        const int pass = u.pm / 33, pm = u.pm - pass * 33, pn = u.pn & 7;
#pragma unroll
        for (int ai = 0; ai < 2; ++ai)
#pragma unroll
            for (int m = 0; m < 4; ++m) {
                const int row = pm * 256 + ai * 128 + wr * 64 + m * 16 + fr;
#pragma unroll
                for (int bj = 0; bj < 2; ++bj) {
                    const int col = pn * 256 + bj * 128 + wc * 32 + 8 * fq;
                    const u32x4 gw = *(const u32x4*)(PL + (size_t)row * NIN + G0 + pass * DM + col);
                    f32x4 v0 = acc[ai][bj][m][0], v1 = acc[ai][bj][m][1];
                    v0[0] *= bflo(gw.x); v0[1] *= bfhi(gw.x); v0[2] *= bflo(gw.y); v0[3] *= bfhi(gw.y);
                    v1[0] *= bflo(gw.z); v1[1] *= bfhi(gw.z); v1[2] *= bflo(gw.w); v1[3] *= bfhi(gw.w);
                    float* mp = MRG + (size_t)row * DM + col;
                    if (pass > 0) { v0 += *(const f32x4*)mp; v1 += *(const f32x4*)(mp + 4); }
                    if (pass < 3) { *(f32x4*)mp = v0; *(f32x4*)(mp + 4) = v1; }
                    else { u32x4 w; w.x = pk2(v0[0], v0[1]); w.y = pk2(v0[2], v0[3]); w.z = pk2(v1[0], v1[1]); w.w = pk2(v1[2], v1[3]);
                           *(u32x4*)(MRGB + (size_t)row * DM + col) = w; }
                }
            }
    }
};
struct EpiF32 {
    static constexpr bool PERM = true, AFTER_DRAIN = false;
    float* Y; int ldc;
    __device__ __forceinline__ void operator()(const f32x4 (&acc)[2][2][4][2], const Unit& u, int wr, int wc, int fr, int fq) const {
#pragma unroll
        for (int ai = 0; ai < 2; ++ai)
#pragma unroll
            for (int m = 0; m < 4; ++m) {
                const int row = u.pm * 256 + ai * 128 + wr * 64 + m * 16 + fr;
#pragma unroll
                for (int bj = 0; bj < 2; ++bj) {
                    const int col = u.pn * 256 + bj * 128 + wc * 32 + 8 * fq;
                    float* yp = Y + (size_t)row * ldc + col;
                    *(f32x4*)yp = acc[ai][bj][m][0]; *(f32x4*)(yp + 4) = acc[ai][bj][m][1];
                }
            }
    }
};
struct EpiSwiglu {
    static constexpr bool PERM = true, AFTER_DRAIN = false;
    bf16_t* H;
    __device__ __forceinline__ void operator()(const f32x4 (&acc)[2][2][4][2], const Unit& u, int wr, int wc, int fr, int fq) const {
#pragma unroll
        for (int ai = 0; ai < 2; ++ai)
#pragma unroll
            for (int m = 0; m < 4; ++m) {
                const int row = u.pm * 256 + ai * 128 + wr * 64 + m * 16 + fr;
                const int col = u.pn * 128 + wc * 32 + 8 * fq;
                f32x4 h0, h1;
#pragma unroll
                for (int e = 0; e < 4; ++e) { h0[e] = siluf_(acc[ai][0][m][0][e]) * acc[ai][1][m][0][e]; h1[e] = siluf_(acc[ai][0][m][1][e]) * acc[ai][1][m][1][e]; }
                u32x4 w; w.x = pk2(h0[0], h0[1]); w.y = pk2(h0[2], h0[3]); w.z = pk2(h1[0], h1[1]); w.w = pk2(h1[2], h1[3]);
                *(u32x4*)(H + (size_t)row * FF + col) = w;
            }
    }
};

#define PG8_LAS __attribute__((address_space(3)))
constexpr int BM = 256, BK = 64, HALF = 128, HTB = HALF * BK * 2, STAGE_BYTES = 8 * HTB;
__device__ __forceinline__ int lds_byte(int r, int c) { const int st = (r >> 4) * 2 + (c >> 5), rr = r & 15, cc = c & 31, ob = rr * 64 + cc * 2; return st * 1024 + (ob ^ (((ob >> 9) & 1) << 5)); }
__device__ __forceinline__ void stage_rc(int b, int& R, int& C) { const int st = b / 1024, sb = b % 1024, swz = sb ^ (((sb >> 9) & 1) << 5); R = (st >> 1) * 16 + swz / 64; C = (st & 1) * 32 + (swz % 64) / 2; }
__device__ __forceinline__ int perm32(int rho) { const int n = rho >> 4, i = rho & 15; return 8 * (i >> 2) + 4 * n + (i & 3); }
template <class Epi, class Sched, bool ALIGN_EPI = true, bool SP2 = true>
__device__ __forceinline__ void gemm_phase(PG8_LAS unsigned char* lds, const Gemm g, const Sched& S, const Epi& E) {
    const int tid = otid(), wid = __builtin_amdgcn_readfirstlane(tid >> 6), lane = tid & 63, wr = wid >> 2, wc = wid & 3, fr = lane & 15, fq = lane >> 4;
    const int K = g.K, nt = K / BK;
    unsigned voffA[2], voffB[2];
#pragma unroll
    for (int i = 0; i < 2; ++i) { int R, C; stage_rc(tid * 16 + i * 8192, R, C); const int Rb = Epi::PERM ? ((R & ~31) + perm32(R & 31)) : R;
        voffA[i] = (unsigned)(R * g.lda + C) * 2u; voffB[i] = (unsigned)(Rb * g.ldb + C) * 2u; }
    const size_t kstep = (size_t)(BK * 2);
    const size_t hstepA = (size_t)HALF * g.lda * 2, hstepB = (size_t)HALF * g.ldb * 2;
    const size_t tstepA = 2 * hstepA, tstepB = 2 * hstepB;
    const unsigned ldsw = (unsigned)wid * 1024u;
    const int aoff = lds_byte(wr * 64 + fr, fq * 8), boff = lds_byte(wc * 32 + fr, fq * 8);
#define PG8_SA(b, h) (((b) * 2 + (h)) * HTB)
#define PG8_SB(b, h) ((4 + (b) * 2 + (h)) * HTB)
#define PG8_STAGE(bufoff, gbase, voff) do { _Pragma("unroll") for (int _i = 0; _i < 2; ++_i) \
        __builtin_amdgcn_global_load_lds((const unsigned*)((const char*)(gbase) + (voff)[_i]), (PG8_LAS unsigned*)(lds + (bufoff) + ldsw + _i * 8192), 16, 0, 0); } while (0)
#define PG8_LDA(dst, b, h) do { _Pragma("unroll") for (int m = 0; m < 4; ++m) _Pragma("unroll") for (int k = 0; k < 2; ++k) dst[m][k] = *(const PG8_LAS bf16x8*)(lds + PG8_SA(b, h) + aoff + m * 2048 + k * 1024); } while (0)
#define PG8_LDB(dst, b, h) do { _Pragma("unroll") for (int n = 0; n < 2; ++n) _Pragma("unroll") for (int k = 0; k < 2; ++k) dst[n][k] = *(const PG8_LAS bf16x8*)(lds + PG8_SB(b, h) + boff + n * 2048 + k * 1024); } while (0)
#define PG8_MMA(ai, bj, At, Bt) do { __builtin_amdgcn_s_setprio(1); _Pragma("unroll") for (int m = 0; m < 4; ++m) _Pragma("unroll") for (int n = 0; n < 2; ++n) _Pragma("unroll") for (int k = 0; k < 2; ++k) \
        acc[ai][bj][m][n] = __builtin_amdgcn_mfma_f32_16x16x32_bf16(Bt[n][k], At[m][k], acc[ai][bj][m][n], 0, 0, 0); __builtin_amdgcn_s_setprio(0); } while (0)
#define PG8_WAIT_V(n) asm volatile("s_waitcnt vmcnt(" #n ")" ::: "memory")
#define PG8_WAIT_L(n) asm volatile("s_waitcnt lgkmcnt(" #n ")" ::: "memory")
#define PG8_BAR __builtin_amdgcn_s_barrier()
#define PG8_SCHED __builtin_amdgcn_sched_barrier(0)
    Unit cur, nxt; int ui = 0;
    if (!S.next(0, cur)) return;
    f32x4 acc[2][2][4][2];
#pragma unroll
    for (int a = 0; a < 2; ++a)
#pragma unroll
        for (int b = 0; b < 2; ++b)
#pragma unroll
            for (int m = 0; m < 4; ++m)
#pragma unroll
                for (int n = 0; n < 2; ++n) acc[a][b][m][n] = (f32x4){0.f, 0.f, 0.f, 0.f};
    bf16x8 At[4][2], B0[2][2], B1[2][2];
    const char* cA = (const char*)g.A + (size_t)cur.pm * tstepA; const char* cB = (const char*)g.Bt + (size_t)cur.pn * tstepB;
    S.a_ready(cur);
    if constexpr (SP2) {
        PG8_STAGE(PG8_SB(0, 0), cB, voffB); PG8_STAGE(PG8_SB(0, 1), cB + hstepB, voffB); PG8_STAGE(PG8_SA(0, 0), cA, voffA); PG8_STAGE(PG8_SA(0, 1), cA + hstepA, voffA);
        if (wr == 1) PG8_BAR;
        PG8_WAIT_V(2); PG8_BAR;
        PG8_STAGE(PG8_SB(1, 0), cB + kstep, voffB); PG8_STAGE(PG8_SA(1, 0), cA + kstep, voffA); PG8_STAGE(PG8_SB(1, 1), cB + hstepB + kstep, voffB);
        PG8_WAIT_V(6); PG8_BAR;
    } else {
        PG8_STAGE(PG8_SB(0, 0), cB, voffB); PG8_STAGE(PG8_SA(0, 0), cA, voffA); PG8_STAGE(PG8_SB(0, 1), cB + hstepB, voffB); PG8_STAGE(PG8_SA(0, 1), cA + hstepA, voffA);
        if (wr == 1) PG8_BAR;
        PG8_WAIT_V(4); PG8_BAR;
        PG8_STAGE(PG8_SB(1, 0), cB + kstep, voffB); PG8_STAGE(PG8_SA(1, 0), cA + kstep, voffA); PG8_STAGE(PG8_SB(1, 1), cB + hstepB + kstep, voffB);
        PG8_WAIT_V(6); PG8_BAR;
    }
    for (;;) {
        const bool has_next = S.next(ui + 1, nxt);
        const char* nA = has_next ? (const char*)g.A + (size_t)nxt.pm * tstepA : cA; const char* nB = has_next ? (const char*)g.Bt + (size_t)nxt.pn * tstepB : cB;
        for (int t = 0; t < nt; t += 2) {
            const bool last = (t == nt - 2);
            const char* a1 = cA + (size_t)(t + 1) * kstep;
            const char* a2 = last ? nA : cA + (size_t)(t + 2) * kstep; const char* b2 = last ? nB : cB + (size_t)(t + 2) * kstep;
            const char* a3 = a2 + kstep; const char* b3 = b2 + kstep;
            if (last && has_next) S.a_ready(nxt);
            if constexpr (SP2) {
            PG8_LDB(B0, 0, 0); PG8_LDB(B1, 0, 1); PG8_SCHED; PG8_LDA(At, 0, 0); PG8_STAGE(PG8_SA(1, 1), a1 + hstepA, voffA);
            PG8_WAIT_V(8); PG8_WAIT_L(0); PG8_BAR; PG8_MMA(0, 0, At, B0); PG8_MMA(0, 1, At, B1); PG8_BAR; PG8_SCHED;
            PG8_LDA(At, 0, 1); PG8_STAGE(PG8_SB(0, 0), b2, voffB); PG8_STAGE(PG8_SB(0, 1), b2 + hstepB, voffB); PG8_STAGE(PG8_SA(0, 0), a2, voffA);
            PG8_WAIT_V(8); PG8_WAIT_L(0); PG8_BAR; PG8_MMA(1, 0, At, B0); PG8_MMA(1, 1, At, B1); PG8_BAR; PG8_SCHED;
            PG8_LDB(B0, 1, 0); PG8_LDB(B1, 1, 1); PG8_SCHED; PG8_LDA(At, 1, 0); PG8_STAGE(PG8_SA(0, 1), a2 + hstepA, voffA);
            PG8_WAIT_V(8); PG8_WAIT_L(0); PG8_BAR; PG8_MMA(0, 0, At, B0); PG8_MMA(0, 1, At, B1); PG8_BAR; PG8_SCHED;
            PG8_LDA(At, 1, 1); PG8_STAGE(PG8_SB(1, 0), b3, voffB); PG8_STAGE(PG8_SB(1, 1), b3 + hstepB, voffB); PG8_STAGE(PG8_SA(1, 0), a3, voffA);
            PG8_WAIT_V(8); PG8_WAIT_L(0); PG8_BAR; PG8_MMA(1, 0, At, B0); PG8_MMA(1, 1, At, B1); PG8_BAR; PG8_SCHED;
            } else {
            PG8_LDB(B0, 0, 0); PG8_SCHED; PG8_LDA(At, 0, 0); PG8_STAGE(PG8_SA(1, 1), a1 + hstepA, voffA);
            PG8_WAIT_L(8); PG8_BAR; PG8_WAIT_L(0); PG8_MMA(0, 0, At, B0); PG8_BAR; PG8_SCHED;
            PG8_LDB(B1, 0, 1); PG8_STAGE(PG8_SB(0, 0), b2, voffB);
            PG8_BAR; PG8_WAIT_L(0); PG8_MMA(0, 1, At, B1); PG8_BAR;
            PG8_LDA(At, 0, 1); PG8_STAGE(PG8_SA(0, 0), a2, voffA);
            PG8_BAR; PG8_WAIT_L(0); PG8_MMA(1, 0, At, B0); PG8_BAR; PG8_SCHED;
            PG8_STAGE(PG8_SB(0, 1), b2 + hstepB, voffB);
            PG8_WAIT_V(6); PG8_BAR; PG8_MMA(1, 1, At, B1); PG8_BAR;
            PG8_LDB(B0, 1, 0); PG8_SCHED; PG8_LDA(At, 1, 0); PG8_STAGE(PG8_SA(0, 1), a2 + hstepA, voffA);
            PG8_WAIT_L(8); PG8_BAR; PG8_WAIT_L(0); PG8_MMA(0, 0, At, B0); PG8_BAR; PG8_SCHED;
            PG8_LDB(B1, 1, 1); PG8_STAGE(PG8_SB(1, 0), b3, voffB);
            PG8_BAR; PG8_WAIT_L(0); PG8_MMA(0, 1, At, B1); PG8_BAR;
            PG8_LDA(At, 1, 1); PG8_STAGE(PG8_SA(1, 0), a3, voffA);
            PG8_BAR; PG8_WAIT_L(0); PG8_MMA(1, 0, At, B0); PG8_BAR; PG8_SCHED;
            PG8_STAGE(PG8_SB(1, 1), b3 + hstepB, voffB);
            PG8_WAIT_V(6); PG8_BAR; PG8_MMA(1, 1, At, B1); PG8_BAR;
            }
        }
        if constexpr (ALIGN_EPI) { if (wr == 0) PG8_BAR; }
        if constexpr (!Epi::AFTER_DRAIN) { E(acc, cur, wr, wc, fr, fq); S.done(cur); }
        if (!has_next) break;
#pragma unroll
        for (int a = 0; a < 2; ++a)
#pragma unroll
            for (int b = 0; b < 2; ++b)
#pragma unroll
                for (int m = 0; m < 4; ++m)
#pragma unroll
                    for (int n = 0; n < 2; ++n) acc[a][b][m][n] = (f32x4){0.f, 0.f, 0.f, 0.f};
        cur = nxt; cA = nA; cB = nB; ++ui;
        if constexpr (ALIGN_EPI) { if (wr == 1) PG8_BAR; }
    }
    PG8_WAIT_V(0);
    if constexpr (!ALIGN_EPI) { if (wr == 0) PG8_BAR; }
    PG8_BAR;
    if constexpr (Epi::AFTER_DRAIN) { E.fused(acc, cur, wr, wc, fr, fq, lds, wid, lane); S.done(cur); }
#undef PG8_SA
#undef PG8_SB
#undef PG8_STAGE
#undef PG8_LDA
#undef PG8_LDB
#undef PG8_MMA
#undef PG8_WAIT_V
#undef PG8_WAIT_L
#undef PG8_BAR
#undef PG8_SCHED
}

__device__ __forceinline__ void tr_item(const float* src, int ldn, int k0, int n0, bf16_t* dst, int dld, int drow0, int dk0, float* scr, int lane) {
    const float* sp = src + (size_t)k0 * ldn + n0 + lane;
#pragma unroll 16
    for (int i = 0; i < 64; ++i) scr[i * 65 + lane] = sp[(size_t)i * ldn];
    __builtin_amdgcn_s_waitcnt(0); asm volatile("" ::: "memory");
    const int c = lane & 7;
#pragma unroll
    for (int j = 0; j < 8; ++j) {
        const int n = (lane >> 3) + 8 * j; const float* s = scr + (8 * c) * 65 + n;
        u32x4 o; o.x = pk2(s[0], s[65]); o.y = pk2(s[2 * 65], s[3 * 65]); o.z = pk2(s[4 * 65], s[5 * 65]); o.w = pk2(s[6 * 65], s[7 * 65]);
        *(u32x4*)(dst + (size_t)(drow0 + n) * dld + dk0 + 8 * c) = o;
    }
    __builtin_amdgcn_s_waitcnt(0); asm volatile("" ::: "memory");
}

__device__ __forceinline__ void phase_prologue(const Args& a, unsigned char* lds, int vcu, int G) {
    const int tid = otid(), wave = tid >> 6, lane = tid & 63;
    const int gw = vcu * NWAVE + wave, NGW = G * NWAVE;
    float* scr = (float*)(lds + wave * 16640);
    constexpr int I_IN = 32 * 192, I_BR = 4 * 8 * 32, I_O = 32 * 32, I_G = 32 * 88, I_D = 88 * 32, I_B = 16;
    constexpr int PLI = I_IN + I_BR + I_O + 2 * I_G + I_D + I_B;
    for (int it = gw; it < 2 * PLI; it += NGW) {
        const int l = it / PLI; int r = it - l * PLI;
        unsigned char* wb = a.ws + WS_W + (size_t)l * WPL;
        if (r < I_IN) { const int kb = r / 192, nb = r % 192; tr_item(a.in[I_WIN] + (size_t)l * DM * NIN, NIN, kb * 64, nb * 64, (bf16_t*)(wb + W_IN), DM, nb * 64, kb * 64, scr, lane); continue; } r -= I_IN;
        if (r < I_BR) { const int i = r >> 8, rr = r & 255, kb = rr >> 5, nb = rr & 31;
            tr_item(a.in[I_WBR] + (size_t)(l * 4 + i) * 512 * DM, DM, kb * 64, nb * 64, (bf16_t*)(wb + W_BR) + (size_t)i * DM * 512, 512, nb * 64, kb * 64, scr, lane); continue; } r -= I_BR;
        if (r < I_O) { const int kb = r >> 5, nb = r & 31; tr_item(a.in[I_WO] + (size_t)l * DM * DM, DM, kb * 64, nb * 64, (bf16_t*)(wb + W_O), DM, nb * 64, kb * 64, scr, lane); continue; } r -= I_O;
        if (r < I_G) { const int kb = r / 88, nb = r % 88, n0 = nb * 64; tr_item(a.in[I_WG] + (size_t)l * DM * FF, FF, kb * 64, n0, (bf16_t*)(wb + W_GU), DM, (n0 >> 7) * 256 + (n0 & 127), kb * 64, scr, lane); continue; } r -= I_G;
        if (r < I_G) { const int kb = r / 88, nb = r % 88, n0 = nb * 64; tr_item(a.in[I_WU] + (size_t)l * DM * FF, FF, kb * 64, n0, (bf16_t*)(wb + W_GU), DM, (n0 >> 7) * 256 + 128 + (n0 & 127), kb * 64, scr, lane); continue; } r -= I_G;
        if (r < I_D) { const int kb = r >> 5, nb = r & 31; tr_item(a.in[I_WD] + (size_t)l * FF * DM, DM, kb * 64, nb * 64, (bf16_t*)(wb + W_D), FF, nb * 64, kb * 64, scr, lane); continue; } r -= I_D;
        { const int g = r >> 2, kb = (r >> 1) & 1, nb = r & 1;
          tr_item(a.in[I_BW] + (size_t)(l * 4 + g) * 128 * 128, 128, kb * 64, nb * 64, (bf16_t*)(wb + W_B), 512, g * 128 + nb * 64, g * 128 + kb * 64, scr, lane); }
    }
    for (int i = vcu * NTHR + tid; i < 2 * 32768; i += G * NTHR) {
        const int l = i >> 15, j = i & 32767, n = j >> 6, kc = j & 63;
        if ((n >> 7) != (kc >> 4)) *(u32x4*)((bf16_t*)(a.ws + WS_W + (size_t)l * WPL + W_B) + (size_t)n * 512 + kc * 8) = (u32x4){0u, 0u, 0u, 0u};
    }
    float* MOD = (float*)(a.ws + WS_CTL + CTL_MOD);
    for (int it = vcu; it < 768; it += G) {
        const int l = it / 384, r = it % 384, cb = r >> 6, kc = r & 63;
        const int col = cb * 2048 + tid * 4;
        f32x4 al = {0.f, 0.f, 0.f, 0.f}, ac = {0.f, 0.f, 0.f, 0.f};
        const float* wp = a.in[I_ADAW] + ((size_t)l * DM + kc * 32) * NIN + col;
#pragma unroll 8
        for (int k = 0; k < 32; ++k) {
            const float sl = siluf_(a.in[I_C][kc * 32 + k]), sc = siluf_(a.in[I_CCTX][kc * 32 + k]);
            const f32x4 w = *(const f32x4*)(wp + (size_t)k * NIN);
            al += sl * w; ac += sc * w;
        }
        if (kc == 0) { const f32x4 b = *(const f32x4*)(a.in[I_ADAB] + (size_t)l * NIN + col); al += b; ac += b; }
        float* ml = MOD + (size_t)(l * 2 + 0) * NIN + col; float* mc = MOD + (size_t)(l * 2 + 1) * NIN + col;
#pragma unroll
        for (int e = 0; e < 4; ++e) { unsafeAtomicAdd(ml + e, al[e]); unsafeAtomicAdd(mc + e, ac[e]); }
    }
}

template <int MODE>
__device__ __forceinline__ void phase_rows(const Args& a, int vcu, int G, int nrows, const float* gpost, const float* modcur, int gate_idx,
                                           const float* gnext, const float* modnext, int sh_idx) {
    const int tid = otid(), wave = tid >> 6, lane = tid & 63;
    const int gw = vcu * NWAVE + wave, NGW = G * NWAVE;
    float* X = (float*)(a.ws + WS_X); const float* Y = (const float*)(a.ws + WS_MRG); bf16_t* XN = (bf16_t*)(a.ws + WS_XN);
    for (int row = gw; row < nrows; row += NGW) {
        const int isctx = row >= SEQ ? 1 : 0;
        f32x4 x[8];
        if (MODE == 0) {
            const float* src = isctx ? a.in[I_CTX] + (size_t)(row - SEQ) * DM : a.in[I_X] + (size_t)row * DM;
#pragma unroll
            for (int j = 0; j < 8; ++j) x[j] = *(const f32x4*)(src + 4 * lane + 256 * j);
        } else {
            f32x4 y[8]; float ss = 0.f;
#pragma unroll
            for (int j = 0; j < 8; ++j) { x[j] = *(const f32x4*)(X + (size_t)row * DM + 4 * lane + 256 * j); y[j] = *(const f32x4*)(Y + (size_t)row * DM + 4 * lane + 256 * j);
                ss += (y[j][0] * y[j][0] + y[j][1] * y[j][1]) + (y[j][2] * y[j][2] + y[j][3] * y[j][3]); }
            const float rstd = 1.0f / sqrtf(wave_sum(ss) * (1.f / DM) + EPS);
            const float* gate = modcur + (size_t)isctx * NIN + gate_idx * DM;
#pragma unroll
            for (int j = 0; j < 8; ++j) { const int col = 4 * lane + 256 * j; const f32x4 gp = *(const f32x4*)(gpost + col), gt = *(const f32x4*)(gate + col);
                x[j] += gt * (y[j] * rstd * gp); }
        }
        if (MODE == 2) {
#pragma unroll
            for (int j = 0; j < 8; ++j) *(f32x4*)(a.out + (size_t)row * DM + 4 * lane + 256 * j) = x[j];
            continue;
        }
        float ss = 0.f;
#pragma unroll
        for (int j = 0; j < 8; ++j) { *(f32x4*)(X + (size_t)row * DM + 4 * lane + 256 * j) = x[j];
            ss += (x[j][0] * x[j][0] + x[j][1] * x[j][1]) + (x[j][2] * x[j][2] + x[j][3] * x[j][3]); }
        const float rstd = 1.0f / sqrtf(wave_sum(ss) * (1.f / DM) + EPS);
        const float* sh = modnext + (size_t)isctx * NIN + sh_idx * DM; const float* sc = sh + DM;
#pragma unroll
        for (int j = 0; j < 8; ++j) { const int col = 4 * lane + 256 * j; const f32x4 gn = *(const f32x4*)(gnext + col), s1 = *(const f32x4*)(sc + col), s0 = *(const f32x4*)(sh + col);
            const f32x4 h = (x[j] * rstd * gn) * (1.f + s1) + s0;
            u32x2 w; w.x = pk2(h[0], h[1]); w.y = pk2(h[2], h[3]); *(u32x2*)(XN + (size_t)row * DM + col) = w; }
    }
}

__device__ __forceinline__ void qk_prep_row(const Args& a, int layer, int row, int lane) {
    bf16_t* p = (bf16_t*)(a.ws + WS_PL) + (size_t)row * NIN;
    const int ax = lane >> 5, f = lane & 31, d1 = ax * 64 + f, d2 = d1 + 32;
    float cs = 1.f, sn = 0.f;
    if (row < SEQ) { const float pos = (float)(ax == 0 ? (row >> 6) : (row & 63)); const float inv = exp2f(-(float)f * (13.287712379549449f / 32.f)); const float ang = pos * inv; cs = cosf(ang); sn = sinf(ang); }
#pragma unroll
    for (int h = 0; h < 6; ++h) {
        const float* gn = (h < 4 ? a.in[I_AQN] : a.in[I_AKN]) + layer * HD;
        bf16_t* hp = p + h * HD;
        float x1 = bf2f(hp[d1]), x2 = bf2f(hp[d2]);
        const float rstd = 1.0f / sqrtf(wave_sum(x1 * x1 + x2 * x2) * (1.f / HD) + EPS);
        x1 = x1 * rstd * gn[d1]; x2 = x2 * rstd * gn[d2];
        hp[d1] = (bf16_t)f2bf(x1 * cs - x2 * sn); hp[d2] = (bf16_t)f2bf(x2 * cs + x1 * sn);
    }
}
__device__ __forceinline__ void dlt_row(const Args& a, int row, int lane) {
    const bf16_t* PL = (const bf16_t*)(a.ws + WS_PL); bf16_t* DLT = (bf16_t*)(a.ws + WS_DLT);
    const int base = row < SEQ ? 0 : SEQ, n = row < SEQ ? SEQ : CTXL, t = row - base, half = 1 << (lane >> 4);
    const int lo = max(t - half, 0), hi = min(t + half, n);
    float s[8];
#pragma unroll
    for (int e = 0; e < 8; ++e) s[e] = 0.f;
    for (int r = lo; r < hi; ++r) { const u32x4 w = *(const u32x4*)(PL + (size_t)(base + r) * NIN + B0 + lane * 8);
        s[0] += bflo(w.x); s[1] += bfhi(w.x); s[2] += bflo(w.y); s[3] += bfhi(w.y); s[4] += bflo(w.z); s[5] += bfhi(w.z); s[6] += bflo(w.w); s[7] += bfhi(w.w); }
    const float inv = 1.f / (float)(hi - lo);
    const u32x4 w = *(const u32x4*)(PL + (size_t)row * NIN + B0 + lane * 8);
    u32x4 o; o.x = pk2(s[0] * inv - bflo(w.x), s[1] * inv - bfhi(w.x)); o.y = pk2(s[2] * inv - bflo(w.y), s[3] * inv - bfhi(w.y));
    o.z = pk2(s[4] * inv - bflo(w.z), s[5] * inv - bfhi(w.z)); o.w = pk2(s[6] * inv - bflo(w.w), s[7] * inv - bfhi(w.w));
    *(u32x4*)(DLT + (size_t)row * 512 + lane * 8) = o;
}
constexpr int CP = 136;
__device__ __forceinline__ void cmix_unit(const Args& a, int layer, int unit, unsigned char* lds) {
    const int tid = otid(), wave = tid >> 6, lane = tid & 63, chunk = unit >> 2, g = unit & 3;
    const bf16_t* PL = (const bf16_t*)(a.ws + WS_PL); bf16_t* OUT = (bf16_t*)(a.ws + WS_OUTS) + (size_t)2 * MR * 512;
    bf16_t* vT = (bf16_t*)lds;
    bf16_t* wsL = (bf16_t*)(lds + 128 * CP * 2);
    float* st = (float*)(lds + 2 * 128 * CP * 2);
    const int t0 = chunk * 128;
    for (int i = 0; i < 16; ++i) {
        const int q = wave * 16 + i;
        const u32x4 w = *(const u32x4*)(PL + (size_t)(t0 + q) * NIN + C_V0 + lane * 8);
        float x[8] = {bflo(w.x), bfhi(w.x), bflo(w.y), bfhi(w.y), bflo(w.z), bfhi(w.z), bflo(w.w), bfhi(w.w)};
        float s = 0.f;
#pragma unroll
        for (int e = 0; e < 8; ++e) s += x[e];
        const float mean = wave_sum(s) * (1.f / 512.f); float q2 = 0.f;
#pragma unroll
        for (int e = 0; e < 8; ++e) { const float d = x[e] - mean; q2 += d * d; }
        const float rstd = 1.0f / sqrtf(wave_sum(q2) * (1.f / 512.f) + EPS);
        if (lane == 0) { st[2 * q] = mean; st[2 * q + 1] = rstd; }
    }
    __syncthreads();
    {
        const int q = tid & 127, cb = tid >> 7; const float mean = st[2 * q], rstd = st[2 * q + 1];
        const float* lg = a.in[I_CNG] + layer * 512 + g * 128 + cb * 32; const float* lb = a.in[I_CNB] + layer * 512 + g * 128 + cb * 32;
        const bf16_t* vp = PL + (size_t)(t0 + q) * NIN + C_V0 + g * 128 + cb * 32;
#pragma unroll
        for (int j = 0; j < 4; ++j) { const u32x4 w = *(const u32x4*)(vp + j * 8);
            const float x[8] = {bflo(w.x), bfhi(w.x), bflo(w.y), bfhi(w.y), bflo(w.z), bfhi(w.z), bflo(w.w), bfhi(w.w)};
#pragma unroll
            for (int e = 0; e < 8; ++e) { const int c = j * 8 + e; vT[(cb * 32 + c) * CP + q] = (bf16_t)f2bf((x[e] - mean) * rstd * lg[c] + lb[c]); } }
        const int p = tid >> 2, qb = (tid & 3) * 32; const float* wp = a.in[I_CWS] + ((size_t)(layer * 4 + g) * 128 + p) * 128 + qb;
#pragma unroll
        for (int j = 0; j < 8; ++j) { const f32x4 w = *(const f32x4*)(wp + j * 4); u32x2 o; o.x = pk2(w[0], w[1]); o.y = pk2(w[2], w[3]); *(u32x2*)(wsL + p * CP + qb + j * 4) = o; }
    }
    __syncthreads();
    {
        const int fr = lane & 15, fq = lane >> 4;
        f32x4 acc[8];
#pragma unroll
        for (int nb = 0; nb < 8; ++nb) acc[nb] = (f32x4){0.f, 0.f, 0.f, 0.f};
#pragma unroll
        for (int ks = 0; ks < 4; ++ks) {
            const bf16x8 wf = *(const bf16x8*)(wsL + (wave * 16 + fr) * CP + ks * 32 + fq * 8);
#pragma unroll
            for (int nb = 0; nb < 8; ++nb) { const bf16x8 vf = *(const bf16x8*)(vT + (nb * 16 + fr) * CP + ks * 32 + fq * 8);
                acc[nb] = __builtin_amdgcn_mfma_f32_16x16x32_bf16(vf, wf, acc[nb], 0, 0, 0); }
        }
        const int p = wave * 16 + fr; const float bs = a.in[I_CBS][(layer * 4 + g) * 128 + p];
        const bf16_t* up = PL + (size_t)(t0 + p) * NIN + C_U0 + g * 128; bf16_t* op = OUT + (size_t)(t0 + p) * 512 + g * 128;
#pragma unroll
        for (int nb = 0; nb < 8; ++nb) { const int c = nb * 16 + 4 * fq; const u32x2 uw = *(const u32x2*)(up + c);
            u32x2 o; o.x = pk2((acc[nb][0] + bs) * bflo(uw.x), (acc[nb][1] + bs) * bfhi(uw.x)); o.y = pk2((acc[nb][2] + bs) * bflo(uw.y), (acc[nb][3] + bs) * bfhi(uw.y));
            *(u32x2*)(op + c) = o; }
    }
    __syncthreads();
}

template <int MODE>
__device__ __forceinline__ void attn_simple_item(const bf16_t* PL, int qcol, int kcol, int vcol, bf16_t* O, int qrow, int h, int kvh, int kbeg, int kend, const float* rpb, int lane) {
    constexpr float C = 0.088388347648318440f * 1.4426950408889634f;
    const int part = lane & 3;
    float q[32], o[32];
    { const bf16_t* qp = PL + (size_t)qrow * NIN + qcol + h * HD + part * 32;
#pragma unroll
      for (int j = 0; j < 4; ++j) { const u32x4 w = *(const u32x4*)(qp + j * 8);
          q[j * 8 + 0] = bflo(w.x) * C; q[j * 8 + 1] = bfhi(w.x) * C; q[j * 8 + 2] = bflo(w.y) * C; q[j * 8 + 3] = bfhi(w.y) * C;
          q[j * 8 + 4] = bflo(w.z) * C; q[j * 8 + 5] = bfhi(w.z) * C; q[j * 8 + 6] = bflo(w.w) * C; q[j * 8 + 7] = bfhi(w.w) * C; } }
#pragma unroll
    for (int d = 0; d < 32; ++d) o[d] = 0.f;
    float mrun = -1e30f, l = 0.f;
    const int r = qrow >> 6, c = qrow & 63, r0 = min(max(r - 4, 0), 120), c0 = min(max(c - 8, 0), 48);
    const int nk = MODE == 0 ? (kend - kbeg) : 384;
    for (int idx = 0; idx < nk; ++idx) {
        int krow; float bias = 0.f;
        if (MODE == 0) krow = kbeg + idx;
        else if (idx < 128) { const int i = idx >> 4, j = idx & 15; krow = (r0 + i) * GW + c0 + j; bias = rpb[(h * 15 + (r0 + i - r + 7)) * 31 + (c0 + j - c + 15)] * 1.4426950408889634f; }
        else krow = SEQ + idx - 128;
        const bf16_t* kp = PL + (size_t)krow * NIN + kcol + kvh * HD + part * 32;
        float s = 0.f;
#pragma unroll
        for (int j = 0; j < 4; ++j) { const u32x4 w = *(const u32x4*)(kp + j * 8);
            s += q[j * 8 + 0] * bflo(w.x) + q[j * 8 + 1] * bfhi(w.x) + q[j * 8 + 2] * bflo(w.y) + q[j * 8 + 3] * bfhi(w.y)
               + q[j * 8 + 4] * bflo(w.z) + q[j * 8 + 5] * bfhi(w.z) + q[j * 8 + 6] * bflo(w.w) + q[j * 8 + 7] * bfhi(w.w); }
        s += __shfl_xor(s, 1); s += __shfl_xor(s, 2);
        s += bias;
        const float mn = fmaxf(mrun, s), alpha = exp2f(mrun - mn), p = exp2f(s - mn);
        l = l * alpha + p; mrun = mn;
        const bf16_t* vp = PL + (size_t)krow * NIN + vcol + kvh * HD + part * 32;
#pragma unroll
        for (int j = 0; j < 4; ++j) { const u32x4 w = *(const u32x4*)(vp + j * 8);
            o[j * 8 + 0] = o[j * 8 + 0] * alpha + p * bflo(w.x); o[j * 8 + 1] = o[j * 8 + 1] * alpha + p * bfhi(w.x);
            o[j * 8 + 2] = o[j * 8 + 2] * alpha + p * bflo(w.y); o[j * 8 + 3] = o[j * 8 + 3] * alpha + p * bfhi(w.y);
            o[j * 8 + 4] = o[j * 8 + 4] * alpha + p * bflo(w.z); o[j * 8 + 5] = o[j * 8 + 5] * alpha + p * bfhi(w.z);
            o[j * 8 + 6] = o[j * 8 + 6] * alpha + p * bflo(w.w); o[j * 8 + 7] = o[j * 8 + 7] * alpha + p * bfhi(w.w); }
    }
    const float il = 1.f / l;
    bf16_t* op = O + (size_t)qrow * 512 + h * HD + part * 32;
#pragma unroll
    for (int j = 0; j < 4; ++j) { u32x4 w; w.x = pk2(o[j * 8 + 0] * il, o[j * 8 + 1] * il); w.y = pk2(o[j * 8 + 2] * il, o[j * 8 + 3] * il);
        w.z = pk2(o[j * 8 + 4] * il, o[j * 8 + 5] * il); w.w = pk2(o[j * 8 + 6] * il, o[j * 8 + 7] * il); *(u32x4*)(op + j * 8) = w; }
}

__device__ __forceinline__ void phase_small(const Args& a, unsigned char* lds, int vcu, int G, int layer, bool last) {
    const int tid = otid(), wave = tid >> 6, lane = tid & 63;
    const int gw = vcu * NWAVE + wave, NGW = G * NWAVE;
    const int nrows = last ? SEQ : MR;
    for (int row = gw; row < MR; row += NGW) qk_prep_row(a, layer, row, lane);
    for (int row = gw; row < nrows; row += NGW) dlt_row(a, row, lane);
    const int nunits = (nrows / 128) * 4;
    for (int u = vcu; u < nunits; u += G) cmix_unit(a, layer, u, lds);
    const bf16_t* PL = (const bf16_t*)(a.ws + WS_PL); bf16_t* OD = (bf16_t*)(a.ws + WS_OUTS) + (size_t)3 * MR * 512;
    const float* rpb = a.in[I_RPB] + layer * 4 * 15 * 31;
    const int n_lat = (SEQ / 16) * 4, n_ctx = last ? 0 : (CTXL / 16) * 4;
    for (int it = gw; it < n_lat + n_ctx; it += NGW) {
        if (it < n_lat) { const int h = it & 3, qt = it >> 2; attn_simple_item<1>(PL, D_Q0, D_K0, D_V0, OD, qt * 16 + (lane >> 2), h, h, 0, 0, rpb, lane); }
        else { const int j = it - n_lat, h = j & 3, qt = j >> 2; attn_simple_item<0>(PL, D_Q0, D_K0, D_V0, OD, SEQ + qt * 16 + (lane >> 2), h, h, SEQ, MR, rpb, lane); }
    }
}
__device__ __forceinline__ void phase_attn_a(const Args& a, int vcu, int G, bool last) {
    const int tid = otid(), wave = tid >> 6, lane = tid & 63;
    const int gw = vcu * NWAVE + wave, NGW = G * NWAVE;
    const bf16_t* PL = (const bf16_t*)(a.ws + WS_PL); bf16_t* OA = (bf16_t*)(a.ws + WS_OUTS);
    const int n_lat = (SEQ / 16) * 4, n_ctx = last ? 0 : (CTXL / 16) * 4;
    for (int it = gw; it < n_lat + n_ctx; it += NGW) {
        if (it < n_lat) { const int h = it & 3, qt = it >> 2; attn_simple_item<0>(PL, A_Q0, A_K0, A_V0, OA, qt * 16 + (lane >> 2), h, h >> 1, 0, MR, nullptr, lane); }
        else { const int j = it - n_lat, h = j & 3, qt = j >> 2; attn_simple_item<0>(PL, A_Q0, A_K0, A_V0, OA, SEQ + qt * 16 + (lane >> 2), h, h >> 1, SEQ, MR, nullptr, lane); }
    }
}

constexpr int NPHASE = 22;
__global__ void __launch_bounds__(NTHR, 2) fwd(Args a) {
    extern __shared__ __attribute__((aligned(16))) unsigned char lds[];
    const int G = gridDim.x, bx = blockIdx.x;
    const int vcu = (G % 8 == 0) ? (bx % 8) * (G / 8) + bx / 8 : bx;
    unsigned char* ws = a.ws;
    const float* MOD = (const float*)(ws + WS_CTL + CTL_MOD);
#if MK_COOP
    cg::grid_group grid = cg::this_grid();
#define SEAM(p) do { if (lo <= (p) && (p) + 1 < hi) grid.sync(); } while (0)
#else
#define SEAM(p) do { } while (0)
#endif
    const int lo = a.ph_lo, hi = a.ph_hi;
#ifndef PHMASK
#define PHMASK 0xffffffu
#endif
#define IN(p) (lo <= (p) && (p) < hi && ((PHMASK >> ((p) < 2 ? (p) : 2 + ((p) - 2) % 10)) & 1u))
    if (IN(0)) { phase_prologue(a, lds, vcu, G); } SEAM(0);
    if (IN(1)) { phase_rows<0>(a, vcu, G, MR, nullptr, nullptr, 0, a.in[I_NPRE_MIX], MOD, 0); } SEAM(1);
#pragma nounroll
    for (int l = 0; l < 2; ++l) {
        const bool last = (l == 1);
        const int pb = 2 + l * 10;
        unsigned char* wb = ws + WS_W + (size_t)l * WPL;
        const float* modl = MOD + (size_t)l * 2 * NIN;
        const int Mrows = last ? SEQ : MR;
        if (IN(pb + 0)) {
            Gemm g{(const bf16_t*)(ws + WS_XN), (const bf16_t*)(wb + W_IN), DM, DM, DM}; StaticOrder S; S.init(MR, NIN, G, bx);
            EpiIn E{(bf16_t*)(ws + WS_PL)}; gemm_phase((PG8_LAS unsigned char*)lds, g, S, E);
        } SEAM(pb + 0);
        if (IN(pb + 1)) { phase_small(a, lds, vcu, G, l, last); } SEAM(pb + 1);
        if (IN(pb + 2)) { phase_attn_a(a, vcu, G, last); } SEAM(pb + 2);
        if (IN(pb + 3)) {
            Gemm g{(const bf16_t*)(ws + WS_DLT), (const bf16_t*)(wb + W_B), 512, 512, 512}; StaticOrder S; S.init(Mrows, 512, G, bx);
            EpiScale E{(bf16_t*)(ws + WS_OUTS) + (size_t)1 * MR * 512, 512, a.in[I_BSCALE] + l * 512}; gemm_phase((PG8_LAS unsigned char*)lds, g, S, E);
        } SEAM(pb + 3);
        if (IN(pb + 4)) {
            Gemm g{(const bf16_t*)(ws + WS_OUTS), (const bf16_t*)(wb + W_BR), 512, 512, 512}; MergeOrder S; S.base.init(Mrows, DM, G, bx);
            EpiMerge E{(const bf16_t*)(ws + WS_PL), (float*)(ws + WS_MRG), (bf16_t*)(ws + WS_MRGB)}; gemm_phase((PG8_LAS unsigned char*)lds, g, S, E);
        } SEAM(pb + 4);
        if (IN(pb + 5)) {
            Gemm g{(const bf16_t*)(ws + WS_MRGB), (const bf16_t*)(wb + W_O), DM, DM, DM}; StaticOrder S; S.init(Mrows, DM, G, bx);
            EpiF32 E{(float*)(ws + WS_MRG), DM}; gemm_phase((PG8_LAS unsigned char*)lds, g, S, E);
        } SEAM(pb + 5);
        if (IN(pb + 6)) { phase_rows<1>(a, vcu, G, Mrows, a.in[I_NPOST_MIX] + l * DM, modl, 2, a.in[I_NPRE_FFN] + l * DM, modl, 3); } SEAM(pb + 6);
        if (IN(pb + 7)) {
            Gemm g{(const bf16_t*)(ws + WS_XN), (const bf16_t*)(wb + W_GU), DM, DM, DM}; StaticOrder S; S.init(Mrows, 2 * FF, G, bx);
            EpiSwiglu E{(bf16_t*)(ws + WS_H)}; gemm_phase((PG8_LAS unsigned char*)lds, g, S, E);
        } SEAM(pb + 7);
        if (IN(pb + 8)) {
            Gemm g{(const bf16_t*)(ws + WS_H), (const bf16_t*)(wb + W_D), FF, FF, FF}; StaticOrder S; S.init(Mrows, DM, G, bx);
            EpiF32 E{(float*)(ws + WS_MRG), DM}; gemm_phase((PG8_LAS unsigned char*)lds, g, S, E);
        } SEAM(pb + 8);
        if (IN(pb + 9)) {
            if (!last) phase_rows<1>(a, vcu, G, MR, a.in[I_NPOST_FFN] + l * DM, modl, 5, a.in[I_NPRE_MIX] + (l + 1) * DM, MOD + (size_t)(l + 1) * 2 * NIN, 0);
            else phase_rows<2>(a, vcu, G, SEQ, a.in[I_NPOST_FFN] + l * DM, modl, 5, nullptr, nullptr, 0);
        }
        if (!last) SEAM(pb + 9);
    }
#undef IN
#undef SEAM
}

extern "C" void kernel_launch(void* const* d_in, const int* in_sizes, int n_in, void* d_out, int out_size, void* d_ws, size_t ws_size, hipStream_t stream) {
    static int grid = 0;
    if (grid == 0) {
        if (n_in != N_IN || out_size != SEQ * DM || ws_size < WS_END) { fprintf(stderr, "kernel_launch: unexpected shapes (n_in %d out %d ws %zu)\n", n_in, out_size, ws_size); grid = -1; return; }
        if (hipFuncSetAttribute((const void*)fwd, hipFuncAttributeMaxDynamicSharedMemorySize, LDS_BYTES) != hipSuccess) { fprintf(stderr, "kernel_launch: hipFuncSetAttribute failed\n"); grid = -1; return; }
        int dev = 0, cus = 0, per_cu = 0;
        hipGetDevice(&dev); hipDeviceGetAttribute(&cus, hipDeviceAttributeMultiprocessorCount, dev);
        hipOccupancyMaxActiveBlocksPerMultiprocessor(&per_cu, (const void*)fwd, NTHR, LDS_BYTES);
        if (per_cu < 1) { fprintf(stderr, "kernel_launch: occupancy query says %d blocks per CU\n", per_cu); per_cu = 1; }
        (void)hipGetLastError();
        grid = cus * per_cu;
        fprintf(stderr, "kernel_launch: grid %d (cus %d x %d)\n", grid, cus, per_cu);
    }
    if (grid < 0) return;
    hipMemsetAsync((char*)d_ws + WS_CTL, 0, CTL_BYTES, stream);
    Args a{};
    for (int i = 0; i < N_IN; ++i) a.in[i] = (const float*)d_in[i];
    a.out = (float*)d_out; a.ws = (unsigned char*)d_ws;
#if MK_COOP
    a.ph_lo = 0; a.ph_hi = NPHASE;
    void* params[] = {&a};
    hipError_t e = hipLaunchCooperativeKernel((const void*)fwd, dim3(grid), dim3(NTHR), params, LDS_BYTES, stream);
    if (e != hipSuccess) fprintf(stderr, "kernel_launch: cooperative launch failed: %s (grid %d)\n", hipGetErrorString(e), grid);
#else
    for (int p = 0; p < NPHASE; ++p) {
        a.ph_lo = p; a.ph_hi = p + 1;
        hipLaunchKernelGGL(fwd, dim3(grid), dim3(NTHR), LDS_BYTES, stream, a);
    }
#endif
}
```

```cpp
#include <hip/hip_runtime.h>
#include <hip/hip_cooperative_groups.h>
#include <cstdio>
#include <cstdint>
namespace cg = cooperative_groups;

#ifndef MK_COOP
#define MK_COOP 1
#endif

typedef unsigned short bf16_t;
typedef short bf16x8 __attribute__((ext_vector_type(8)));
typedef float f32x4 __attribute__((ext_vector_type(4)));
typedef unsigned u32x4 __attribute__((ext_vector_type(4)));
typedef unsigned u32x2 __attribute__((ext_vector_type(2)));

constexpr int DM = 2048, SEQ = 8192, CTXL = 256, MR = SEQ + CTXL, NIN = 12288, FF = 5632, HD = 128, GW = 64;
constexpr int A_Q0 = 0, A_K0 = 512, A_V0 = 768, B0 = 1024, C_U0 = 1536, C_V0 = 2048, D_Q0 = 2560, D_K0 = 3072, D_V0 = 3584, G0 = 4096;
constexpr float EPS = 1e-6f;
constexpr int NTHR = 512, NWAVE = 8;
constexpr int LDS_BYTES = 147456;

enum { I_X = 0, I_C, I_CTX, I_CCTX, I_ADAW, I_ADAB, I_NPRE_MIX, I_NPOST_MIX, I_NPRE_FFN, I_NPOST_FFN, I_WIN, I_AQN, I_AKN, I_BW, I_BSCALE,
       I_CNG, I_CNB, I_CWS, I_CBS, I_RPB, I_WBR, I_WO, I_WG, I_WU, I_WD, N_IN };

constexpr size_t MiB = 1u << 20;
constexpr size_t WS_CTL = 0, CTL_BYTES = 1 * MiB;
constexpr size_t CTL_MOD = 256 * 1024;
constexpr size_t WS_W = 2 * MiB, WPL = 131 * MiB;
constexpr size_t W_IN = 0, W_BR = 48 * MiB, W_O = 56 * MiB, W_GU = 64 * MiB, W_D = 108 * MiB, W_B = 130 * MiB;
constexpr size_t WS_X = 264 * MiB;
constexpr size_t WS_XN = 330 * MiB;
constexpr size_t WS_PL = 363 * MiB;
constexpr size_t WS_H = WS_PL;
constexpr size_t WS_OUTS = 561 * MiB;
constexpr size_t WS_DLT = 594 * MiB;
constexpr size_t WS_MRG = 603 * MiB;
constexpr size_t WS_MRGB = 669 * MiB;
constexpr size_t WS_END = 702 * MiB;

struct Args { const float* in[N_IN]; float* out; unsigned char* ws; int ph_lo, ph_hi; };

__device__ __forceinline__ unsigned f2bf(float f) { unsigned u = __builtin_bit_cast(unsigned, f); return (u + 0x7fffu + ((u >> 16) & 1u)) >> 16; }
__device__ __forceinline__ unsigned pk2(float lo, float hi) { return f2bf(lo) | (f2bf(hi) << 16); }
__device__ __forceinline__ float bflo(unsigned w) { return __builtin_bit_cast(float, w << 16); }
__device__ __forceinline__ float bfhi(unsigned w) { return __builtin_bit_cast(float, w & 0xffff0000u); }
__device__ __forceinline__ float bf2f(bf16_t h) { return __builtin_bit_cast(float, (unsigned)h << 16); }
__device__ __forceinline__ float wave_sum(float v) {
#pragma unroll
    for (int o = 32; o >= 1; o >>= 1) v += __shfl_xor(v, o);
    return v;
}
__device__ __forceinline__ int otid() { int t = threadIdx.x; asm volatile("" : "+v"(t)); return t; }
__device__ __forceinline__ float sigmoidf_(float x) { return 1.f / (1.f + __expf(-x)); }
__device__ __forceinline__ float siluf_(float x) { return x / (1.f + __expf(-x)); }

struct Unit { int pm, pn; };
struct Gemm { const bf16_t* A; const bf16_t* Bt; int lda, ldb, K; };
constexpr int NXCD = 8, WGM = 8;
struct StaticOrder {
    int nM, nN, nwg, G, c;
    __device__ void init(int M, int N, int G_, int c_) { nM = M / 256; nN = N / 256; nwg = nM * nN; G = G_; c = c_; }
    __device__ bool next(int i, Unit& u) const {
        const long L = (long)i * G + c; if (L >= nwg) return false;
        int wgid = (int)L; { const int q = nwg / NXCD, r = nwg % NXCD, xcd = wgid % NXCD, off = wgid / NXCD; wgid = (xcd < r ? xcd * (q + 1) : r * (q + 1) + (xcd - r) * q) + off; }
        const int nig = WGM * nN, gid = wgid / nig, fm = gid * WGM, gsz = (nM - fm) < WGM ? (nM - fm) : WGM;
        u.pm = fm + ((wgid % nig) % gsz); u.pn = (wgid % nig) / gsz; return true;
    }
    __device__ __forceinline__ void a_ready(const Unit&) const {}
    __device__ __forceinline__ void done(const Unit&) const {}
};
struct MergeOrder {
    StaticOrder base;
    __device__ bool next(int i, Unit& u) const { Unit t; if (!base.next(i >> 2, t)) return false; const int pass = i & 3; u.pm = pass * 33 + t.pm; u.pn = pass * 8 + t.pn; return true; }
    __device__ __forceinline__ void a_ready(const Unit&) const {}
    __device__ __forceinline__ void done(const Unit&) const {}
};

struct EpiIn {
    static constexpr bool PERM = true, AFTER_DRAIN = false;
    bf16_t* PL;
    __device__ __forceinline__ void operator()(const f32x4 (&acc)[2][2][4][2], const Unit& u, int wr, int wc, int fr, int fq) const {
        const bool gate = u.pn >= (G0 / 256);
#pragma unroll
        for (int ai = 0; ai < 2; ++ai)
#pragma unroll
            for (int m = 0; m < 4; ++m) {
                const int row = u.pm * 256 + ai * 128 + wr * 64 + m * 16 + fr;
#pragma unroll
                for (int bj = 0; bj < 2; ++bj) {
                    const int col = u.pn * 256 + bj * 128 + wc * 32 + 8 * fq;
                    f32x4 v0 = acc[ai][bj][m][0], v1 = acc[ai][bj][m][1];
                    if (gate) {
#pragma unroll
                        for (int e = 0; e < 4; ++e) { v0[e] = sigmoidf_(v0[e]); v1[e] = sigmoidf_(v1[e]); }
                    }
                    u32x4 w; w.x = pk2(v0[0], v0[1]); w.y = pk2(v0[2], v0[3]); w.z = pk2(v1[0], v1[1]); w.w = pk2(v1[2], v1[3]);
                    *(u32x4*)(PL + (size_t)row * NIN + col) = w;
                }
            }
    }
};
struct EpiScale {
    static constexpr bool PERM = true, AFTER_DRAIN = false;
    bf16_t* O; int ldc; const float* scale;
    __device__ __forceinline__ void operator()(const f32x4 (&acc)[2][2][4][2], const Unit& u, int wr, int wc, int fr, int fq) const {
#pragma unroll
        for (int bj = 0; bj < 2; ++bj) {
            const int col = u.pn * 256 + bj * 128 + wc * 32 + 8 * fq;
            const f32x4 s0 = *(const f32x4*)(scale + col), s1 = *(const f32x4*)(scale + col + 4);
#pragma unroll
            for (int ai = 0; ai < 2; ++ai)
#pragma unroll
                for (int m = 0; m < 4; ++m) {
                    const int row = u.pm * 256 + ai * 128 + wr * 64 + m * 16 + fr;
                    const f32x4 v0 = acc[ai][bj][m][0] * s0, v1 = acc[ai][bj][m][1] * s1;
                    u32x4 w; w.x = pk2(v0[0], v0[1]); w.y = pk2(v0[2], v0[3]); w.z = pk2(v1[0], v1[1]); w.w = pk2(v1[2], v1[3]);
                    *(u32x4*)(O + (size_t)row * ldc + col) = w;
                }
        }
    }
};
struct EpiMerge {
    static constexpr bool PERM = true, AFTER_DRAIN = false;
    const bf16_t* PL; float* MRG; bf16_t* MRGB;
    __device__ __forceinline__ void operator()(const f32x4 (&acc)[2][2][4][2], const Unit& u, int wr, int wc, int fr, int fq) const {
        const int pass = u.pm / 33, pm = u.pm - pass * 33, pn = u.pn & 7;
#pragma unroll
        for (int ai = 0; ai < 2; ++ai)
#pragma unroll
            for (int m = 0; m < 4; ++m) {
                const int row = pm * 256 + ai * 128 + wr * 64 + m * 16 + fr;
#pragma unroll
                for (int bj = 0; bj < 2; ++bj) {
                    const int col = pn * 256 + bj * 128 + wc * 32 + 8 * fq;
                    const u32x4 gw = *(const u32x4*)(PL + (size_t)row * NIN + G0 + pass * DM + col);
                    f32x4 v0 = acc[ai][bj][m][0], v1 = acc[ai][bj][m][1];
                    v0[0] *= bflo(gw.x); v0[1] *= bfhi(gw.x); v0[2] *= bflo(gw.y); v0[3] *= bfhi(gw.y);
                    v1[0] *= bflo(gw.z); v1[1] *= bfhi(gw.z); v1[2] *= bflo(gw.w); v1[3] *= bfhi(gw.w);
                    float* mp = MRG + (size_t)row * DM + col;
                    if (pass > 0) { v0 += *(const f32x4*)mp; v1 += *(const f32x4*)(mp + 4); }
                    if (pass < 3) { *(f32x4*)mp = v0; *(f32x4*)(mp + 4) = v1; }
                    else { u32x4 w; w.x = pk2(v0[0], v0[1]); w.y = pk2(v0[2], v0[3]); w.z = pk2(v1[0], v1[1]); w.w = pk2(v1[2], v1[3]);
                           *(u32x4*)(MRGB + (size_t)row * DM + col) = w; }
                }
            }
    }
};
struct EpiF32 {
    static constexpr bool PERM = true, AFTER_DRAIN = false;
    float* Y; int ldc;
    __device__ __forceinline__ void operator()(const f32x4 (&acc)[2][2][4][2], const Unit& u, int wr, int wc, int fr, int fq) const {
#pragma unroll
        for (int ai = 0; ai < 2; ++ai)
#pragma unroll
            for (int m = 0; m < 4; ++m) {
                const int row = u.pm * 256 + ai * 128 + wr * 64 + m * 16 + fr;
#pragma unroll
                for (int bj = 0; bj < 2; ++bj) {
                    const int col = u.pn * 256 + bj * 128 + wc * 32 + 8 * fq;
                    float* yp = Y + (size_t)row * ldc + col;
                    *(f32x4*)yp = acc[ai][bj][m][0]; *(f32x4*)(yp + 4) = acc[ai][bj][m][1];
                }
            }
    }
};
struct EpiSwiglu {
    static constexpr bool PERM = true, AFTER_DRAIN = false;
    bf16_t* H;
    __device__ __forceinline__ void operator()(const f32x4 (&acc)[2][2][4][2], const Unit& u, int wr, int wc, int fr, int fq) const {
#pragma unroll
        for (int ai = 0; ai < 2; ++ai)
#pragma unroll
            for (int m = 0; m < 4; ++m) {
                const int row = u.pm * 256 + ai * 128 + wr * 64 + m * 16 + fr;
                const int col = u.pn * 128 + wc * 32 + 8 * fq;
                f32x4 h0, h1;
#pragma unroll
                for (int e = 0; e < 4; ++e) { h0[e] = siluf_(acc[ai][0][m][0][e]) * acc[ai][1][m][0][e]; h1[e] = siluf_(acc[ai][0][m][1][e]) * acc[ai][1][m][1][e]; }
                u32x4 w; w.x = pk2(h0[0], h0[1]); w.y = pk2(h0[2], h0[3]); w.z = pk2(h1[0], h1[1]); w.w = pk2(h1[2], h1[3]);
                *(u32x4*)(H + (size_t)row * FF + col) = w;
            }
    }
};

#define PG8_LAS __attribute__((address_space(3)))
constexpr int BM = 256, BK = 64, HALF = 128, HTB = HALF * BK * 2, STAGE_BYTES = 8 * HTB;
__device__ __forceinline__ int lds_byte(int r, int c) { const int st = (r >> 4) * 2 + (c >> 5), rr = r & 15, cc = c & 31, ob = rr * 64 + cc * 2; return st * 1024 + (ob ^ (((ob >> 9) & 1) << 5)); }
__device__ __forceinline__ void stage_rc(int b, int& R, int& C) { const int st = b / 1024, sb = b % 1024, swz = sb ^ (((sb >> 9) & 1) << 5); R = (st >> 1) * 16 + swz / 64; C = (st & 1) * 32 + (swz % 64) / 2; }
__device__ __forceinline__ int perm32(int rho) { const int n = rho >> 4, i = rho & 15; return 8 * (i >> 2) + 4 * n + (i & 3); }
template <class Epi, class Sched, bool ALIGN_EPI = true, bool SP2 = true>
__device__ __forceinline__ void gemm_phase(PG8_LAS unsigned char* lds, const Gemm g, const Sched& S, const Epi& E) {
    const int tid = otid(), wid = __builtin_amdgcn_readfirstlane(tid >> 6), lane = tid & 63, wr = wid >> 2, wc = wid & 3, fr = lane & 15, fq = lane >> 4;
    const int K = g.K, nt = K / BK;
    unsigned voffA[2], voffB[2];
#pragma unroll
    for (int i = 0; i < 2; ++i) { int R, C; stage_rc(tid * 16 + i * 8192, R, C); const int Rb = Epi::PERM ? ((R & ~31) + perm32(R & 31)) : R;
        voffA[i] = (unsigned)(R * g.lda + C) * 2u; voffB[i] = (unsigned)(Rb * g.ldb + C) * 2u; }
    const size_t kstep = (size_t)(BK * 2);
    const size_t hstepA = (size_t)HALF * g.lda * 2, hstepB = (size_t)HALF * g.ldb * 2;
    const size_t tstepA = 2 * hstepA, tstepB = 2 * hstepB;
    const unsigned ldsw = (unsigned)wid * 1024u;
    const int aoff = lds_byte(wr * 64 + fr, fq * 8), boff = lds_byte(wc * 32 + fr, fq * 8);
#define PG8_SA(b, h) (((b) * 2 + (h)) * HTB)
#define PG8_SB(b, h) ((4 + (b) * 2 + (h)) * HTB)
#define PG8_STAGE(bufoff, gbase, voff) do { _Pragma("unroll") for (int _i = 0; _i < 2; ++_i) \
        __builtin_amdgcn_global_load_lds((const unsigned*)((const char*)(gbase) + (voff)[_i]), (PG8_LAS unsigned*)(lds + (bufoff) + ldsw + _i * 8192), 16, 0, 0); } while (0)
#define PG8_LDA(dst, b, h) do { _Pragma("unroll") for (int m = 0; m < 4; ++m) _Pragma("unroll") for (int k = 0; k < 2; ++k) dst[m][k] = *(const PG8_LAS bf16x8*)(lds + PG8_SA(b, h) + aoff + m * 2048 + k * 1024); } while (0)
#define PG8_LDB(dst, b, h) do { _Pragma("unroll") for (int n = 0; n < 2; ++n) _Pragma("unroll") for (int k = 0; k < 2; ++k) dst[n][k] = *(const PG8_LAS bf16x8*)(lds + PG8_SB(b, h) + boff + n * 2048 + k * 1024); } while (0)
#define PG8_MMA(ai, bj, At, Bt) do { __builtin_amdgcn_s_setprio(1); _Pragma("unroll") for (int m = 0; m < 4; ++m) _Pragma("unroll") for (int n = 0; n < 2; ++n) _Pragma("unroll") for (int k = 0; k < 2; ++k) \
        acc[ai][bj][m][n] = __builtin_amdgcn_mfma_f32_16x16x32_bf16(Bt[n][k], At[m][k], acc[ai][bj][m][n], 0, 0, 0); __builtin_amdgcn_s_setprio(0); } while (0)
#define PG8_WAIT_V(n) asm volatile("s_waitcnt vmcnt(" #n ")" ::: "memory")
#define PG8_WAIT_L(n) asm volatile("s_waitcnt lgkmcnt(" #n ")" ::: "memory")
#define PG8_BAR __builtin_amdgcn_s_barrier()
#define PG8_SCHED __builtin_amdgcn_sched_barrier(0)
    Unit cur, nxt; int ui = 0;
    if (!S.next(0, cur)) return;
    f32x4 acc[2][2][4][2];
#pragma unroll
    for (int a = 0; a < 2; ++a)
#pragma unroll
        for (int b = 0; b < 2; ++b)
#pragma unroll
            for (int m = 0; m < 4; ++m)
#pragma unroll
                for (int n = 0; n < 2; ++n) acc[a][b][m][n] = (f32x4){0.f, 0.f, 0.f, 0.f};
    bf16x8 At[4][2], B0[2][2], B1[2][2];
    const char* cA = (const char*)g.A + (size_t)cur.pm * tstepA; const char* cB = (const char*)g.Bt + (size_t)cur.pn * tstepB;
    S.a_ready(cur);
    if constexpr (SP2) {
        PG8_STAGE(PG8_SB(0, 0), cB, voffB); PG8_STAGE(PG8_SB(0, 1), cB + hstepB, voffB); PG8_STAGE(PG8_SA(0, 0), cA, voffA); PG8_STAGE(PG8_SA(0, 1), cA + hstepA, voffA);
        if (wr == 1) PG8_BAR;
        PG8_WAIT_V(2); PG8_BAR;
        PG8_STAGE(PG8_SB(1, 0), cB + kstep, voffB); PG8_STAGE(PG8_SA(1, 0), cA + kstep, voffA); PG8_STAGE(PG8_SB(1, 1), cB + hstepB + kstep, voffB);
        PG8_WAIT_V(6); PG8_BAR;
    } else {
        PG8_STAGE(PG8_SB(0, 0), cB, voffB); PG8_STAGE(PG8_SA(0, 0), cA, voffA); PG8_STAGE(PG8_SB(0, 1), cB + hstepB, voffB); PG8_STAGE(PG8_SA(0, 1), cA + hstepA, voffA);
        if (wr == 1) PG8_BAR;
        PG8_WAIT_V(4); PG8_BAR;
        PG8_STAGE(PG8_SB(1, 0), cB + kstep, voffB); PG8_STAGE(PG8_SA(1, 0), cA + kstep, voffA); PG8_STAGE(PG8_SB(1, 1), cB + hstepB + kstep, voffB);
        PG8_WAIT_V(6); PG8_BAR;
    }
    for (;;) {
        const bool has_next = S.next(ui + 1, nxt);
        const char* nA = has_next ? (const char*)g.A + (size_t)nxt.pm * tstepA : cA; const char* nB = has_next ? (const char*)g.Bt + (size_t)nxt.pn * tstepB : cB;
        for (int t = 0; t < nt; t += 2) {
            const bool last = (t == nt - 2);
            const char* a1 = cA + (size_t)(t + 1) * kstep;
            const char* a2 = last ? nA : cA + (size_t)(t + 2) * kstep; const char* b2 = last ? nB : cB + (size_t)(t + 2) * kstep;
            const char* a3 = a2 + kstep; const char* b3 = b2 + kstep;
            if (last && has_next) S.a_ready(nxt);
            if constexpr (SP2) {
            PG8_LDB(B0, 0, 0); PG8_LDB(B1, 0, 1); PG8_SCHED; PG8_LDA(At, 0, 0); PG8_STAGE(PG8_SA(1, 1), a1 + hstepA, voffA);
            PG8_WAIT_V(8); PG8_WAIT_L(0); PG8_BAR; PG8_MMA(0, 0, At, B0); PG8_MMA(0, 1, At, B1); PG8_BAR; PG8_SCHED;
            PG8_LDA(At, 0, 1); PG8_STAGE(PG8_SB(0, 0), b2, voffB); PG8_STAGE(PG8_SB(0, 1), b2 + hstepB, voffB); PG8_STAGE(PG8_SA(0, 0), a2, voffA);
            PG8_WAIT_V(8); PG8_WAIT_L(0); PG8_BAR; PG8_MMA(1, 0, At, B0); PG8_MMA(1, 1, At, B1); PG8_BAR; PG8_SCHED;
            PG8_LDB(B0, 1, 0); PG8_LDB(B1, 1, 1); PG8_SCHED; PG8_LDA(At, 1, 0); PG8_STAGE(PG8_SA(0, 1), a2 + hstepA, voffA);
            PG8_WAIT_V(8); PG8_WAIT_L(0); PG8_BAR; PG8_MMA(0, 0, At, B0); PG8_MMA(0, 1, At, B1); PG8_BAR; PG8_SCHED;
            PG8_LDA(At, 1, 1); PG8_STAGE(PG8_SB(1, 0), b3, voffB); PG8_STAGE(PG8_SB(1, 1), b3 + hstepB, voffB); PG8_STAGE(PG8_SA(1, 0), a3, voffA);
            PG8_WAIT_V(8); PG8_WAIT_L(0); PG8_BAR; PG8_MMA(1, 0, At, B0); PG8_MMA(1, 1, At, B1); PG8_BAR; PG8_SCHED;
            } else {
            PG8_LDB(B0, 0, 0); PG8_SCHED; PG8_LDA(At, 0, 0); PG8_STAGE(PG8_SA(1, 1), a1 + hstepA, voffA);
            PG8_WAIT_L(8); PG8_BAR; PG8_WAIT_L(0); PG8_MMA(0, 0, At, B0); PG8_BAR; PG8_SCHED;
            PG8_LDB(B1, 0, 1); PG8_STAGE(PG8_SB(0, 0), b2, voffB);
            PG8_BAR; PG8_WAIT_L(0); PG8_MMA(0, 1, At, B1); PG8_BAR;
            PG8_LDA(At, 0, 1); PG8_STAGE(PG8_SA(0, 0), a2, voffA);
            PG8_BAR; PG8_WAIT_L(0); PG8_MMA(1, 0, At, B0); PG8_BAR; PG8_SCHED;
            PG8_STAGE(PG8_SB(0, 1), b2 + hstepB, voffB);
            PG8_WAIT_V(6); PG8_BAR; PG8_MMA(1, 1, At, B1); PG8_BAR;
            PG8_LDB(B0, 1, 0); PG8_SCHED; PG8_LDA(At, 1, 0); PG8_STAGE(PG8_SA(0, 1), a2 + hstepA, voffA);
            PG8_WAIT_L(8); PG8_BAR; PG8_WAIT_L(0); PG8_MMA(0, 0, At, B0); PG8_BAR; PG8_SCHED;
            PG8_LDB(B1, 1, 1); PG8_STAGE(PG8_SB(1, 0), b3, voffB);
            PG8_BAR; PG8_WAIT_L(0); PG8_MMA(0, 1, At, B1); PG8_BAR;
            PG8_LDA(At, 1, 1); PG8_STAGE(PG8_SA(1, 0), a3, voffA);
            PG8_BAR; PG8_WAIT_L(0); PG8_MMA(1, 0, At, B0); PG8_BAR; PG8_SCHED;
            PG8_STAGE(PG8_SB(1, 1), b3 + hstepB, voffB);
            PG8_WAIT_V(6); PG8_BAR; PG8_MMA(1, 1, At, B1); PG8_BAR;
            }
        }
        if constexpr (ALIGN_EPI) { if (wr == 0) PG8_BAR; }
        if constexpr (!Epi::AFTER_DRAIN) { E(acc, cur, wr, wc, fr, fq); S.done(cur); }
        if (!has_next) break;
#pragma unroll
        for (int a = 0; a < 2; ++a)
#pragma unroll
            for (int b = 0; b < 2; ++b)
#pragma unroll
                for (int m = 0; m < 4; ++m)
#pragma unroll
                    for (int n = 0; n < 2; ++n) acc[a][b][m][n] = (f32x4){0.f, 0.f, 0.f, 0.f};
        cur = nxt; cA = nA; cB = nB; ++ui;
        if constexpr (ALIGN_EPI) { if (wr == 1) PG8_BAR; }
    }
    PG8_WAIT_V(0);
    if constexpr (!ALIGN_EPI) { if (wr == 0) PG8_BAR; }
    PG8_BAR;
    if constexpr (Epi::AFTER_DRAIN) { E.fused(acc, cur, wr, wc, fr, fq, lds, wid, lane); S.done(cur); }
#undef PG8_SA
#undef PG8_SB
#undef PG8_STAGE
#undef PG8_LDA
#undef PG8_LDB
#undef PG8_MMA
#undef PG8_WAIT_V
#undef PG8_WAIT_L
#undef PG8_BAR
#undef PG8_SCHED
}

__device__ __forceinline__ void tr_item(const float* src, int ldn, int k0, int n0, bf16_t* dst, int dld, int drow0, int dk0, float* scr, int lane) {
    const float* sp = src + (size_t)k0 * ldn + n0 + lane;
#pragma unroll 16
    for (int i = 0; i < 64; ++i) scr[i * 65 + lane] = sp[(size_t)i * ldn];
    __builtin_amdgcn_s_waitcnt(0); asm volatile("" ::: "memory");
    const int c = lane & 7;
#pragma unroll
    for (int j = 0; j < 8; ++j) {
        const int n = (lane >> 3) + 8 * j; const float* s = scr + (8 * c) * 65 + n;
        u32x4 o; o.x = pk2(s[0], s[65]); o.y = pk2(s[2 * 65], s[3 * 65]); o.z = pk2(s[4 * 65], s[5 * 65]); o.w = pk2(s[6 * 65], s[7 * 65]);
        *(u32x4*)(dst + (size_t)(drow0 + n) * dld + dk0 + 8 * c) = o;
    }
    __builtin_amdgcn_s_waitcnt(0); asm volatile("" ::: "memory");
}

__device__ __forceinline__ void phase_prologue(const Args& a, unsigned char* lds, int vcu, int G) {
    const int tid = otid(), wave = tid >> 6, lane = tid & 63;
    const int gw = vcu * NWAVE + wave, NGW = G * NWAVE;
    float* scr = (float*)(lds + wave * 16640);
    constexpr int I_IN = 32 * 192, I_BR = 4 * 8 * 32, I_O = 32 * 32, I_G = 32 * 88, I_D = 88 * 32, I_B = 16;
    constexpr int PLI = I_IN + I_BR + I_O + 2 * I_G + I_D + I_B;
    for (int it = gw; it < 2 * PLI; it += NGW) {
        const int l = it / PLI; int r = it - l * PLI;
        unsigned char* wb = a.ws + WS_W + (size_t)l * WPL;
        if (r < I_IN) { const int kb = r / 192, nb = r % 192; tr_item(a.in[I_WIN] + (size_t)l * DM * NIN, NIN, kb * 64, nb * 64, (bf16_t*)(wb + W_IN), DM, nb * 64, kb * 64, scr, lane); continue; } r -= I_IN;
        if (r < I_BR) { const int i = r >> 8, rr = r & 255, kb = rr >> 5, nb = rr & 31;
            tr_item(a.in[I_WBR] + (size_t)(l * 4 + i) * 512 * DM, DM, kb * 64, nb * 64, (bf16_t*)(wb + W_BR) + (size_t)i * DM * 512, 512, nb * 64, kb * 64, scr, lane); continue; } r -= I_BR;
        if (r < I_O) { const int kb = r >> 5, nb = r & 31; tr_item(a.in[I_WO] + (size_t)l * DM * DM, DM, kb * 64, nb * 64, (bf16_t*)(wb + W_O), DM, nb * 64, kb * 64, scr, lane); continue; } r -= I_O;
        if (r < I_G) { const int kb = r / 88, nb = r % 88, n0 = nb * 64; tr_item(a.in[I_WG] + (size_t)l * DM * FF, FF, kb * 64, n0, (bf16_t*)(wb + W_GU), DM, (n0 >> 7) * 256 + (n0 & 127), kb * 64, scr, lane); continue; } r -= I_G;
        if (r < I_G) { const int kb = r / 88, nb = r % 88, n0 = nb * 64; tr_item(a.in[I_WU] + (size_t)l * DM * FF, FF, kb * 64, n0, (bf16_t*)(wb + W_GU), DM, (n0 >> 7) * 256 + 128 + (n0 & 127), kb * 64, scr, lane); continue; } r -= I_G;
        if (r < I_D) { const int kb = r >> 5, nb = r & 31; tr_item(a.in[I_WD] + (size_t)l * FF * DM, DM, kb * 64, nb * 64, (bf16_t*)(wb + W_D), FF, nb * 64, kb * 64, scr, lane); continue; } r -= I_D;
        { const int g = r >> 2, kb = (r >> 1) & 1, nb = r & 1;
          tr_item(a.in[I_BW] + (size_t)(l * 4 + g) * 128 * 128, 128, kb * 64, nb * 64, (bf16_t*)(wb + W_B), 512, g * 128 + nb * 64, g * 128 + kb * 64, scr, lane); }
    }
    for (int i = vcu * NTHR + tid; i < 2 * 32768; i += G * NTHR) {
        const int l = i >> 15, j = i & 32767, n = j >> 6, kc = j & 63;
        if ((n >> 7) != (kc >> 4)) *(u32x4*)((bf16_t*)(a.ws + WS_W + (size_t)l * WPL + W_B) + (size_t)n * 512 + kc * 8) = (u32x4){0u, 0u, 0u, 0u};
    }
    float* MOD = (float*)(a.ws + WS_CTL + CTL_MOD);
    for (int it = vcu; it < 768; it += G) {
        const int l = it / 384, r = it % 384, cb = r >> 6, kc = r & 63;
        const int col = cb * 2048 + tid * 4;
        f32x4 al = {0.f, 0.f, 0.f, 0.f}, ac = {0.f, 0.f, 0.f, 0.f};
        const float* wp = a.in[I_ADAW] + ((size_t)l * DM + kc * 32) * NIN + col;
#pragma unroll 8
        for (int k = 0; k < 32; ++k) {
            const float sl = siluf_(a.in[I_C][kc * 32 + k]), sc = siluf_(a.in[I_CCTX][kc * 32 + k]);
            const f32x4 w = *(const f32x4*)(wp + (size_t)k * NIN);
            al += sl * w; ac += sc * w;
        }
        if (kc == 0) { const f32x4 b = *(const f32x4*)(a.in[I_ADAB] + (size_t)l * NIN + col); al += b; ac += b; }
        float* ml = MOD + (size_t)(l * 2 + 0) * NIN + col; float* mc = MOD + (size_t)(l * 2 + 1) * NIN + col;
#pragma unroll
        for (int e = 0; e < 4; ++e) { unsafeAtomicAdd(ml + e, al[e]); unsafeAtomicAdd(mc + e, ac[e]); }
    }
}

template <int MODE>
__device__ __forceinline__ void phase_rows(const Args& a, int vcu, int G, int nrows, const float* gpost, const float* modcur, int gate_idx,
                                           const float* gnext, const float* modnext, int sh_idx) {
    const int tid = otid(), wave = tid >> 6, lane = tid & 63;
    const int gw = vcu * NWAVE + wave, NGW = G * NWAVE;
    float* X = (float*)(a.ws + WS_X); const float* Y = (const float*)(a.ws + WS_MRG); bf16_t* XN = (bf16_t*)(a.ws + WS_XN);
    for (int row = gw; row < nrows; row += NGW) {
        const int isctx = row >= SEQ ? 1 : 0;
        f32x4 x[8];
        if (MODE == 0) {
            const float* src = isctx ? a.in[I_CTX] + (size_t)(row - SEQ) * DM : a.in[I_X] + (size_t)row * DM;
#pragma unroll
            for (int j = 0; j < 8; ++j) x[j] = *(const f32x4*)(src + 4 * lane + 256 * j);
        } else {
            f32x4 y[8]; float ss = 0.f;
#pragma unroll
            for (int j = 0; j < 8; ++j) { x[j] = *(const f32x4*)(X + (size_t)row * DM + 4 * lane + 256 * j); y[j] = *(const f32x4*)(Y + (size_t)row * DM + 4 * lane + 256 * j);
                ss += (y[j][0] * y[j][0] + y[j][1] * y[j][1]) + (y[j][2] * y[j][2] + y[j][3] * y[j][3]); }
            const float rstd = 1.0f / sqrtf(wave_sum(ss) * (1.f / DM) + EPS);
            const float* gate = modcur + (size_t)isctx * NIN + gate_idx * DM;
#pragma unroll
            for (int j = 0; j < 8; ++j) { const int col = 4 * lane + 256 * j; const f32x4 gp = *(const f32x4*)(gpost + col), gt = *(const f32x4*)(gate + col);
                x[j] += gt * (y[j] * rstd * gp); }
        }
        if (MODE == 2) {
#pragma unroll
            for (int j = 0; j < 8; ++j) *(f32x4*)(a.out + (size_t)row * DM + 4 * lane + 256 * j) = x[j];
            continue;
        }
        float ss = 0.f;
#pragma unroll
        for (int j = 0; j < 8; ++j) { *(f32x4*)(X + (size_t)row * DM + 4 * lane + 256 * j) = x[j];
            ss += (x[j][0] * x[j][0] + x[j][1] * x[j][1]) + (x[j][2] * x[j][2] + x[j][3] * x[j][3]); }
        const float rstd = 1.0f / sqrtf(wave_sum(ss) * (1.f / DM) + EPS);
        const float* sh = modnext + (size_t)isctx * NIN + sh_idx * DM; const float* sc = sh + DM;
#pragma unroll
        for (int j = 0; j < 8; ++j) { const int col = 4 * lane + 256 * j; const f32x4 gn = *(const f32x4*)(gnext + col), s1 = *(const f32x4*)(sc + col), s0 = *(const f32x4*)(sh + col);
            const f32x4 h = (x[j] * rstd * gn) * (1.f + s1) + s0;
            u32x2 w; w.x = pk2(h[0], h[1]); w.y = pk2(h[2], h[3]); *(u32x2*)(XN + (size_t)row * DM + col) = w; }
    }
}

__device__ __forceinline__ void qk_prep_row(const Args& a, int layer, int row, int lane) {
    bf16_t* p = (bf16_t*)(a.ws + WS_PL) + (size_t)row * NIN;
    const int ax = lane >> 5, f = lane & 31, d1 = ax * 64 + f, d2 = d1 + 32;
    float cs = 1.f, sn = 0.f;
    if (row < SEQ) { const float pos = (float)(ax == 0 ? (row >> 6) : (row & 63)); const float inv = exp2f(-(float)f * (13.287712379549449f / 32.f)); const float ang = pos * inv; cs = cosf(ang); sn = sinf(ang); }
#pragma unroll
    for (int h = 0; h < 6; ++h) {
        const float* gn = (h < 4 ? a.in[I_AQN] : a.in[I_AKN]) + layer * HD;
        bf16_t* hp = p + h * HD;
        float x1 = bf2f(hp[d1]), x2 = bf2f(hp[d2]);
        const float rstd = 1.0f / sqrtf(wave_sum(x1 * x1 + x2 * x2) * (1.f / HD) + EPS);
        x1 = x1 * rstd * gn[d1]; x2 = x2 * rstd * gn[d2];
        hp[d1] = (bf16_t)f2bf(x1 * cs - x2 * sn); hp[d2] = (bf16_t)f2bf(x2 * cs + x1 * sn);
    }
}
__device__ __forceinline__ void dlt_row(const Args& a, int row, int lane) {
    const bf16_t* PL = (const bf16_t*)(a.ws + WS_PL); bf16_t* DLT = (bf16_t*)(a.ws + WS_DLT);
    const int base = row < SEQ ? 0 : SEQ, n = row < SEQ ? SEQ : CTXL, t = row - base, half = 1 << (lane >> 4);
    const int lo = max(t - half, 0), hi = min(t + half, n);
    float s[8];
#pragma unroll
    for (int e = 0; e < 8; ++e) s[e] = 0.f;
    for (int r = lo; r < hi; ++r) { const u32x4 w = *(const u32x4*)(PL + (size_t)(base + r) * NIN + B0 + lane * 8);
        s[0] += bflo(w.x); s[1] += bfhi(w.x); s[2] += bflo(w.y); s[3] += bfhi(w.y); s[4] += bflo(w.z); s[5] += bfhi(w.z); s[6] += bflo(w.w); s[7] += bfhi(w.w); }
    const float inv = 1.f / (float)(hi - lo);
    const u32x4 w = *(const u32x4*)(PL + (size_t)row * NIN + B0 + lane * 8);
    u32x4 o; o.x = pk2(s[0] * inv - bflo(w.x), s[1] * inv - bfhi(w.x)); o.y = pk2(s[2] * inv - bflo(w.y), s[3] * inv - bfhi(w.y));
    o.z = pk2(s[4] * inv - bflo(w.z), s[5] * inv - bfhi(w.z)); o.w = pk2(s[6] * inv - bflo(w.w), s[7] * inv - bfhi(w.w));
    *(u32x4*)(DLT + (size_t)row * 512 + lane * 8) = o;
}
constexpr int CP = 136;
__device__ __forceinline__ void cmix_unit(const Args& a, int layer, int unit, unsigned char* lds) {
    const int tid = otid(), wave = tid >> 6, lane = tid & 63, chunk = unit >> 2, g = unit & 3;
    const bf16_t* PL = (const bf16_t*)(a.ws + WS_PL); bf16_t* OUT = (bf16_t*)(a.ws + WS_OUTS) + (size_t)2 * MR * 512;
    bf16_t* vT = (bf16_t*)lds;
    bf16_t* wsL = (bf16_t*)(lds + 128 * CP * 2);
    float* st = (float*)(lds + 2 * 128 * CP * 2);
    const int t0 = chunk * 128;
    for (int i = 0; i < 16; ++i) {
        const int q = wave * 16 + i;
        const u32x4 w = *(const u32x4*)(PL + (size_t)(t0 + q) * NIN + C_V0 + lane * 8);
        float x[8] = {bflo(w.x), bfhi(w.x), bflo(w.y), bfhi(w.y), bflo(w.z), bfhi(w.z), bflo(w.w), bfhi(w.w)};
        float s = 0.f;
#pragma unroll
        for (int e = 0; e < 8; ++e) s += x[e];
        const float mean = wave_sum(s) * (1.f / 512.f); float q2 = 0.f;
#pragma unroll
        for (int e = 0; e < 8; ++e) { const float d = x[e] - mean; q2 += d * d; }
        const float rstd = 1.0f / sqrtf(wave_sum(q2) * (1.f / 512.f) + EPS);
        if (lane == 0) { st[2 * q] = mean; st[2 * q + 1] = rstd; }
    }
    __syncthreads();
    {
        const int q = tid & 127, cb = tid >> 7; const float mean = st[2 * q], rstd = st[2 * q + 1];
        const float* lg = a.in[I_CNG] + layer * 512 + g * 128 + cb * 32; const float* lb = a.in[I_CNB] + layer * 512 + g * 128 + cb * 32;
        const bf16_t* vp = PL + (size_t)(t0 + q) * NIN + C_V0 + g * 128 + cb * 32;
#pragma unroll
        for (int j = 0; j < 4; ++j) { const u32x4 w = *(const u32x4*)(vp + j * 8);
            const float x[8] = {bflo(w.x), bfhi(w.x), bflo(w.y), bfhi(w.y), bflo(w.z), bfhi(w.z), bflo(w.w), bfhi(w.w)};
#pragma unroll
            for (int e = 0; e < 8; ++e) { const int c = j * 8 + e; vT[(cb * 32 + c) * CP + q] = (bf16_t)f2bf((x[e] - mean) * rstd * lg[c] + lb[c]); } }
        const int p = tid >> 2, qb = (tid & 3) * 32; const float* wp = a.in[I_CWS] + ((size_t)(layer * 4 + g) * 128 + p) * 128 + qb;
#pragma unroll
        for (int j = 0; j < 8; ++j) { const f32x4 w = *(const f32x4*)(wp + j * 4); u32x2 o; o.x = pk2(w[0], w[1]); o.y = pk2(w[2], w[3]); *(u32x2*)(wsL + p * CP + qb + j * 4) = o; }
    }
    __syncthreads();
    {
        const int fr = lane & 15, fq = lane >> 4;
        f32x4 acc[8];
#pragma unroll
        for (int nb = 0; nb < 8; ++nb) acc[nb] = (f32x4){0.f, 0.f, 0.f, 0.f};
#pragma unroll
        for (int ks = 0; ks < 4; ++ks) {
            const bf16x8 wf = *(const bf16x8*)(wsL + (wave * 16 + fr) * CP + ks * 32 + fq * 8);
#pragma unroll
            for (int nb = 0; nb < 8; ++nb) { const bf16x8 vf = *(const bf16x8*)(vT + (nb * 16 + fr) * CP + ks * 32 + fq * 8);
                acc[nb] = __builtin_amdgcn_mfma_f32_16x16x32_bf16(vf, wf, acc[nb], 0, 0, 0); }
        }
        const int p = wave * 16 + fr; const float bs = a.in[I_CBS][(layer * 4 + g) * 128 + p];
        const bf16_t* up = PL + (size_t)(t0 + p) * NIN + C_U0 + g * 128; bf16_t* op = OUT + (size_t)(t0 + p) * 512 + g * 128;
#pragma unroll
        for (int nb = 0; nb < 8; ++nb) { const int c = nb * 16 + 4 * fq; const u32x2 uw = *(const u32x2*)(up + c);
            u32x2 o; o.x = pk2((acc[nb][0] + bs) * bflo(uw.x), (acc[nb][1] + bs) * bfhi(uw.x)); o.y = pk2((acc[nb][2] + bs) * bflo(uw.y), (acc[nb][3] + bs) * bfhi(uw.y));
            *(u32x2*)(op + c) = o; }
    }
    __syncthreads();
}

template <int MODE>
__device__ __forceinline__ void attn_simple_item(const bf16_t* PL, int qcol, int kcol, int vcol, bf16_t* O, int qrow, int h, int kvh, int kbeg, int kend, const float* rpb, int lane) {
    constexpr float C = 0.088388347648318440f * 1.4426950408889634f;
    const int part = lane & 3;
    float q[32], o[32];
    { const bf16_t* qp = PL + (size_t)qrow * NIN + qcol + h * HD + part * 32;
#pragma unroll
      for (int j = 0; j < 4; ++j) { const u32x4 w = *(const u32x4*)(qp + j * 8);
          q[j * 8 + 0] = bflo(w.x) * C; q[j * 8 + 1] = bfhi(w.x) * C; q[j * 8 + 2] = bflo(w.y) * C; q[j * 8 + 3] = bfhi(w.y) * C;
          q[j * 8 + 4] = bflo(w.z) * C; q[j * 8 + 5] = bfhi(w.z) * C; q[j * 8 + 6] = bflo(w.w) * C; q[j * 8 + 7] = bfhi(w.w) * C; } }
#pragma unroll
    for (int d = 0; d < 32; ++d) o[d] = 0.f;
    float mrun = -1e30f, l = 0.f;
    const int r = qrow >> 6, c = qrow & 63, r0 = min(max(r - 4, 0), 120), c0 = min(max(c - 8, 0), 48);
    const int nk = MODE == 0 ? (kend - kbeg) : 384;
    for (int idx = 0; idx < nk; ++idx) {
        int krow; float bias = 0.f;
        if (MODE == 0) krow = kbeg + idx;
        else if (idx < 128) { const int i = idx >> 4, j = idx & 15; krow = (r0 + i) * GW + c0 + j; bias = rpb[(h * 15 + (r0 + i - r + 7)) * 31 + (c0 + j - c + 15)] * 1.4426950408889634f; }
        else krow = SEQ + idx - 128;
        const bf16_t* kp = PL + (size_t)krow * NIN + kcol + kvh * HD + part * 32;
        float s = 0.f;
#pragma unroll
        for (int j = 0; j < 4; ++j) { const u32x4 w = *(const u32x4*)(kp + j * 8);
            s += q[j * 8 + 0] * bflo(w.x) + q[j * 8 + 1] * bfhi(w.x) + q[j * 8 + 2] * bflo(w.y) + q[j * 8 + 3] * bfhi(w.y)
               + q[j * 8 + 4] * bflo(w.z) + q[j * 8 + 5] * bfhi(w.z) + q[j * 8 + 6] * bflo(w.w) + q[j * 8 + 7] * bfhi(w.w); }
        s += __shfl_xor(s, 1); s += __shfl_xor(s, 2);
        s += bias;
        const float mn = fmaxf(mrun, s), alpha = exp2f(mrun - mn), p = exp2f(s - mn);
        l = l * alpha + p; mrun = mn;
        const bf16_t* vp = PL + (size_t)krow * NIN + vcol + kvh * HD + part * 32;
#pragma unroll
        for (int j = 0; j < 4; ++j) { const u32x4 w = *(const u32x4*)(vp + j * 8);
            o[j * 8 + 0] = o[j * 8 + 0] * alpha + p * bflo(w.x); o[j * 8 + 1] = o[j * 8 + 1] * alpha + p * bfhi(w.x);
            o[j * 8 + 2] = o[j * 8 + 2] * alpha + p * bflo(w.y); o[j * 8 + 3] = o[j * 8 + 3] * alpha + p * bfhi(w.y);
            o[j * 8 + 4] = o[j * 8 + 4] * alpha + p * bflo(w.z); o[j * 8 + 5] = o[j * 8 + 5] * alpha + p * bfhi(w.z);
            o[j * 8 + 6] = o[j * 8 + 6] * alpha + p * bflo(w.w); o[j * 8 + 7] = o[j * 8 + 7] * alpha + p * bfhi(w.w); }
    }
    const float il = 1.f / l;
    bf16_t* op = O + (size_t)qrow * 512 + h * HD + part * 32;
#pragma unroll
    for (int j = 0; j < 4; ++j) { u32x4 w; w.x = pk2(o[j * 8 + 0] * il, o[j * 8 + 1] * il); w.y = pk2(o[j * 8 + 2] * il, o[j * 8 + 3] * il);
        w.z = pk2(o[j * 8 + 4] * il, o[j * 8 + 5] * il); w.w = pk2(o[j * 8 + 6] * il, o[j * 8 + 7] * il); *(u32x4*)(op + j * 8) = w; }
}


namespace att {
using s16x4 = __attribute__((ext_vector_type(4))) short;
using f32x16 = __attribute__((ext_vector_type(16))) float;
constexpr int KVBLK = 64;
constexpr float SCALE = 0.088388347648318440f, THR = 8.f;
constexpr int SHM_V = KVBLK * HD * 2, SHM_K = KVBLK * HD * 2, SHM_ATTN = 2 * SHM_V + 2 * SHM_K + NWAVE * 64 * 4;
#define KSWZ(row, colB) ((row) * 256 + ((colB) ^ (((row) & 7) << 4)))
#define SBAR() __builtin_amdgcn_sched_barrier(0)
__device__ __forceinline__ int crow(int r, int hi) { return (r & 3) + 8 * (r >> 2) + 4 * hi; }
__device__ __forceinline__ unsigned cvtpk(float lo, float hi) { unsigned r; asm volatile("v_cvt_pk_bf16_f32 %0, %1, %2" : "=v"(r) : "v"(lo), "v"(hi)); return r; }
__device__ __forceinline__ void partialSM(f32x16& p0, f32x16& p1, float& m_reg, float& mn, float& alpha) {
  constexpr float C = SCALE * 1.4426950408889634f;
  float pmax = p0[0];
#pragma unroll
  for (int r = 1; r < 16; ++r) pmax = fmaxf(pmax, p0[r]);
#pragma unroll
  for (int r = 0; r < 16; ++r) pmax = fmaxf(pmax, p1[r]);
  { auto rr = __builtin_amdgcn_permlane32_swap(__float_as_uint(pmax), __float_as_uint(pmax), false, false);
    pmax = fmaxf(__uint_as_float(rr[0]), __uint_as_float(rr[1])); }
  if (__builtin_expect(__all(pmax - m_reg <= THR / SCALE), 1)) { mn = m_reg; alpha = 1.f; }
  else { mn = fmaxf(m_reg, pmax); alpha = __builtin_amdgcn_exp2f((m_reg - mn) * C); m_reg = mn; }
  float mnC = -mn * C;
#pragma unroll
  for (int r = 0; r < 16; ++r) p0[r] = fmaf(p0[r], C, mnC);
#pragma unroll
  for (int r = 0; r < 16; ++r) p1[r] = fmaf(p1[r], C, mnC);
#pragma unroll
  for (int r = 0; r < 16; ++r) p0[r] = __builtin_amdgcn_exp2f(p0[r]);
}
__device__ __forceinline__ void finishSM(f32x16& p0, f32x16& p1, float alpha, float& l_reg, bf16x8& pa0, bf16x8& pa1, bf16x8& pa2, bf16x8& pa3) {
#pragma unroll
  for (int r = 0; r < 16; ++r) p1[r] = __builtin_amdgcn_exp2f(p1[r]);
  float ps = 0;
#pragma unroll
  for (int r = 0; r < 16; ++r) ps += p0[r];
#pragma unroll
  for (int r = 0; r < 16; ++r) ps += p1[r];
  { auto rr = __builtin_amdgcn_permlane32_swap(__float_as_uint(ps), __float_as_uint(ps), false, false);
    ps = __uint_as_float(rr[0]) + __uint_as_float(rr[1]); }
  l_reg = l_reg * alpha + ps;
#define PK4(P, BASE, OUT) do { unsigned a0 = cvtpk(P[BASE + 0], P[BASE + 1]), a1 = cvtpk(P[BASE + 2], P[BASE + 3]);   \
    unsigned b0 = cvtpk(P[BASE + 4], P[BASE + 5]), b1 = cvtpk(P[BASE + 6], P[BASE + 7]);                              \
    auto r0 = __builtin_amdgcn_permlane32_swap(a0, b0, false, false); auto r1 = __builtin_amdgcn_permlane32_swap(a1, b1, false, false); \
    u32x4 w = {r0[0], r1[0], r0[1], r1[1]}; OUT = *reinterpret_cast<bf16x8*>(&w); } while (0)
  PK4(p0, 0, pa0); PK4(p0, 8, pa1); PK4(p1, 0, pa2); PK4(p1, 8, pa3);
#undef PK4
}
__device__ __forceinline__ void qkt(f32x16& p0, f32x16& p1, const char* Ks, const bf16x8* qr, int r32, int hi) {
  p0 = f32x16{}; p1 = f32x16{};
#pragma unroll
  for (int d0 = 0; d0 < 8; ++d0) { int cb = (d0 * 16 + hi * 8) * 2;
    bf16x8 b0 = *reinterpret_cast<const bf16x8*>(Ks + KSWZ(r32, cb));
    bf16x8 b1 = *reinterpret_cast<const bf16x8*>(Ks + KSWZ(32 + r32, cb));
    p0 = __builtin_amdgcn_mfma_f32_32x32x16_bf16(b0, qr[d0], p0, 0, 0, 0);
    p1 = __builtin_amdgcn_mfma_f32_32x32x16_bf16(b1, qr[d0], p1, 0, 0, 0); }
}
__device__ __forceinline__ int v_st(int k, int c) { const int kk = (k & ~0xC) | ((k & 4) << 1) | ((k & 8) >> 1); return ((kk >> 3) * 4 + (c >> 5)) * 512 + ((kk & 7) * 32 + (c & 31)) * 2; }
__device__ __forceinline__ int v_rd_base(int lane) { return ((lane & 3) << 3) | (((lane >> 2) & 3) << 6) | (((lane >> 4) & 1) << 5) | (((lane >> 5) & 1) << 8); }
constexpr int v_rd_off(int d0, int ks, int half) { return d0 * 512 + ks * 4096 + half * 2048; }
template <int OFF> __device__ __forceinline__ s16x4 tr_read(int vb) {
  s16x4 r; asm volatile("ds_read_b64_tr_b16 %0, %1 offset:%2" : "=&v"(r) : "v"(vb), "i"(OFF) : "memory"); return r;
}
template <int D0> __device__ __forceinline__ void pv_one(f32x16& od, int vb, bf16x8 pa0, bf16x8 pa1, bf16x8 pa2, bf16x8 pa3) {
  const s16x4 l0 = tr_read<v_rd_off(D0, 0, 0)>(vb), h0 = tr_read<v_rd_off(D0, 0, 1)>(vb), l1 = tr_read<v_rd_off(D0, 1, 0)>(vb), h1 = tr_read<v_rd_off(D0, 1, 1)>(vb);
  const s16x4 l2 = tr_read<v_rd_off(D0, 2, 0)>(vb), h2 = tr_read<v_rd_off(D0, 2, 1)>(vb), l3 = tr_read<v_rd_off(D0, 3, 0)>(vb), h3 = tr_read<v_rd_off(D0, 3, 1)>(vb);
  asm volatile("s_waitcnt lgkmcnt(0)" ::: "memory"); SBAR();
#define PK(L, H) (bf16x8){L[0], L[1], L[2], L[3], H[0], H[1], H[2], H[3]}
  od = __builtin_amdgcn_mfma_f32_32x32x16_bf16(pa0, PK(l0, h0), od, 0, 0, 0);
  od = __builtin_amdgcn_mfma_f32_32x32x16_bf16(pa1, PK(l1, h1), od, 0, 0, 0);
  od = __builtin_amdgcn_mfma_f32_32x32x16_bf16(pa2, PK(l2, h2), od, 0, 0, 0);
  od = __builtin_amdgcn_mfma_f32_32x32x16_bf16(pa3, PK(l3, h3), od, 0, 0, 0);
#undef PK
}
__device__ __forceinline__ void pv_d0(f32x16* o, int vb, bf16x8 pa0, bf16x8 pa1, bf16x8 pa2, bf16x8 pa3) {
  pv_one<0>(o[0], vb, pa0, pa1, pa2, pa3); pv_one<1>(o[1], vb, pa0, pa1, pa2, pa3); pv_one<2>(o[2], vb, pa0, pa1, pa2, pa3); pv_one<3>(o[3], vb, pa0, pa1, pa2, pa3);
}
__device__ __forceinline__ void na_hook(f32x16& p0, f32x16& p1, int kr, int qr, int qc, int hi, const float* rpbh) {
  const int r0 = min(max(qr - 4, 0), 120), c0 = min(max(qc - 8, 0), 48);
  if (kr < r0 || kr >= r0 + 8) {
#pragma unroll
    for (int r = 0; r < 16; ++r) { p0[r] = -1e30f; p1[r] = -1e30f; }
  } else {
    const float* bp = rpbh + (kr - qr + 7) * 31 + 15 - qc;
#pragma unroll
    for (int r = 0; r < 16; ++r) {
      const int kc0 = crow(r, hi), kc1 = 32 + kc0;
      const bool v0 = (unsigned)(kc0 - c0) < 16u, v1 = (unsigned)(kc1 - c0) < 16u;
      const float b0 = v0 ? bp[kc0] : 0.f, b1 = v1 ? bp[kc1] : 0.f;
      p0[r] = v0 ? fmaf(b0, 1.f / SCALE, p0[r]) : -1e30f;
      p1[r] = v1 ? fmaf(b1, 1.f / SCALE, p1[r]) : -1e30f;
    }
  }
}
template <int MODE, bool DIRECT>
__device__ __forceinline__ void attn_unit(const bf16_t* __restrict__ PL, int qrow0, int qcol, int kcol, int vcol, int NT, int base0, int n0, int base1,
                                          const float* rpbh, bf16_t* Obf, float* Opart, float* LSE, char* lds) {
  const int tid = otid(), wid = tid >> 6, lane = tid & 63, r32 = lane & 31, hi = lane >> 5;
  char* V_lds = lds; char* K_lds = lds + 2 * SHM_V;
  float* wsf = (float*)(lds + 2 * SHM_V + 2 * SHM_K) + wid * 64; float* li_l = wsf; float* al_l = wsf + 32;
  float m_reg = -1e30f, l_reg = 0; f32x16 o[4] = {}; bf16x8 qr[8];
  const bf16_t* Qw = PL + (size_t)(qrow0 + wid * 32 + r32) * NIN + qcol + hi * 8;
#pragma unroll
  for (int d0 = 0; d0 < 8; ++d0) qr[d0] = *reinterpret_cast<const bf16x8*>(Qw + d0 * 16);
  const int qtok = qrow0 + wid * 32 + r32, qgr = qtok >> 6, qgc = qtok & 63;
  const int sr = tid >> 4, sc = (tid & 15) * 8, vst0 = v_st(sr, sc), vst1 = v_st(32 + sr, sc);
  const int vb0 = (int)(uintptr_t)V_lds + v_rd_base(lane);
  const bf16_t* Kg = PL + (size_t)sr * NIN + kcol + sc; const bf16_t* Vg = PL + (size_t)sr * NIN + vcol + sc;
  struct { bf16x8 vs0, vs1, ks0, ks1; } sr_[2];
#define KROW(j) ((j) < n0 ? base0 + 64 * (j) : base1 + 64 * ((j) - n0))
#define SLOAD(i, j) do { const size_t ko_ = (size_t)KROW(j) * NIN; sr_[i].vs0 = *reinterpret_cast<const bf16x8*>(Vg + ko_); sr_[i].vs1 = *reinterpret_cast<const bf16x8*>(Vg + ko_ + (size_t)32 * NIN); \
    sr_[i].ks0 = *reinterpret_cast<const bf16x8*>(Kg + ko_); sr_[i].ks1 = *reinterpret_cast<const bf16x8*>(Kg + ko_ + (size_t)32 * NIN); } while (0)
#define SWRITE(b, i) do { *(bf16x8*)(V_lds + (b) * SHM_V + vst0) = sr_[i].vs0;          \
    *(bf16x8*)(V_lds + (b) * SHM_V + vst1) = sr_[i].vs1; int kc = sc * 2;               \
    *(bf16x8*)(K_lds + (b) * SHM_K + KSWZ(sr, kc)) = sr_[i].ks0;                       \
    *(bf16x8*)(K_lds + (b) * SHM_K + KSWZ(32 + sr, kc)) = sr_[i].ks1; } while (0)
#define SWAIT() asm volatile("s_waitcnt vmcnt(4)" ::: "memory")
#define RESC(a) do { if (__any((a) < 1.f)) { if (hi == 0) al_l[r32] = (a); asm volatile("s_waitcnt lgkmcnt(0)" ::: "memory"); \
    _Pragma("unroll") for (int d = 0; d < 4; ++d) _Pragma("unroll") for (int r = 0; r < 16; ++r) o[d][r] *= al_l[crow(r, hi)]; } } while (0)
#define HOOK(P0, P1, j) do { if (MODE == 1) { if ((j) >= n0) na_hook(P0, P1, (base1 >> 6) + (j) - n0, qgr, qgc, hi, rpbh); } } while (0)
  f32x16 pA0, pA1, pB0, pB1; float mnA, mnB, alA, alB; bf16x8 pa0, pa1, pa2, pa3;
  constexpr int SE = 0, SO = 1;
  SLOAD(SE, 0); asm volatile("s_waitcnt vmcnt(0)" ::: "memory"); SWRITE(0, SE); __syncthreads();
  qkt(pA0, pA1, K_lds, qr, r32, hi); HOOK(pA0, pA1, 0); partialSM(pA0, pA1, m_reg, mnA, alA);
  SLOAD(SO, 1); if (2 < NT) SLOAD(SE, 2);
  SWAIT(); SWRITE(1, SO); __syncthreads();
  for (int j = 1; j + 1 < NT; j += 2) {
    SBAR(); qkt(pB0, pB1, K_lds + SHM_K, qr, r32, hi); HOOK(pB0, pB1, j);
    finishSM(pA0, pA1, alA, l_reg, pa0, pa1, pa2, pa3); SBAR();
    SLOAD(SO, j + 2); SBAR();
    pv_d0(o, vb0, pa0, pa1, pa2, pa3); partialSM(pB0, pB1, m_reg, mnB, alB);
    __syncthreads(); SWAIT(); SWRITE(0, SE);
    RESC(alB); __syncthreads();
    SBAR(); qkt(pA0, pA1, K_lds, qr, r32, hi); HOOK(pA0, pA1, j + 1);
    finishSM(pB0, pB1, alB, l_reg, pa0, pa1, pa2, pa3); SBAR();
    if (j + 3 < NT) SLOAD(SE, j + 3); SBAR();
    pv_d0(o, vb0 + SHM_V, pa0, pa1, pa2, pa3); partialSM(pA0, pA1, m_reg, mnA, alA);
    __syncthreads(); SWAIT(); SWRITE(1, SO);
    RESC(alA); __syncthreads();
  }
  SBAR(); qkt(pB0, pB1, K_lds + SHM_K, qr, r32, hi); HOOK(pB0, pB1, NT - 1);
  finishSM(pA0, pA1, alA, l_reg, pa0, pa1, pa2, pa3); SBAR();
  pv_d0(o, vb0, pa0, pa1, pa2, pa3); partialSM(pB0, pB1, m_reg, mnB, alB);
  __syncthreads(); RESC(alB);
  finishSM(pB0, pB1, alB, l_reg, pa0, pa1, pa2, pa3); SBAR();
  pv_d0(o, vb0 + SHM_V, pa0, pa1, pa2, pa3);
  if (hi == 0) li_l[r32] = l_reg; asm volatile("s_waitcnt lgkmcnt(0)" ::: "memory");
  float rli[16];
#pragma unroll
  for (int r = 0; r < 16; ++r) rli[r] = __builtin_amdgcn_rcpf(li_l[crow(r, hi)]);
  if (DIRECT) {
    bf16_t* Ow = Obf + (size_t)(wid * 32) * 512;
#pragma unroll
    for (int r = 0; r < 16; ++r) { const int orow = crow(r, hi);
#pragma unroll
      for (int d0 = 0; d0 < 4; ++d0) Ow[(size_t)orow * 512 + d0 * 32 + r32] = (bf16_t)f2bf(o[d0][r] * rli[r]); }
  } else {
    float* Ow = Opart + (size_t)(wid * 32) * 512;
#pragma unroll
    for (int r = 0; r < 16; ++r) { const int orow = crow(r, hi);
#pragma unroll
      for (int d0 = 0; d0 < 4; ++d0) Ow[(size_t)orow * 512 + d0 * 32 + r32] = o[d0][r] * rli[r]; }
    if (hi == 0) LSE[(size_t)(wid * 32 + r32) * 4] = m_reg * (SCALE * 1.4426950408889634f) + log2f(l_reg);
  }
  __syncthreads();
#undef KROW
#undef SLOAD
#undef SWRITE
#undef SWAIT
#undef RESC
#undef HOOK
}
}

__device__ __forceinline__ void phase_small(const Args& a, unsigned char* lds, int vcu, int G, int layer, bool last) {
    const int tid = otid(), wave = tid >> 6, lane = tid & 63;
    const int gw = vcu * NWAVE + wave, NGW = G * NWAVE;
    const int nrows = last ? SEQ : MR;
    for (int row = gw; row < MR; row += NGW) qk_prep_row(a, layer, row, lane);
    for (int row = gw; row < nrows; row += NGW) dlt_row(a, row, lane);
    const int nunits = (nrows / 128) * 4;
    for (int u = vcu; u < nunits; u += G) cmix_unit(a, layer, u, lds);
    const bf16_t* PL = (const bf16_t*)(a.ws + WS_PL); bf16_t* OD = (bf16_t*)(a.ws + WS_OUTS) + (size_t)3 * MR * 512;
    const float* rpb = a.in[I_RPB] + layer * 4 * 15 * 31;
    const int n_lat = (SEQ / 16) * 4, n_ctx = last ? 0 : (CTXL / 16) * 4;
    for (int it = gw; it < n_lat + n_ctx; it += NGW) {
        if (it < n_lat) { const int h = it & 3, qt = it >> 2; attn_simple_item<1>(PL, D_Q0, D_K0, D_V0, OD, qt * 16 + (lane >> 2), h, h, 0, 0, rpb, lane); }
        else { const int j = it - n_lat, h = j & 3, qt = j >> 2; attn_simple_item<0>(PL, D_Q0, D_K0, D_V0, OD, SEQ + qt * 16 + (lane >> 2), h, h, SEQ, MR, rpb, lane); }
    }
}
constexpr size_t OPART_LSE = (size_t)2 * SEQ * 512 * 4;
__device__ __forceinline__ void phase_attn_a(const Args& a, unsigned char* lds, int vcu, int G, bool last) {
    const bf16_t* PL = (const bf16_t*)(a.ws + WS_PL); bf16_t* OA = (bf16_t*)(a.ws + WS_OUTS);
    float* Opart = (float*)(a.ws + WS_MRG); float* LSE = (float*)(a.ws + WS_MRG + OPART_LSE);
    const int nu = 256 + (last ? 0 : 4);
    for (int u = vcu; u < nu; u += G) {
        if (u < 256) { const int half = u >> 7, h = (u >> 5) & 3, qb = u & 31, kvh = h >> 1;
            att::attn_unit<0, false>(PL, qb * 256, A_Q0 + h * HD, A_K0 + kvh * HD, A_V0 + kvh * HD, 66, half * 4224, 66, 0, nullptr, nullptr,
                                     Opart + ((size_t)half * SEQ + qb * 256) * 512 + h * HD, LSE + ((size_t)half * SEQ + qb * 256) * 4 + h, (char*)lds); }
        else { const int h = u - 256, kvh = h >> 1;
            att::attn_unit<0, true>(PL, SEQ, A_Q0 + h * HD, A_K0 + kvh * HD, A_V0 + kvh * HD, 4, SEQ, 4, 0, nullptr, OA + (size_t)SEQ * 512 + h * HD, nullptr, nullptr, (char*)lds); }
    }
}
__device__ __forceinline__ void phase_combine_a(const Args& a, int vcu, int G) {
    const int tid = otid(), wave = tid >> 6, lane = tid & 63;
    const int gw = vcu * NWAVE + wave, NGW = G * NWAVE;
    const float* Opart = (const float*)(a.ws + WS_MRG); const float* LSE = (const float*)(a.ws + WS_MRG + OPART_LSE); bf16_t* OA = (bf16_t*)(a.ws + WS_OUTS);
    for (int row = gw; row < SEQ; row += NGW) {
        const float l0 = LSE[(size_t)row * 4 + (lane >> 4)], l1 = LSE[((size_t)SEQ + row) * 4 + (lane >> 4)];
        const float mx = fmaxf(l0, l1), w0 = exp2f(l0 - mx), w1 = exp2f(l1 - mx), inv = 1.f / (w0 + w1), c0 = w0 * inv, c1 = w1 * inv;
        const float* p0 = Opart + (size_t)row * 512 + lane * 8; const float* p1 = p0 + (size_t)SEQ * 512;
        const f32x4 a0 = *(const f32x4*)p0, a1 = *(const f32x4*)(p0 + 4), b0 = *(const f32x4*)p1, b1 = *(const f32x4*)(p1 + 4);
        const f32x4 r0 = a0 * c0 + b0 * c1, r1 = a1 * c0 + b1 * c1;
        u32x4 w; w.x = pk2(r0[0], r0[1]); w.y = pk2(r0[2], r0[3]); w.z = pk2(r1[0], r1[1]); w.w = pk2(r1[2], r1[3]);
        *(u32x4*)(OA + (size_t)row * 512 + lane * 8) = w;
    }
}

constexpr int NPHASE = 22;
__global__ void __launch_bounds__(NTHR, 2) fwd(Args a) {
    extern __shared__ __attribute__((aligned(16))) unsigned char lds[];
    const int G = gridDim.x, bx = blockIdx.x;
    const int vcu = (G % 8 == 0) ? (bx % 8) * (G / 8) + bx / 8 : bx;
    unsigned char* ws = a.ws;
    const float* MOD = (const float*)(ws + WS_CTL + CTL_MOD);
#if MK_COOP
    cg::grid_group grid = cg::this_grid();
#define SEAM(p) do { if (lo <= (p) && (p) + 1 < hi) grid.sync(); } while (0)
#else
#define SEAM(p) do { } while (0)
#endif
    const int lo = a.ph_lo, hi = a.ph_hi;
#ifndef PHMASK
#define PHMASK 0xffffffu
#endif
#define IN(p) (lo <= (p) && (p) < hi && ((PHMASK >> ((p) < 2 ? (p) : 2 + ((p) - 2) % 10)) & 1u))
    if (IN(0)) { phase_prologue(a, lds, vcu, G); } SEAM(0);
    if (IN(1)) { phase_rows<0>(a, vcu, G, MR, nullptr, nullptr, 0, a.in[I_NPRE_MIX], MOD, 0); } SEAM(1);
#pragma nounroll
    for (int l = 0; l < 2; ++l) {
        const bool last = (l == 1);
        const int pb = 2 + l * 10;
        unsigned char* wb = ws + WS_W + (size_t)l * WPL;
        const float* modl = MOD + (size_t)l * 2 * NIN;
        const int Mrows = last ? SEQ : MR;
        if (IN(pb + 0)) {
            Gemm g{(const bf16_t*)(ws + WS_XN), (const bf16_t*)(wb + W_IN), DM, DM, DM}; StaticOrder S; S.init(MR, NIN, G, bx);
            EpiIn E{(bf16_t*)(ws + WS_PL)}; gemm_phase((PG8_LAS unsigned char*)lds, g, S, E);
        } SEAM(pb + 0);
        if (IN(pb + 1)) { phase_small(a, lds, vcu, G, l, last); } SEAM(pb + 1);
        if (IN(pb + 2)) { phase_attn_a(a, lds, vcu, G, last); } SEAM(pb + 2);
        if (IN(pb + 3)) {
            phase_combine_a(a, vcu, G);
            Gemm g{(const bf16_t*)(ws + WS_DLT), (const bf16_t*)(wb + W_B), 512, 512, 512}; StaticOrder S; S.init(Mrows, 512, G, bx);
            EpiScale E{(bf16_t*)(ws + WS_OUTS) + (size_t)1 * MR * 512, 512, a.in[I_BSCALE] + l * 512}; gemm_phase((PG8_LAS unsigned char*)lds, g, S, E);
        } SEAM(pb + 3);
        if (IN(pb + 4)) {
            Gemm g{(const bf16_t*)(ws + WS_OUTS), (const bf16_t*)(wb + W_BR), 512, 512, 512}; MergeOrder S; S.base.init(Mrows, DM, G, bx);
            EpiMerge E{(const bf16_t*)(ws + WS_PL), (float*)(ws + WS_MRG), (bf16_t*)(ws + WS_MRGB)}; gemm_phase((PG8_LAS unsigned char*)lds, g, S, E);
        } SEAM(pb + 4);
        if (IN(pb + 5)) {
            Gemm g{(const bf16_t*)(ws + WS_MRGB), (const bf16_t*)(wb + W_O), DM, DM, DM}; StaticOrder S; S.init(Mrows, DM, G, bx);
            EpiF32 E{(float*)(ws + WS_MRG), DM}; gemm_phase((PG8_LAS unsigned char*)lds, g, S, E);
        } SEAM(pb + 5);
        if (IN(pb + 6)) { phase_rows<1>(a, vcu, G, Mrows, a.in[I_NPOST_MIX] + l * DM, modl, 2, a.in[I_NPRE_FFN] + l * DM, modl, 3); } SEAM(pb + 6);
        if (IN(pb + 7)) {
            Gemm g{(const bf16_t*)(ws + WS_XN), (const bf16_t*)(wb + W_GU), DM, DM, DM}; StaticOrder S; S.init(Mrows, 2 * FF, G, bx);
            EpiSwiglu E{(bf16_t*)(ws + WS_H)}; gemm_phase((PG8_LAS unsigned char*)lds, g, S, E);
        } SEAM(pb + 7);
        if (IN(pb + 8)) {
            Gemm g{(const bf16_t*)(ws + WS_H), (const bf16_t*)(wb + W_D), FF, FF, FF}; StaticOrder S; S.init(Mrows, DM, G, bx);
            EpiF32 E{(float*)(ws + WS_MRG), DM}; gemm_phase((PG8_LAS unsigned char*)lds, g, S, E);
        } SEAM(pb + 8);
        if (IN(pb + 9)) {
            if (!last) phase_rows<1>(a, vcu, G, MR, a.in[I_NPOST_FFN] + l * DM, modl, 5, a.in[I_NPRE_MIX] + (l + 1) * DM, MOD + (size_t)(l + 1) * 2 * NIN, 0);
            else phase_rows<2>(a, vcu, G, SEQ, a.in[I_NPOST_FFN] + l * DM, modl, 5, nullptr, nullptr, 0);
        }
        if (!last) SEAM(pb + 9);
    }
#undef IN
#undef SEAM
}

extern "C" void kernel_launch(void* const* d_in, const int* in_sizes, int n_in, void* d_out, int out_size, void* d_ws, size_t ws_size, hipStream_t stream) {
    static int grid = 0;
    if (grid == 0) {
        if (n_in != N_IN || out_size != SEQ * DM || ws_size < WS_END) { fprintf(stderr, "kernel_launch: unexpected shapes (n_in %d out %d ws %zu)\n", n_in, out_size, ws_size); grid = -1; return; }
        if (hipFuncSetAttribute((const void*)fwd, hipFuncAttributeMaxDynamicSharedMemorySize, LDS_BYTES) != hipSuccess) { fprintf(stderr, "kernel_launch: hipFuncSetAttribute failed\n"); grid = -1; return; }
        int dev = 0, cus = 0, per_cu = 0;
        hipGetDevice(&dev); hipDeviceGetAttribute(&cus, hipDeviceAttributeMultiprocessorCount, dev);
        hipOccupancyMaxActiveBlocksPerMultiprocessor(&per_cu, (const void*)fwd, NTHR, LDS_BYTES);
        if (per_cu < 1) { fprintf(stderr, "kernel_launch: occupancy query says %d blocks per CU\n", per_cu); per_cu = 1; }
        (void)hipGetLastError();
        grid = cus * per_cu;
        fprintf(stderr, "kernel_launch: grid %d (cus %d x %d)\n", grid, cus, per_cu);
    }
    if (grid < 0) return;
    hipMemsetAsync((char*)d_ws + WS_CTL, 0, CTL_BYTES, stream);
    Args a{};
    for (int i = 0; i < N_IN; ++i) a.in[i] = (const float*)d_in[i];
    a.out = (float*)d_out; a.ws = (unsigned char*)d_ws;
#if MK_COOP
    a.ph_lo = 0; a.ph_hi = NPHASE;
    void* params[] = {&a};
    hipError_t e = hipLaunchCooperativeKernel((const void*)fwd, dim3(grid), dim3(NTHR), params, LDS_BYTES, stream);
    if (e != hipSuccess) fprintf(stderr, "kernel_launch: cooperative launch failed: %s (grid %d)\n", hipGetErrorString(e), grid);
#else
    for (int p = 0; p < NPHASE; ++p) {
        a.ph_lo = p; a.ph_hi = p + 1;
        hipLaunchKernelGGL(fwd, dim3(grid), dim3(NTHR), LDS_BYTES, stream, a);
    }
#endif
}
```

```cpp
#include <hip/hip_runtime.h>
#include <hip/hip_cooperative_groups.h>
#include <cstdio>
#include <cstdint>
namespace cg = cooperative_groups;

#ifndef MK_COOP
#define MK_COOP 1
#endif

typedef unsigned short bf16_t;
typedef short bf16x8 __attribute__((ext_vector_type(8)));
typedef float f32x4 __attribute__((ext_vector_type(4)));
typedef unsigned u32x4 __attribute__((ext_vector_type(4)));
typedef unsigned u32x2 __attribute__((ext_vector_type(2)));

constexpr int DM = 2048, SEQ = 8192, CTXL = 256, MR = SEQ + CTXL, NIN = 12288, FF = 5632, HD = 128, GW = 64;
constexpr int A_Q0 = 0, A_K0 = 512, A_V0 = 768, B0 = 1024, C_U0 = 1536, C_V0 = 2048, D_Q0 = 2560, D_K0 = 3072, D_V0 = 3584, G0 = 4096;
constexpr float EPS = 1e-6f;
constexpr int NTHR = 512, NWAVE = 8;
constexpr int LDS_BYTES = 147456;

enum { I_X = 0, I_C, I_CTX, I_CCTX, I_ADAW, I_ADAB, I_NPRE_MIX, I_NPOST_MIX, I_NPRE_FFN, I_NPOST_FFN, I_WIN, I_AQN, I_AKN, I_BW, I_BSCALE,
       I_CNG, I_CNB, I_CWS, I_CBS, I_RPB, I_WBR, I_WO, I_WG, I_WU, I_WD, N_IN };

constexpr size_t MiB = 1u << 20;
constexpr size_t WS_CTL = 0, CTL_BYTES = 1 * MiB;
constexpr size_t CTL_MOD = 256 * 1024;
constexpr size_t WS_W = 2 * MiB, WPL = 131 * MiB;
constexpr size_t W_IN = 0, W_BR = 48 * MiB, W_O = 56 * MiB, W_GU = 64 * MiB, W_D = 108 * MiB, W_B = 130 * MiB;
constexpr size_t WS_X = 264 * MiB;
constexpr size_t WS_XN = 330 * MiB;
constexpr size_t WS_PL = 363 * MiB;
constexpr size_t WS_H = WS_PL;
constexpr size_t WS_OUTS = 561 * MiB;
constexpr size_t WS_DLT = 594 * MiB;
constexpr size_t WS_MRG = 603 * MiB;
constexpr size_t WS_MRGB = 669 * MiB;
constexpr size_t WS_END = 702 * MiB;

struct Args { const float* in[N_IN]; float* out; unsigned char* ws; int ph_lo, ph_hi; };

__device__ __forceinline__ unsigned f2bf(float f) { unsigned u = __builtin_bit_cast(unsigned, f); return (u + 0x7fffu + ((u >> 16) & 1u)) >> 16; }
__device__ __forceinline__ unsigned pk2(float lo, float hi) { return f2bf(lo) | (f2bf(hi) << 16); }
__device__ __forceinline__ float bflo(unsigned w) { return __builtin_bit_cast(float, w << 16); }
__device__ __forceinline__ float bfhi(unsigned w) { return __builtin_bit_cast(float, w & 0xffff0000u); }
__device__ __forceinline__ float bf2f(bf16_t h) { return __builtin_bit_cast(float, (unsigned)h << 16); }
__device__ __forceinline__ float wave_sum(float v) {
#pragma unroll
    for (int o = 32; o >= 1; o >>= 1) v += __shfl_xor(v, o);
    return v;
}
__device__ __forceinline__ int otid() { int t = threadIdx.x; asm volatile("" : "+v"(t)); return t; }
__device__ __forceinline__ float sigmoidf_(float x) { return 1.f / (1.f + __expf(-x)); }
__device__ __forceinline__ float siluf_(float x) { return x / (1.f + __expf(-x)); }

struct Unit { int pm, pn; };
struct Gemm { const bf16_t* A; const bf16_t* Bt; int lda, ldb, K; };
constexpr int NXCD = 8, WGM = 8;
struct StaticOrder {
    int nM, nN, nwg, G, c;
    __device__ void init(int M, int N, int G_, int c_) { nM = M / 256; nN = N / 256; nwg = nM * nN; G = G_; c = c_; }
    __device__ bool next(int i, Unit& u) const {
        const long L = (long)i * G + c; if (L >= nwg) return false;
        int wgid = (int)L; { const int q = nwg / NXCD, r = nwg % NXCD, xcd = wgid % NXCD, off = wgid / NXCD; wgid = (xcd < r ? xcd * (q + 1) : r * (q + 1) + (xcd - r) * q) + off; }
        const int nig = WGM * nN, gid = wgid / nig, fm = gid * WGM, gsz = (nM - fm) < WGM ? (nM - fm) : WGM;
        u.pm = fm + ((wgid % nig) % gsz); u.pn = (wgid % nig) / gsz; return true;
    }
    __device__ __forceinline__ void a_ready(const Unit&) const {}
    __device__ __forceinline__ void done(const Unit&) const {}
};
struct MergeOrder {
    StaticOrder base;
    __device__ bool next(int i, Unit& u) const { Unit t; if (!base.next(i >> 2, t)) return false; const int pass = i & 3; u.pm = pass * 33 + t.pm; u.pn = pass * 8 + t.pn; return true; }
    __device__ __forceinline__ void a_ready(const Unit&) const {}
    __device__ __forceinline__ void done(const Unit&) const {}
};

struct EpiIn {
    static constexpr bool PERM = true, AFTER_DRAIN = false;
    bf16_t* PL;
    __device__ __forceinline__ void operator()(const f32x4 (&acc)[2][2][4][2], const Unit& u, int wr, int wc, int fr, int fq) const {
        const bool gate = u.pn >= (G0 / 256);
#pragma unroll
        for (int ai = 0; ai < 2; ++ai)
#pragma unroll
            for (int m = 0; m < 4; ++m) {
                const int row = u.pm * 256 + ai * 128 + wr * 64 + m * 16 + fr;
#pragma unroll
                for (int bj = 0; bj < 2; ++bj) {
                    const int col = u.pn * 256 + bj * 128 + wc * 32 + 8 * fq;
                    f32x4 v0 = acc[ai][bj][m][0], v1 = acc[ai][bj][m][1];
                    if (gate) {
#pragma unroll
                        for (int e = 0; e < 4; ++e) { v0[e] = sigmoidf_(v0[e]); v1[e] = sigmoidf_(v1[e]); }
                    }
                    u32x4 w; w.x = pk2(v0[0], v0[1]); w.y = pk2(v0[2], v0[3]); w.z = pk2(v1[0], v1[1]); w.w = pk2(v1[2], v1[3]);
                    *(u32x4*)(PL + (size_t)row * NIN + col) = w;
                }
            }
    }
};
struct EpiScale {
    static constexpr bool PERM = true, AFTER_DRAIN = false;
    bf16_t* O; int ldc; const float* scale;
    __device__ __forceinline__ void operator()(const f32x4 (&acc)[2][2][4][2], const Unit& u, int wr, int wc, int fr, int fq) const {
#pragma unroll
        for (int bj = 0; bj < 2; ++bj) {
            const int col = u.pn * 256 + bj * 128 + wc * 32 + 8 * fq;
            const f32x4 s0 = *(const f32x4*)(scale + col), s1 = *(const f32x4*)(scale + col + 4);
#pragma unroll
            for (int ai = 0; ai < 2; ++ai)
#pragma unroll
                for (int m = 0; m < 4; ++m) {
                    const int row = u.pm * 256 + ai * 128 + wr * 64 + m * 16 + fr;
                    const f32x4 v0 = acc[ai][bj][m][0] * s0, v1 = acc[ai][bj][m][1] * s1;
                    u32x4 w; w.x = pk2(v0[0], v0[1]); w.y = pk2(v0[2], v0[3]); w.z = pk2(v1[0], v1[1]); w.w = pk2(v1[2], v1[3]);
                    *(u32x4*)(O + (size_t)row * ldc + col) = w;
                }
        }
    }
};
struct EpiMerge {
    static constexpr bool PERM = true, AFTER_DRAIN = false;
    const bf16_t* PL; float* MRG; bf16_t* MRGB;
    __device__ __forceinline__ void operator()(const f32x4 (&acc)[2][2][4][2], const Unit& u, int wr, int wc, int fr, int fq) const {
        const int pass = u.pm / 33, pm = u.pm - pass * 33, pn = u.pn & 7;
#pragma unroll
        for (int ai = 0; ai < 2; ++ai)
#pragma unroll
            for (int m = 0; m < 4; ++m) {
                const int row = pm * 256 + ai * 128 + wr * 64 + m * 16 + fr;
#pragma unroll
                for (int bj = 0; bj < 2; ++bj) {
                    const int col = pn * 256 + bj * 128 + wc * 32 + 8 * fq;
                    const u32x4 gw = *(const u32x4*)(PL + (size_t)row * NIN + G0 + pass * DM + col);
                    f32x4 v0 = acc[ai][bj][m][0], v1 = acc[ai][bj][m][1];
                    v0[0] *= bflo(gw.x); v0[1] *= bfhi(gw.x); v0[2] *= bflo(gw.y); v0[3] *= bfhi(gw.y);
                    v1[0] *= bflo(gw.z); v1[1] *= bfhi(gw.z); v1[2] *= bflo(gw.w); v1[3] *= bfhi(gw.w);
                    float* mp = MRG + (size_t)row * DM + col;
                    if (pass > 0) { v0 += *(const f32x4*)mp; v1 += *(const f32x4*)(mp + 4); }
                    if (pass < 3) { *(f32x4*)mp = v0; *(f32x4*)(mp + 4) = v1; }
                    else { u32x4 w; w.x = pk2(v0[0], v0[1]); w.y = pk2(v0[2], v0[3]); w.z = pk2(v1[0], v1[1]); w.w = pk2(v1[2], v1[3]);
                           *(u32x4*)(MRGB + (size_t)row * DM + col) = w; }
                }
            }
    }
};
struct EpiF32 {
    static constexpr bool PERM = true, AFTER_DRAIN = false;
    float* Y; int ldc;
    __device__ __forceinline__ void operator()(const f32x4 (&acc)[2][2][4][2], const Unit& u, int wr, int wc, int fr, int fq) const {
#pragma unroll
        for (int ai = 0; ai < 2; ++ai)
#pragma unroll
            for (int m = 0; m < 4; ++m) {
                const int row = u.pm * 256 + ai * 128 + wr * 64 + m * 16 + fr;
#pragma unroll
                for (int bj = 0; bj < 2; ++bj) {
                    const int col = u.pn * 256 + bj * 128 + wc * 32 + 8 * fq;
                    float* yp = Y + (size_t)row * ldc + col;
                    *(f32x4*)yp = acc[ai][bj][m][0]; *(f32x4*)(yp + 4) = acc[ai][bj][m][1];
                }
            }
    }
};
struct EpiSwiglu {
    static constexpr bool PERM = true, AFTER_DRAIN = false;
    bf16_t* H;
    __device__ __forceinline__ void operator()(const f32x4 (&acc)[2][2][4][2], const Unit& u, int wr, int wc, int fr, int fq) const {
#pragma unroll
        for (int ai = 0; ai < 2; ++ai)
#pragma unroll
            for (int m = 0; m < 4; ++m) {
                const int row = u.pm * 256 + ai * 128 + wr * 64 + m * 16 + fr;
                const int col = u.pn * 128 + wc * 32 + 8 * fq;
                f32x4 h0, h1;
#pragma unroll
                for (int e = 0; e < 4; ++e) { h0[e] = siluf_(acc[ai][0][m][0][e]) * acc[ai][1][m][0][e]; h1[e] = siluf_(acc[ai][0][m][1][e]) * acc[ai][1][m][1][e]; }
                u32x4 w; w.x = pk2(h0[0], h0[1]); w.y = pk2(h0[2], h0[3]); w.z = pk2(h1[0], h1[1]); w.w = pk2(h1[2], h1[3]);
                *(u32x4*)(H + (size_t)row * FF + col) = w;
            }
    }
};

#define PG8_LAS __attribute__((address_space(3)))
constexpr int BM = 256, BK = 64, HALF = 128, HTB = HALF * BK * 2, STAGE_BYTES = 8 * HTB;
__device__ __forceinline__ int lds_byte(int r, int c) { const int st = (r >> 4) * 2 + (c >> 5), rr = r & 15, cc = c & 31, ob = rr * 64 + cc * 2; return st * 1024 + (ob ^ (((ob >> 9) & 1) << 5)); }
__device__ __forceinline__ void stage_rc(int b, int& R, int& C) { const int st = b / 1024, sb = b % 1024, swz = sb ^ (((sb >> 9) & 1) << 5); R = (st >> 1) * 16 + swz / 64; C = (st & 1) * 32 + (swz % 64) / 2; }
__device__ __forceinline__ int perm32(int rho) { const int n = rho >> 4, i = rho & 15; return 8 * (i >> 2) + 4 * n + (i & 3); }
template <class Epi, class Sched, bool ALIGN_EPI = true, bool SP2 = true>
__device__ __forceinline__ void gemm_phase(PG8_LAS unsigned char* lds, const Gemm g, const Sched& S, const Epi& E) {
    const int tid = otid(), wid = __builtin_amdgcn_readfirstlane(tid >> 6), lane = tid & 63, wr = wid >> 2, wc = wid & 3, fr = lane & 15, fq = lane >> 4;
    const int K = g.K, nt = K / BK;
    unsigned voffA[2], voffB[2];
#pragma unroll
    for (int i = 0; i < 2; ++i) { int R, C; stage_rc(tid * 16 + i * 8192, R, C); const int Rb = Epi::PERM ? ((R & ~31) + perm32(R & 31)) : R;
        voffA[i] = (unsigned)(R * g.lda + C) * 2u; voffB[i] = (unsigned)(Rb * g.ldb + C) * 2u; }
    const size_t kstep = (size_t)(BK * 2);
    const size_t hstepA = (size_t)HALF * g.lda * 2, hstepB = (size_t)HALF * g.ldb * 2;
    const size_t tstepA = 2 * hstepA, tstepB = 2 * hstepB;
    const unsigned ldsw = (unsigned)wid * 1024u;
    const int aoff = lds_byte(wr * 64 + fr, fq * 8), boff = lds_byte(wc * 32 + fr, fq * 8);
#define PG8_SA(b, h) (((b) * 2 + (h)) * HTB)
#define PG8_SB(b, h) ((4 + (b) * 2 + (h)) * HTB)
#define PG8_STAGE(bufoff, gbase, voff) do { _Pragma("unroll") for (int _i = 0; _i < 2; ++_i) \
        __builtin_amdgcn_global_load_lds((const unsigned*)((const char*)(gbase) + (voff)[_i]), (PG8_LAS unsigned*)(lds + (bufoff) + ldsw + _i * 8192), 16, 0, 0); } while (0)
#define PG8_LDA(dst, b, h) do { _Pragma("unroll") for (int m = 0; m < 4; ++m) _Pragma("unroll") for (int k = 0; k < 2; ++k) dst[m][k] = *(const PG8_LAS bf16x8*)(lds + PG8_SA(b, h) + aoff + m * 2048 + k * 1024); } while (0)
#define PG8_LDB(dst, b, h) do { _Pragma("unroll") for (int n = 0; n < 2; ++n) _Pragma("unroll") for (int k = 0; k < 2; ++k) dst[n][k] = *(const PG8_LAS bf16x8*)(lds + PG8_SB(b, h) + boff + n * 2048 + k * 1024); } while (0)
#define PG8_MMA(ai, bj, At, Bt) do { __builtin_amdgcn_s_setprio(1); _Pragma("unroll") for (int m = 0; m < 4; ++m) _Pragma("unroll") for (int n = 0; n < 2; ++n) _Pragma("unroll") for (int k = 0; k < 2; ++k) \
        acc[ai][bj][m][n] = __builtin_amdgcn_mfma_f32_16x16x32_bf16(Bt[n][k], At[m][k], acc[ai][bj][m][n], 0, 0, 0); __builtin_amdgcn_s_setprio(0); } while (0)
#define PG8_WAIT_V(n) asm volatile("s_waitcnt vmcnt(" #n ")" ::: "memory")
#define PG8_WAIT_L(n) asm volatile("s_waitcnt lgkmcnt(" #n ")" ::: "memory")
#define PG8_BAR __builtin_amdgcn_s_barrier()
#define PG8_SCHED __builtin_amdgcn_sched_barrier(0)
    Unit cur, nxt; int ui = 0;
    if (!S.next(0, cur)) return;
    f32x4 acc[2][2][4][2];
#pragma unroll
    for (int a = 0; a < 2; ++a)
#pragma unroll
        for (int b = 0; b < 2; ++b)
#pragma unroll
            for (int m = 0; m < 4; ++m)
#pragma unroll
                for (int n = 0; n < 2; ++n) acc[a][b][m][n] = (f32x4){0.f, 0.f, 0.f, 0.f};
    bf16x8 At[4][2], B0[2][2], B1[2][2];
    const char* cA = (const char*)g.A + (size_t)cur.pm * tstepA; const char* cB = (const char*)g.Bt + (size_t)cur.pn * tstepB;
    S.a_ready(cur);
    if constexpr (SP2) {
        PG8_STAGE(PG8_SB(0, 0), cB, voffB); PG8_STAGE(PG8_SB(0, 1), cB + hstepB, voffB); PG8_STAGE(PG8_SA(0, 0), cA, voffA); PG8_STAGE(PG8_SA(0, 1), cA + hstepA, voffA);
        if (wr == 1) PG8_BAR;
        PG8_WAIT_V(2); PG8_BAR;
        PG8_STAGE(PG8_SB(1, 0), cB + kstep, voffB); PG8_STAGE(PG8_SA(1, 0), cA + kstep, voffA); PG8_STAGE(PG8_SB(1, 1), cB + hstepB + kstep, voffB);
        PG8_WAIT_V(6); PG8_BAR;
    } else {
        PG8_STAGE(PG8_SB(0, 0), cB, voffB); PG8_STAGE(PG8_SA(0, 0), cA, voffA); PG8_STAGE(PG8_SB(0, 1), cB + hstepB, voffB); PG8_STAGE(PG8_SA(0, 1), cA + hstepA, voffA);
        if (wr == 1) PG8_BAR;
        PG8_WAIT_V(4); PG8_BAR;
        PG8_STAGE(PG8_SB(1, 0), cB + kstep, voffB); PG8_STAGE(PG8_SA(1, 0), cA + kstep, voffA); PG8_STAGE(PG8_SB(1, 1), cB + hstepB + kstep, voffB);
        PG8_WAIT_V(6); PG8_BAR;
    }
    for (;;) {
        const bool has_next = S.next(ui + 1, nxt);
        const char* nA = has_next ? (const char*)g.A + (size_t)nxt.pm * tstepA : cA; const char* nB = has_next ? (const char*)g.Bt + (size_t)nxt.pn * tstepB : cB;
        for (int t = 0; t < nt; t += 2) {
            const bool last = (t == nt - 2);
            const char* a1 = cA + (size_t)(t + 1) * kstep;
            const char* a2 = last ? nA : cA + (size_t)(t + 2) * kstep; const char* b2 = last ? nB : cB + (size_t)(t + 2) * kstep;
            const char* a3 = a2 + kstep; const char* b3 = b2 + kstep;
            if (last && has_next) S.a_ready(nxt);
            if constexpr (SP2) {
            PG8_LDB(B0, 0, 0); PG8_LDB(B1, 0, 1); PG8_SCHED; PG8_LDA(At, 0, 0); PG8_STAGE(PG8_SA(1, 1), a1 + hstepA, voffA);
            PG8_WAIT_V(8); PG8_WAIT_L(0); PG8_BAR; PG8_MMA(0, 0, At, B0); PG8_MMA(0, 1, At, B1); PG8_BAR; PG8_SCHED;
            PG8_LDA(At, 0, 1); PG8_STAGE(PG8_SB(0, 0), b2, voffB); PG8_STAGE(PG8_SB(0, 1), b2 + hstepB, voffB); PG8_STAGE(PG8_SA(0, 0), a2, voffA);
            PG8_WAIT_V(8); PG8_WAIT_L(0); PG8_BAR; PG8_MMA(1, 0, At, B0); PG8_MMA(1, 1, At, B1); PG8_BAR; PG8_SCHED;
            PG8_LDB(B0, 1, 0); PG8_LDB(B1, 1, 1); PG8_SCHED; PG8_LDA(At, 1, 0); PG8_STAGE(PG8_SA(0, 1), a2 + hstepA, voffA);
            PG8_WAIT_V(8); PG8_WAIT_L(0); PG8_BAR; PG8_MMA(0, 0, At, B0); PG8_MMA(0, 1, At, B1); PG8_BAR; PG8_SCHED;
            PG8_LDA(At, 1, 1); PG8_STAGE(PG8_SB(1, 0), b3, voffB); PG8_STAGE(PG8_SB(1, 1), b3 + hstepB, voffB); PG8_STAGE(PG8_SA(1, 0), a3, voffA);
            PG8_WAIT_V(8); PG8_WAIT_L(0); PG8_BAR; PG8_MMA(1, 0, At, B0); PG8_MMA(1, 1, At, B1); PG8_BAR; PG8_SCHED;
            } else {
            PG8_LDB(B0, 0, 0); PG8_SCHED; PG8_LDA(At, 0, 0); PG8_STAGE(PG8_SA(1, 1), a1 + hstepA, voffA);
            PG8_WAIT_L(8); PG8_BAR; PG8_WAIT_L(0); PG8_MMA(0, 0, At, B0); PG8_BAR; PG8_SCHED;
            PG8_LDB(B1, 0, 1); PG8_STAGE(PG8_SB(0, 0), b2, voffB);
            PG8_BAR; PG8_WAIT_L(0); PG8_MMA(0, 1, At, B1); PG8_BAR;
            PG8_LDA(At, 0, 1); PG8_STAGE(PG8_SA(0, 0), a2, voffA);
            PG8_BAR; PG8_WAIT_L(0); PG8_MMA(1, 0, At, B0); PG8_BAR; PG8_SCHED;
            PG8_STAGE(PG8_SB(0, 1), b2 + hstepB, voffB);
            PG8_WAIT_V(6); PG8_BAR; PG8_MMA(1, 1, At, B1); PG8_BAR;
            PG8_LDB(B0, 1, 0); PG8_SCHED; PG8_LDA(At, 1, 0); PG8_STAGE(PG8_SA(0, 1), a2 + hstepA, voffA);
            PG8_WAIT_L(8); PG8_BAR; PG8_WAIT_L(0); PG8_MMA(0, 0, At, B0); PG8_BAR; PG8_SCHED;
            PG8_LDB(B1, 1, 1); PG8_STAGE(PG8_SB(1, 0), b3, voffB);
            PG8_BAR; PG8_WAIT_L(0); PG8_MMA(0, 1, At, B1); PG8_BAR;
            PG8_LDA(At, 1, 1); PG8_STAGE(PG8_SA(1, 0), a3, voffA);
            PG8_BAR; PG8_WAIT_L(0); PG8_MMA(1, 0, At, B0); PG8_BAR; PG8_SCHED;
            PG8_STAGE(PG8_SB(1, 1), b3 + hstepB, voffB);
            PG8_WAIT_V(6); PG8_BAR; PG8_MMA(1, 1, At, B1); PG8_BAR;
            }
        }
        if constexpr (ALIGN_EPI) { if (wr == 0) PG8_BAR; }
        if constexpr (!Epi::AFTER_DRAIN) { E(acc, cur, wr, wc, fr, fq); S.done(cur); }
        if (!has_next) break;
#pragma unroll
        for (int a = 0; a < 2; ++a)
#pragma unroll
            for (int b = 0; b < 2; ++b)
#pragma unroll
                for (int m = 0; m < 4; ++m)
#pragma unroll
                    for (int n = 0; n < 2; ++n) acc[a][b][m][n] = (f32x4){0.f, 0.f, 0.f, 0.f};
        cur = nxt; cA = nA; cB = nB; ++ui;
        if constexpr (ALIGN_EPI) { if (wr == 1) PG8_BAR; }
    }
    PG8_WAIT_V(0);
    if constexpr (!ALIGN_EPI) { if (wr == 0) PG8_BAR; }
    PG8_BAR;
    if constexpr (Epi::AFTER_DRAIN) { E.fused(acc, cur, wr, wc, fr, fq, lds, wid, lane); S.done(cur); }
#undef PG8_SA
#undef PG8_SB
#undef PG8_STAGE
#undef PG8_LDA
#undef PG8_LDB
#undef PG8_MMA
#undef PG8_WAIT_V
#undef PG8_WAIT_L
#undef PG8_BAR
#undef PG8_SCHED
}

__device__ __forceinline__ void tr_item(const float* src, int ldn, int k0, int n0, bf16_t* dst, int dld, int drow0, int dk0, float* scr, int lane) {
    const float* sp = src + (size_t)k0 * ldn + n0 + lane;
#pragma unroll 16
    for (int i = 0; i < 64; ++i) scr[i * 65 + lane] = sp[(size_t)i * ldn];
    __builtin_amdgcn_s_waitcnt(0); asm volatile("" ::: "memory");
    const int c = lane & 7;
#pragma unroll
    for (int j = 0; j < 8; ++j) {
        const int n = (lane >> 3) + 8 * j; const float* s = scr + (8 * c) * 65 + n;
        u32x4 o; o.x = pk2(s[0], s[65]); o.y = pk2(s[2 * 65], s[3 * 65]); o.z = pk2(s[4 * 65], s[5 * 65]); o.w = pk2(s[6 * 65], s[7 * 65]);
        *(u32x4*)(dst + (size_t)(drow0 + n) * dld + dk0 + 8 * c) = o;
    }
    __builtin_amdgcn_s_waitcnt(0); asm volatile("" ::: "memory");
}

__device__ __forceinline__ void phase_prologue(const Args& a, unsigned char* lds, int vcu, int G) {
    const int tid = otid(), wave = tid >> 6, lane = tid & 63;
    const int gw = vcu * NWAVE + wave, NGW = G * NWAVE;
    float* scr = (float*)(lds + wave * 16640);
    constexpr int I_IN = 32 * 192, I_BR = 4 * 8 * 32, I_O = 32 * 32, I_G = 32 * 88, I_D = 88 * 32, I_B = 16;
    constexpr int PLI = I_IN + I_BR + I_O + 2 * I_G + I_D + I_B;
    for (int it = gw; it < 2 * PLI; it += NGW) {
        const int l = it / PLI; int r = it - l * PLI;
        unsigned char* wb = a.ws + WS_W + (size_t)l * WPL;
        if (r < I_IN) { const int kb = r / 192, nb = r % 192; tr_item(a.in[I_WIN] + (size_t)l * DM * NIN, NIN, kb * 64, nb * 64, (bf16_t*)(wb + W_IN), DM, nb * 64, kb * 64, scr, lane); continue; } r -= I_IN;
        if (r < I_BR) { const int i = r >> 8, rr = r & 255, kb = rr >> 5, nb = rr & 31;
            tr_item(a.in[I_WBR] + (size_t)(l * 4 + i) * 512 * DM, DM, kb * 64, nb * 64, (bf16_t*)(wb + W_BR) + (size_t)i * DM * 512, 512, nb * 64, kb * 64, scr, lane); continue; } r -= I_BR;
        if (r < I_O) { const int kb = r >> 5, nb = r & 31; tr_item(a.in[I_WO] + (size_t)l * DM * DM, DM, kb * 64, nb * 64, (bf16_t*)(wb + W_O), DM, nb * 64, kb * 64, scr, lane); continue; } r -= I_O;
        if (r < I_G) { const int kb = r / 88, nb = r % 88, n0 = nb * 64; tr_item(a.in[I_WG] + (size_t)l * DM * FF, FF, kb * 64, n0, (bf16_t*)(wb + W_GU), DM, (n0 >> 7) * 256 + (n0 & 127), kb * 64, scr, lane); continue; } r -= I_G;
        if (r < I_G) { const int kb = r / 88, nb = r % 88, n0 = nb * 64; tr_item(a.in[I_WU] + (size_t)l * DM * FF, FF, kb * 64, n0, (bf16_t*)(wb + W_GU), DM, (n0 >> 7) * 256 + 128 + (n0 & 127), kb * 64, scr, lane); continue; } r -= I_G;
        if (r < I_D) { const int kb = r >> 5, nb = r & 31; tr_item(a.in[I_WD] + (size_t)l * FF * DM, DM, kb * 64, nb * 64, (bf16_t*)(wb + W_D), FF, nb * 64, kb * 64, scr, lane); continue; } r -= I_D;
        { const int g = r >> 2, kb = (r >> 1) & 1, nb = r & 1;
          tr_item(a.in[I_BW] + (size_t)(l * 4 + g) * 128 * 128, 128, kb * 64, nb * 64, (bf16_t*)(wb + W_B), 512, g * 128 + nb * 64, g * 128 + kb * 64, scr, lane); }
    }
    for (int i = vcu * NTHR + tid; i < 2 * 32768; i += G * NTHR) {
        const int l = i >> 15, j = i & 32767, n = j >> 6, kc = j & 63;
        if ((n >> 7) != (kc >> 4)) *(u32x4*)((bf16_t*)(a.ws + WS_W + (size_t)l * WPL + W_B) + (size_t)n * 512 + kc * 8) = (u32x4){0u, 0u, 0u, 0u};
    }
    float* MOD = (float*)(a.ws + WS_CTL + CTL_MOD);
    for (int it = vcu; it < 768; it += G) {
        const int l = it / 384, r = it % 384, cb = r >> 6, kc = r & 63;
        const int col = cb * 2048 + tid * 4;
        f32x4 al = {0.f, 0.f, 0.f, 0.f}, ac = {0.f, 0.f, 0.f, 0.f};
        const float* wp = a.in[I_ADAW] + ((size_t)l * DM + kc * 32) * NIN + col;
#pragma unroll 8
        for (int k = 0; k < 32; ++k) {
            const float sl = siluf_(a.in[I_C][kc * 32 + k]), sc = siluf_(a.in[I_CCTX][kc * 32 + k]);
            const f32x4 w = *(const f32x4*)(wp + (size_t)k * NIN);
            al += sl * w; ac += sc * w;
        }
        if (kc == 0) { const f32x4 b = *(const f32x4*)(a.in[I_ADAB] + (size_t)l * NIN + col); al += b; ac += b; }
        float* ml = MOD + (size_t)(l * 2 + 0) * NIN + col; float* mc = MOD + (size_t)(l * 2 + 1) * NIN + col;
#pragma unroll
        for (int e = 0; e < 4; ++e) { unsafeAtomicAdd(ml + e, al[e]); unsafeAtomicAdd(mc + e, ac[e]); }
    }
}

template <int MODE>
__device__ __forceinline__ void phase_rows(const Args& a, int vcu, int G, int nrows, const float* gpost, const float* modcur, int gate_idx,
                                           const float* gnext, const float* modnext, int sh_idx) {
    const int tid = otid(), wave = tid >> 6, lane = tid & 63;
    const int gw = vcu * NWAVE + wave, NGW = G * NWAVE;
    float* X = (float*)(a.ws + WS_X); const float* Y = (const float*)(a.ws + WS_MRG); bf16_t* XN = (bf16_t*)(a.ws + WS_XN);
    for (int row = gw; row < nrows; row += NGW) {
        const int isctx = row >= SEQ ? 1 : 0;
        f32x4 x[8];
        if (MODE == 0) {
            const float* src = isctx ? a.in[I_CTX] + (size_t)(row - SEQ) * DM : a.in[I_X] + (size_t)row * DM;
#pragma unroll
            for (int j = 0; j < 8; ++j) x[j] = *(const f32x4*)(src + 4 * lane + 256 * j);
        } else {
            f32x4 y[8]; float ss = 0.f;
#pragma unroll
            for (int j = 0; j < 8; ++j) { x[j] = *(const f32x4*)(X + (size_t)row * DM + 4 * lane + 256 * j); y[j] = *(const f32x4*)(Y + (size_t)row * DM + 4 * lane + 256 * j);
                ss += (y[j][0] * y[j][0] + y[j][1] * y[j][1]) + (y[j][2] * y[j][2] + y[j][3] * y[j][3]); }
            const float rstd = 1.0f / sqrtf(wave_sum(ss) * (1.f / DM) + EPS);
            const float* gate = modcur + (size_t)isctx * NIN + gate_idx * DM;
#pragma unroll
            for (int j = 0; j < 8; ++j) { const int col = 4 * lane + 256 * j; const f32x4 gp = *(const f32x4*)(gpost + col), gt = *(const f32x4*)(gate + col);
                x[j] += gt * (y[j] * rstd * gp); }
        }
        if (MODE == 2) {
#pragma unroll
            for (int j = 0; j < 8; ++j) *(f32x4*)(a.out + (size_t)row * DM + 4 * lane + 256 * j) = x[j];
            continue;
        }
        float ss = 0.f;
#pragma unroll
        for (int j = 0; j < 8; ++j) { *(f32x4*)(X + (size_t)row * DM + 4 * lane + 256 * j) = x[j];
            ss += (x[j][0] * x[j][0] + x[j][1] * x[j][1]) + (x[j][2] * x[j][2] + x[j][3] * x[j][3]); }
        const float rstd = 1.0f / sqrtf(wave_sum(ss) * (1.f / DM) + EPS);
        const float* sh = modnext + (size_t)isctx * NIN + sh_idx * DM; const float* sc = sh + DM;
#pragma unroll
        for (int j = 0; j < 8; ++j) { const int col = 4 * lane + 256 * j; const f32x4 gn = *(const f32x4*)(gnext + col), s1 = *(const f32x4*)(sc + col), s0 = *(const f32x4*)(sh + col);
            const f32x4 h = (x[j] * rstd * gn) * (1.f + s1) + s0;
            u32x2 w; w.x = pk2(h[0], h[1]); w.y = pk2(h[2], h[3]); *(u32x2*)(XN + (size_t)row * DM + col) = w; }
    }
}

__device__ __forceinline__ void qk_prep_row(const Args& a, int layer, int row, int lane) {
    bf16_t* p = (bf16_t*)(a.ws + WS_PL) + (size_t)row * NIN;
    const int ax = lane >> 5, f = lane & 31, d1 = ax * 64 + f, d2 = d1 + 32;
    float cs = 1.f, sn = 0.f;
    if (row < SEQ) { const float pos = (float)(ax == 0 ? (row >> 6) : (row & 63)); const float inv = exp2f(-(float)f * (13.287712379549449f / 32.f)); const float ang = pos * inv; cs = cosf(ang); sn = sinf(ang); }
#pragma unroll
    for (int h = 0; h < 6; ++h) {
        const float* gn = (h < 4 ? a.in[I_AQN] : a.in[I_AKN]) + layer * HD;
        bf16_t* hp = p + h * HD;
        float x1 = bf2f(hp[d1]), x2 = bf2f(hp[d2]);
        const float rstd = 1.0f / sqrtf(wave_sum(x1 * x1 + x2 * x2) * (1.f / HD) + EPS);
        x1 = x1 * rstd * gn[d1]; x2 = x2 * rstd * gn[d2];
        hp[d1] = (bf16_t)f2bf(x1 * cs - x2 * sn); hp[d2] = (bf16_t)f2bf(x2 * cs + x1 * sn);
    }
}
__device__ __forceinline__ void dlt_row(const Args& a, int row, int lane) {
    const bf16_t* PL = (const bf16_t*)(a.ws + WS_PL); bf16_t* DLT = (bf16_t*)(a.ws + WS_DLT);
    const int base = row < SEQ ? 0 : SEQ, n = row < SEQ ? SEQ : CTXL, t = row - base, half = 1 << (lane >> 4);
    const int lo = max(t - half, 0), hi = min(t + half, n);
    float s[8];
#pragma unroll
    for (int e = 0; e < 8; ++e) s[e] = 0.f;
    for (int r = lo; r < hi; ++r) { const u32x4 w = *(const u32x4*)(PL + (size_t)(base + r) * NIN + B0 + lane * 8);
        s[0] += bflo(w.x); s[1] += bfhi(w.x); s[2] += bflo(w.y); s[3] += bfhi(w.y); s[4] += bflo(w.z); s[5] += bfhi(w.z); s[6] += bflo(w.w); s[7] += bfhi(w.w); }
    const float inv = 1.f / (float)(hi - lo);
    const u32x4 w = *(const u32x4*)(PL + (size_t)row * NIN + B0 + lane * 8);
    u32x4 o; o.x = pk2(s[0] * inv - bflo(w.x), s[1] * inv - bfhi(w.x)); o.y = pk2(s[2] * inv - bflo(w.y), s[3] * inv - bfhi(w.y));
    o.z = pk2(s[4] * inv - bflo(w.z), s[5] * inv - bfhi(w.z)); o.w = pk2(s[6] * inv - bflo(w.w), s[7] * inv - bfhi(w.w));
    *(u32x4*)(DLT + (size_t)row * 512 + lane * 8) = o;
}
constexpr int CP = 136;
__device__ __forceinline__ void cmix_unit(const Args& a, int layer, int unit, unsigned char* lds) {
    const int tid = otid(), wave = tid >> 6, lane = tid & 63, chunk = unit >> 2, g = unit & 3;
    const bf16_t* PL = (const bf16_t*)(a.ws + WS_PL); bf16_t* OUT = (bf16_t*)(a.ws + WS_OUTS) + (size_t)2 * MR * 512;
    bf16_t* vT = (bf16_t*)lds;
    bf16_t* wsL = (bf16_t*)(lds + 128 * CP * 2);
    float* st = (float*)(lds + 2 * 128 * CP * 2);
    const int t0 = chunk * 128;
    for (int i = 0; i < 16; ++i) {
        const int q = wave * 16 + i;
        const u32x4 w = *(const u32x4*)(PL + (size_t)(t0 + q) * NIN + C_V0 + lane * 8);
        float x[8] = {bflo(w.x), bfhi(w.x), bflo(w.y), bfhi(w.y), bflo(w.z), bfhi(w.z), bflo(w.w), bfhi(w.w)};
        float s = 0.f;
#pragma unroll
        for (int e = 0; e < 8; ++e) s += x[e];
        const float mean = wave_sum(s) * (1.f / 512.f); float q2 = 0.f;
#pragma unroll
        for (int e = 0; e < 8; ++e) { const float d = x[e] - mean; q2 += d * d; }
        const float rstd = 1.0f / sqrtf(wave_sum(q2) * (1.f / 512.f) + EPS);
        if (lane == 0) { st[2 * q] = mean; st[2 * q + 1] = rstd; }
    }
    __syncthreads();
    {
        const int q = tid & 127, cb = tid >> 7; const float mean = st[2 * q], rstd = st[2 * q + 1];
        const float* lg = a.in[I_CNG] + layer * 512 + g * 128 + cb * 32; const float* lb = a.in[I_CNB] + layer * 512 + g * 128 + cb * 32;
        const bf16_t* vp = PL + (size_t)(t0 + q) * NIN + C_V0 + g * 128 + cb * 32;
#pragma unroll
        for (int j = 0; j < 4; ++j) { const u32x4 w = *(const u32x4*)(vp + j * 8);
            const float x[8] = {bflo(w.x), bfhi(w.x), bflo(w.y), bfhi(w.y), bflo(w.z), bfhi(w.z), bflo(w.w), bfhi(w.w)};
#pragma unroll
            for (int e = 0; e < 8; ++e) { const int c = j * 8 + e; vT[(cb * 32 + c) * CP + q] = (bf16_t)f2bf((x[e] - mean) * rstd * lg[c] + lb[c]); } }
        const int p = tid >> 2, qb = (tid & 3) * 32; const float* wp = a.in[I_CWS] + ((size_t)(layer * 4 + g) * 128 + p) * 128 + qb;
#pragma unroll
        for (int j = 0; j < 8; ++j) { const f32x4 w = *(const f32x4*)(wp + j * 4); u32x2 o; o.x = pk2(w[0], w[1]); o.y = pk2(w[2], w[3]); *(u32x2*)(wsL + p * CP + qb + j * 4) = o; }
    }
    __syncthreads();
    {
        const int fr = lane & 15, fq = lane >> 4;
        f32x4 acc[8];
#pragma unroll
        for (int nb = 0; nb < 8; ++nb) acc[nb] = (f32x4){0.f, 0.f, 0.f, 0.f};
#pragma unroll
        for (int ks = 0; ks < 4; ++ks) {
            const bf16x8 wf = *(const bf16x8*)(wsL + (wave * 16 + fr) * CP + ks * 32 + fq * 8);
#pragma unroll
            for (int nb = 0; nb < 8; ++nb) { const bf16x8 vf = *(const bf16x8*)(vT + (nb * 16 + fr) * CP + ks * 32 + fq * 8);
                acc[nb] = __builtin_amdgcn_mfma_f32_16x16x32_bf16(vf, wf, acc[nb], 0, 0, 0); }
        }
        const int p = wave * 16 + fr; const float bs = a.in[I_CBS][(layer * 4 + g) * 128 + p];
        const bf16_t* up = PL + (size_t)(t0 + p) * NIN + C_U0 + g * 128; bf16_t* op = OUT + (size_t)(t0 + p) * 512 + g * 128;
#pragma unroll
        for (int nb = 0; nb < 8; ++nb) { const int c = nb * 16 + 4 * fq; const u32x2 uw = *(const u32x2*)(up + c);
            u32x2 o; o.x = pk2((acc[nb][0] + bs) * bflo(uw.x), (acc[nb][1] + bs) * bfhi(uw.x)); o.y = pk2((acc[nb][2] + bs) * bflo(uw.y), (acc[nb][3] + bs) * bfhi(uw.y));
            *(u32x2*)(op + c) = o; }
    }
    __syncthreads();
}

template <int MODE>
__device__ __forceinline__ void attn_simple_item(const bf16_t* PL, int qcol, int kcol, int vcol, bf16_t* O, int qrow, int h, int kvh, int kbeg, int kend, const float* rpb, int lane) {
    constexpr float C = 0.088388347648318440f * 1.4426950408889634f;
    const int part = lane & 3;
    float q[32], o[32];
    { const bf16_t* qp = PL + (size_t)qrow * NIN + qcol + h * HD + part * 32;
#pragma unroll
      for (int j = 0; j < 4; ++j) { const u32x4 w = *(const u32x4*)(qp + j * 8);
          q[j * 8 + 0] = bflo(w.x) * C; q[j * 8 + 1] = bfhi(w.x) * C; q[j * 8 + 2] = bflo(w.y) * C; q[j * 8 + 3] = bfhi(w.y) * C;
          q[j * 8 + 4] = bflo(w.z) * C; q[j * 8 + 5] = bfhi(w.z) * C; q[j * 8 + 6] = bflo(w.w) * C; q[j * 8 + 7] = bfhi(w.w) * C; } }
#pragma unroll
    for (int d = 0; d < 32; ++d) o[d] = 0.f;
    float mrun = -1e30f, l = 0.f;
    const int r = qrow >> 6, c = qrow & 63, r0 = min(max(r - 4, 0), 120), c0 = min(max(c - 8, 0), 48);
    const int nk = MODE == 0 ? (kend - kbeg) : 384;
    for (int idx = 0; idx < nk; ++idx) {
        int krow; float bias = 0.f;
        if (MODE == 0) krow = kbeg + idx;
        else if (idx < 128) { const int i = idx >> 4, j = idx & 15; krow = (r0 + i) * GW + c0 + j; bias = rpb[(h * 15 + (r0 + i - r + 7)) * 31 + (c0 + j - c + 15)] * 1.4426950408889634f; }
        else krow = SEQ + idx - 128;
        const bf16_t* kp = PL + (size_t)krow * NIN + kcol + kvh * HD + part * 32;
        float s = 0.f;
#pragma unroll
        for (int j = 0; j < 4; ++j) { const u32x4 w = *(const u32x4*)(kp + j * 8);
            s += q[j * 8 + 0] * bflo(w.x) + q[j * 8 + 1] * bfhi(w.x) + q[j * 8 + 2] * bflo(w.y) + q[j * 8 + 3] * bfhi(w.y)
               + q[j * 8 + 4] * bflo(w.z) + q[j * 8 + 5] * bfhi(w.z) + q[j * 8 + 6] * bflo(w.w) + q[j * 8 + 7] * bfhi(w.w); }
        s += __shfl_xor(s, 1); s += __shfl_xor(s, 2);
        s += bias;
        const float mn = fmaxf(mrun, s), alpha = exp2f(mrun - mn), p = exp2f(s - mn);
        l = l * alpha + p; mrun = mn;
        const bf16_t* vp = PL + (size_t)krow * NIN + vcol + kvh * HD + part * 32;
#pragma unroll
        for (int j = 0; j < 4; ++j) { const u32x4 w = *(const u32x4*)(vp + j * 8);
            o[j * 8 + 0] = o[j * 8 + 0] * alpha + p * bflo(w.x); o[j * 8 + 1] = o[j * 8 + 1] * alpha + p * bfhi(w.x);
            o[j * 8 + 2] = o[j * 8 + 2] * alpha + p * bflo(w.y); o[j * 8 + 3] = o[j * 8 + 3] * alpha + p * bfhi(w.y);
            o[j * 8 + 4] = o[j * 8 + 4] * alpha + p * bflo(w.z); o[j * 8 + 5] = o[j * 8 + 5] * alpha + p * bfhi(w.z);
            o[j * 8 + 6] = o[j * 8 + 6] * alpha + p * bflo(w.w); o[j * 8 + 7] = o[j * 8 + 7] * alpha + p * bfhi(w.w); }
    }
    const float il = 1.f / l;
    bf16_t* op = O + (size_t)qrow * 512 + h * HD + part * 32;
#pragma unroll
    for (int j = 0; j < 4; ++j) { u32x4 w; w.x = pk2(o[j * 8 + 0] * il, o[j * 8 + 1] * il); w.y = pk2(o[j * 8 + 2] * il, o[j * 8 + 3] * il);
        w.z = pk2(o[j * 8 + 4] * il, o[j * 8 + 5] * il); w.w = pk2(o[j * 8 + 6] * il, o[j * 8 + 7] * il); *(u32x4*)(op + j * 8) = w; }
}


namespace att {
using s16x4 = __attribute__((ext_vector_type(4))) short;
using f32x16 = __attribute__((ext_vector_type(16))) float;
constexpr int KVBLK = 64;
constexpr float SCALE = 0.088388347648318440f, THR = 8.f;
constexpr int SHM_V = KVBLK * HD * 2, SHM_K = KVBLK * HD * 2, SHM_ATTN = 2 * SHM_V + 2 * SHM_K + NWAVE * 64 * 4;
#define KSWZ(row, colB) ((row) * 256 + ((colB) ^ (((row) & 7) << 4)))
#define SBAR() __builtin_amdgcn_sched_barrier(0)
__device__ __forceinline__ int crow(int r, int hi) { return (r & 3) + 8 * (r >> 2) + 4 * hi; }
__device__ __forceinline__ unsigned cvtpk(float lo, float hi) { unsigned r; asm volatile("v_cvt_pk_bf16_f32 %0, %1, %2" : "=v"(r) : "v"(lo), "v"(hi)); return r; }
__device__ __forceinline__ void partialSM(f32x16& p0, f32x16& p1, float& m_reg, float& mn, float& alpha) {
  constexpr float C = SCALE * 1.4426950408889634f;
  float pmax = p0[0];
#pragma unroll
  for (int r = 1; r < 16; ++r) pmax = fmaxf(pmax, p0[r]);
#pragma unroll
  for (int r = 0; r < 16; ++r) pmax = fmaxf(pmax, p1[r]);
  { auto rr = __builtin_amdgcn_permlane32_swap(__float_as_uint(pmax), __float_as_uint(pmax), false, false);
    pmax = fmaxf(__uint_as_float(rr[0]), __uint_as_float(rr[1])); }
  if (__builtin_expect(__all(pmax - m_reg <= THR / SCALE), 1)) { mn = m_reg; alpha = 1.f; }
  else { mn = fmaxf(m_reg, pmax); alpha = __builtin_amdgcn_exp2f((m_reg - mn) * C); m_reg = mn; }
  float mnC = -mn * C;
#pragma unroll
  for (int r = 0; r < 16; ++r) p0[r] = fmaf(p0[r], C, mnC);
#pragma unroll
  for (int r = 0; r < 16; ++r) p1[r] = fmaf(p1[r], C, mnC);
#pragma unroll
  for (int r = 0; r < 16; ++r) p0[r] = __builtin_amdgcn_exp2f(p0[r]);
}
__device__ __forceinline__ void finishSM(f32x16& p0, f32x16& p1, float alpha, float& l_reg, bf16x8& pa0, bf16x8& pa1, bf16x8& pa2, bf16x8& pa3) {
#pragma unroll
  for (int r = 0; r < 16; ++r) p1[r] = __builtin_amdgcn_exp2f(p1[r]);
  float ps = 0;
#pragma unroll
  for (int r = 0; r < 16; ++r) ps += p0[r];
#pragma unroll
  for (int r = 0; r < 16; ++r) ps += p1[r];
  { auto rr = __builtin_amdgcn_permlane32_swap(__float_as_uint(ps), __float_as_uint(ps), false, false);
    ps = __uint_as_float(rr[0]) + __uint_as_float(rr[1]); }
  l_reg = l_reg * alpha + ps;
#define PK4(P, BASE, OUT) do { unsigned a0 = cvtpk(P[BASE + 0], P[BASE + 1]), a1 = cvtpk(P[BASE + 2], P[BASE + 3]);   \
    unsigned b0 = cvtpk(P[BASE + 4], P[BASE + 5]), b1 = cvtpk(P[BASE + 6], P[BASE + 7]);                              \
    auto r0 = __builtin_amdgcn_permlane32_swap(a0, b0, false, false); auto r1 = __builtin_amdgcn_permlane32_swap(a1, b1, false, false); \
    u32x4 w = {r0[0], r1[0], r0[1], r1[1]}; OUT = *reinterpret_cast<bf16x8*>(&w); } while (0)
  PK4(p0, 0, pa0); PK4(p0, 8, pa1); PK4(p1, 0, pa2); PK4(p1, 8, pa3);
#undef PK4
}
__device__ __forceinline__ void qkt(f32x16& p0, f32x16& p1, const char* Ks, const bf16x8* qr, int r32, int hi) {
  p0 = f32x16{}; p1 = f32x16{};
#pragma unroll
  for (int d0 = 0; d0 < 8; ++d0) { int cb = (d0 * 16 + hi * 8) * 2;
    bf16x8 b0 = *reinterpret_cast<const bf16x8*>(Ks + KSWZ(r32, cb));
    bf16x8 b1 = *reinterpret_cast<const bf16x8*>(Ks + KSWZ(32 + r32, cb));
    p0 = __builtin_amdgcn_mfma_f32_32x32x16_bf16(b0, qr[d0], p0, 0, 0, 0);
    p1 = __builtin_amdgcn_mfma_f32_32x32x16_bf16(b1, qr[d0], p1, 0, 0, 0); }
}
__device__ __forceinline__ int v_st(int k, int c) { const int kk = (k & ~0xC) | ((k & 4) << 1) | ((k & 8) >> 1); return ((kk >> 3) * 4 + (c >> 5)) * 512 + ((kk & 7) * 32 + (c & 31)) * 2; }
__device__ __forceinline__ int v_rd_base(int lane) { return ((lane & 3) << 3) | (((lane >> 2) & 3) << 6) | (((lane >> 4) & 1) << 5) | (((lane >> 5) & 1) << 8); }
constexpr int v_rd_off(int d0, int ks, int half) { return d0 * 512 + ks * 4096 + half * 2048; }
template <int OFF> __device__ __forceinline__ s16x4 tr_read(int vb) {
  s16x4 r; asm volatile("ds_read_b64_tr_b16 %0, %1 offset:%2" : "=&v"(r) : "v"(vb), "i"(OFF) : "memory"); return r;
}
template <int D0> __device__ __forceinline__ void pv_one(f32x16& od, int vb, bf16x8 pa0, bf16x8 pa1, bf16x8 pa2, bf16x8 pa3) {
  const s16x4 l0 = tr_read<v_rd_off(D0, 0, 0)>(vb), h0 = tr_read<v_rd_off(D0, 0, 1)>(vb), l1 = tr_read<v_rd_off(D0, 1, 0)>(vb), h1 = tr_read<v_rd_off(D0, 1, 1)>(vb);
  const s16x4 l2 = tr_read<v_rd_off(D0, 2, 0)>(vb), h2 = tr_read<v_rd_off(D0, 2, 1)>(vb), l3 = tr_read<v_rd_off(D0, 3, 0)>(vb), h3 = tr_read<v_rd_off(D0, 3, 1)>(vb);
  asm volatile("s_waitcnt lgkmcnt(0)" ::: "memory"); SBAR();
#define PK(L, H) (bf16x8){L[0], L[1], L[2], L[3], H[0], H[1], H[2], H[3]}
  od = __builtin_amdgcn_mfma_f32_32x32x16_bf16(pa0, PK(l0, h0), od, 0, 0, 0);
  od = __builtin_amdgcn_mfma_f32_32x32x16_bf16(pa1, PK(l1, h1), od, 0, 0, 0);
  od = __builtin_amdgcn_mfma_f32_32x32x16_bf16(pa2, PK(l2, h2), od, 0, 0, 0);
  od = __builtin_amdgcn_mfma_f32_32x32x16_bf16(pa3, PK(l3, h3), od, 0, 0, 0);
#undef PK
}
__device__ __forceinline__ void pv_d0(f32x16* o, int vb, bf16x8 pa0, bf16x8 pa1, bf16x8 pa2, bf16x8 pa3) {
  pv_one<0>(o[0], vb, pa0, pa1, pa2, pa3); pv_one<1>(o[1], vb, pa0, pa1, pa2, pa3); pv_one<2>(o[2], vb, pa0, pa1, pa2, pa3); pv_one<3>(o[3], vb, pa0, pa1, pa2, pa3);
}
__device__ __forceinline__ void na_hook(f32x16& p0, f32x16& p1, int kr, int qr, int qc, int hi, const float* rpbh) {
  const int r0 = min(max(qr - 4, 0), 120), c0 = min(max(qc - 8, 0), 48);
  if (kr < r0 || kr >= r0 + 8) {
#pragma unroll
    for (int r = 0; r < 16; ++r) { p0[r] = -1e30f; p1[r] = -1e30f; }
  } else {
    const float* bp = rpbh + (kr - qr + 7) * 31 + 15 - qc;
#pragma unroll
    for (int r = 0; r < 16; ++r) {
      const int kc0 = crow(r, hi), kc1 = 32 + kc0;
      const bool v0 = (unsigned)(kc0 - c0) < 16u, v1 = (unsigned)(kc1 - c0) < 16u;
      const float b0 = v0 ? bp[kc0] : 0.f, b1 = v1 ? bp[kc1] : 0.f;
      p0[r] = v0 ? fmaf(b0, 1.f / SCALE, p0[r]) : -1e30f;
      p1[r] = v1 ? fmaf(b1, 1.f / SCALE, p1[r]) : -1e30f;
      if ((r & 3) == 3) SBAR();
    }
  }
}
template <int MODE, bool DIRECT>
__device__ __forceinline__ void attn_unit(const bf16_t* __restrict__ PL, int qrow0, int qcol, int kcol, int vcol, int NT, int base0, int n0, int base1,
                                          const float* rpbh, bf16_t* Obf, float* Opart, float* LSE, char* lds) {
  const int tid = otid(), wid = tid >> 6, lane = tid & 63, r32 = lane & 31, hi = lane >> 5;
  char* V_lds = lds; char* K_lds = lds + 2 * SHM_V;
  float* wsf = (float*)(lds + 2 * SHM_V + 2 * SHM_K) + wid * 64; float* li_l = wsf; float* al_l = wsf + 32;
  float m_reg = -1e30f, l_reg = 0; f32x16 o[4] = {}; bf16x8 qr[8];
  const bf16_t* Qw = PL + (size_t)(qrow0 + wid * 32 + r32) * NIN + qcol + hi * 8;
#pragma unroll
  for (int d0 = 0; d0 < 8; ++d0) qr[d0] = *reinterpret_cast<const bf16x8*>(Qw + d0 * 16);
  const int qgr = __builtin_amdgcn_readfirstlane((qrow0 + wid * 32) >> 6);
  const int sr = tid >> 4, sc = (tid & 15) * 8, vst0 = v_st(sr, sc), vst1 = v_st(32 + sr, sc);
  const int vb0 = (int)(uintptr_t)V_lds + v_rd_base(lane);
  const bf16_t* Kg = PL + (size_t)sr * NIN + kcol + sc; const bf16_t* Vg = PL + (size_t)sr * NIN + vcol + sc;
  constexpr int SD = 1;
  struct { bf16x8 vs0, vs1, ks0, ks1; } sr_[SD];
#define KROW(j) ((j) < n0 ? base0 + 64 * (j) : base1 + 64 * ((j) - n0))
#define SLOAD(i, j) do { const size_t ko_ = (size_t)KROW(j) * NIN; sr_[i].vs0 = *reinterpret_cast<const bf16x8*>(Vg + ko_); sr_[i].vs1 = *reinterpret_cast<const bf16x8*>(Vg + ko_ + (size_t)32 * NIN); \
    sr_[i].ks0 = *reinterpret_cast<const bf16x8*>(Kg + ko_); sr_[i].ks1 = *reinterpret_cast<const bf16x8*>(Kg + ko_ + (size_t)32 * NIN); } while (0)
#define SWRITE(b, i) do { *(bf16x8*)(V_lds + (b) * SHM_V + vst0) = sr_[i].vs0;          \
    *(bf16x8*)(V_lds + (b) * SHM_V + vst1) = sr_[i].vs1; int kc = sc * 2;               \
    *(bf16x8*)(K_lds + (b) * SHM_K + KSWZ(sr, kc)) = sr_[i].ks0;                       \
    *(bf16x8*)(K_lds + (b) * SHM_K + KSWZ(32 + sr, kc)) = sr_[i].ks1; } while (0)
#define SWAIT() do { if constexpr (SD == 2) asm volatile("s_waitcnt vmcnt(4)" ::: "memory"); else asm volatile("s_waitcnt vmcnt(0)" ::: "memory"); } while (0)
#define RESC(a) do { if (__any((a) < 1.f)) { if (hi == 0) al_l[r32] = (a); asm volatile("s_waitcnt lgkmcnt(0)" ::: "memory"); \
    _Pragma("unroll") for (int d = 0; d < 4; ++d) _Pragma("unroll") for (int r = 0; r < 16; ++r) o[d][r] *= al_l[crow(r, hi)]; } } while (0)
#define HOOK(P0, P1, j) do { if (MODE == 1) { if ((j) >= n0) na_hook(P0, P1, (base1 >> 6) + (j) - n0, qgr, ((wid & 1) << 5) + r32, hi, rpbh); } } while (0)
  f32x16 pA0, pA1, pB0, pB1; float mnA, mnB, alA, alB; bf16x8 pa0, pa1, pa2, pa3;
  constexpr int SE = 0, SO = SD - 1;
  SLOAD(SE, 0); asm volatile("s_waitcnt vmcnt(0)" ::: "memory"); SWRITE(0, SE); __syncthreads();
  qkt(pA0, pA1, K_lds, qr, r32, hi); HOOK(pA0, pA1, 0); partialSM(pA0, pA1, m_reg, mnA, alA);
  SLOAD(SO, 1); if constexpr (SD == 2) { if (2 < NT) SLOAD(SE, 2); }
  SWAIT(); SWRITE(1, SO); __syncthreads();
  for (int j = 1; j + 1 < NT; j += 2) {
    SBAR(); qkt(pB0, pB1, K_lds + SHM_K, qr, r32, hi); HOOK(pB0, pB1, j);
    finishSM(pA0, pA1, alA, l_reg, pa0, pa1, pa2, pa3); SBAR();
    SLOAD(SO, j + SD); SBAR();
    pv_d0(o, vb0, pa0, pa1, pa2, pa3); partialSM(pB0, pB1, m_reg, mnB, alB);
    __syncthreads(); SWAIT(); SWRITE(0, SE);
    RESC(alB); __syncthreads();
    SBAR(); qkt(pA0, pA1, K_lds, qr, r32, hi); HOOK(pA0, pA1, j + 1);
    finishSM(pB0, pB1, alB, l_reg, pa0, pa1, pa2, pa3); SBAR();
    if (SD == 1 || j + 3 < NT) SLOAD(SE, j + 1 + SD); SBAR();
    pv_d0(o, vb0 + SHM_V, pa0, pa1, pa2, pa3); partialSM(pA0, pA1, m_reg, mnA, alA);
    __syncthreads(); SWAIT(); SWRITE(1, SO);
    RESC(alA); __syncthreads();
  }
  SBAR(); qkt(pB0, pB1, K_lds + SHM_K, qr, r32, hi); HOOK(pB0, pB1, NT - 1);
  finishSM(pA0, pA1, alA, l_reg, pa0, pa1, pa2, pa3); SBAR();
  pv_d0(o, vb0, pa0, pa1, pa2, pa3); partialSM(pB0, pB1, m_reg, mnB, alB);
  __syncthreads(); RESC(alB);
  finishSM(pB0, pB1, alB, l_reg, pa0, pa1, pa2, pa3); SBAR();
  pv_d0(o, vb0 + SHM_V, pa0, pa1, pa2, pa3);
  if (hi == 0) li_l[r32] = l_reg; asm volatile("s_waitcnt lgkmcnt(0)" ::: "memory");
  float rli[16];
#pragma unroll
  for (int r = 0; r < 16; ++r) rli[r] = __builtin_amdgcn_rcpf(li_l[crow(r, hi)]);
  if (DIRECT) {
    bf16_t* Ow = Obf + (size_t)(wid * 32) * 512;
#pragma unroll
    for (int r = 0; r < 16; ++r) { const int orow = crow(r, hi);
#pragma unroll
      for (int d0 = 0; d0 < 4; ++d0) Ow[(size_t)orow * 512 + d0 * 32 + r32] = (bf16_t)f2bf(o[d0][r] * rli[r]); }
  } else {
    float* Ow = Opart + (size_t)(wid * 32) * 512;
#pragma unroll
    for (int r = 0; r < 16; ++r) { const int orow = crow(r, hi);
#pragma unroll
      for (int d0 = 0; d0 < 4; ++d0) Ow[(size_t)orow * 512 + d0 * 32 + r32] = o[d0][r] * rli[r]; }
    if (hi == 0) LSE[(size_t)(wid * 32 + r32) * 4] = m_reg * (SCALE * 1.4426950408889634f) + log2f(l_reg);
  }
  __syncthreads();
#undef KROW
#undef SLOAD
#undef SWRITE
#undef SWAIT
#undef RESC
#undef HOOK
}
__device__ __forceinline__ void attn_unit_na(const bf16_t* __restrict__ PL, int qrow0, int qcol, int kcol, int vcol, int R0, const float* rpbh, bf16_t* Obf, char* lds) {
  const int tid = otid(), wid = tid >> 6, lane = tid & 63, r32 = lane & 31, hi = lane >> 5;
  constexpr int NT = 16, n0 = 4;
  char* V_lds = lds; char* K_lds = lds + 2 * SHM_V;
  float* wsf = (float*)(lds + 2 * SHM_V + 2 * SHM_K) + wid * 64; float* li_l = wsf; float* al_l = wsf + 32;
  float m_reg = -1e30f, l_reg = 0; f32x16 o[4] = {}; bf16x8 qr[8];
  const bf16_t* Qw = PL + (size_t)(qrow0 + wid * 32 + r32) * NIN + qcol + hi * 8;
#pragma unroll
  for (int d0 = 0; d0 < 8; ++d0) qr[d0] = *reinterpret_cast<const bf16x8*>(Qw + d0 * 16);
  const int qgr = (qrow0 + wid * 32) >> 6, qgc = ((wid & 1) << 5) + r32;
  const int sr = tid >> 4, sc = (tid & 15) * 8, vst0 = v_st(sr, sc), vst1 = v_st(32 + sr, sc);
  const int vb0 = (int)(uintptr_t)V_lds + v_rd_base(lane);
  const bf16_t* Kg = PL + (size_t)sr * NIN + kcol + sc; const bf16_t* Vg = PL + (size_t)sr * NIN + vcol + sc;
  bf16x8 vs0, vs1, ks0, ks1;
#define KROW(j) ((j) < n0 ? SEQ + 64 * (j) : (R0 + (j) - n0) * 64)
#define SLOAD(j) do { const size_t ko_ = (size_t)KROW(j) * NIN; vs0 = *reinterpret_cast<const bf16x8*>(Vg + ko_); vs1 = *reinterpret_cast<const bf16x8*>(Vg + ko_ + (size_t)32 * NIN); \
    ks0 = *reinterpret_cast<const bf16x8*>(Kg + ko_); ks1 = *reinterpret_cast<const bf16x8*>(Kg + ko_ + (size_t)32 * NIN); } while (0)
  SLOAD(0);
  for (int j = 0; j < NT; ++j) {
    asm volatile("s_waitcnt vmcnt(0)" ::: "memory");
    *(bf16x8*)(V_lds + vst0) = vs0; *(bf16x8*)(V_lds + vst1) = vs1;
    *(bf16x8*)(K_lds + KSWZ(sr, sc * 2)) = ks0; *(bf16x8*)(K_lds + KSWZ(32 + sr, sc * 2)) = ks1;
    __syncthreads();
    if (j + 1 < NT) SLOAD(j + 1);
    f32x16 p0, p1; float mn, al; bf16x8 pa0, pa1, pa2, pa3;
    qkt(p0, p1, K_lds, qr, r32, hi);
    if (j >= n0) na_hook(p0, p1, R0 + j - n0, qgr, qgc, hi, rpbh);
    partialSM(p0, p1, m_reg, mn, al);
    if (__any(al < 1.f)) { if (hi == 0) al_l[r32] = al; asm volatile("s_waitcnt lgkmcnt(0)" ::: "memory");
#pragma unroll
      for (int d = 0; d < 4; ++d)
#pragma unroll
        for (int r = 0; r < 16; ++r) o[d][r] *= al_l[crow(r, hi)]; }
    finishSM(p0, p1, al, l_reg, pa0, pa1, pa2, pa3); SBAR();
    pv_d0(o, vb0, pa0, pa1, pa2, pa3);
    __syncthreads();
  }
  if (hi == 0) li_l[r32] = l_reg; asm volatile("s_waitcnt lgkmcnt(0)" ::: "memory");
  bf16_t* Ow = Obf + (size_t)(wid * 32) * 512;
#pragma unroll
  for (int r = 0; r < 16; ++r) { const int orow = crow(r, hi); const float rl = __builtin_amdgcn_rcpf(li_l[orow]);
#pragma unroll
    for (int d0 = 0; d0 < 4; ++d0) Ow[(size_t)orow * 512 + d0 * 32 + r32] = (bf16_t)f2bf(o[d0][r] * rl); }
  __syncthreads();
#undef KROW
#undef SLOAD
}
}

__device__ __forceinline__ void phase_small(const Args& a, unsigned char* lds, int vcu, int G, int layer, bool last) {
    const int tid = otid(), wave = tid >> 6, lane = tid & 63;
    const int gw = vcu * NWAVE + wave, NGW = G * NWAVE;
    const int nrows = last ? SEQ : MR;
    for (int row = gw; row < MR; row += NGW) qk_prep_row(a, layer, row, lane);
    for (int row = gw; row < nrows; row += NGW) dlt_row(a, row, lane);
    const int nunits = (nrows / 128) * 4;
    for (int u = G - 1 - vcu; u < nunits; u += G) cmix_unit(a, layer, u, lds);
    const bf16_t* PL = (const bf16_t*)(a.ws + WS_PL); bf16_t* OD = (bf16_t*)(a.ws + WS_OUTS) + (size_t)3 * MR * 512;
    const float* rpb = a.in[I_RPB] + layer * 4 * 15 * 31;
    const int nu = 128 + (last ? 0 : 4);
    for (int u = vcu; u < nu; u += G) {
        if (u < 128) { const int h = u & 3, i = u >> 2, R0 = min(max(4 * i - 4, 0), 120);
            att::attn_unit_na(PL, i * 256, D_Q0 + h * HD, D_K0 + h * HD, D_V0 + h * HD, R0, rpb + h * 465, OD + (size_t)(i * 256) * 512 + h * HD, (char*)lds); }
        else { const int h = u - 128;
            att::attn_unit<0, true>(PL, SEQ, D_Q0 + h * HD, D_K0 + h * HD, D_V0 + h * HD, 4, SEQ, 4, 0, nullptr, OD + (size_t)SEQ * 512 + h * HD, nullptr, nullptr, (char*)lds); }
    }
}
constexpr size_t OPART_LSE = (size_t)2 * SEQ * 512 * 4;
__device__ __forceinline__ void phase_attn_a(const Args& a, unsigned char* lds, int vcu, int G, bool last) {
    const bf16_t* PL = (const bf16_t*)(a.ws + WS_PL); bf16_t* OA = (bf16_t*)(a.ws + WS_OUTS);
    float* Opart = (float*)(a.ws + WS_MRG); float* LSE = (float*)(a.ws + WS_MRG + OPART_LSE);
    const int nu = 256 + (last ? 0 : 4);
    for (int u = vcu; u < nu; u += G) {
        if (u < 256) { const int half = u >> 7, h = (u >> 5) & 3, qb = u & 31, kvh = h >> 1;
            att::attn_unit<0, false>(PL, qb * 256, A_Q0 + h * HD, A_K0 + kvh * HD, A_V0 + kvh * HD, 66, half * 4224, 66, 0, nullptr, nullptr,
                                     Opart + ((size_t)half * SEQ + qb * 256) * 512 + h * HD, LSE + ((size_t)half * SEQ + qb * 256) * 4 + h, (char*)lds); }
        else { const int h = u - 256, kvh = h >> 1;
            att::attn_unit<0, true>(PL, SEQ, A_Q0 + h * HD, A_K0 + kvh * HD, A_V0 + kvh * HD, 4, SEQ, 4, 0, nullptr, OA + (size_t)SEQ * 512 + h * HD, nullptr, nullptr, (char*)lds); }
    }
}
__device__ __forceinline__ void phase_combine_a(const Args& a, int vcu, int G) {
    const int tid = otid(), wave = tid >> 6, lane = tid & 63;
    const int gw = vcu * NWAVE + wave, NGW = G * NWAVE;
    const float* Opart = (const float*)(a.ws + WS_MRG); const float* LSE = (const float*)(a.ws + WS_MRG + OPART_LSE); bf16_t* OA = (bf16_t*)(a.ws + WS_OUTS);
    for (int row = gw; row < SEQ; row += NGW) {
        const float l0 = LSE[(size_t)row * 4 + (lane >> 4)], l1 = LSE[((size_t)SEQ + row) * 4 + (lane >> 4)];
        const float mx = fmaxf(l0, l1), w0 = exp2f(l0 - mx), w1 = exp2f(l1 - mx), inv = 1.f / (w0 + w1), c0 = w0 * inv, c1 = w1 * inv;
        const float* p0 = Opart + (size_t)row * 512 + lane * 8; const float* p1 = p0 + (size_t)SEQ * 512;
        const f32x4 a0 = *(const f32x4*)p0, a1 = *(const f32x4*)(p0 + 4), b0 = *(const f32x4*)p1, b1 = *(const f32x4*)(p1 + 4);
        const f32x4 r0 = a0 * c0 + b0 * c1, r1 = a1 * c0 + b1 * c1;
        u32x4 w; w.x = pk2(r0[0], r0[1]); w.y = pk2(r0[2], r0[3]); w.z = pk2(r1[0], r1[1]); w.w = pk2(r1[2], r1[3]);
        *(u32x4*)(OA + (size_t)row * 512 + lane * 8) = w;
    }
}

constexpr int NPHASE = 22;
__global__ void __launch_bounds__(NTHR, 2) fwd(Args a) {
    extern __shared__ __attribute__((aligned(16))) unsigned char lds[];
    const int G = gridDim.x, bx = blockIdx.x;
    const int vcu = (G % 8 == 0) ? (bx % 8) * (G / 8) + bx / 8 : bx;
    unsigned char* ws = a.ws;
    const float* MOD = (const float*)(ws + WS_CTL + CTL_MOD);
#if MK_COOP
    cg::grid_group grid = cg::this_grid();
#define SEAM(p) do { if (lo <= (p) && (p) + 1 < hi) grid.sync(); } while (0)
#else
#define SEAM(p) do { } while (0)
#endif
    const int lo = a.ph_lo, hi = a.ph_hi;
#ifndef PHMASK
#define PHMASK 0xffffffu
#endif
#define IN(p) (lo <= (p) && (p) < hi && ((PHMASK >> ((p) < 2 ? (p) : 2 + ((p) - 2) % 10)) & 1u))
    if (IN(0)) { phase_prologue(a, lds, vcu, G); } SEAM(0);
    if (IN(1)) { phase_rows<0>(a, vcu, G, MR, nullptr, nullptr, 0, a.in[I_NPRE_MIX], MOD, 0); } SEAM(1);
    {
        constexpr int l = 0; constexpr bool last = (l == 1); const int pb = 2 + l * 10;
        unsigned char* wb = ws + WS_W + (size_t)l * WPL;
        const float* modl = MOD + (size_t)l * 2 * NIN;
        const int Mrows = last ? SEQ : MR;
        if (IN(pb + 0)) {
            Gemm g{(const bf16_t*)(ws + WS_XN), (const bf16_t*)(wb + W_IN), DM, DM, DM}; StaticOrder S; S.init(MR, NIN, G, bx);
            EpiIn E{(bf16_t*)(ws + WS_PL)}; gemm_phase((PG8_LAS unsigned char*)lds, g, S, E);
        } SEAM(pb + 0);
        if (IN(pb + 1)) { phase_small(a, lds, vcu, G, l, last); } SEAM(pb + 1);
        if (IN(pb + 2)) { phase_attn_a(a, lds, vcu, G, last); } SEAM(pb + 2);
        if (IN(pb + 3)) {
            phase_combine_a(a, vcu, G);
            Gemm g{(const bf16_t*)(ws + WS_DLT), (const bf16_t*)(wb + W_B), 512, 512, 512}; StaticOrder S; S.init(Mrows, 512, G, bx);
            EpiScale E{(bf16_t*)(ws + WS_OUTS) + (size_t)1 * MR * 512, 512, a.in[I_BSCALE] + l * 512}; gemm_phase((PG8_LAS unsigned char*)lds, g, S, E);
        } SEAM(pb + 3);
        if (IN(pb + 4)) {
            Gemm g{(const bf16_t*)(ws + WS_OUTS), (const bf16_t*)(wb + W_BR), 512, 512, 512}; MergeOrder S; S.base.init(Mrows, DM, G, bx);
            EpiMerge E{(const bf16_t*)(ws + WS_PL), (float*)(ws + WS_MRG), (bf16_t*)(ws + WS_MRGB)}; gemm_phase((PG8_LAS unsigned char*)lds, g, S, E);
        } SEAM(pb + 4);
        if (IN(pb + 5)) {
            Gemm g{(const bf16_t*)(ws + WS_MRGB), (const bf16_t*)(wb + W_O), DM, DM, DM}; StaticOrder S; S.init(Mrows, DM, G, bx);
            EpiF32 E{(float*)(ws + WS_MRG), DM}; gemm_phase((PG8_LAS unsigned char*)lds, g, S, E);
        } SEAM(pb + 5);
        if (IN(pb + 6)) { phase_rows<1>(a, vcu, G, Mrows, a.in[I_NPOST_MIX] + l * DM, modl, 2, a.in[I_NPRE_FFN] + l * DM, modl, 3); } SEAM(pb + 6);
        if (IN(pb + 7)) {
            Gemm g{(const bf16_t*)(ws + WS_XN), (const bf16_t*)(wb + W_GU), DM, DM, DM}; StaticOrder S; S.init(Mrows, 2 * FF, G, bx);
            EpiSwiglu E{(bf16_t*)(ws + WS_H)}; gemm_phase((PG8_LAS unsigned char*)lds, g, S, E);
        } SEAM(pb + 7);
        if (IN(pb + 8)) {
            Gemm g{(const bf16_t*)(ws + WS_H), (const bf16_t*)(wb + W_D), FF, FF, FF}; StaticOrder S; S.init(Mrows, DM, G, bx);
            EpiF32 E{(float*)(ws + WS_MRG), DM}; gemm_phase((PG8_LAS unsigned char*)lds, g, S, E);
        } SEAM(pb + 8);
        if (IN(pb + 9)) {
            if (!last) phase_rows<1>(a, vcu, G, MR, a.in[I_NPOST_FFN] + l * DM, modl, 5, a.in[I_NPRE_MIX] + (l + 1) * DM, MOD + (size_t)(l + 1) * 2 * NIN, 0);
            else phase_rows<2>(a, vcu, G, SEQ, a.in[I_NPOST_FFN] + l * DM, modl, 5, nullptr, nullptr, 0);
        }
        if (!last) SEAM(pb + 9);
        }
    {
        constexpr int l = 1; constexpr bool last = (l == 1); const int pb = 2 + l * 10;
        unsigned char* wb = ws + WS_W + (size_t)l * WPL;
        const float* modl = MOD + (size_t)l * 2 * NIN;
        const int Mrows = last ? SEQ : MR;
        if (IN(pb + 0)) {
            Gemm g{(const bf16_t*)(ws + WS_XN), (const bf16_t*)(wb + W_IN), DM, DM, DM}; StaticOrder S; S.init(MR, NIN, G, bx);
            EpiIn E{(bf16_t*)(ws + WS_PL)}; gemm_phase((PG8_LAS unsigned char*)lds, g, S, E);
        } SEAM(pb + 0);
        if (IN(pb + 1)) { phase_small(a, lds, vcu, G, l, last); } SEAM(pb + 1);
        if (IN(pb + 2)) { phase_attn_a(a, lds, vcu, G, last); } SEAM(pb + 2);
        if (IN(pb + 3)) {
            phase_combine_a(a, vcu, G);
            Gemm g{(const bf16_t*)(ws + WS_DLT), (const bf16_t*)(wb + W_B), 512, 512, 512}; StaticOrder S; S.init(Mrows, 512, G, bx);
            EpiScale E{(bf16_t*)(ws + WS_OUTS) + (size_t)1 * MR * 512, 512, a.in[I_BSCALE] + l * 512}; gemm_phase((PG8_LAS unsigned char*)lds, g, S, E);
        } SEAM(pb + 3);
        if (IN(pb + 4)) {
            Gemm g{(const bf16_t*)(ws + WS_OUTS), (const bf16_t*)(wb + W_BR), 512, 512, 512}; MergeOrder S; S.base.init(Mrows, DM, G, bx);
            EpiMerge E{(const bf16_t*)(ws + WS_PL), (float*)(ws + WS_MRG), (bf16_t*)(ws + WS_MRGB)}; gemm_phase((PG8_LAS unsigned char*)lds, g, S, E);
        } SEAM(pb + 4);
        if (IN(pb + 5)) {
            Gemm g{(const bf16_t*)(ws + WS_MRGB), (const bf16_t*)(wb + W_O), DM, DM, DM}; StaticOrder S; S.init(Mrows, DM, G, bx);
            EpiF32 E{(float*)(ws + WS_MRG), DM}; gemm_phase((PG8_LAS unsigned char*)lds, g, S, E);
        } SEAM(pb + 5);
        if (IN(pb + 6)) { phase_rows<1>(a, vcu, G, Mrows, a.in[I_NPOST_MIX] + l * DM, modl, 2, a.in[I_NPRE_FFN] + l * DM, modl, 3); } SEAM(pb + 6);
        if (IN(pb + 7)) {
            Gemm g{(const bf16_t*)(ws + WS_XN), (const bf16_t*)(wb + W_GU), DM, DM, DM}; StaticOrder S; S.init(Mrows, 2 * FF, G, bx);
            EpiSwiglu E{(bf16_t*)(ws + WS_H)}; gemm_phase((PG8_LAS unsigned char*)lds, g, S, E);
        } SEAM(pb + 7);
        if (IN(pb + 8)) {
            Gemm g{(const bf16_t*)(ws + WS_H), (const bf16_t*)(wb + W_D), FF, FF, FF}; StaticOrder S; S.init(Mrows, DM, G, bx);
            EpiF32 E{(float*)(ws + WS_MRG), DM}; gemm_phase((PG8_LAS unsigned char*)lds, g, S, E);
        } SEAM(pb + 8);
        if (IN(pb + 9)) {
            if (!last) phase_rows<1>(a, vcu, G, MR, a.in[I_NPOST_FFN] + l * DM, modl, 5, a.in[I_NPRE_MIX] + (l + 1) * DM, MOD + (size_t)(l + 1) * 2 * NIN, 0);
            else phase_rows<2>(a, vcu, G, SEQ, a.in[I_NPOST_FFN] + l * DM, modl, 5, nullptr, nullptr, 0);
        }
        if (!last) SEAM(pb + 9);
        }
#undef IN
#undef SEAM
}

extern "C" void kernel_launch(void* const* d_in, const int* in_sizes, int n_in, void* d_out, int out_size, void* d_ws, size_t ws_size, hipStream_t stream) {
    static int grid = 0;
    if (grid == 0) {
        if (n_in != N_IN || out_size != SEQ * DM || ws_size < WS_END) { fprintf(stderr, "kernel_launch: unexpected shapes (n_in %d out %d ws %zu)\n", n_in, out_size, ws_size); grid = -1; return; }
        if (hipFuncSetAttribute((const void*)fwd, hipFuncAttributeMaxDynamicSharedMemorySize, LDS_BYTES) != hipSuccess) { fprintf(stderr, "kernel_launch: hipFuncSetAttribute failed\n"); grid = -1; return; }
        int dev = 0, cus = 0, per_cu = 0;
        hipGetDevice(&dev); hipDeviceGetAttribute(&cus, hipDeviceAttributeMultiprocessorCount, dev);
        hipOccupancyMaxActiveBlocksPerMultiprocessor(&per_cu, (const void*)fwd, NTHR, LDS_BYTES);
        if (per_cu < 1) { fprintf(stderr, "kernel_launch: occupancy query says %d blocks per CU\n", per_cu); per_cu = 1; }
        (void)hipGetLastError();
        grid = cus * per_cu;
        fprintf(stderr, "kernel_launch: grid %d (cus %d x %d)\n", grid, cus, per_cu);
    }
    if (grid < 0) return;
    hipMemsetAsync((char*)d_ws + WS_CTL, 0, CTL_BYTES, stream);
    Args a{};
    for (int i = 0; i < N_IN; ++i) a.in[i] = (const float*)d_in[i];
    a.out = (float*)d_out; a.ws = (unsigned char*)d_ws;
#if MK_COOP
    a.ph_lo = 0; a.ph_hi = NPHASE;
    void* params[] = {&a};
    hipError_t e = hipLaunchCooperativeKernel((const void*)fwd, dim3(grid), dim3(NTHR), params, LDS_BYTES, stream);
    if (e != hipSuccess) fprintf(stderr, "kernel_launch: cooperative launch failed: %s (grid %d)\n", hipGetErrorString(e), grid);
#else
    for (int p = 0; p < NPHASE; ++p) {
        a.ph_lo = p; a.ph_hi = p + 1;
        hipLaunchKernelGGL(fwd, dim3(grid), dim3(NTHR), LDS_BYTES, stream, a);
    }
#endif
}
```

```cpp
#include <hip/hip_runtime.h>
#include <hip/hip_cooperative_groups.h>
#include <cstdio>
#include <cstdint>
namespace cg = cooperative_groups;

#ifndef MK_COOP
#define MK_COOP 1
#endif

typedef unsigned short bf16_t;
typedef short bf16x8 __attribute__((ext_vector_type(8)));
typedef float f32x4 __attribute__((ext_vector_type(4)));
typedef unsigned u32x4 __attribute__((ext_vector_type(4)));
typedef unsigned u32x2 __attribute__((ext_vector_type(2)));

constexpr int DM = 2048, SEQ = 8192, CTXL = 256, MR = SEQ + CTXL, NIN = 12288, FF = 5632, HD = 128, GW = 64;
constexpr int A_Q0 = 0, A_K0 = 512, A_V0 = 768, B0 = 1024, C_U0 = 1536, C_V0 = 2048, D_Q0 = 2560, D_K0 = 3072, D_V0 = 3584, G0 = 4096;
constexpr float EPS = 1e-6f;
constexpr int NTHR = 512, NWAVE = 8;
constexpr int LDS_BYTES = 147456;

enum { I_X = 0, I_C, I_CTX, I_CCTX, I_ADAW, I_ADAB, I_NPRE_MIX, I_NPOST_MIX, I_NPRE_FFN, I_NPOST_FFN, I_WIN, I_AQN, I_AKN, I_BW, I_BSCALE,
       I_CNG, I_CNB, I_CWS, I_CBS, I_RPB, I_WBR, I_WO, I_WG, I_WU, I_WD, N_IN };

constexpr size_t MiB = 1u << 20;
constexpr size_t WS_CTL = 0, CTL_BYTES = 1 * MiB;
constexpr size_t CTL_MOD = 256 * 1024;
constexpr size_t WS_W = 2 * MiB, WPL = 131 * MiB;
constexpr size_t W_IN = 0, W_BR = 48 * MiB, W_O = 56 * MiB, W_GU = 64 * MiB, W_D = 108 * MiB, W_B = 130 * MiB;
constexpr size_t WS_X = 264 * MiB;
constexpr size_t WS_XN = 330 * MiB;
constexpr size_t WS_PL = 363 * MiB;
constexpr size_t WS_H = WS_PL;
constexpr size_t WS_OUTS = 561 * MiB;
constexpr size_t WS_DLT = 594 * MiB;
constexpr size_t WS_MRG = 603 * MiB;
constexpr size_t WS_MRGB = 669 * MiB;
constexpr size_t WS_END = 702 * MiB;

struct Args { const float* in[N_IN]; float* out; unsigned char* ws; int ph_lo, ph_hi; };

__device__ __forceinline__ unsigned f2bf(float f) { unsigned u = __builtin_bit_cast(unsigned, f); return (u + 0x7fffu + ((u >> 16) & 1u)) >> 16; }
__device__ __forceinline__ unsigned pk2(float lo, float hi) { return f2bf(lo) | (f2bf(hi) << 16); }
__device__ __forceinline__ float bflo(unsigned w) { return __builtin_bit_cast(float, w << 16); }
__device__ __forceinline__ float bfhi(unsigned w) { return __builtin_bit_cast(float, w & 0xffff0000u); }
__device__ __forceinline__ float bf2f(bf16_t h) { return __builtin_bit_cast(float, (unsigned)h << 16); }
__device__ __forceinline__ float wave_sum(float v) {
#pragma unroll
    for (int o = 32; o >= 1; o >>= 1) v += __shfl_xor(v, o);
    return v;
}
__device__ __forceinline__ int otid() { int t = threadIdx.x; asm volatile("" : "+v"(t)); return t; }
__device__ __forceinline__ float sigmoidf_(float x) { return __builtin_amdgcn_rcpf(1.f + __expf(-x)); }
__device__ __forceinline__ float siluf_(float x) { return x * __builtin_amdgcn_rcpf(1.f + __expf(-x)); }

struct Unit { int pm, pn; };
struct Gemm { const bf16_t* A; const bf16_t* Bt; int lda, ldb, K; };
constexpr int NXCD = 8, WGM = 8;
struct StaticOrder {
    int nM, nN, nwg, G, c;
    __device__ void init(int M, int N, int G_, int c_) { nM = M / 256; nN = N / 256; nwg = nM * nN; G = G_; c = c_; }
    __device__ bool next(int i, Unit& u) const {
        const long L = (long)i * G + c; if (L >= nwg) return false;
        int wgid = (int)L; { const int q = nwg / NXCD, r = nwg % NXCD, xcd = wgid % NXCD, off = wgid / NXCD; wgid = (xcd < r ? xcd * (q + 1) : r * (q + 1) + (xcd - r) * q) + off; }
        const int nig = WGM * nN, gid = wgid / nig, fm = gid * WGM, gsz = (nM - fm) < WGM ? (nM - fm) : WGM;
        u.pm = fm + ((wgid % nig) % gsz); u.pn = (wgid % nig) / gsz; return true;
    }
    __device__ __forceinline__ void a_ready(const Unit&) const {}
    __device__ __forceinline__ void done(const Unit&) const {}
};
struct MergeOrder {
    StaticOrder base;
    __device__ bool next(int i, Unit& u) const { Unit t; if (!base.next(i >> 2, t)) return false; const int pass = i & 3; u.pm = pass * 33 + t.pm; u.pn = pass * 8 + t.pn; return true; }
    __device__ __forceinline__ void a_ready(const Unit&) const {}
    __device__ __forceinline__ void done(const Unit&) const {}
};

struct EpiIn {
    static constexpr bool PERM = true, AFTER_DRAIN = false;
    bf16_t* PL;
    __device__ __forceinline__ void operator()(const f32x4 (&acc)[2][2][4][2], const Unit& u, int wr, int wc, int fr, int fq) const {
        const bool gate = u.pn >= (G0 / 256);
#pragma unroll
        for (int ai = 0; ai < 2; ++ai)
#pragma unroll
            for (int m = 0; m < 4; ++m) {
                const int row = u.pm * 256 + ai * 128 + wr * 64 + m * 16 + fr;
#pragma unroll
                for (int bj = 0; bj < 2; ++bj) {
                    const int col = u.pn * 256 + bj * 128 + wc * 32 + 8 * fq;
                    f32x4 v0 = acc[ai][bj][m][0], v1 = acc[ai][bj][m][1];
                    if (gate) {
#pragma unroll
                        for (int e = 0; e < 4; ++e) { v0[e] = sigmoidf_(v0[e]); v1[e] = sigmoidf_(v1[e]); }
                    }
                    u32x4 w; w.x = pk2(v0[0], v0[1]); w.y = pk2(v0[2], v0[3]); w.z = pk2(v1[0], v1[1]); w.w = pk2(v1[2], v1[3]);
                    *(u32x4*)(PL + (size_t)row * NIN + col) = w;
                }
            }
    }
};
struct EpiScale {
    static constexpr bool PERM = true, AFTER_DRAIN = false;
    bf16_t* O; int ldc; const float* scale;
    __device__ __forceinline__ void operator()(const f32x4 (&acc)[2][2][4][2], const Unit& u, int wr, int wc, int fr, int fq) const {
#pragma unroll
        for (int bj = 0; bj < 2; ++bj) {
            const int col = u.pn * 256 + bj * 128 + wc * 32 + 8 * fq;
            const f32x4 s0 = *(const f32x4*)(scale + col), s1 = *(const f32x4*)(scale + col + 4);
#pragma unroll
            for (int ai = 0; ai < 2; ++ai)
#pragma unroll
                for (int m = 0; m < 4; ++m) {
                    const int row = u.pm * 256 + ai * 128 + wr * 64 + m * 16 + fr;
                    const f32x4 v0 = acc[ai][bj][m][0] * s0, v1 = acc[ai][bj][m][1] * s1;
                    u32x4 w; w.x = pk2(v0[0], v0[1]); w.y = pk2(v0[2], v0[3]); w.z = pk2(v1[0], v1[1]); w.w = pk2(v1[2], v1[3]);
                    *(u32x4*)(O + (size_t)row * ldc + col) = w;
                }
        }
    }
};
struct EpiMerge {
    static constexpr bool PERM = true, AFTER_DRAIN = false;
    const bf16_t* PL; float* MRG; bf16_t* MRGB;
    __device__ __forceinline__ void operator()(const f32x4 (&acc)[2][2][4][2], const Unit& u, int wr, int wc, int fr, int fq) const {
        const int pass = u.pm / 33, pm = u.pm - pass * 33, pn = u.pn & 7;
#pragma unroll
        for (int ai = 0; ai < 2; ++ai)
#pragma unroll
            for (int m = 0; m < 4; ++m) {
                const int row = pm * 256 + ai * 128 + wr * 64 + m * 16 + fr;
#pragma unroll
                for (int bj = 0; bj < 2; ++bj) {
                    const int col = pn * 256 + bj * 128 + wc * 32 + 8 * fq;
                    const u32x4 gw = *(const u32x4*)(PL + (size_t)row * NIN + G0 + pass * DM + col);
                    f32x4 v0 = acc[ai][bj][m][0], v1 = acc[ai][bj][m][1];
                    v0[0] *= bflo(gw.x); v0[1] *= bfhi(gw.x); v0[2] *= bflo(gw.y); v0[3] *= bfhi(gw.y);
                    v1[0] *= bflo(gw.z); v1[1] *= bfhi(gw.z); v1[2] *= bflo(gw.w); v1[3] *= bfhi(gw.w);
                    float* mp = MRG + (size_t)row * DM + col;
                    if (pass > 0) { v0 += *(const f32x4*)mp; v1 += *(const f32x4*)(mp + 4); }
                    if (pass < 3) { *(f32x4*)mp = v0; *(f32x4*)(mp + 4) = v1; }
                    else { u32x4 w; w.x = pk2(v0[0], v0[1]); w.y = pk2(v0[2], v0[3]); w.z = pk2(v1[0], v1[1]); w.w = pk2(v1[2], v1[3]);
                           *(u32x4*)(MRGB + (size_t)row * DM + col) = w; }
                }
            }
    }
};
struct EpiF32 {
    static constexpr bool PERM = true, AFTER_DRAIN = false;
    float* Y; int ldc;
    __device__ __forceinline__ void operator()(const f32x4 (&acc)[2][2][4][2], const Unit& u, int wr, int wc, int fr, int fq) const {
#pragma unroll
        for (int ai = 0; ai < 2; ++ai)
#pragma unroll
            for (int m = 0; m < 4; ++m) {
                const int row = u.pm * 256 + ai * 128 + wr * 64 + m * 16 + fr;
#pragma unroll
                for (int bj = 0; bj < 2; ++bj) {
                    const int col = u.pn * 256 + bj * 128 + wc * 32 + 8 * fq;
                    float* yp = Y + (size_t)row * ldc + col;
                    *(f32x4*)yp = acc[ai][bj][m][0]; *(f32x4*)(yp + 4) = acc[ai][bj][m][1];
                }
            }
    }
};
struct EpiSwiglu {
    static constexpr bool PERM = true, AFTER_DRAIN = false;
    bf16_t* H;
    __device__ __forceinline__ void operator()(const f32x4 (&acc)[2][2][4][2], const Unit& u, int wr, int wc, int fr, int fq) const {
#pragma unroll
        for (int ai = 0; ai < 2; ++ai)
#pragma unroll
            for (int m = 0; m < 4; ++m) {
                const int row = u.pm * 256 + ai * 128 + wr * 64 + m * 16 + fr;
                const int col = u.pn * 128 + wc * 32 + 8 * fq;
                f32x4 h0, h1;
#pragma unroll
                for (int e = 0; e < 4; ++e) { h0[e] = siluf_(acc[ai][0][m][0][e]) * acc[ai][1][m][0][e]; h1[e] = siluf_(acc[ai][0][m][1][e]) * acc[ai][1][m][1][e]; }
                u32x4 w; w.x = pk2(h0[0], h0[1]); w.y = pk2(h0[2], h0[3]); w.z = pk2(h1[0], h1[1]); w.w = pk2(h1[2], h1[3]);
                *(u32x4*)(H + (size_t)row * FF + col) = w;
            }
    }
};

#define PG8_LAS __attribute__((address_space(3)))
constexpr int BM = 256, BK = 64, HALF = 128, HTB = HALF * BK * 2, STAGE_BYTES = 8 * HTB;
__device__ __forceinline__ int lds_byte(int r, int c) { const int st = (r >> 4) * 2 + (c >> 5), rr = r & 15, cc = c & 31, ob = rr * 64 + cc * 2; return st * 1024 + (ob ^ (((ob >> 9) & 1) << 5)); }
__device__ __forceinline__ void stage_rc(int b, int& R, int& C) { const int st = b / 1024, sb = b % 1024, swz = sb ^ (((sb >> 9) & 1) << 5); R = (st >> 1) * 16 + swz / 64; C = (st & 1) * 32 + (swz % 64) / 2; }
__device__ __forceinline__ int perm32(int rho) { const int n = rho >> 4, i = rho & 15; return 8 * (i >> 2) + 4 * n + (i & 3); }
template <class Epi, class Sched, bool ALIGN_EPI = true, bool SP2 = true>
__device__ __forceinline__ void gemm_phase(PG8_LAS unsigned char* lds, const Gemm g, const Sched& S, const Epi& E) {
    const int tid = otid(), wid = __builtin_amdgcn_readfirstlane(tid >> 6), lane = tid & 63, wr = wid >> 2, wc = wid & 3, fr = lane & 15, fq = lane >> 4;
    const int K = g.K, nt = K / BK;
    unsigned voffA[2], voffB[2];
#pragma unroll
    for (int i = 0; i < 2; ++i) { int R, C; stage_rc(tid * 16 + i * 8192, R, C); const int Rb = Epi::PERM ? ((R & ~31) + perm32(R & 31)) : R;
        voffA[i] = (unsigned)(R * g.lda + C) * 2u; voffB[i] = (unsigned)(Rb * g.ldb + C) * 2u; }
    const size_t kstep = (size_t)(BK * 2);
    const size_t hstepA = (size_t)HALF * g.lda * 2, hstepB = (size_t)HALF * g.ldb * 2;
    const size_t tstepA = 2 * hstepA, tstepB = 2 * hstepB;
    const unsigned ldsw = (unsigned)wid * 1024u;
    const int aoff = lds_byte(wr * 64 + fr, fq * 8), boff = lds_byte(wc * 32 + fr, fq * 8);
#define PG8_SA(b, h) (((b) * 2 + (h)) * HTB)
#define PG8_SB(b, h) ((4 + (b) * 2 + (h)) * HTB)
#define PG8_STAGE(bufoff, gbase, voff) do { _Pragma("unroll") for (int _i = 0; _i < 2; ++_i) \
        __builtin_amdgcn_global_load_lds((const unsigned*)((const char*)(gbase) + (voff)[_i]), (PG8_LAS unsigned*)(lds + (bufoff) + ldsw + _i * 8192), 16, 0, 0); } while (0)
#define PG8_LDA(dst, b, h) do { _Pragma("unroll") for (int m = 0; m < 4; ++m) _Pragma("unroll") for (int k = 0; k < 2; ++k) dst[m][k] = *(const PG8_LAS bf16x8*)(lds + PG8_SA(b, h) + aoff + m * 2048 + k * 1024); } while (0)
#define PG8_LDB(dst, b, h) do { _Pragma("unroll") for (int n = 0; n < 2; ++n) _Pragma("unroll") for (int k = 0; k < 2; ++k) dst[n][k] = *(const PG8_LAS bf16x8*)(lds + PG8_SB(b, h) + boff + n * 2048 + k * 1024); } while (0)
#define PG8_MMA(ai, bj, At, Bt) do { __builtin_amdgcn_s_setprio(1); _Pragma("unroll") for (int m = 0; m < 4; ++m) _Pragma("unroll") for (int n = 0; n < 2; ++n) _Pragma("unroll") for (int k = 0; k < 2; ++k) \
        acc[ai][bj][m][n] = __builtin_amdgcn_mfma_f32_16x16x32_bf16(Bt[n][k], At[m][k], acc[ai][bj][m][n], 0, 0, 0); __builtin_amdgcn_s_setprio(0); } while (0)
#define PG8_WAIT_V(n) asm volatile("s_waitcnt vmcnt(" #n ")" ::: "memory")
#define PG8_WAIT_L(n) asm volatile("s_waitcnt lgkmcnt(" #n ")" ::: "memory")
#define PG8_BAR __builtin_amdgcn_s_barrier()
#define PG8_SCHED __builtin_amdgcn_sched_barrier(0)
    Unit cur, nxt; int ui = 0;
    if (!S.next(0, cur)) return;
    f32x4 acc[2][2][4][2];
#pragma unroll
    for (int a = 0; a < 2; ++a)
#pragma unroll
        for (int b = 0; b < 2; ++b)
#pragma unroll
            for (int m = 0; m < 4; ++m)
#pragma unroll
                for (int n = 0; n < 2; ++n) acc[a][b][m][n] = (f32x4){0.f, 0.f, 0.f, 0.f};
    bf16x8 At[4][2], B0[2][2], B1[2][2];
    const char* cA = (const char*)g.A + (size_t)cur.pm * tstepA; const char* cB = (const char*)g.Bt + (size_t)cur.pn * tstepB;
    S.a_ready(cur);
    if constexpr (SP2) {
        PG8_STAGE(PG8_SB(0, 0), cB, voffB); PG8_STAGE(PG8_SB(0, 1), cB + hstepB, voffB); PG8_STAGE(PG8_SA(0, 0), cA, voffA); PG8_STAGE(PG8_SA(0, 1), cA + hstepA, voffA);
        if (wr == 1) PG8_BAR;
        PG8_WAIT_V(2); PG8_BAR;
        PG8_STAGE(PG8_SB(1, 0), cB + kstep, voffB); PG8_STAGE(PG8_SA(1, 0), cA + kstep, voffA); PG8_STAGE(PG8_SB(1, 1), cB + hstepB + kstep, voffB);
        PG8_WAIT_V(6); PG8_BAR;
    } else {
        PG8_STAGE(PG8_SB(0, 0), cB, voffB); PG8_STAGE(PG8_SA(0, 0), cA, voffA); PG8_STAGE(PG8_SB(0, 1), cB + hstepB, voffB); PG8_STAGE(PG8_SA(0, 1), cA + hstepA, voffA);
        if (wr == 1) PG8_BAR;
        PG8_WAIT_V(4); PG8_BAR;
        PG8_STAGE(PG8_SB(1, 0), cB + kstep, voffB); PG8_STAGE(PG8_SA(1, 0), cA + kstep, voffA); PG8_STAGE(PG8_SB(1, 1), cB + hstepB + kstep, voffB);
        PG8_WAIT_V(6); PG8_BAR;
    }
    for (;;) {
        const bool has_next = S.next(ui + 1, nxt);
        const char* nA = has_next ? (const char*)g.A + (size_t)nxt.pm * tstepA : cA; const char* nB = has_next ? (const char*)g.Bt + (size_t)nxt.pn * tstepB : cB;
        for (int t = 0; t < nt; t += 2) {
            const bool last = (t == nt - 2);
            const char* a1 = cA + (size_t)(t + 1) * kstep;
            const char* a2 = last ? nA : cA + (size_t)(t + 2) * kstep; const char* b2 = last ? nB : cB + (size_t)(t + 2) * kstep;
            const char* a3 = a2 + kstep; const char* b3 = b2 + kstep;
            if (last && has_next) S.a_ready(nxt);
            if constexpr (SP2) {
            PG8_LDB(B0, 0, 0); PG8_LDB(B1, 0, 1); PG8_SCHED; PG8_LDA(At, 0, 0); PG8_STAGE(PG8_SA(1, 1), a1 + hstepA, voffA);
            PG8_WAIT_V(8); PG8_WAIT_L(0); PG8_BAR; PG8_MMA(0, 0, At, B0); PG8_MMA(0, 1, At, B1); PG8_BAR; PG8_SCHED;
            PG8_LDA(At, 0, 1); PG8_STAGE(PG8_SB(0, 0), b2, voffB); PG8_STAGE(PG8_SB(0, 1), b2 + hstepB, voffB); PG8_STAGE(PG8_SA(0, 0), a2, voffA);
            PG8_WAIT_V(8); PG8_WAIT_L(0); PG8_BAR; PG8_MMA(1, 0, At, B0); PG8_MMA(1, 1, At, B1); PG8_BAR; PG8_SCHED;
            PG8_LDB(B0, 1, 0); PG8_LDB(B1, 1, 1); PG8_SCHED; PG8_LDA(At, 1, 0); PG8_STAGE(PG8_SA(0, 1), a2 + hstepA, voffA);
            PG8_WAIT_V(8); PG8_WAIT_L(0); PG8_BAR; PG8_MMA(0, 0, At, B0); PG8_MMA(0, 1, At, B1); PG8_BAR; PG8_SCHED;
            PG8_LDA(At, 1, 1); PG8_STAGE(PG8_SB(1, 0), b3, voffB); PG8_STAGE(PG8_SB(1, 1), b3 + hstepB, voffB); PG8_STAGE(PG8_SA(1, 0), a3, voffA);
            PG8_WAIT_V(8); PG8_WAIT_L(0); PG8_BAR; PG8_MMA(1, 0, At, B0); PG8_MMA(1, 1, At, B1); PG8_BAR; PG8_SCHED;
            } else {
            PG8_LDB(B0, 0, 0); PG8_SCHED; PG8_LDA(At, 0, 0); PG8_STAGE(PG8_SA(1, 1), a1 + hstepA, voffA);
            PG8_WAIT_L(8); PG8_BAR; PG8_WAIT_L(0); PG8_MMA(0, 0, At, B0); PG8_BAR; PG8_SCHED;
            PG8_LDB(B1, 0, 1); PG8_STAGE(PG8_SB(0, 0), b2, voffB);
            PG8_BAR; PG8_WAIT_L(0); PG8_MMA(0, 1, At, B1); PG8_BAR;
            PG8_LDA(At, 0, 1); PG8_STAGE(PG8_SA(0, 0), a2, voffA);
            PG8_BAR; PG8_WAIT_L(0); PG8_MMA(1, 0, At, B0); PG8_BAR; PG8_SCHED;
            PG8_STAGE(PG8_SB(0, 1), b2 + hstepB, voffB);
            PG8_WAIT_V(6); PG8_BAR; PG8_MMA(1, 1, At, B1); PG8_BAR;
            PG8_LDB(B0, 1, 0); PG8_SCHED; PG8_LDA(At, 1, 0); PG8_STAGE(PG8_SA(0, 1), a2 + hstepA, voffA);
            PG8_WAIT_L(8); PG8_BAR; PG8_WAIT_L(0); PG8_MMA(0, 0, At, B0); PG8_BAR; PG8_SCHED;
            PG8_LDB(B1, 1, 1); PG8_STAGE(PG8_SB(1, 0), b3, voffB);
            PG8_BAR; PG8_WAIT_L(0); PG8_MMA(0, 1, At, B1); PG8_BAR;
            PG8_LDA(At, 1, 1); PG8_STAGE(PG8_SA(1, 0), a3, voffA);
            PG8_BAR; PG8_WAIT_L(0); PG8_MMA(1, 0, At, B0); PG8_BAR; PG8_SCHED;
            PG8_STAGE(PG8_SB(1, 1), b3 + hstepB, voffB);
            PG8_WAIT_V(6); PG8_BAR; PG8_MMA(1, 1, At, B1); PG8_BAR;
            }
        }
        if constexpr (ALIGN_EPI) { if (wr == 0) PG8_BAR; }
        if constexpr (!Epi::AFTER_DRAIN) { E(acc, cur, wr, wc, fr, fq); S.done(cur); }
        if (!has_next) break;
#pragma unroll
        for (int a = 0; a < 2; ++a)
#pragma unroll
            for (int b = 0; b < 2; ++b)
#pragma unroll
                for (int m = 0; m < 4; ++m)
#pragma unroll
                    for (int n = 0; n < 2; ++n) acc[a][b][m][n] = (f32x4){0.f, 0.f, 0.f, 0.f};
        cur = nxt; cA = nA; cB = nB; ++ui;
        if constexpr (ALIGN_EPI) { if (wr == 1) PG8_BAR; }
    }
    PG8_WAIT_V(0);
    if constexpr (!ALIGN_EPI) { if (wr == 0) PG8_BAR; }
    PG8_BAR;
    if constexpr (Epi::AFTER_DRAIN) { E.fused(acc, cur, wr, wc, fr, fq, lds, wid, lane); S.done(cur); }
#undef PG8_SA
#undef PG8_SB
#undef PG8_STAGE
#undef PG8_LDA
#undef PG8_LDB
#undef PG8_MMA
#undef PG8_WAIT_V
#undef PG8_WAIT_L
#undef PG8_BAR
#undef PG8_SCHED
}

__device__ __forceinline__ void tr_item(const float* src, int ldn, int k0, int n0, bf16_t* dst, int dld, int drow0, int dk0, float* scr, int lane) {
    const float* sp = src + (size_t)k0 * ldn + n0 + lane;
    float t[64];
#pragma unroll
    for (int i = 0; i < 64; ++i) t[i] = __builtin_nontemporal_load(sp + (size_t)i * ldn);
#pragma unroll
    for (int i = 0; i < 64; ++i) scr[i * 65 + lane] = t[i];
    __builtin_amdgcn_s_waitcnt(0); asm volatile("" ::: "memory");
    const int c = lane & 7;
#pragma unroll
    for (int j = 0; j < 8; ++j) {
        const int n = (lane >> 3) + 8 * j; const float* s = scr + (8 * c) * 65 + n;
        u32x4 o; o.x = pk2(s[0], s[65]); o.y = pk2(s[2 * 65], s[3 * 65]); o.z = pk2(s[4 * 65], s[5 * 65]); o.w = pk2(s[6 * 65], s[7 * 65]);
        *(u32x4*)(dst + (size_t)(drow0 + n) * dld + dk0 + 8 * c) = o;
    }
    __builtin_amdgcn_s_waitcnt(0); asm volatile("" ::: "memory");
}

__device__ __forceinline__ void convert_layer(const Args& a, unsigned char* lds, int l, int widx, int nw) {
    const int tid = otid(), wave = tid >> 6, lane = tid & 63;
    float* scr = (float*)(lds + wave * 16640);
    constexpr int I_IN = 32 * 192, I_BR = 4 * 8 * 32, I_O = 32 * 32, I_G = 32 * 88, I_D = 88 * 32, I_B = 16;
    constexpr int PLI = I_IN + I_BR + I_O + 2 * I_G + I_D + I_B;
    unsigned char* wb = a.ws + WS_W + (size_t)l * WPL;
    for (int it = widx; it < PLI; it += nw) {
        int r = it;
        if (r < I_IN) { const int kb = r / 192, nb = r % 192; tr_item(a.in[I_WIN] + (size_t)l * DM * NIN, NIN, kb * 64, nb * 64, (bf16_t*)(wb + W_IN), DM, nb * 64, kb * 64, scr, lane); continue; } r -= I_IN;
        if (r < I_BR) { const int i = r >> 8, rr = r & 255, kb = rr >> 5, nb = rr & 31;
            tr_item(a.in[I_WBR] + (size_t)(l * 4 + i) * 512 * DM, DM, kb * 64, nb * 64, (bf16_t*)(wb + W_BR) + (size_t)i * DM * 512, 512, nb * 64, kb * 64, scr, lane); continue; } r -= I_BR;
        if (r < I_O) { const int kb = r >> 5, nb = r & 31; tr_item(a.in[I_WO] + (size_t)l * DM * DM, DM, kb * 64, nb * 64, (bf16_t*)(wb + W_O), DM, nb * 64, kb * 64, scr, lane); continue; } r -= I_O;
        if (r < I_G) { const int kb = r / 88, nb = r % 88, n0 = nb * 64; tr_item(a.in[I_WG] + (size_t)l * DM * FF, FF, kb * 64, n0, (bf16_t*)(wb + W_GU), DM, (n0 >> 7) * 256 + (n0 & 127), kb * 64, scr, lane); continue; } r -= I_G;
        if (r < I_G) { const int kb = r / 88, nb = r % 88, n0 = nb * 64; tr_item(a.in[I_WU] + (size_t)l * DM * FF, FF, kb * 64, n0, (bf16_t*)(wb + W_GU), DM, (n0 >> 7) * 256 + 128 + (n0 & 127), kb * 64, scr, lane); continue; } r -= I_G;
        if (r < I_D) { const int kb = r >> 5, nb = r & 31; tr_item(a.in[I_WD] + (size_t)l * FF * DM, DM, kb * 64, nb * 64, (bf16_t*)(wb + W_D), FF, nb * 64, kb * 64, scr, lane); continue; } r -= I_D;
        { const int g = r >> 2, kb = (r >> 1) & 1, nb = r & 1;
          tr_item(a.in[I_BW] + (size_t)(l * 4 + g) * 128 * 128, 128, kb * 64, nb * 64, (bf16_t*)(wb + W_B), 512, g * 128 + nb * 64, g * 128 + kb * 64, scr, lane); }
    }
}
__device__ __forceinline__ void phase_prologue(const Args& a, unsigned char* lds, int vcu, int G) {
    const int tid = otid(), wave = tid >> 6;
    convert_layer(a, lds, 0, vcu * NWAVE + wave, G * NWAVE);
    for (int i = vcu * NTHR + tid; i < 2 * 32768; i += G * NTHR) {
        const int l = i >> 15, j = i & 32767, n = j >> 6, kc = j & 63;
        if ((n >> 7) != (kc >> 4)) *(u32x4*)((bf16_t*)(a.ws + WS_W + (size_t)l * WPL + W_B) + (size_t)n * 512 + kc * 8) = (u32x4){0u, 0u, 0u, 0u};
    }
    float* MOD = (float*)(a.ws + WS_CTL + CTL_MOD);
    for (int it = vcu; it < 768; it += G) {
        const int l = it / 384, r = it % 384, cb = r >> 6, kc = r & 63;
        const int col = cb * 2048 + tid * 4;
        f32x4 al = {0.f, 0.f, 0.f, 0.f}, ac = {0.f, 0.f, 0.f, 0.f};
        const float* wp = a.in[I_ADAW] + ((size_t)l * DM + kc * 32) * NIN + col;
#pragma unroll 8
        for (int k = 0; k < 32; ++k) {
            const float sl = siluf_(a.in[I_C][kc * 32 + k]), sc = siluf_(a.in[I_CCTX][kc * 32 + k]);
            const f32x4 w = *(const f32x4*)(wp + (size_t)k * NIN);
            al += sl * w; ac += sc * w;
        }
        if (kc == 0) { const f32x4 b = *(const f32x4*)(a.in[I_ADAB] + (size_t)l * NIN + col); al += b; ac += b; }
        float* ml = MOD + (size_t)(l * 2 + 0) * NIN + col; float* mc = MOD + (size_t)(l * 2 + 1) * NIN + col;
#pragma unroll
        for (int e = 0; e < 4; ++e) { unsafeAtomicAdd(ml + e, al[e]); unsafeAtomicAdd(mc + e, ac[e]); }
    }
}

template <int MODE>
__device__ __forceinline__ void phase_rows(const Args& a, int vcu, int G, int nrows, const float* gpost, const float* modcur, int gate_idx,
                                           const float* gnext, const float* modnext, int sh_idx) {
    const int tid = otid(), wave = tid >> 6, lane = tid & 63;
    const int gw = vcu * NWAVE + wave, NGW = G * NWAVE;
    float* X = (float*)(a.ws + WS_X); const float* Y = (const float*)(a.ws + WS_MRG); bf16_t* XN = (bf16_t*)(a.ws + WS_XN);
    for (int row = gw; row < nrows; row += NGW) {
        const int isctx = row >= SEQ ? 1 : 0;
        f32x4 x[8];
        if (MODE == 0) {
            const float* src = isctx ? a.in[I_CTX] + (size_t)(row - SEQ) * DM : a.in[I_X] + (size_t)row * DM;
#pragma unroll
            for (int j = 0; j < 8; ++j) x[j] = *(const f32x4*)(src + 4 * lane + 256 * j);
        } else {
            f32x4 y[8]; float ss = 0.f;
#pragma unroll
            for (int j = 0; j < 8; ++j) { x[j] = *(const f32x4*)(X + (size_t)row * DM + 4 * lane + 256 * j); y[j] = *(const f32x4*)(Y + (size_t)row * DM + 4 * lane + 256 * j);
                ss += (y[j][0] * y[j][0] + y[j][1] * y[j][1]) + (y[j][2] * y[j][2] + y[j][3] * y[j][3]); }
            const float rstd = 1.0f / sqrtf(wave_sum(ss) * (1.f / DM) + EPS);
            const float* gate = modcur + (size_t)isctx * NIN + gate_idx * DM;
#pragma unroll
            for (int j = 0; j < 8; ++j) { const int col = 4 * lane + 256 * j; const f32x4 gp = *(const f32x4*)(gpost + col), gt = *(const f32x4*)(gate + col);
                x[j] += gt * (y[j] * rstd * gp); }
        }
        if (MODE == 2) {
#pragma unroll
            for (int j = 0; j < 8; ++j) *(f32x4*)(a.out + (size_t)row * DM + 4 * lane + 256 * j) = x[j];
            continue;
        }
        float ss = 0.f;
#pragma unroll
        for (int j = 0; j < 8; ++j) { *(f32x4*)(X + (size_t)row * DM + 4 * lane + 256 * j) = x[j];
            ss += (x[j][0] * x[j][0] + x[j][1] * x[j][1]) + (x[j][2] * x[j][2] + x[j][3] * x[j][3]); }
        const float rstd = 1.0f / sqrtf(wave_sum(ss) * (1.f / DM) + EPS);
        const float* sh = modnext + (size_t)isctx * NIN + sh_idx * DM; const float* sc = sh + DM;
#pragma unroll
        for (int j = 0; j < 8; ++j) { const int col = 4 * lane + 256 * j; const f32x4 gn = *(const f32x4*)(gnext + col), s1 = *(const f32x4*)(sc + col), s0 = *(const f32x4*)(sh + col);
            const f32x4 h = (x[j] * rstd * gn) * (1.f + s1) + s0;
            u32x2 w; w.x = pk2(h[0], h[1]); w.y = pk2(h[2], h[3]); *(u32x2*)(XN + (size_t)row * DM + col) = w; }
    }
}

__device__ __forceinline__ void qk_prep_row(const Args& a, int layer, int row, int lane) {
    bf16_t* p = (bf16_t*)(a.ws + WS_PL) + (size_t)row * NIN;
    const int ax = lane >> 5, f = lane & 31, d1 = ax * 64 + f, d2 = d1 + 32;
    float cs = 1.f, sn = 0.f;
    if (row < SEQ) { const float pos = (float)(ax == 0 ? (row >> 6) : (row & 63)); const float inv = exp2f(-(float)f * (13.287712379549449f / 32.f)); const float ang = pos * inv; cs = cosf(ang); sn = sinf(ang); }
#pragma unroll
    for (int h = 0; h < 6; ++h) {
        const float* gn = (h < 4 ? a.in[I_AQN] : a.in[I_AKN]) + layer * HD;
        bf16_t* hp = p + h * HD;
        float x1 = bf2f(hp[d1]), x2 = bf2f(hp[d2]);
        const float rstd = 1.0f / sqrtf(wave_sum(x1 * x1 + x2 * x2) * (1.f / HD) + EPS);
        x1 = x1 * rstd * gn[d1]; x2 = x2 * rstd * gn[d2];
        hp[d1] = (bf16_t)f2bf(x1 * cs - x2 * sn); hp[d2] = (bf16_t)f2bf(x2 * cs + x1 * sn);
    }
}
__device__ __forceinline__ void dlt_row(const Args& a, int row, int lane) {
    const bf16_t* PL = (const bf16_t*)(a.ws + WS_PL); bf16_t* DLT = (bf16_t*)(a.ws + WS_DLT);
    const int base = row < SEQ ? 0 : SEQ, n = row < SEQ ? SEQ : CTXL, t = row - base, half = 1 << (lane >> 4);
    const int lo = max(t - half, 0), hi = min(t + half, n);
    float s[8];
#pragma unroll
    for (int e = 0; e < 8; ++e) s[e] = 0.f;
    for (int r = lo; r < hi; ++r) { const u32x4 w = *(const u32x4*)(PL + (size_t)(base + r) * NIN + B0 + lane * 8);
        s[0] += bflo(w.x); s[1] += bfhi(w.x); s[2] += bflo(w.y); s[3] += bfhi(w.y); s[4] += bflo(w.z); s[5] += bfhi(w.z); s[6] += bflo(w.w); s[7] += bfhi(w.w); }
    const float inv = 1.f / (float)(hi - lo);
    const u32x4 w = *(const u32x4*)(PL + (size_t)row * NIN + B0 + lane * 8);
    u32x4 o; o.x = pk2(s[0] * inv - bflo(w.x), s[1] * inv - bfhi(w.x)); o.y = pk2(s[2] * inv - bflo(w.y), s[3] * inv - bfhi(w.y));
    o.z = pk2(s[4] * inv - bflo(w.z), s[5] * inv - bfhi(w.z)); o.w = pk2(s[6] * inv - bflo(w.w), s[7] * inv - bfhi(w.w));
    *(u32x4*)(DLT + (size_t)row * 512 + lane * 8) = o;
}
constexpr int CP = 136;
__device__ __forceinline__ void cmix_unit(const Args& a, int layer, int unit, unsigned char* lds) {
    const int tid = otid(), wave = tid >> 6, lane = tid & 63, chunk = unit >> 2, g = unit & 3;
    const bf16_t* PL = (const bf16_t*)(a.ws + WS_PL); bf16_t* OUT = (bf16_t*)(a.ws + WS_OUTS) + (size_t)2 * MR * 512;
    bf16_t* vT = (bf16_t*)lds;
    bf16_t* wsL = (bf16_t*)(lds + 128 * CP * 2);
    float* st = (float*)(lds + 2 * 128 * CP * 2);
    const int t0 = chunk * 128;
    for (int i = 0; i < 16; ++i) {
        const int q = wave * 16 + i;
        const u32x4 w = *(const u32x4*)(PL + (size_t)(t0 + q) * NIN + C_V0 + lane * 8);
        float x[8] = {bflo(w.x), bfhi(w.x), bflo(w.y), bfhi(w.y), bflo(w.z), bfhi(w.z), bflo(w.w), bfhi(w.w)};
        float s = 0.f;
#pragma unroll
        for (int e = 0; e < 8; ++e) s += x[e];
        const float mean = wave_sum(s) * (1.f / 512.f); float q2 = 0.f;
#pragma unroll
        for (int e = 0; e < 8; ++e) { const float d = x[e] - mean; q2 += d * d; }
        const float rstd = 1.0f / sqrtf(wave_sum(q2) * (1.f / 512.f) + EPS);
        if (lane == 0) { st[2 * q] = mean; st[2 * q + 1] = rstd; }
    }
    __syncthreads();
    {
        const int q = tid & 127, cb = tid >> 7; const float mean = st[2 * q], rstd = st[2 * q + 1];
        const float* lg = a.in[I_CNG] + layer * 512 + g * 128 + cb * 32; const float* lb = a.in[I_CNB] + layer * 512 + g * 128 + cb * 32;
        const bf16_t* vp = PL + (size_t)(t0 + q) * NIN + C_V0 + g * 128 + cb * 32;
#pragma unroll
        for (int j = 0; j < 4; ++j) { const u32x4 w = *(const u32x4*)(vp + j * 8);
            const float x[8] = {bflo(w.x), bfhi(w.x), bflo(w.y), bfhi(w.y), bflo(w.z), bfhi(w.z), bflo(w.w), bfhi(w.w)};
#pragma unroll
            for (int e = 0; e < 8; ++e) { const int c = j * 8 + e; vT[(cb * 32 + c) * CP + q] = (bf16_t)f2bf((x[e] - mean) * rstd * lg[c] + lb[c]); } }
        const int p = tid >> 2, qb = (tid & 3) * 32; const float* wp = a.in[I_CWS] + ((size_t)(layer * 4 + g) * 128 + p) * 128 + qb;
#pragma unroll
        for (int j = 0; j < 8; ++j) { const f32x4 w = *(const f32x4*)(wp + j * 4); u32x2 o; o.x = pk2(w[0], w[1]); o.y = pk2(w[2], w[3]); *(u32x2*)(wsL + p * CP + qb + j * 4) = o; }
    }
    __syncthreads();
    {
        const int fr = lane & 15, fq = lane >> 4;
        f32x4 acc[8];
#pragma unroll
        for (int nb = 0; nb < 8; ++nb) acc[nb] = (f32x4){0.f, 0.f, 0.f, 0.f};
#pragma unroll
        for (int ks = 0; ks < 4; ++ks) {
            const bf16x8 wf = *(const bf16x8*)(wsL + (wave * 16 + fr) * CP + ks * 32 + fq * 8);
#pragma unroll
            for (int nb = 0; nb < 8; ++nb) { const bf16x8 vf = *(const bf16x8*)(vT + (nb * 16 + fr) * CP + ks * 32 + fq * 8);
                acc[nb] = __builtin_amdgcn_mfma_f32_16x16x32_bf16(vf, wf, acc[nb], 0, 0, 0); }
        }
        const int p = wave * 16 + fr; const float bs = a.in[I_CBS][(layer * 4 + g) * 128 + p];
        const bf16_t* up = PL + (size_t)(t0 + p) * NIN + C_U0 + g * 128; bf16_t* op = OUT + (size_t)(t0 + p) * 512 + g * 128;
#pragma unroll
        for (int nb = 0; nb < 8; ++nb) { const int c = nb * 16 + 4 * fq; const u32x2 uw = *(const u32x2*)(up + c);
            u32x2 o; o.x = pk2((acc[nb][0] + bs) * bflo(uw.x), (acc[nb][1] + bs) * bfhi(uw.x)); o.y = pk2((acc[nb][2] + bs) * bflo(uw.y), (acc[nb][3] + bs) * bfhi(uw.y));
            *(u32x2*)(op + c) = o; }
    }
    __syncthreads();
}

template <int MODE>
__device__ __forceinline__ void attn_simple_item(const bf16_t* PL, int qcol, int kcol, int vcol, bf16_t* O, int qrow, int h, int kvh, int kbeg, int kend, const float* rpb, int lane) {
    constexpr float C = 0.088388347648318440f * 1.4426950408889634f;
    const int part = lane & 3;
    float q[32], o[32];
    { const bf16_t* qp = PL + (size_t)qrow * NIN + qcol + h * HD + part * 32;
#pragma unroll
      for (int j = 0; j < 4; ++j) { const u32x4 w = *(const u32x4*)(qp + j * 8);
          q[j * 8 + 0] = bflo(w.x) * C; q[j * 8 + 1] = bfhi(w.x) * C; q[j * 8 + 2] = bflo(w.y) * C; q[j * 8 + 3] = bfhi(w.y) * C;
          q[j * 8 + 4] = bflo(w.z) * C; q[j * 8 + 5] = bfhi(w.z) * C; q[j * 8 + 6] = bflo(w.w) * C; q[j * 8 + 7] = bfhi(w.w) * C; } }
#pragma unroll
    for (int d = 0; d < 32; ++d) o[d] = 0.f;
    float mrun = -1e30f, l = 0.f;
    const int r = qrow >> 6, c = qrow & 63, r0 = min(max(r - 4, 0), 120), c0 = min(max(c - 8, 0), 48);
    const int nk = MODE == 0 ? (kend - kbeg) : 384;
    for (int idx = 0; idx < nk; ++idx) {
        int krow; float bias = 0.f;
        if (MODE == 0) krow = kbeg + idx;
        else if (idx < 128) { const int i = idx >> 4, j = idx & 15; krow = (r0 + i) * GW + c0 + j; bias = rpb[(h * 15 + (r0 + i - r + 7)) * 31 + (c0 + j - c + 15)] * 1.4426950408889634f; }
        else krow = SEQ + idx - 128;
        const bf16_t* kp = PL + (size_t)krow * NIN + kcol + kvh * HD + part * 32;
        float s = 0.f;
#pragma unroll
        for (int j = 0; j < 4; ++j) { const u32x4 w = *(const u32x4*)(kp + j * 8);
            s += q[j * 8 + 0] * bflo(w.x) + q[j * 8 + 1] * bfhi(w.x) + q[j * 8 + 2] * bflo(w.y) + q[j * 8 + 3] * bfhi(w.y)
               + q[j * 8 + 4] * bflo(w.z) + q[j * 8 + 5] * bfhi(w.z) + q[j * 8 + 6] * bflo(w.w) + q[j * 8 + 7] * bfhi(w.w); }
        s += __shfl_xor(s, 1); s += __shfl_xor(s, 2);
        s += bias;
        const float mn = fmaxf(mrun, s), alpha = exp2f(mrun - mn), p = exp2f(s - mn);
        l = l * alpha + p; mrun = mn;
        const bf16_t* vp = PL + (size_t)krow * NIN + vcol + kvh * HD + part * 32;
#pragma unroll
        for (int j = 0; j < 4; ++j) { const u32x4 w = *(const u32x4*)(vp + j * 8);
            o[j * 8 + 0] = o[j * 8 + 0] * alpha + p * bflo(w.x); o[j * 8 + 1] = o[j * 8 + 1] * alpha + p * bfhi(w.x);
            o[j * 8 + 2] = o[j * 8 + 2] * alpha + p * bflo(w.y); o[j * 8 + 3] = o[j * 8 + 3] * alpha + p * bfhi(w.y);
            o[j * 8 + 4] = o[j * 8 + 4] * alpha + p * bflo(w.z); o[j * 8 + 5] = o[j * 8 + 5] * alpha + p * bfhi(w.z);
            o[j * 8 + 6] = o[j * 8 + 6] * alpha + p * bflo(w.w); o[j * 8 + 7] = o[j * 8 + 7] * alpha + p * bfhi(w.w); }
    }
    const float il = 1.f / l;
    bf16_t* op = O + (size_t)qrow * 512 + h * HD + part * 32;
#pragma unroll
    for (int j = 0; j < 4; ++j) { u32x4 w; w.x = pk2(o[j * 8 + 0] * il, o[j * 8 + 1] * il); w.y = pk2(o[j * 8 + 2] * il, o[j * 8 + 3] * il);
        w.z = pk2(o[j * 8 + 4] * il, o[j * 8 + 5] * il); w.w = pk2(o[j * 8 + 6] * il, o[j * 8 + 7] * il); *(u32x4*)(op + j * 8) = w; }
}


namespace att {
using s16x4 = __attribute__((ext_vector_type(4))) short;
using f32x16 = __attribute__((ext_vector_type(16))) float;
constexpr int KVBLK = 64;
constexpr float SCALE = 0.088388347648318440f, THR = 8.f;
constexpr int SHM_V = KVBLK * HD * 2, SHM_K = KVBLK * HD * 2, SHM_ATTN = 2 * SHM_V + 2 * SHM_K + NWAVE * 64 * 4;
#define KSWZ(row, colB) ((row) * 256 + ((colB) ^ (((row) & 7) << 4)))
#define SBAR() __builtin_amdgcn_sched_barrier(0)
__device__ __forceinline__ int crow(int r, int hi) { return (r & 3) + 8 * (r >> 2) + 4 * hi; }
__device__ __forceinline__ unsigned cvtpk(float lo, float hi) { unsigned r; asm volatile("v_cvt_pk_bf16_f32 %0, %1, %2" : "=v"(r) : "v"(lo), "v"(hi)); return r; }
__device__ __forceinline__ void partialSM(f32x16& p0, f32x16& p1, float& m_reg, float& mn, float& alpha) {
  constexpr float C = SCALE * 1.4426950408889634f;
  float pmax = p0[0];
#pragma unroll
  for (int r = 1; r < 16; ++r) pmax = fmaxf(pmax, p0[r]);
#pragma unroll
  for (int r = 0; r < 16; ++r) pmax = fmaxf(pmax, p1[r]);
  { auto rr = __builtin_amdgcn_permlane32_swap(__float_as_uint(pmax), __float_as_uint(pmax), false, false);
    pmax = fmaxf(__uint_as_float(rr[0]), __uint_as_float(rr[1])); }
  if (__builtin_expect(__all(pmax - m_reg <= THR / SCALE), 1)) { mn = m_reg; alpha = 1.f; }
  else { mn = fmaxf(m_reg, pmax); alpha = __builtin_amdgcn_exp2f((m_reg - mn) * C); m_reg = mn; }
  float mnC = -mn * C;
#pragma unroll
  for (int r = 0; r < 16; ++r) p0[r] = fmaf(p0[r], C, mnC);
#pragma unroll
  for (int r = 0; r < 16; ++r) p1[r] = fmaf(p1[r], C, mnC);
#pragma unroll
  for (int r = 0; r < 16; ++r) p0[r] = __builtin_amdgcn_exp2f(p0[r]);
}
__device__ __forceinline__ void finishSM(f32x16& p0, f32x16& p1, float alpha, float& l_reg, bf16x8& pa0, bf16x8& pa1, bf16x8& pa2, bf16x8& pa3) {
#pragma unroll
  for (int r = 0; r < 16; ++r) p1[r] = __builtin_amdgcn_exp2f(p1[r]);
  float ps = 0;
#pragma unroll
  for (int r = 0; r < 16; ++r) ps += p0[r];
#pragma unroll
  for (int r = 0; r < 16; ++r) ps += p1[r];
  { auto rr = __builtin_amdgcn_permlane32_swap(__float_as_uint(ps), __float_as_uint(ps), false, false);
    ps = __uint_as_float(rr[0]) + __uint_as_float(rr[1]); }
  l_reg = l_reg * alpha + ps;
#define PK4(P, BASE, OUT) do { unsigned a0 = cvtpk(P[BASE + 0], P[BASE + 1]), a1 = cvtpk(P[BASE + 2], P[BASE + 3]);   \
    unsigned b0 = cvtpk(P[BASE + 4], P[BASE + 5]), b1 = cvtpk(P[BASE + 6], P[BASE + 7]);                              \
    auto r0 = __builtin_amdgcn_permlane32_swap(a0, b0, false, false); auto r1 = __builtin_amdgcn_permlane32_swap(a1, b1, false, false); \
    u32x4 w = {r0[0], r1[0], r0[1], r1[1]}; OUT = *reinterpret_cast<bf16x8*>(&w); } while (0)
  PK4(p0, 0, pa0); PK4(p0, 8, pa1); PK4(p1, 0, pa2); PK4(p1, 8, pa3);
#undef PK4
}
__device__ __forceinline__ void qkt(f32x16& p0, f32x16& p1, const char* Ks, const bf16x8* qr, int r32, int hi) {
  p0 = f32x16{}; p1 = f32x16{};
#pragma unroll
  for (int d0 = 0; d0 < 8; ++d0) { int cb = (d0 * 16 + hi * 8) * 2;
    bf16x8 b0 = *reinterpret_cast<const bf16x8*>(Ks + KSWZ(r32, cb));
    bf16x8 b1 = *reinterpret_cast<const bf16x8*>(Ks + KSWZ(32 + r32, cb));
    p0 = __builtin_amdgcn_mfma_f32_32x32x16_bf16(b0, qr[d0], p0, 0, 0, 0);
    p1 = __builtin_amdgcn_mfma_f32_32x32x16_bf16(b1, qr[d0], p1, 0, 0, 0); }
}
__device__ __forceinline__ int v_st(int k, int c) { const int kk = (k & ~0xC) | ((k & 4) << 1) | ((k & 8) >> 1); return ((kk >> 3) * 4 + (c >> 5)) * 512 + ((kk & 7) * 32 + (c & 31)) * 2; }
__device__ __forceinline__ int v_rd_base(int lane) { return ((lane & 3) << 3) | (((lane >> 2) & 3) << 6) | (((lane >> 4) & 1) << 5) | (((lane >> 5) & 1) << 8); }
constexpr int v_rd_off(int d0, int ks, int half) { return d0 * 512 + ks * 4096 + half * 2048; }
template <int OFF> __device__ __forceinline__ s16x4 tr_read(int vb) {
  s16x4 r; asm volatile("ds_read_b64_tr_b16 %0, %1 offset:%2" : "=&v"(r) : "v"(vb), "i"(OFF) : "memory"); return r;
}
template <int D0> __device__ __forceinline__ void pv_one(f32x16& od, int vb, bf16x8 pa0, bf16x8 pa1, bf16x8 pa2, bf16x8 pa3) {
  const s16x4 l0 = tr_read<v_rd_off(D0, 0, 0)>(vb), h0 = tr_read<v_rd_off(D0, 0, 1)>(vb), l1 = tr_read<v_rd_off(D0, 1, 0)>(vb), h1 = tr_read<v_rd_off(D0, 1, 1)>(vb);
  const s16x4 l2 = tr_read<v_rd_off(D0, 2, 0)>(vb), h2 = tr_read<v_rd_off(D0, 2, 1)>(vb), l3 = tr_read<v_rd_off(D0, 3, 0)>(vb), h3 = tr_read<v_rd_off(D0, 3, 1)>(vb);
  asm volatile("s_waitcnt lgkmcnt(0)" ::: "memory"); SBAR();
#define PK(L, H) (bf16x8){L[0], L[1], L[2], L[3], H[0], H[1], H[2], H[3]}
  od = __builtin_amdgcn_mfma_f32_32x32x16_bf16(pa0, PK(l0, h0), od, 0, 0, 0);
  od = __builtin_amdgcn_mfma_f32_32x32x16_bf16(pa1, PK(l1, h1), od, 0, 0, 0);
  od = __builtin_amdgcn_mfma_f32_32x32x16_bf16(pa2, PK(l2, h2), od, 0, 0, 0);
  od = __builtin_amdgcn_mfma_f32_32x32x16_bf16(pa3, PK(l3, h3), od, 0, 0, 0);
#undef PK
}
__device__ __forceinline__ void pv_d0(f32x16* o, int vb, bf16x8 pa0, bf16x8 pa1, bf16x8 pa2, bf16x8 pa3) {
  pv_one<0>(o[0], vb, pa0, pa1, pa2, pa3); pv_one<1>(o[1], vb, pa0, pa1, pa2, pa3); pv_one<2>(o[2], vb, pa0, pa1, pa2, pa3); pv_one<3>(o[3], vb, pa0, pa1, pa2, pa3);
}
__device__ __forceinline__ void na_hook(f32x16& p0, f32x16& p1, int kr, int qr, int qc, int hi, const float* rpbh) {
  const int r0 = min(max(qr - 4, 0), 120), c0 = min(max(qc - 8, 0), 48);
  if (kr < r0 || kr >= r0 + 8) {
#pragma unroll
    for (int r = 0; r < 16; ++r) { p0[r] = -1e30f; p1[r] = -1e30f; }
  } else {
    const float* bp = rpbh + (kr - qr + 7) * 31 + 15 - qc;
#pragma unroll
    for (int r = 0; r < 16; ++r) {
      const int kc0 = crow(r, hi), kc1 = 32 + kc0;
      const bool v0 = (unsigned)(kc0 - c0) < 16u, v1 = (unsigned)(kc1 - c0) < 16u;
      const float b0 = v0 ? bp[kc0] : 0.f, b1 = v1 ? bp[kc1] : 0.f;
      p0[r] = v0 ? fmaf(b0, 1.f / SCALE, p0[r]) : -1e30f;
      p1[r] = v1 ? fmaf(b1, 1.f / SCALE, p1[r]) : -1e30f;
      if ((r & 3) == 3) SBAR();
    }
  }
}
template <int MODE, bool DIRECT>
__device__ __forceinline__ void attn_unit(const bf16_t* __restrict__ PL, int qrow0, int qcol, int kcol, int vcol, int NT, int base0, int n0, int base1,
                                          const float* rpbh, bf16_t* Obf, float* Opart, float* LSE, char* lds) {
  const int tid = otid(), wid = tid >> 6, lane = tid & 63, r32 = lane & 31, hi = lane >> 5;
  char* V_lds = lds; char* K_lds = lds + 2 * SHM_V;
  float* wsf = (float*)(lds + 2 * SHM_V + 2 * SHM_K) + wid * 64; float* li_l = wsf; float* al_l = wsf + 32;
  float m_reg = -1e30f, l_reg = 0; f32x16 o[4] = {}; bf16x8 qr[8];
  const bf16_t* Qw = PL + (size_t)(qrow0 + wid * 32 + r32) * NIN + qcol + hi * 8;
#pragma unroll
  for (int d0 = 0; d0 < 8; ++d0) qr[d0] = *reinterpret_cast<const bf16x8*>(Qw + d0 * 16);
  const int qgr = __builtin_amdgcn_readfirstlane((qrow0 + wid * 32) >> 6);
  const int sr = tid >> 4, sc = (tid & 15) * 8, vst0 = v_st(sr, sc), vst1 = v_st(32 + sr, sc);
  const int vb0 = (int)(uintptr_t)V_lds + v_rd_base(lane);
  const bf16_t* Kg = PL + (size_t)sr * NIN + kcol + sc; const bf16_t* Vg = PL + (size_t)sr * NIN + vcol + sc;
  constexpr int SD = 1;
  struct { bf16x8 vs0, vs1, ks0, ks1; } sr_[SD];
#define KROW(j) ((j) < n0 ? base0 + 64 * (j) : base1 + 64 * ((j) - n0))
#define SLOAD(i, j) do { const size_t ko_ = (size_t)KROW(j) * NIN; sr_[i].vs0 = *reinterpret_cast<const bf16x8*>(Vg + ko_); sr_[i].vs1 = *reinterpret_cast<const bf16x8*>(Vg + ko_ + (size_t)32 * NIN); \
    sr_[i].ks0 = *reinterpret_cast<const bf16x8*>(Kg + ko_); sr_[i].ks1 = *reinterpret_cast<const bf16x8*>(Kg + ko_ + (size_t)32 * NIN); } while (0)
#define SWRITE(b, i) do { *(bf16x8*)(V_lds + (b) * SHM_V + vst0) = sr_[i].vs0;          \
    *(bf16x8*)(V_lds + (b) * SHM_V + vst1) = sr_[i].vs1; int kc = sc * 2;               \
    *(bf16x8*)(K_lds + (b) * SHM_K + KSWZ(sr, kc)) = sr_[i].ks0;                       \
    *(bf16x8*)(K_lds + (b) * SHM_K + KSWZ(32 + sr, kc)) = sr_[i].ks1; } while (0)
#define SWAIT() do { if constexpr (SD == 2) asm volatile("s_waitcnt vmcnt(4)" ::: "memory"); else asm volatile("s_waitcnt vmcnt(0)" ::: "memory"); } while (0)
#define RESC(a) do { if (__any((a) < 1.f)) { if (hi == 0) al_l[r32] = (a); asm volatile("s_waitcnt lgkmcnt(0)" ::: "memory"); \
    _Pragma("unroll") for (int d = 0; d < 4; ++d) _Pragma("unroll") for (int r = 0; r < 16; ++r) o[d][r] *= al_l[crow(r, hi)]; } } while (0)
#define HOOK(P0, P1, j) do { if (MODE == 1) { if ((j) >= n0) na_hook(P0, P1, (base1 >> 6) + (j) - n0, qgr, ((wid & 1) << 5) + r32, hi, rpbh); } } while (0)
  f32x16 pA0, pA1, pB0, pB1; float mnA, mnB, alA, alB; bf16x8 pa0, pa1, pa2, pa3;
  constexpr int SE = 0, SO = SD - 1;
  SLOAD(SE, 0); asm volatile("s_waitcnt vmcnt(0)" ::: "memory"); SWRITE(0, SE); __syncthreads();
  qkt(pA0, pA1, K_lds, qr, r32, hi); HOOK(pA0, pA1, 0); partialSM(pA0, pA1, m_reg, mnA, alA);
  SLOAD(SO, 1); if constexpr (SD == 2) { if (2 < NT) SLOAD(SE, 2); }
  SWAIT(); SWRITE(1, SO); __syncthreads();
  for (int j = 1; j + 1 < NT; j += 2) {
    SBAR(); qkt(pB0, pB1, K_lds + SHM_K, qr, r32, hi); HOOK(pB0, pB1, j);
    finishSM(pA0, pA1, alA, l_reg, pa0, pa1, pa2, pa3); SBAR();
    SLOAD(SO, j + SD); SBAR();
    pv_d0(o, vb0, pa0, pa1, pa2, pa3); partialSM(pB0, pB1, m_reg, mnB, alB);
    __syncthreads(); SWAIT(); SWRITE(0, SE);
    RESC(alB); __syncthreads();
    SBAR(); qkt(pA0, pA1, K_lds, qr, r32, hi); HOOK(pA0, pA1, j + 1);
    finishSM(pB0, pB1, alB, l_reg, pa0, pa1, pa2, pa3); SBAR();
    if (SD == 1 || j + 3 < NT) SLOAD(SE, j + 1 + SD); SBAR();
    pv_d0(o, vb0 + SHM_V, pa0, pa1, pa2, pa3); partialSM(pA0, pA1, m_reg, mnA, alA);
    __syncthreads(); SWAIT(); SWRITE(1, SO);
    RESC(alA); __syncthreads();
  }
  SBAR(); qkt(pB0, pB1, K_lds + SHM_K, qr, r32, hi); HOOK(pB0, pB1, NT - 1);
  finishSM(pA0, pA1, alA, l_reg, pa0, pa1, pa2, pa3); SBAR();
  pv_d0(o, vb0, pa0, pa1, pa2, pa3); partialSM(pB0, pB1, m_reg, mnB, alB);
  __syncthreads(); RESC(alB);
  finishSM(pB0, pB1, alB, l_reg, pa0, pa1, pa2, pa3); SBAR();
  pv_d0(o, vb0 + SHM_V, pa0, pa1, pa2, pa3);
  if (hi == 0) li_l[r32] = l_reg; asm volatile("s_waitcnt lgkmcnt(0)" ::: "memory");
  float rli[16];
#pragma unroll
  for (int r = 0; r < 16; ++r) rli[r] = __builtin_amdgcn_rcpf(li_l[crow(r, hi)]);
  if (DIRECT) {
    bf16_t* Ow = Obf + (size_t)(wid * 32) * 512;
#pragma unroll
    for (int r = 0; r < 16; ++r) { const int orow = crow(r, hi);
#pragma unroll
      for (int d0 = 0; d0 < 4; ++d0) Ow[(size_t)orow * 512 + d0 * 32 + r32] = (bf16_t)f2bf(o[d0][r] * rli[r]); }
  } else {
    float* Ow = Opart + (size_t)(wid * 32) * 512;
#pragma unroll
    for (int r = 0; r < 16; ++r) { const int orow = crow(r, hi);
#pragma unroll
      for (int d0 = 0; d0 < 4; ++d0) Ow[(size_t)orow * 512 + d0 * 32 + r32] = o[d0][r] * rli[r]; }
    if (hi == 0) LSE[(size_t)(wid * 32 + r32) * 4] = m_reg * (SCALE * 1.4426950408889634f) + log2f(l_reg);
  }
  __syncthreads();
#undef KROW
#undef SLOAD
#undef SWRITE
#undef SWAIT
#undef RESC
#undef HOOK
}
__device__ __forceinline__ void attn_unit_na(const bf16_t* __restrict__ PL, int qrow0, int qcol, int kcol, int vcol, int R0, const float* rpbh, bf16_t* Obf, char* lds) {
  const int tid = otid(), wid = tid >> 6, lane = tid & 63, r32 = lane & 31, hi = lane >> 5;
  constexpr int NT = 16, n0 = 4;
  char* V_lds = lds; char* K_lds = lds + 2 * SHM_V;
  float* wsf = (float*)(lds + 2 * SHM_V + 2 * SHM_K) + wid * 64; float* li_l = wsf; float* al_l = wsf + 32;
  float m_reg = -1e30f, l_reg = 0; f32x16 o[4] = {}; bf16x8 qr[8];
  const bf16_t* Qw = PL + (size_t)(qrow0 + wid * 32 + r32) * NIN + qcol + hi * 8;
#pragma unroll
  for (int d0 = 0; d0 < 8; ++d0) qr[d0] = *reinterpret_cast<const bf16x8*>(Qw + d0 * 16);
  const int qgr = (qrow0 + wid * 32) >> 6, qgc = ((wid & 1) << 5) + r32;
  const int sr = tid >> 4, sc = (tid & 15) * 8, vst0 = v_st(sr, sc), vst1 = v_st(32 + sr, sc);
  const int vb0 = (int)(uintptr_t)V_lds + v_rd_base(lane);
  const bf16_t* Kg = PL + (size_t)sr * NIN + kcol + sc; const bf16_t* Vg = PL + (size_t)sr * NIN + vcol + sc;
  bf16x8 vs0, vs1, ks0, ks1;
#define KROW(j) ((j) < n0 ? SEQ + 64 * (j) : (R0 + (j) - n0) * 64)
#define SLOAD(j) do { const size_t ko_ = (size_t)KROW(j) * NIN; vs0 = *reinterpret_cast<const bf16x8*>(Vg + ko_); vs1 = *reinterpret_cast<const bf16x8*>(Vg + ko_ + (size_t)32 * NIN); \
    ks0 = *reinterpret_cast<const bf16x8*>(Kg + ko_); ks1 = *reinterpret_cast<const bf16x8*>(Kg + ko_ + (size_t)32 * NIN); } while (0)
  SLOAD(0);
  for (int j = 0; j < NT; ++j) {
    asm volatile("s_waitcnt vmcnt(0)" ::: "memory");
    *(bf16x8*)(V_lds + vst0) = vs0; *(bf16x8*)(V_lds + vst1) = vs1;
    *(bf16x8*)(K_lds + KSWZ(sr, sc * 2)) = ks0; *(bf16x8*)(K_lds + KSWZ(32 + sr, sc * 2)) = ks1;
    __syncthreads();
    if (j + 1 < NT) SLOAD(j + 1);
    f32x16 p0, p1; float mn, al; bf16x8 pa0, pa1, pa2, pa3;
    qkt(p0, p1, K_lds, qr, r32, hi);
    if (j >= n0) na_hook(p0, p1, R0 + j - n0, qgr, qgc, hi, rpbh);
    partialSM(p0, p1, m_reg, mn, al);
    if (__any(al < 1.f)) { if (hi == 0) al_l[r32] = al; asm volatile("s_waitcnt lgkmcnt(0)" ::: "memory");
#pragma unroll
      for (int d = 0; d < 4; ++d)
#pragma unroll
        for (int r = 0; r < 16; ++r) o[d][r] *= al_l[crow(r, hi)]; }
    finishSM(p0, p1, al, l_reg, pa0, pa1, pa2, pa3); SBAR();
    pv_d0(o, vb0, pa0, pa1, pa2, pa3);
    __syncthreads();
  }
  if (hi == 0) li_l[r32] = l_reg; asm volatile("s_waitcnt lgkmcnt(0)" ::: "memory");
  bf16_t* Ow = Obf + (size_t)(wid * 32) * 512;
#pragma unroll
  for (int r = 0; r < 16; ++r) { const int orow = crow(r, hi); const float rl = __builtin_amdgcn_rcpf(li_l[orow]);
#pragma unroll
    for (int d0 = 0; d0 < 4; ++d0) Ow[(size_t)orow * 512 + d0 * 32 + r32] = (bf16_t)f2bf(o[d0][r] * rl); }
  __syncthreads();
#undef KROW
#undef SLOAD
}
}

__device__ __forceinline__ void phase_small(const Args& a, unsigned char* lds, int vcu, int G, int layer, bool last) {
    const int tid = otid(), wave = tid >> 6, lane = tid & 63;
    const int gw = vcu * NWAVE + wave, NGW = G * NWAVE;
    const int nrows = last ? SEQ : MR;
    for (int row = gw; row < MR; row += NGW) qk_prep_row(a, layer, row, lane);
    for (int row = gw; row < nrows; row += NGW) dlt_row(a, row, lane);
    const int nunits = (nrows / 128) * 4;
    for (int u = G - 1 - vcu; u < nunits; u += G) cmix_unit(a, layer, u, lds);
    const bf16_t* PL = (const bf16_t*)(a.ws + WS_PL); bf16_t* OD = (bf16_t*)(a.ws + WS_OUTS) + (size_t)3 * MR * 512;
    const float* rpb = a.in[I_RPB] + layer * 4 * 15 * 31;
    const int nu = 128 + (last ? 0 : 4);
    for (int u = vcu; u < nu; u += G) {
        if (u < 128) { const int h = u & 3, i = u >> 2, R0 = min(max(4 * i - 4, 0), 120);
            att::attn_unit_na(PL, i * 256, D_Q0 + h * HD, D_K0 + h * HD, D_V0 + h * HD, R0, rpb + h * 465, OD + (size_t)(i * 256) * 512 + h * HD, (char*)lds); }
        else { const int h = u - 128;
            att::attn_unit<0, true>(PL, SEQ, D_Q0 + h * HD, D_K0 + h * HD, D_V0 + h * HD, 4, SEQ, 4, 0, nullptr, OD + (size_t)SEQ * 512 + h * HD, nullptr, nullptr, (char*)lds); }
    }
}
constexpr size_t OPART_LSE = (size_t)2 * SEQ * 512 * 4;
__device__ __forceinline__ void phase_attn_a(const Args& a, unsigned char* lds, int vcu, int G, bool last) {
    const bf16_t* PL = (const bf16_t*)(a.ws + WS_PL); bf16_t* OA = (bf16_t*)(a.ws + WS_OUTS);
    float* Opart = (float*)(a.ws + WS_MRG); float* LSE = (float*)(a.ws + WS_MRG + OPART_LSE);
    const int nu = 256 + (last ? 0 : 4);
    for (int u = vcu; u < nu; u += G) {
        if (u < 256) { const int half = u >> 7, h = (u >> 5) & 3, qb = u & 31, kvh = h >> 1;
            att::attn_unit<0, false>(PL, qb * 256, A_Q0 + h * HD, A_K0 + kvh * HD, A_V0 + kvh * HD, 66, half * 4224, 66, 0, nullptr, nullptr,
                                     Opart + ((size_t)half * SEQ + qb * 256) * 512 + h * HD, LSE + ((size_t)half * SEQ + qb * 256) * 4 + h, (char*)lds); }
        else { const int h = u - 256, kvh = h >> 1;
            att::attn_unit<0, true>(PL, SEQ, A_Q0 + h * HD, A_K0 + kvh * HD, A_V0 + kvh * HD, 4, SEQ, 4, 0, nullptr, OA + (size_t)SEQ * 512 + h * HD, nullptr, nullptr, (char*)lds); }
    }
}
__device__ __forceinline__ void phase_combine_a(const Args& a, int vcu, int G) {
    const int tid = otid(), wave = tid >> 6, lane = tid & 63;
    const int gw = vcu * NWAVE + wave, NGW = G * NWAVE;
    const float* Opart = (const float*)(a.ws + WS_MRG); const float* LSE = (const float*)(a.ws + WS_MRG + OPART_LSE); bf16_t* OA = (bf16_t*)(a.ws + WS_OUTS);
    for (int row = gw; row < SEQ; row += NGW) {
        const float l0 = LSE[(size_t)row * 4 + (lane >> 4)], l1 = LSE[((size_t)SEQ + row) * 4 + (lane >> 4)];
        const float mx = fmaxf(l0, l1), w0 = exp2f(l0 - mx), w1 = exp2f(l1 - mx), inv = 1.f / (w0 + w1), c0 = w0 * inv, c1 = w1 * inv;
        const float* p0 = Opart + (size_t)row * 512 + lane * 8; const float* p1 = p0 + (size_t)SEQ * 512;
        const f32x4 a0 = *(const f32x4*)p0, a1 = *(const f32x4*)(p0 + 4), b0 = *(const f32x4*)p1, b1 = *(const f32x4*)(p1 + 4);
        const f32x4 r0 = a0 * c0 + b0 * c1, r1 = a1 * c0 + b1 * c1;
        u32x4 w; w.x = pk2(r0[0], r0[1]); w.y = pk2(r0[2], r0[3]); w.z = pk2(r1[0], r1[1]); w.w = pk2(r1[2], r1[3]);
        *(u32x4*)(OA + (size_t)row * 512 + lane * 8) = w;
    }
}

constexpr int NPHASE = 22;
__global__ void __launch_bounds__(NTHR, 2) fwd(Args a) {
    extern __shared__ __attribute__((aligned(16))) unsigned char lds[];
    const int G = gridDim.x, bx = blockIdx.x;
    const int vcu = (G % 8 == 0) ? (bx % 8) * (G / 8) + bx / 8 : bx;
    unsigned char* ws = a.ws;
    const float* MOD = (const float*)(ws + WS_CTL + CTL_MOD);
#if MK_COOP
    cg::grid_group grid = cg::this_grid();
#define SEAM(p) do { if (lo <= (p) && (p) + 1 < hi) grid.sync(); } while (0)
#else
#define SEAM(p) do { } while (0)
#endif
    const int lo = a.ph_lo, hi = a.ph_hi;
#ifndef PHMASK
#define PHMASK 0xffffffu
#endif
#define IN(p) (lo <= (p) && (p) < hi && ((PHMASK >> ((p) < 2 ? (p) : 2 + ((p) - 2) % 10)) & 1u))
    if (IN(0)) { phase_prologue(a, lds, vcu, G); } SEAM(0);
    if (IN(1)) { phase_rows<0>(a, vcu, G, MR, nullptr, nullptr, 0, a.in[I_NPRE_MIX], MOD, 0); } SEAM(1);
    {
        constexpr int l = 0; constexpr bool last = (l == 1); const int pb = 2 + l * 10;
        unsigned char* wb = ws + WS_W + (size_t)l * WPL;
        const float* modl = MOD + (size_t)l * 2 * NIN;
        const int Mrows = last ? SEQ : MR;
        if (IN(pb + 0)) {
            Gemm g{(const bf16_t*)(ws + WS_XN), (const bf16_t*)(wb + W_IN), DM, DM, DM}; StaticOrder S; S.init(MR, NIN, G, bx);
            EpiIn E{(bf16_t*)(ws + WS_PL)}; gemm_phase((PG8_LAS unsigned char*)lds, g, S, E);
        } SEAM(pb + 0);
        if (IN(pb + 1)) { phase_small(a, lds, vcu, G, l, last); } SEAM(pb + 1);
        if (IN(pb + 2)) { phase_attn_a(a, lds, vcu, G, last); } SEAM(pb + 2);
        if (IN(pb + 3)) {
            phase_combine_a(a, vcu, G);
            Gemm g{(const bf16_t*)(ws + WS_DLT), (const bf16_t*)(wb + W_B), 512, 512, 512}; StaticOrder S; S.init(Mrows, 512, G, bx);
            EpiScale E{(bf16_t*)(ws + WS_OUTS) + (size_t)1 * MR * 512, 512, a.in[I_BSCALE] + l * 512}; gemm_phase((PG8_LAS unsigned char*)lds, g, S, E);
        } SEAM(pb + 3);
        if (IN(pb + 4)) {
            Gemm g{(const bf16_t*)(ws + WS_OUTS), (const bf16_t*)(wb + W_BR), 512, 512, 512}; MergeOrder S; S.base.init(Mrows, DM, G, bx);
            EpiMerge E{(const bf16_t*)(ws + WS_PL), (float*)(ws + WS_MRG), (bf16_t*)(ws + WS_MRGB)}; gemm_phase((PG8_LAS unsigned char*)lds, g, S, E);
        } SEAM(pb + 4);
        if (IN(pb + 5)) {
            Gemm g{(const bf16_t*)(ws + WS_MRGB), (const bf16_t*)(wb + W_O), DM, DM, DM}; StaticOrder S; S.init(Mrows, DM, G, bx);
            EpiF32 E{(float*)(ws + WS_MRG), DM}; gemm_phase((PG8_LAS unsigned char*)lds, g, S, E);
        } SEAM(pb + 5);
        if (IN(pb + 6)) { phase_rows<1>(a, vcu, G, Mrows, a.in[I_NPOST_MIX] + l * DM, modl, 2, a.in[I_NPRE_FFN] + l * DM, modl, 3); } SEAM(pb + 6);
        if (IN(pb + 7)) {
            Gemm g{(const bf16_t*)(ws + WS_XN), (const bf16_t*)(wb + W_GU), DM, DM, DM}; StaticOrder S; S.init(Mrows, 2 * FF, G, bx);
            EpiSwiglu E{(bf16_t*)(ws + WS_H)}; gemm_phase((PG8_LAS unsigned char*)lds, g, S, E);
        } SEAM(pb + 7);
        if (IN(pb + 8)) {
            Gemm g{(const bf16_t*)(ws + WS_H), (const bf16_t*)(wb + W_D), FF, FF, FF}; StaticOrder S; S.init(Mrows, DM, G, bx);
            EpiF32 E{(float*)(ws + WS_MRG), DM}; gemm_phase((PG8_LAS unsigned char*)lds, g, S, E);
            if (bx >= 8) convert_layer(a, lds, 1, (bx - 8) * NWAVE + (otid() >> 6), (G - 8) * NWAVE);
        } SEAM(pb + 8);
        if (IN(pb + 9)) {
            if (!last) phase_rows<1>(a, vcu, G, MR, a.in[I_NPOST_FFN] + l * DM, modl, 5, a.in[I_NPRE_MIX] + (l + 1) * DM, MOD + (size_t)(l + 1) * 2 * NIN, 0);
            else phase_rows<2>(a, vcu, G, SEQ, a.in[I_NPOST_FFN] + l * DM, modl, 5, nullptr, nullptr, 0);
        }
        if (!last) SEAM(pb + 9);
        }
    {
        constexpr int l = 1; constexpr bool last = (l == 1); const int pb = 2 + l * 10;
        unsigned char* wb = ws + WS_W + (size_t)l * WPL;
        const float* modl = MOD + (size_t)l * 2 * NIN;
        const int Mrows = last ? SEQ : MR;
        if (IN(pb + 0)) {
            Gemm g{(const bf16_t*)(ws + WS_XN), (const bf16_t*)(wb + W_IN), DM, DM, DM}; StaticOrder S; S.init(MR, NIN, G, bx);
            EpiIn E{(bf16_t*)(ws + WS_PL)}; gemm_phase((PG8_LAS unsigned char*)lds, g, S, E);
        } SEAM(pb + 0);
        if (IN(pb + 1)) { phase_small(a, lds, vcu, G, l, last); } SEAM(pb + 1);
        if (IN(pb + 2)) { phase_attn_a(a, lds, vcu, G, last); } SEAM(pb + 2);
        if (IN(pb + 3)) {
            phase_combine_a(a, vcu, G);
            Gemm g{(const bf16_t*)(ws + WS_DLT), (const bf16_t*)(wb + W_B), 512, 512, 512}; StaticOrder S; S.init(Mrows, 512, G, bx);
            EpiScale E{(bf16_t*)(ws + WS_OUTS) + (size_t)1 * MR * 512, 512, a.in[I_BSCALE] + l * 512}; gemm_phase((PG8_LAS unsigned char*)lds, g, S, E);
        } SEAM(pb + 3);
        if (IN(pb + 4)) {
            Gemm g{(const bf16_t*)(ws + WS_OUTS), (const bf16_t*)(wb + W_BR), 512, 512, 512}; MergeOrder S; S.base.init(Mrows, DM, G, bx);
            EpiMerge E{(const bf16_t*)(ws + WS_PL), (float*)(ws + WS_MRG), (bf16_t*)(ws + WS_MRGB)}; gemm_phase((PG8_LAS unsigned char*)lds, g, S, E);
        } SEAM(pb + 4);
        if (IN(pb + 5)) {
            Gemm g{(const bf16_t*)(ws + WS_MRGB), (const bf16_t*)(wb + W_O), DM, DM, DM}; StaticOrder S; S.init(Mrows, DM, G, bx);
            EpiF32 E{(float*)(ws + WS_MRG), DM}; gemm_phase((PG8_LAS unsigned char*)lds, g, S, E);
        } SEAM(pb + 5);
        if (IN(pb + 6)) { phase_rows<1>(a, vcu, G, Mrows, a.in[I_NPOST_MIX] + l * DM, modl, 2, a.in[I_NPRE_FFN] + l * DM, modl, 3); } SEAM(pb + 6);
        if (IN(pb + 7)) {
            Gemm g{(const bf16_t*)(ws + WS_XN), (const bf16_t*)(wb + W_GU), DM, DM, DM}; StaticOrder S; S.init(Mrows, 2 * FF, G, bx);
            EpiSwiglu E{(bf16_t*)(ws + WS_H)}; gemm_phase((PG8_LAS unsigned char*)lds, g, S, E);
        } SEAM(pb + 7);
        if (IN(pb + 8)) {
            Gemm g{(const bf16_t*)(ws + WS_H), (const bf16_t*)(wb + W_D), FF, FF, FF}; StaticOrder S; S.init(Mrows, DM, G, bx);
            EpiF32 E{(float*)(ws + WS_MRG), DM}; gemm_phase((PG8_LAS unsigned char*)lds, g, S, E);
        } SEAM(pb + 8);
        if (IN(pb + 9)) {
            if (!last) phase_rows<1>(a, vcu, G, MR, a.in[I_NPOST_FFN] + l * DM, modl, 5, a.in[I_NPRE_MIX] + (l + 1) * DM, MOD + (size_t)(l + 1) * 2 * NIN, 0);
            else phase_rows<2>(a, vcu, G, SEQ, a.in[I_NPOST_FFN] + l * DM, modl, 5, nullptr, nullptr, 0);
        }
        if (!last) SEAM(pb + 9);
        }
#undef IN
#undef SEAM
}

extern "C" void kernel_launch(void* const* d_in, const int* in_sizes, int n_in, void* d_out, int out_size, void* d_ws, size_t ws_size, hipStream_t stream) {
    static int grid = 0;
    if (grid == 0) {
        if (n_in != N_IN || out_size != SEQ * DM || ws_size < WS_END) { fprintf(stderr, "kernel_launch: unexpected shapes (n_in %d out %d ws %zu)\n", n_in, out_size, ws_size); grid = -1; return; }
        if (hipFuncSetAttribute((const void*)fwd, hipFuncAttributeMaxDynamicSharedMemorySize, LDS_BYTES) != hipSuccess) { fprintf(stderr, "kernel_launch: hipFuncSetAttribute failed\n"); grid = -1; return; }
        int dev = 0, cus = 0, per_cu = 0;
        hipGetDevice(&dev); hipDeviceGetAttribute(&cus, hipDeviceAttributeMultiprocessorCount, dev);
        hipOccupancyMaxActiveBlocksPerMultiprocessor(&per_cu, (const void*)fwd, NTHR, LDS_BYTES);
        if (per_cu < 1) { fprintf(stderr, "kernel_launch: occupancy query says %d blocks per CU\n", per_cu); per_cu = 1; }
        (void)hipGetLastError();
        grid = cus * per_cu;
        fprintf(stderr, "kernel_launch: grid %d (cus %d x %d)\n", grid, cus, per_cu);
    }
    if (grid < 0) return;
    hipMemsetAsync((char*)d_ws + WS_CTL, 0, CTL_BYTES, stream);
    Args a{};
    for (int i = 0; i < N_IN; ++i) a.in[i] = (const float*)d_in[i];
    a.out = (float*)d_out; a.ws = (unsigned char*)d_ws;
#if MK_COOP
    a.ph_lo = 0; a.ph_hi = NPHASE;
    void* params[] = {&a};
    hipError_t e = hipLaunchCooperativeKernel((const void*)fwd, dim3(grid), dim3(NTHR), params, LDS_BYTES, stream);
    if (e != hipSuccess) fprintf(stderr, "kernel_launch: cooperative launch failed: %s (grid %d)\n", hipGetErrorString(e), grid);
#else
    for (int p = 0; p < NPHASE; ++p) {
        a.ph_lo = p; a.ph_hi = p + 1;
        hipLaunchKernelGGL(fwd, dim3(grid), dim3(NTHR), LDS_BYTES, stream, a);
    }
#endif
}
```

```cpp
#include <hip/hip_runtime.h>
#include <hip/hip_cooperative_groups.h>
#include <cstdio>
#include <cstdint>
namespace cg = cooperative_groups;

#ifndef MK_COOP
#define MK_COOP 1
#endif

typedef unsigned short bf16_t;
typedef short bf16x8 __attribute__((ext_vector_type(8)));
typedef float f32x4 __attribute__((ext_vector_type(4)));
typedef unsigned u32x4 __attribute__((ext_vector_type(4)));
typedef unsigned u32x2 __attribute__((ext_vector_type(2)));

constexpr int DM = 2048, SEQ = 8192, CTXL = 256, MR = SEQ + CTXL, NIN = 12288, FF = 5632, HD = 128, GW = 64;
constexpr int A_Q0 = 0, A_K0 = 512, A_V0 = 768, B0 = 1024, C_U0 = 1536, C_V0 = 2048, D_Q0 = 2560, D_K0 = 3072, D_V0 = 3584, G0 = 4096;
constexpr float EPS = 1e-6f;
constexpr int NTHR = 512, NWAVE = 8;
constexpr int LDS_BYTES = 147456;

enum { I_X = 0, I_C, I_CTX, I_CCTX, I_ADAW, I_ADAB, I_NPRE_MIX, I_NPOST_MIX, I_NPRE_FFN, I_NPOST_FFN, I_WIN, I_AQN, I_AKN, I_BW, I_BSCALE,
       I_CNG, I_CNB, I_CWS, I_CBS, I_RPB, I_WBR, I_WO, I_WG, I_WU, I_WD, N_IN };

constexpr size_t MiB = 1u << 20;
constexpr size_t WS_CTL = 0, CTL_BYTES = 1 * MiB;
constexpr size_t CTL_MOD = 256 * 1024;
constexpr size_t WS_W = 2 * MiB, WPL = 131 * MiB;
constexpr size_t W_IN = 0, W_BR = 48 * MiB, W_O = 56 * MiB, W_GU = 64 * MiB, W_D = 108 * MiB, W_B = 130 * MiB;
constexpr size_t WS_X = 264 * MiB;
constexpr size_t WS_XN = 330 * MiB;
constexpr size_t WS_PL = 363 * MiB;
constexpr size_t WS_H = WS_PL;
constexpr size_t WS_OUTS = 561 * MiB;
constexpr size_t WS_DLT = 594 * MiB;
constexpr size_t WS_MRG = 603 * MiB;
constexpr size_t WS_MRGB = 669 * MiB;
constexpr size_t WS_END = 702 * MiB;

struct Args { const float* in[N_IN]; float* out; unsigned char* ws; int ph_lo, ph_hi; };

__device__ __forceinline__ unsigned f2bf(float f) { unsigned u = __builtin_bit_cast(unsigned, f); return (u + 0x7fffu + ((u >> 16) & 1u)) >> 16; }
__device__ __forceinline__ unsigned pk2(float lo, float hi) { return f2bf(lo) | (f2bf(hi) << 16); }
__device__ __forceinline__ float bflo(unsigned w) { return __builtin_bit_cast(float, w << 16); }
__device__ __forceinline__ float bfhi(unsigned w) { return __builtin_bit_cast(float, w & 0xffff0000u); }
__device__ __forceinline__ float bf2f(bf16_t h) { return __builtin_bit_cast(float, (unsigned)h << 16); }
__device__ __forceinline__ float wave_sum(float v) {
#pragma unroll
    for (int o = 32; o >= 1; o >>= 1) v += __shfl_xor(v, o);
    return v;
}
__device__ __forceinline__ int otid() { int t = threadIdx.x; asm volatile("" : "+v"(t)); return t; }
__device__ __forceinline__ float sigmoidf_(float x) { return __builtin_amdgcn_rcpf(1.f + __expf(-x)); }
__device__ __forceinline__ float siluf_(float x) { return x * __builtin_amdgcn_rcpf(1.f + __expf(-x)); }

struct Unit { int pm, pn; };
struct Gemm { const bf16_t* A; const bf16_t* Bt; int lda, ldb, K; };
constexpr int NXCD = 8, WGM = 8;
struct StaticOrder {
    int nM, nN, nwg, G, c;
    __device__ void init(int M, int N, int G_, int c_) { nM = M / 256; nN = N / 256; nwg = nM * nN; G = G_; c = c_; }
    __device__ bool next(int i, Unit& u) const {
        const long L = (long)i * G + c; if (L >= nwg) return false;
        int wgid = (int)L; { const int q = nwg / NXCD, r = nwg % NXCD, xcd = wgid % NXCD, off = wgid / NXCD; wgid = (xcd < r ? xcd * (q + 1) : r * (q + 1) + (xcd - r) * q) + off; }
        const int nig = WGM * nN, gid = wgid / nig, fm = gid * WGM, gsz = (nM - fm) < WGM ? (nM - fm) : WGM;
        u.pm = fm + ((wgid % nig) % gsz); u.pn = (wgid % nig) / gsz; return true;
    }
    __device__ __forceinline__ void a_ready(const Unit&) const {}
    __device__ __forceinline__ void done(const Unit&) const {}
};
struct MergeOrder {
    StaticOrder base;
    __device__ bool next(int i, Unit& u) const { Unit t; if (!base.next(i >> 2, t)) return false; const int pass = i & 3; u.pm = pass * 33 + t.pm; u.pn = pass * 8 + t.pn; return true; }
    __device__ __forceinline__ void a_ready(const Unit&) const {}
    __device__ __forceinline__ void done(const Unit&) const {}
};

struct EpiIn {
    static constexpr bool PERM = true, AFTER_DRAIN = false, KHOOK = false;
    bf16_t* PL;
    __device__ __forceinline__ void operator()(const f32x4 (&acc)[2][2][4][2], const Unit& u, int wr, int wc, int fr, int fq) const {
        const bool gate = u.pn >= (G0 / 256);
#pragma unroll
        for (int ai = 0; ai < 2; ++ai)
#pragma unroll
            for (int m = 0; m < 4; ++m) {
                const int row = u.pm * 256 + ai * 128 + wr * 64 + m * 16 + fr;
#pragma unroll
                for (int bj = 0; bj < 2; ++bj) {
                    const int col = u.pn * 256 + bj * 128 + wc * 32 + 8 * fq;
                    f32x4 v0 = acc[ai][bj][m][0], v1 = acc[ai][bj][m][1];
                    if (gate) {
#pragma unroll
                        for (int e = 0; e < 4; ++e) { v0[e] = sigmoidf_(v0[e]); v1[e] = sigmoidf_(v1[e]); }
                    }
                    u32x4 w; w.x = pk2(v0[0], v0[1]); w.y = pk2(v0[2], v0[3]); w.z = pk2(v1[0], v1[1]); w.w = pk2(v1[2], v1[3]);
                    *(u32x4*)(PL + (size_t)row * NIN + col) = w;
                }
            }
    }
};
struct EpiScale {
    static constexpr bool PERM = true, AFTER_DRAIN = false, KHOOK = false;
    bf16_t* O; int ldc; const float* scale;
    __device__ __forceinline__ void operator()(const f32x4 (&acc)[2][2][4][2], const Unit& u, int wr, int wc, int fr, int fq) const {
#pragma unroll
        for (int bj = 0; bj < 2; ++bj) {
            const int col = u.pn * 256 + bj * 128 + wc * 32 + 8 * fq;
            const f32x4 s0 = *(const f32x4*)(scale + col), s1 = *(const f32x4*)(scale + col + 4);
#pragma unroll
            for (int ai = 0; ai < 2; ++ai)
#pragma unroll
                for (int m = 0; m < 4; ++m) {
                    const int row = u.pm * 256 + ai * 128 + wr * 64 + m * 16 + fr;
                    const f32x4 v0 = acc[ai][bj][m][0] * s0, v1 = acc[ai][bj][m][1] * s1;
                    u32x4 w; w.x = pk2(v0[0], v0[1]); w.y = pk2(v0[2], v0[3]); w.z = pk2(v1[0], v1[1]); w.w = pk2(v1[2], v1[3]);
                    *(u32x4*)(O + (size_t)row * ldc + col) = w;
                }
        }
    }
};
struct EpiMerge {
    static constexpr bool PERM = true, AFTER_DRAIN = false, KHOOK = true;
    const bf16_t* PL; bf16_t* MRGB;
    __device__ __forceinline__ void khook(f32x4 (&acc)[2][2][4][2], const Unit& u, int s, int wr, int wc, int fr, int fq) const {
#pragma unroll
        for (int ai = 0; ai < 2; ++ai)
#pragma unroll
            for (int m = 0; m < 4; ++m) {
                const int row = u.pm * 256 + ai * 128 + wr * 64 + m * 16 + fr;
#pragma unroll
                for (int bj = 0; bj < 2; ++bj) {
                    const int col = u.pn * 256 + bj * 128 + wc * 32 + 8 * fq;
                    const bf16_t* gp = PL + (size_t)row * NIN + G0 + (s - 1) * DM + col;
                    const u32x4 ga = *(const u32x4*)gp, gb = *(const u32x4*)(gp + DM);
                    f32x4& v0 = acc[ai][bj][m][0]; f32x4& v1 = acc[ai][bj][m][1];
                    v0[0] *= bflo(ga.x) * __builtin_amdgcn_rcpf(fmaxf(bflo(gb.x), 1e-30f)); v0[1] *= bfhi(ga.x) * __builtin_amdgcn_rcpf(fmaxf(bfhi(gb.x), 1e-30f));
                    v0[2] *= bflo(ga.y) * __builtin_amdgcn_rcpf(fmaxf(bflo(gb.y), 1e-30f)); v0[3] *= bfhi(ga.y) * __builtin_amdgcn_rcpf(fmaxf(bfhi(gb.y), 1e-30f));
                    v1[0] *= bflo(ga.z) * __builtin_amdgcn_rcpf(fmaxf(bflo(gb.z), 1e-30f)); v1[1] *= bfhi(ga.z) * __builtin_amdgcn_rcpf(fmaxf(bfhi(gb.z), 1e-30f));
                    v1[2] *= bflo(ga.w) * __builtin_amdgcn_rcpf(fmaxf(bflo(gb.w), 1e-30f)); v1[3] *= bfhi(ga.w) * __builtin_amdgcn_rcpf(fmaxf(bfhi(gb.w), 1e-30f));
                }
            }
        asm volatile("s_waitcnt vmcnt(0)" ::: "memory");
    }
    __device__ __forceinline__ void operator()(const f32x4 (&acc)[2][2][4][2], const Unit& u, int wr, int wc, int fr, int fq) const {
#pragma unroll
        for (int ai = 0; ai < 2; ++ai)
#pragma unroll
            for (int m = 0; m < 4; ++m) {
                const int row = u.pm * 256 + ai * 128 + wr * 64 + m * 16 + fr;
#pragma unroll
                for (int bj = 0; bj < 2; ++bj) {
                    const int col = u.pn * 256 + bj * 128 + wc * 32 + 8 * fq;
                    const u32x4 gw = *(const u32x4*)(PL + (size_t)row * NIN + G0 + 3 * DM + col);
                    f32x4 v0 = acc[ai][bj][m][0], v1 = acc[ai][bj][m][1];
                    v0[0] *= bflo(gw.x); v0[1] *= bfhi(gw.x); v0[2] *= bflo(gw.y); v0[3] *= bfhi(gw.y);
                    v1[0] *= bflo(gw.z); v1[1] *= bfhi(gw.z); v1[2] *= bflo(gw.w); v1[3] *= bfhi(gw.w);
                    u32x4 w; w.x = pk2(v0[0], v0[1]); w.y = pk2(v0[2], v0[3]); w.z = pk2(v1[0], v1[1]); w.w = pk2(v1[2], v1[3]);
                    *(u32x4*)(MRGB + (size_t)row * DM + col) = w;
                }
            }
    }
};
struct EpiF32 {
    static constexpr bool PERM = true, AFTER_DRAIN = false, KHOOK = false;
    float* Y; int ldc;
    __device__ __forceinline__ void operator()(const f32x4 (&acc)[2][2][4][2], const Unit& u, int wr, int wc, int fr, int fq) const {
#pragma unroll
        for (int ai = 0; ai < 2; ++ai)
#pragma unroll
            for (int m = 0; m < 4; ++m) {
                const int row = u.pm * 256 + ai * 128 + wr * 64 + m * 16 + fr;
#pragma unroll
                for (int bj = 0; bj < 2; ++bj) {
                    const int col = u.pn * 256 + bj * 128 + wc * 32 + 8 * fq;
                    float* yp = Y + (size_t)row * ldc + col;
                    *(f32x4*)yp = acc[ai][bj][m][0]; *(f32x4*)(yp + 4) = acc[ai][bj][m][1];
                }
            }
    }
};
struct EpiSwiglu {
    static constexpr bool PERM = true, AFTER_DRAIN = false, KHOOK = false;
    bf16_t* H;
    __device__ __forceinline__ void operator()(const f32x4 (&acc)[2][2][4][2], const Unit& u, int wr, int wc, int fr, int fq) const {
#pragma unroll
        for (int ai = 0; ai < 2; ++ai)
#pragma unroll
            for (int m = 0; m < 4; ++m) {
                const int row = u.pm * 256 + ai * 128 + wr * 64 + m * 16 + fr;
                const int col = u.pn * 128 + wc * 32 + 8 * fq;
                f32x4 h0, h1;
#pragma unroll
                for (int e = 0; e < 4; ++e) { h0[e] = siluf_(acc[ai][0][m][0][e]) * acc[ai][1][m][0][e]; h1[e] = siluf_(acc[ai][0][m][1][e]) * acc[ai][1][m][1][e]; }
                u32x4 w; w.x = pk2(h0[0], h0[1]); w.y = pk2(h0[2], h0[3]); w.z = pk2(h1[0], h1[1]); w.w = pk2(h1[2], h1[3]);
                *(u32x4*)(H + (size_t)row * FF + col) = w;
            }
    }
};

#define PG8_LAS __attribute__((address_space(3)))
constexpr int BM = 256, BK = 64, HALF = 128, HTB = HALF * BK * 2, STAGE_BYTES = 8 * HTB;
__device__ __forceinline__ int lds_byte(int r, int c) { const int st = (r >> 4) * 2 + (c >> 5), rr = r & 15, cc = c & 31, ob = rr * 64 + cc * 2; return st * 1024 + (ob ^ (((ob >> 9) & 1) << 5)); }
__device__ __forceinline__ void stage_rc(int b, int& R, int& C) { const int st = b / 1024, sb = b % 1024, swz = sb ^ (((sb >> 9) & 1) << 5); R = (st >> 1) * 16 + swz / 64; C = (st & 1) * 32 + (swz % 64) / 2; }
__device__ __forceinline__ int perm32(int rho) { const int n = rho >> 4, i = rho & 15; return 8 * (i >> 2) + 4 * n + (i & 3); }
template <class Epi, class Sched, bool ALIGN_EPI = true, bool SP2 = true>
__device__ __forceinline__ void gemm_phase(PG8_LAS unsigned char* lds, const Gemm g, const Sched& S, const Epi& E) {
    const int tid = otid(), wid = __builtin_amdgcn_readfirstlane(tid >> 6), lane = tid & 63, wr = wid >> 2, wc = wid & 3, fr = lane & 15, fq = lane >> 4;
    const int K = g.K, nt = K / BK;
    unsigned voffA[2], voffB[2];
#pragma unroll
    for (int i = 0; i < 2; ++i) { int R, C; stage_rc(tid * 16 + i * 8192, R, C); const int Rb = Epi::PERM ? ((R & ~31) + perm32(R & 31)) : R;
        voffA[i] = (unsigned)(R * g.lda + C) * 2u; voffB[i] = (unsigned)(Rb * g.ldb + C) * 2u; }
    const size_t kstep = (size_t)(BK * 2);
    const size_t hstepA = (size_t)HALF * g.lda * 2, hstepB = (size_t)HALF * g.ldb * 2;
    const size_t tstepA = 2 * hstepA, tstepB = 2 * hstepB;
    const unsigned ldsw = (unsigned)wid * 1024u;
    const int aoff = lds_byte(wr * 64 + fr, fq * 8), boff = lds_byte(wc * 32 + fr, fq * 8);
#define PG8_SA(b, h) (((b) * 2 + (h)) * HTB)
#define PG8_SB(b, h) ((4 + (b) * 2 + (h)) * HTB)
#define PG8_STAGE(bufoff, gbase, voff) do { _Pragma("unroll") for (int _i = 0; _i < 2; ++_i) \
        __builtin_amdgcn_global_load_lds((const unsigned*)((const char*)(gbase) + (voff)[_i]), (PG8_LAS unsigned*)(lds + (bufoff) + ldsw + _i * 8192), 16, 0, 0); } while (0)
#define PG8_LDA(dst, b, h) do { _Pragma("unroll") for (int m = 0; m < 4; ++m) _Pragma("unroll") for (int k = 0; k < 2; ++k) dst[m][k] = *(const PG8_LAS bf16x8*)(lds + PG8_SA(b, h) + aoff + m * 2048 + k * 1024); } while (0)
#define PG8_LDB(dst, b, h) do { _Pragma("unroll") for (int n = 0; n < 2; ++n) _Pragma("unroll") for (int k = 0; k < 2; ++k) dst[n][k] = *(const PG8_LAS bf16x8*)(lds + PG8_SB(b, h) + boff + n * 2048 + k * 1024); } while (0)
#define PG8_MMA(ai, bj, At, Bt) do { __builtin_amdgcn_s_setprio(1); _Pragma("unroll") for (int m = 0; m < 4; ++m) _Pragma("unroll") for (int n = 0; n < 2; ++n) _Pragma("unroll") for (int k = 0; k < 2; ++k) \
        acc[ai][bj][m][n] = __builtin_amdgcn_mfma_f32_16x16x32_bf16(Bt[n][k], At[m][k], acc[ai][bj][m][n], 0, 0, 0); __builtin_amdgcn_s_setprio(0); } while (0)
#define PG8_WAIT_V(n) asm volatile("s_waitcnt vmcnt(" #n ")" ::: "memory")
#define PG8_WAIT_L(n) asm volatile("s_waitcnt lgkmcnt(" #n ")" ::: "memory")
#define PG8_BAR __builtin_amdgcn_s_barrier()
#define PG8_SCHED __builtin_amdgcn_sched_barrier(0)
    Unit cur, nxt; int ui = 0;
    if (!S.next(0, cur)) return;
    f32x4 acc[2][2][4][2];
#pragma unroll
    for (int a = 0; a < 2; ++a)
#pragma unroll
        for (int b = 0; b < 2; ++b)
#pragma unroll
            for (int m = 0; m < 4; ++m)
#pragma unroll
                for (int n = 0; n < 2; ++n) acc[a][b][m][n] = (f32x4){0.f, 0.f, 0.f, 0.f};
    bf16x8 At[4][2], B0[2][2], B1[2][2];
    const char* cA = (const char*)g.A + (size_t)cur.pm * tstepA; const char* cB = (const char*)g.Bt + (size_t)cur.pn * tstepB;
    S.a_ready(cur);
    if constexpr (SP2) {
        PG8_STAGE(PG8_SB(0, 0), cB, voffB); PG8_STAGE(PG8_SB(0, 1), cB + hstepB, voffB); PG8_STAGE(PG8_SA(0, 0), cA, voffA); PG8_STAGE(PG8_SA(0, 1), cA + hstepA, voffA);
        if (wr == 1) PG8_BAR;
        PG8_WAIT_V(2); PG8_BAR;
        PG8_STAGE(PG8_SB(1, 0), cB + kstep, voffB); PG8_STAGE(PG8_SA(1, 0), cA + kstep, voffA); PG8_STAGE(PG8_SB(1, 1), cB + hstepB + kstep, voffB);
        PG8_WAIT_V(6); PG8_BAR;
    } else {
        PG8_STAGE(PG8_SB(0, 0), cB, voffB); PG8_STAGE(PG8_SA(0, 0), cA, voffA); PG8_STAGE(PG8_SB(0, 1), cB + hstepB, voffB); PG8_STAGE(PG8_SA(0, 1), cA + hstepA, voffA);
        if (wr == 1) PG8_BAR;
        PG8_WAIT_V(4); PG8_BAR;
        PG8_STAGE(PG8_SB(1, 0), cB + kstep, voffB); PG8_STAGE(PG8_SA(1, 0), cA + kstep, voffA); PG8_STAGE(PG8_SB(1, 1), cB + hstepB + kstep, voffB);
        PG8_WAIT_V(6); PG8_BAR;
    }
    for (;;) {
        const bool has_next = S.next(ui + 1, nxt);
        const char* nA = has_next ? (const char*)g.A + (size_t)nxt.pm * tstepA : cA; const char* nB = has_next ? (const char*)g.Bt + (size_t)nxt.pn * tstepB : cB;
        for (int t = 0; t < nt; t += 2) {
            if constexpr (Epi::KHOOK) { if (t > 0 && (t & 7) == 0) E.khook(acc, cur, t >> 3, wr, wc, fr, fq); }
            const bool last = (t == nt - 2);
            const char* a1 = cA + (size_t)(t + 1) * kstep;
            const char* a2 = last ? nA : cA + (size_t)(t + 2) * kstep; const char* b2 = last ? nB : cB + (size_t)(t + 2) * kstep;
            const char* a3 = a2 + kstep; const char* b3 = b2 + kstep;
            if (last && has_next) S.a_ready(nxt);
            if constexpr (SP2) {
            PG8_LDB(B0, 0, 0); PG8_LDB(B1, 0, 1); PG8_SCHED; PG8_LDA(At, 0, 0); PG8_STAGE(PG8_SA(1, 1), a1 + hstepA, voffA);
            PG8_WAIT_V(8); PG8_WAIT_L(0); PG8_BAR; PG8_MMA(0, 0, At, B0); PG8_MMA(0, 1, At, B1); PG8_BAR; PG8_SCHED;
            PG8_LDA(At, 0, 1); PG8_STAGE(PG8_SB(0, 0), b2, voffB); PG8_STAGE(PG8_SB(0, 1), b2 + hstepB, voffB); PG8_STAGE(PG8_SA(0, 0), a2, voffA);
            PG8_WAIT_V(8); PG8_WAIT_L(0); PG8_BAR; PG8_MMA(1, 0, At, B0); PG8_MMA(1, 1, At, B1); PG8_BAR; PG8_SCHED;
            PG8_LDB(B0, 1, 0); PG8_LDB(B1, 1, 1); PG8_SCHED; PG8_LDA(At, 1, 0); PG8_STAGE(PG8_SA(0, 1), a2 + hstepA, voffA);
            PG8_WAIT_V(8); PG8_WAIT_L(0); PG8_BAR; PG8_MMA(0, 0, At, B0); PG8_MMA(0, 1, At, B1); PG8_BAR; PG8_SCHED;
            PG8_LDA(At, 1, 1); PG8_STAGE(PG8_SB(1, 0), b3, voffB); PG8_STAGE(PG8_SB(1, 1), b3 + hstepB, voffB); PG8_STAGE(PG8_SA(1, 0), a3, voffA);
            PG8_WAIT_V(8); PG8_WAIT_L(0); PG8_BAR; PG8_MMA(1, 0, At, B0); PG8_MMA(1, 1, At, B1); PG8_BAR; PG8_SCHED;
            } else {
            PG8_LDB(B0, 0, 0); PG8_SCHED; PG8_LDA(At, 0, 0); PG8_STAGE(PG8_SA(1, 1), a1 + hstepA, voffA);
            PG8_WAIT_L(8); PG8_BAR; PG8_WAIT_L(0); PG8_MMA(0, 0, At, B0); PG8_BAR; PG8_SCHED;
            PG8_LDB(B1, 0, 1); PG8_STAGE(PG8_SB(0, 0), b2, voffB);
            PG8_BAR; PG8_WAIT_L(0); PG8_MMA(0, 1, At, B1); PG8_BAR;
            PG8_LDA(At, 0, 1); PG8_STAGE(PG8_SA(0, 0), a2, voffA);
            PG8_BAR; PG8_WAIT_L(0); PG8_MMA(1, 0, At, B0); PG8_BAR; PG8_SCHED;
            PG8_STAGE(PG8_SB(0, 1), b2 + hstepB, voffB);
            PG8_WAIT_V(6); PG8_BAR; PG8_MMA(1, 1, At, B1); PG8_BAR;
            PG8_LDB(B0, 1, 0); PG8_SCHED; PG8_LDA(At, 1, 0); PG8_STAGE(PG8_SA(0, 1), a2 + hstepA, voffA);
            PG8_WAIT_L(8); PG8_BAR; PG8_WAIT_L(0); PG8_MMA(0, 0, At, B0); PG8_BAR; PG8_SCHED;
            PG8_LDB(B1, 1, 1); PG8_STAGE(PG8_SB(1, 0), b3, voffB);
            PG8_BAR; PG8_WAIT_L(0); PG8_MMA(0, 1, At, B1); PG8_BAR;
            PG8_LDA(At, 1, 1); PG8_STAGE(PG8_SA(1, 0), a3, voffA);
            PG8_BAR; PG8_WAIT_L(0); PG8_MMA(1, 0, At, B0); PG8_BAR; PG8_SCHED;
            PG8_STAGE(PG8_SB(1, 1), b3 + hstepB, voffB);
            PG8_WAIT_V(6); PG8_BAR; PG8_MMA(1, 1, At, B1); PG8_BAR;
            }
        }
        if constexpr (ALIGN_EPI) { if (wr == 0) PG8_BAR; }
        if constexpr (!Epi::AFTER_DRAIN) { E(acc, cur, wr, wc, fr, fq); S.done(cur); }
        if (!has_next) break;
#pragma unroll
        for (int a = 0; a < 2; ++a)
#pragma unroll
            for (int b = 0; b < 2; ++b)
#pragma unroll
                for (int m = 0; m < 4; ++m)
#pragma unroll
                    for (int n = 0; n < 2; ++n) acc[a][b][m][n] = (f32x4){0.f, 0.f, 0.f, 0.f};
        cur = nxt; cA = nA; cB = nB; ++ui;
        if constexpr (ALIGN_EPI) { if (wr == 1) PG8_BAR; }
    }
    PG8_WAIT_V(0);
    if constexpr (!ALIGN_EPI) { if (wr == 0) PG8_BAR; }
    PG8_BAR;
    if constexpr (Epi::AFTER_DRAIN) { E.fused(acc, cur, wr, wc, fr, fq, lds, wid, lane); S.done(cur); }
#undef PG8_SA
#undef PG8_SB
#undef PG8_STAGE
#undef PG8_LDA
#undef PG8_LDB
#undef PG8_MMA
#undef PG8_WAIT_V
#undef PG8_WAIT_L
#undef PG8_BAR
#undef PG8_SCHED
}

__device__ __forceinline__ void tr_item(const float* src, int ldn, int k0, int n0, bf16_t* dst, int dld, int drow0, int dk0, float* scr, int lane) {
    const float* sp = src + (size_t)k0 * ldn + n0 + lane;
    float t[64];
#pragma unroll
    for (int i = 0; i < 64; ++i) t[i] = __builtin_nontemporal_load(sp + (size_t)i * ldn);
#pragma unroll
    for (int i = 0; i < 64; ++i) scr[i * 65 + lane] = t[i];
    __builtin_amdgcn_s_waitcnt(0); asm volatile("" ::: "memory");
    const int c = lane & 7;
#pragma unroll
    for (int j = 0; j < 8; ++j) {
        const int n = (lane >> 3) + 8 * j; const float* s = scr + (8 * c) * 65 + n;
        u32x4 o; o.x = pk2(s[0], s[65]); o.y = pk2(s[2 * 65], s[3 * 65]); o.z = pk2(s[4 * 65], s[5 * 65]); o.w = pk2(s[6 * 65], s[7 * 65]);
        *(u32x4*)(dst + (size_t)(drow0 + n) * dld + dk0 + 8 * c) = o;
    }
    __builtin_amdgcn_s_waitcnt(0); asm volatile("" ::: "memory");
}

__device__ __forceinline__ void convert_layer(const Args& a, unsigned char* lds, int l, int widx, int nw) {
    const int tid = otid(), wave = tid >> 6, lane = tid & 63;
    float* scr = (float*)(lds + wave * 16640);
    constexpr int I_IN = 32 * 192, I_BR = 4 * 8 * 32, I_O = 32 * 32, I_G = 32 * 88, I_D = 88 * 32, I_B = 16;
    constexpr int PLI = I_IN + I_BR + I_O + 2 * I_G + I_D + I_B;
    unsigned char* wb = a.ws + WS_W + (size_t)l * WPL;
    for (int it = widx; it < PLI; it += nw) {
        int r = it;
        if (r < I_IN) { const int kb = r / 192, nb = r % 192; tr_item(a.in[I_WIN] + (size_t)l * DM * NIN, NIN, kb * 64, nb * 64, (bf16_t*)(wb + W_IN), DM, nb * 64, kb * 64, scr, lane); continue; } r -= I_IN;
        if (r < I_BR) { const int i = r >> 8, rr = r & 255, kb = rr >> 5, nb = rr & 31;
            tr_item(a.in[I_WBR] + (size_t)(l * 4 + i) * 512 * DM, DM, kb * 64, nb * 64, (bf16_t*)(wb + W_BR), DM, nb * 64, i * 512 + kb * 64, scr, lane); continue; } r -= I_BR;
        if (r < I_O) { const int kb = r >> 5, nb = r & 31; tr_item(a.in[I_WO] + (size_t)l * DM * DM, DM, kb * 64, nb * 64, (bf16_t*)(wb + W_O), DM, nb * 64, kb * 64, scr, lane); continue; } r -= I_O;
        if (r < I_G) { const int kb = r / 88, nb = r % 88, n0 = nb * 64; tr_item(a.in[I_WG] + (size_t)l * DM * FF, FF, kb * 64, n0, (bf16_t*)(wb + W_GU), DM, (n0 >> 7) * 256 + (n0 & 127), kb * 64, scr, lane); continue; } r -= I_G;
        if (r < I_G) { const int kb = r / 88, nb = r % 88, n0 = nb * 64; tr_item(a.in[I_WU] + (size_t)l * DM * FF, FF, kb * 64, n0, (bf16_t*)(wb + W_GU), DM, (n0 >> 7) * 256 + 128 + (n0 & 127), kb * 64, scr, lane); continue; } r -= I_G;
        if (r < I_D) { const int kb = r >> 5, nb = r & 31; tr_item(a.in[I_WD] + (size_t)l * FF * DM, DM, kb * 64, nb * 64, (bf16_t*)(wb + W_D), FF, nb * 64, kb * 64, scr, lane); continue; } r -= I_D;
        { const int g = r >> 2, kb = (r >> 1) & 1, nb = r & 1;
          tr_item(a.in[I_BW] + (size_t)(l * 4 + g) * 128 * 128, 128, kb * 64, nb * 64, (bf16_t*)(wb + W_B), 512, g * 128 + nb * 64, g * 128 + kb * 64, scr, lane); }
    }
}
__device__ __forceinline__ void phase_prologue(const Args& a, unsigned char* lds, int vcu, int G) {
    const int tid = otid(), wave = tid >> 6;
    convert_layer(a, lds, 0, vcu * NWAVE + wave, G * NWAVE);
    for (int i = vcu * NTHR + tid; i < 2 * 32768; i += G * NTHR) {
        const int l = i >> 15, j = i & 32767, n = j >> 6, kc = j & 63;
        if ((n >> 7) != (kc >> 4)) *(u32x4*)((bf16_t*)(a.ws + WS_W + (size_t)l * WPL + W_B) + (size_t)n * 512 + kc * 8) = (u32x4){0u, 0u, 0u, 0u};
    }
    float* MOD = (float*)(a.ws + WS_CTL + CTL_MOD);
    for (int it = vcu; it < 768; it += G) {
        const int l = it / 384, r = it % 384, cb = r >> 6, kc = r & 63;
        const int col = cb * 2048 + tid * 4;
        f32x4 al = {0.f, 0.f, 0.f, 0.f}, ac = {0.f, 0.f, 0.f, 0.f};
        const float* wp = a.in[I_ADAW] + ((size_t)l * DM + kc * 32) * NIN + col;
#pragma unroll 8
        for (int k = 0; k < 32; ++k) {
            const float sl = siluf_(a.in[I_C][kc * 32 + k]), sc = siluf_(a.in[I_CCTX][kc * 32 + k]);
            const f32x4 w = *(const f32x4*)(wp + (size_t)k * NIN);
            al += sl * w; ac += sc * w;
        }
        if (kc == 0) { const f32x4 b = *(const f32x4*)(a.in[I_ADAB] + (size_t)l * NIN + col); al += b; ac += b; }
        float* ml = MOD + (size_t)(l * 2 + 0) * NIN + col; float* mc = MOD + (size_t)(l * 2 + 1) * NIN + col;
#pragma unroll
        for (int e = 0; e < 4; ++e) { unsafeAtomicAdd(ml + e, al[e]); unsafeAtomicAdd(mc + e, ac[e]); }
    }
}

template <int MODE>
__device__ __forceinline__ void phase_rows(const Args& a, int vcu, int G, int nrows, const float* gpost, const float* modcur, int gate_idx,
                                           const float* gnext, const float* modnext, int sh_idx) {
    const int tid = otid(), wave = tid >> 6, lane = tid & 63;
    const int gw = vcu * NWAVE + wave, NGW = G * NWAVE;
    float* X = (float*)(a.ws + WS_X); const float* Y = (const float*)(a.ws + WS_MRG); bf16_t* XN = (bf16_t*)(a.ws + WS_XN);
    for (int row = gw; row < nrows; row += NGW) {
        const int isctx = row >= SEQ ? 1 : 0;
        f32x4 x[8];
        if (MODE == 0) {
            const float* src = isctx ? a.in[I_CTX] + (size_t)(row - SEQ) * DM : a.in[I_X] + (size_t)row * DM;
#pragma unroll
            for (int j = 0; j < 8; ++j) x[j] = *(const f32x4*)(src + 4 * lane + 256 * j);
        } else {
            f32x4 y[8]; float ss = 0.f;
#pragma unroll
            for (int j = 0; j < 8; ++j) { x[j] = *(const f32x4*)(X + (size_t)row * DM + 4 * lane + 256 * j); y[j] = *(const f32x4*)(Y + (size_t)row * DM + 4 * lane + 256 * j);
                ss += (y[j][0] * y[j][0] + y[j][1] * y[j][1]) + (y[j][2] * y[j][2] + y[j][3] * y[j][3]); }
            const float rstd = 1.0f / sqrtf(wave_sum(ss) * (1.f / DM) + EPS);
            const float* gate = modcur + (size_t)isctx * NIN + gate_idx * DM;
#pragma unroll
            for (int j = 0; j < 8; ++j) { const int col = 4 * lane + 256 * j; const f32x4 gp = *(const f32x4*)(gpost + col), gt = *(const f32x4*)(gate + col);
                x[j] += gt * (y[j] * rstd * gp); }
        }
        if (MODE == 2) {
#pragma unroll
            for (int j = 0; j < 8; ++j) *(f32x4*)(a.out + (size_t)row * DM + 4 * lane + 256 * j) = x[j];
            continue;
        }
        float ss = 0.f;
#pragma unroll
        for (int j = 0; j < 8; ++j) { *(f32x4*)(X + (size_t)row * DM + 4 * lane + 256 * j) = x[j];
            ss += (x[j][0] * x[j][0] + x[j][1] * x[j][1]) + (x[j][2] * x[j][2] + x[j][3] * x[j][3]); }
        const float rstd = 1.0f / sqrtf(wave_sum(ss) * (1.f / DM) + EPS);
        const float* sh = modnext + (size_t)isctx * NIN + sh_idx * DM; const float* sc = sh + DM;
#pragma unroll
        for (int j = 0; j < 8; ++j) { const int col = 4 * lane + 256 * j; const f32x4 gn = *(const f32x4*)(gnext + col), s1 = *(const f32x4*)(sc + col), s0 = *(const f32x4*)(sh + col);
            const f32x4 h = (x[j] * rstd * gn) * (1.f + s1) + s0;
            u32x2 w; w.x = pk2(h[0], h[1]); w.y = pk2(h[2], h[3]); *(u32x2*)(XN + (size_t)row * DM + col) = w; }
    }
}

__device__ __forceinline__ void qk_prep_row(const Args& a, int layer, int row, int lane) {
    bf16_t* p = (bf16_t*)(a.ws + WS_PL) + (size_t)row * NIN;
    const int ax = lane >> 5, f = lane & 31, d1 = ax * 64 + f, d2 = d1 + 32;
    float cs = 1.f, sn = 0.f;
    if (row < SEQ) { const float pos = (float)(ax == 0 ? (row >> 6) : (row & 63)); const float inv = exp2f(-(float)f * (13.287712379549449f / 32.f)); const float ang = pos * inv; cs = cosf(ang); sn = sinf(ang); }
#pragma unroll
    for (int h = 0; h < 6; ++h) {
        const float* gn = (h < 4 ? a.in[I_AQN] : a.in[I_AKN]) + layer * HD;
        bf16_t* hp = p + h * HD;
        float x1 = bf2f(hp[d1]), x2 = bf2f(hp[d2]);
        const float rstd = 1.0f / sqrtf(wave_sum(x1 * x1 + x2 * x2) * (1.f / HD) + EPS);
        x1 = x1 * rstd * gn[d1]; x2 = x2 * rstd * gn[d2];
        hp[d1] = (bf16_t)f2bf(x1 * cs - x2 * sn); hp[d2] = (bf16_t)f2bf(x2 * cs + x1 * sn);
    }
}
__device__ __forceinline__ void dlt_row(const Args& a, int row, int lane) {
    const bf16_t* PL = (const bf16_t*)(a.ws + WS_PL); bf16_t* DLT = (bf16_t*)(a.ws + WS_DLT);
    const int base = row < SEQ ? 0 : SEQ, n = row < SEQ ? SEQ : CTXL, t = row - base, half = 1 << (lane >> 4);
    const int lo = max(t - half, 0), hi = min(t + half, n);
    float s[8];
#pragma unroll
    for (int e = 0; e < 8; ++e) s[e] = 0.f;
    for (int r = lo; r < hi; ++r) { const u32x4 w = *(const u32x4*)(PL + (size_t)(base + r) * NIN + B0 + lane * 8);
        s[0] += bflo(w.x); s[1] += bfhi(w.x); s[2] += bflo(w.y); s[3] += bfhi(w.y); s[4] += bflo(w.z); s[5] += bfhi(w.z); s[6] += bflo(w.w); s[7] += bfhi(w.w); }
    const float inv = 1.f / (float)(hi - lo);
    const u32x4 w = *(const u32x4*)(PL + (size_t)row * NIN + B0 + lane * 8);
    u32x4 o; o.x = pk2(s[0] * inv - bflo(w.x), s[1] * inv - bfhi(w.x)); o.y = pk2(s[2] * inv - bflo(w.y), s[3] * inv - bfhi(w.y));
    o.z = pk2(s[4] * inv - bflo(w.z), s[5] * inv - bfhi(w.z)); o.w = pk2(s[6] * inv - bflo(w.w), s[7] * inv - bfhi(w.w));
    *(u32x4*)(DLT + (size_t)row * 512 + lane * 8) = o;
}
constexpr int CP = 136;
__device__ __forceinline__ void cmix_unit(const Args& a, int layer, int unit, unsigned char* lds) {
    const int tid = otid(), wave = tid >> 6, lane = tid & 63, chunk = unit >> 2, g = unit & 3;
    const bf16_t* PL = (const bf16_t*)(a.ws + WS_PL); bf16_t* OUT = (bf16_t*)(a.ws + WS_OUTS) + 2 * 512;
    bf16_t* vT = (bf16_t*)lds;
    bf16_t* wsL = (bf16_t*)(lds + 128 * CP * 2);
    float* st = (float*)(lds + 2 * 128 * CP * 2);
    const int t0 = chunk * 128;
    for (int i = 0; i < 16; ++i) {
        const int q = wave * 16 + i;
        const u32x4 w = *(const u32x4*)(PL + (size_t)(t0 + q) * NIN + C_V0 + lane * 8);
        float x[8] = {bflo(w.x), bfhi(w.x), bflo(w.y), bfhi(w.y), bflo(w.z), bfhi(w.z), bflo(w.w), bfhi(w.w)};
        float s = 0.f;
#pragma unroll
        for (int e = 0; e < 8; ++e) s += x[e];
        const float mean = wave_sum(s) * (1.f / 512.f); float q2 = 0.f;
#pragma unroll
        for (int e = 0; e < 8; ++e) { const float d = x[e] - mean; q2 += d * d; }
        const float rstd = 1.0f / sqrtf(wave_sum(q2) * (1.f / 512.f) + EPS);
        if (lane == 0) { st[2 * q] = mean; st[2 * q + 1] = rstd; }
    }
    __syncthreads();
    {
        const int q = tid & 127, cb = tid >> 7; const float mean = st[2 * q], rstd = st[2 * q + 1];
        const float* lg = a.in[I_CNG] + layer * 512 + g * 128 + cb * 32; const float* lb = a.in[I_CNB] + layer * 512 + g * 128 + cb * 32;
        const bf16_t* vp = PL + (size_t)(t0 + q) * NIN + C_V0 + g * 128 + cb * 32;
#pragma unroll
        for (int j = 0; j < 4; ++j) { const u32x4 w = *(const u32x4*)(vp + j * 8);
            const float x[8] = {bflo(w.x), bfhi(w.x), bflo(w.y), bfhi(w.y), bflo(w.z), bfhi(w.z), bflo(w.w), bfhi(w.w)};
#pragma unroll
            for (int e = 0; e < 8; ++e) { const int c = j * 8 + e; vT[(cb * 32 + c) * CP + q] = (bf16_t)f2bf((x[e] - mean) * rstd * lg[c] + lb[c]); } }
        const int p = tid >> 2, qb = (tid & 3) * 32; const float* wp = a.in[I_CWS] + ((size_t)(layer * 4 + g) * 128 + p) * 128 + qb;
#pragma unroll
        for (int j = 0; j < 8; ++j) { const f32x4 w = *(const f32x4*)(wp + j * 4); u32x2 o; o.x = pk2(w[0], w[1]); o.y = pk2(w[2], w[3]); *(u32x2*)(wsL + p * CP + qb + j * 4) = o; }
    }
    __syncthreads();
    {
        const int fr = lane & 15, fq = lane >> 4;
        f32x4 acc[8];
#pragma unroll
        for (int nb = 0; nb < 8; ++nb) acc[nb] = (f32x4){0.f, 0.f, 0.f, 0.f};
#pragma unroll
        for (int ks = 0; ks < 4; ++ks) {
            const bf16x8 wf = *(const bf16x8*)(wsL + (wave * 16 + fr) * CP + ks * 32 + fq * 8);
#pragma unroll
            for (int nb = 0; nb < 8; ++nb) { const bf16x8 vf = *(const bf16x8*)(vT + (nb * 16 + fr) * CP + ks * 32 + fq * 8);
                acc[nb] = __builtin_amdgcn_mfma_f32_16x16x32_bf16(vf, wf, acc[nb], 0, 0, 0); }
        }
        const int p = wave * 16 + fr; const float bs = a.in[I_CBS][(layer * 4 + g) * 128 + p];
        const bf16_t* up = PL + (size_t)(t0 + p) * NIN + C_U0 + g * 128; bf16_t* op = OUT + (size_t)(t0 + p) * DM + g * 128;
#pragma unroll
        for (int nb = 0; nb < 8; ++nb) { const int c = nb * 16 + 4 * fq; const u32x2 uw = *(const u32x2*)(up + c);
            u32x2 o; o.x = pk2((acc[nb][0] + bs) * bflo(uw.x), (acc[nb][1] + bs) * bfhi(uw.x)); o.y = pk2((acc[nb][2] + bs) * bflo(uw.y), (acc[nb][3] + bs) * bfhi(uw.y));
            *(u32x2*)(op + c) = o; }
    }
    __syncthreads();
}

template <int MODE>
__device__ __forceinline__ void attn_simple_item(const bf16_t* PL, int qcol, int kcol, int vcol, bf16_t* O, int qrow, int h, int kvh, int kbeg, int kend, const float* rpb, int lane) {
    constexpr float C = 0.088388347648318440f * 1.4426950408889634f;
    const int part = lane & 3;
    float q[32], o[32];
    { const bf16_t* qp = PL + (size_t)qrow * NIN + qcol + h * HD + part * 32;
#pragma unroll
      for (int j = 0; j < 4; ++j) { const u32x4 w = *(const u32x4*)(qp + j * 8);
          q[j * 8 + 0] = bflo(w.x) * C; q[j * 8 + 1] = bfhi(w.x) * C; q[j * 8 + 2] = bflo(w.y) * C; q[j * 8 + 3] = bfhi(w.y) * C;
          q[j * 8 + 4] = bflo(w.z) * C; q[j * 8 + 5] = bfhi(w.z) * C; q[j * 8 + 6] = bflo(w.w) * C; q[j * 8 + 7] = bfhi(w.w) * C; } }
#pragma unroll
    for (int d = 0; d < 32; ++d) o[d] = 0.f;
    float mrun = -1e30f, l = 0.f;
    const int r = qrow >> 6, c = qrow & 63, r0 = min(max(r - 4, 0), 120), c0 = min(max(c - 8, 0), 48);
    const int nk = MODE == 0 ? (kend - kbeg) : 384;
    for (int idx = 0; idx < nk; ++idx) {
        int krow; float bias = 0.f;
        if (MODE == 0) krow = kbeg + idx;
        else if (idx < 128) { const int i = idx >> 4, j = idx & 15; krow = (r0 + i) * GW + c0 + j; bias = rpb[(h * 15 + (r0 + i - r + 7)) * 31 + (c0 + j - c + 15)] * 1.4426950408889634f; }
        else krow = SEQ + idx - 128;
        const bf16_t* kp = PL + (size_t)krow * NIN + kcol + kvh * HD + part * 32;
        float s = 0.f;
#pragma unroll
        for (int j = 0; j < 4; ++j) { const u32x4 w = *(const u32x4*)(kp + j * 8);
            s += q[j * 8 + 0] * bflo(w.x) + q[j * 8 + 1] * bfhi(w.x) + q[j * 8 + 2] * bflo(w.y) + q[j * 8 + 3] * bfhi(w.y)
               + q[j * 8 + 4] * bflo(w.z) + q[j * 8 + 5] * bfhi(w.z) + q[j * 8 + 6] * bflo(w.w) + q[j * 8 + 7] * bfhi(w.w); }
        s += __shfl_xor(s, 1); s += __shfl_xor(s, 2);
        s += bias;
        const float mn = fmaxf(mrun, s), alpha = exp2f(mrun - mn), p = exp2f(s - mn);
        l = l * alpha + p; mrun = mn;
        const bf16_t* vp = PL + (size_t)krow * NIN + vcol + kvh * HD + part * 32;
#pragma unroll
        for (int j = 0; j < 4; ++j) { const u32x4 w = *(const u32x4*)(vp + j * 8);
            o[j * 8 + 0] = o[j * 8 + 0] * alpha + p * bflo(w.x); o[j * 8 + 1] = o[j * 8 + 1] * alpha + p * bfhi(w.x);
            o[j * 8 + 2] = o[j * 8 + 2] * alpha + p * bflo(w.y); o[j * 8 + 3] = o[j * 8 + 3] * alpha + p * bfhi(w.y);
            o[j * 8 + 4] = o[j * 8 + 4] * alpha + p * bflo(w.z); o[j * 8 + 5] = o[j * 8 + 5] * alpha + p * bfhi(w.z);
            o[j * 8 + 6] = o[j * 8 + 6] * alpha + p * bflo(w.w); o[j * 8 + 7] = o[j * 8 + 7] * alpha + p * bfhi(w.w); }
    }
    const float il = 1.f / l;
    bf16_t* op = O + (size_t)qrow * 512 + h * HD + part * 32;
#pragma unroll
    for (int j = 0; j < 4; ++j) { u32x4 w; w.x = pk2(o[j * 8 + 0] * il, o[j * 8 + 1] * il); w.y = pk2(o[j * 8 + 2] * il, o[j * 8 + 3] * il);
        w.z = pk2(o[j * 8 + 4] * il, o[j * 8 + 5] * il); w.w = pk2(o[j * 8 + 6] * il, o[j * 8 + 7] * il); *(u32x4*)(op + j * 8) = w; }
}


namespace att {
using s16x4 = __attribute__((ext_vector_type(4))) short;
using f32x16 = __attribute__((ext_vector_type(16))) float;
constexpr int KVBLK = 64;
constexpr float SCALE = 0.088388347648318440f, THR = 8.f;
constexpr int SHM_V = KVBLK * HD * 2, SHM_K = KVBLK * HD * 2, SHM_ATTN = 2 * SHM_V + 2 * SHM_K + NWAVE * 64 * 4;
#define KSWZ(row, colB) ((row) * 256 + ((colB) ^ (((row) & 7) << 4)))
#define SBAR() __builtin_amdgcn_sched_barrier(0)
__device__ __forceinline__ int crow(int r, int hi) { return (r & 3) + 8 * (r >> 2) + 4 * hi; }
__device__ __forceinline__ unsigned cvtpk(float lo, float hi) { unsigned r; asm volatile("v_cvt_pk_bf16_f32 %0, %1, %2" : "=v"(r) : "v"(lo), "v"(hi)); return r; }
__device__ __forceinline__ void partialSM(f32x16& p0, f32x16& p1, float& m_reg, float& mn, float& alpha) {
  constexpr float C = SCALE * 1.4426950408889634f;
  float pmax = p0[0];
#pragma unroll
  for (int r = 1; r < 16; ++r) pmax = fmaxf(pmax, p0[r]);
#pragma unroll
  for (int r = 0; r < 16; ++r) pmax = fmaxf(pmax, p1[r]);
  { auto rr = __builtin_amdgcn_permlane32_swap(__float_as_uint(pmax), __float_as_uint(pmax), false, false);
    pmax = fmaxf(__uint_as_float(rr[0]), __uint_as_float(rr[1])); }
  if (__builtin_expect(__all(pmax - m_reg <= THR / SCALE), 1)) { mn = m_reg; alpha = 1.f; }
  else { mn = fmaxf(m_reg, pmax); alpha = __builtin_amdgcn_exp2f((m_reg - mn) * C); m_reg = mn; }
  float mnC = -mn * C;
#pragma unroll
  for (int r = 0; r < 16; ++r) p0[r] = fmaf(p0[r], C, mnC);
#pragma unroll
  for (int r = 0; r < 16; ++r) p1[r] = fmaf(p1[r], C, mnC);
#pragma unroll
  for (int r = 0; r < 16; ++r) p0[r] = __builtin_amdgcn_exp2f(p0[r]);
}
__device__ __forceinline__ void finishSM(f32x16& p0, f32x16& p1, float alpha, float& l_reg, bf16x8& pa0, bf16x8& pa1, bf16x8& pa2, bf16x8& pa3) {
#pragma unroll
  for (int r = 0; r < 16; ++r) p1[r] = __builtin_amdgcn_exp2f(p1[r]);
  float ps = 0;
#pragma unroll
  for (int r = 0; r < 16; ++r) ps += p0[r];
#pragma unroll
  for (int r = 0; r < 16; ++r) ps += p1[r];
  { auto rr = __builtin_amdgcn_permlane32_swap(__float_as_uint(ps), __float_as_uint(ps), false, false);
    ps = __uint_as_float(rr[0]) + __uint_as_float(rr[1]); }
  l_reg = l_reg * alpha + ps;
#define PK4(P, BASE, OUT) do { unsigned a0 = cvtpk(P[BASE + 0], P[BASE + 1]), a1 = cvtpk(P[BASE + 2], P[BASE + 3]);   \
    unsigned b0 = cvtpk(P[BASE + 4], P[BASE + 5]), b1 = cvtpk(P[BASE + 6], P[BASE + 7]);                              \
    auto r0 = __builtin_amdgcn_permlane32_swap(a0, b0, false, false); auto r1 = __builtin_amdgcn_permlane32_swap(a1, b1, false, false); \
    u32x4 w = {r0[0], r1[0], r0[1], r1[1]}; OUT = *reinterpret_cast<bf16x8*>(&w); } while (0)
  PK4(p0, 0, pa0); PK4(p0, 8, pa1); PK4(p1, 0, pa2); PK4(p1, 8, pa3);
#undef PK4
}
__device__ __forceinline__ void qkt(f32x16& p0, f32x16& p1, const char* Ks, const bf16x8* qr, int r32, int hi) {
  p0 = f32x16{}; p1 = f32x16{};
#pragma unroll
  for (int d0 = 0; d0 < 8; ++d0) { int cb = (d0 * 16 + hi * 8) * 2;
    bf16x8 b0 = *reinterpret_cast<const bf16x8*>(Ks + KSWZ(r32, cb));
    bf16x8 b1 = *reinterpret_cast<const bf16x8*>(Ks + KSWZ(32 + r32, cb));
    p0 = __builtin_amdgcn_mfma_f32_32x32x16_bf16(b0, qr[d0], p0, 0, 0, 0);
    p1 = __builtin_amdgcn_mfma_f32_32x32x16_bf16(b1, qr[d0], p1, 0, 0, 0); }
}
__device__ __forceinline__ int v_st(int k, int c) { const int kk = (k & ~0xC) | ((k & 4) << 1) | ((k & 8) >> 1); return ((kk >> 3) * 4 + (c >> 5)) * 512 + ((kk & 7) * 32 + (c & 31)) * 2; }
__device__ __forceinline__ int v_rd_base(int lane) { return ((lane & 3) << 3) | (((lane >> 2) & 3) << 6) | (((lane >> 4) & 1) << 5) | (((lane >> 5) & 1) << 8); }
constexpr int v_rd_off(int d0, int ks, int half) { return d0 * 512 + ks * 4096 + half * 2048; }
template <int OFF> __device__ __forceinline__ s16x4 tr_read(int vb) {
  s16x4 r; asm volatile("ds_read_b64_tr_b16 %0, %1 offset:%2" : "=&v"(r) : "v"(vb), "i"(OFF) : "memory"); return r;
}
template <int D0> __device__ __forceinline__ void pv_one(f32x16& od, int vb, bf16x8 pa0, bf16x8 pa1, bf16x8 pa2, bf16x8 pa3) {
  const s16x4 l0 = tr_read<v_rd_off(D0, 0, 0)>(vb), h0 = tr_read<v_rd_off(D0, 0, 1)>(vb), l1 = tr_read<v_rd_off(D0, 1, 0)>(vb), h1 = tr_read<v_rd_off(D0, 1, 1)>(vb);
  const s16x4 l2 = tr_read<v_rd_off(D0, 2, 0)>(vb), h2 = tr_read<v_rd_off(D0, 2, 1)>(vb), l3 = tr_read<v_rd_off(D0, 3, 0)>(vb), h3 = tr_read<v_rd_off(D0, 3, 1)>(vb);
  asm volatile("s_waitcnt lgkmcnt(0)" ::: "memory"); SBAR();
#define PK(L, H) (bf16x8){L[0], L[1], L[2], L[3], H[0], H[1], H[2], H[3]}
  od = __builtin_amdgcn_mfma_f32_32x32x16_bf16(pa0, PK(l0, h0), od, 0, 0, 0);
  od = __builtin_amdgcn_mfma_f32_32x32x16_bf16(pa1, PK(l1, h1), od, 0, 0, 0);
  od = __builtin_amdgcn_mfma_f32_32x32x16_bf16(pa2, PK(l2, h2), od, 0, 0, 0);
  od = __builtin_amdgcn_mfma_f32_32x32x16_bf16(pa3, PK(l3, h3), od, 0, 0, 0);
#undef PK
}
__device__ __forceinline__ void pv_d0(f32x16* o, int vb, bf16x8 pa0, bf16x8 pa1, bf16x8 pa2, bf16x8 pa3) {
  pv_one<0>(o[0], vb, pa0, pa1, pa2, pa3); pv_one<1>(o[1], vb, pa0, pa1, pa2, pa3); pv_one<2>(o[2], vb, pa0, pa1, pa2, pa3); pv_one<3>(o[3], vb, pa0, pa1, pa2, pa3);
}
__device__ __forceinline__ void na_hook(f32x16& p0, f32x16& p1, int kr, int qr, int qc, int hi, const float* rpbh) {
  const int r0 = min(max(qr - 4, 0), 120), c0 = min(max(qc - 8, 0), 48);
  if (kr < r0 || kr >= r0 + 8) {
#pragma unroll
    for (int r = 0; r < 16; ++r) { p0[r] = -1e30f; p1[r] = -1e30f; }
  } else {
    const float* bp = rpbh + (kr - qr + 7) * 31 + 15 - qc;
#pragma unroll
    for (int r = 0; r < 16; ++r) {
      const int kc0 = crow(r, hi), kc1 = 32 + kc0;
      const bool v0 = (unsigned)(kc0 - c0) < 16u, v1 = (unsigned)(kc1 - c0) < 16u;
      const float b0 = v0 ? bp[kc0] : 0.f, b1 = v1 ? bp[kc1] : 0.f;
      p0[r] = v0 ? fmaf(b0, 1.f / SCALE, p0[r]) : -1e30f;
      p1[r] = v1 ? fmaf(b1, 1.f / SCALE, p1[r]) : -1e30f;
      if ((r & 3) == 3) SBAR();
    }
  }
}
template <int MODE, bool DIRECT>
__device__ __forceinline__ void attn_unit(const bf16_t* __restrict__ PL, int qrow0, int qcol, int kcol, int vcol, int NT, int base0, int n0, int base1,
                                          const float* rpbh, bf16_t* Obf, float* Opart, float* LSE, char* lds) {
  const int tid = otid(), wid = tid >> 6, lane = tid & 63, r32 = lane & 31, hi = lane >> 5;
  char* V_lds = lds; char* K_lds = lds + 2 * SHM_V;
  float* wsf = (float*)(lds + 2 * SHM_V + 2 * SHM_K) + wid * 64; float* li_l = wsf; float* al_l = wsf + 32;
  float m_reg = -1e30f, l_reg = 0; f32x16 o[4] = {}; bf16x8 qr[8];
  const bf16_t* Qw = PL + (size_t)(qrow0 + wid * 32 + r32) * NIN + qcol + hi * 8;
#pragma unroll
  for (int d0 = 0; d0 < 8; ++d0) qr[d0] = *reinterpret_cast<const bf16x8*>(Qw + d0 * 16);
  const int qgr = __builtin_amdgcn_readfirstlane((qrow0 + wid * 32) >> 6);
  const int sr = tid >> 4, sc = (tid & 15) * 8, vst0 = v_st(sr, sc), vst1 = v_st(32 + sr, sc);
  const int vb0 = (int)(uintptr_t)V_lds + v_rd_base(lane);
  const bf16_t* Kg = PL + (size_t)sr * NIN + kcol + sc; const bf16_t* Vg = PL + (size_t)sr * NIN + vcol + sc;
  constexpr int SD = 1;
  struct { bf16x8 vs0, vs1, ks0, ks1; } sr_[SD];
#define KROW(j) ((j) < n0 ? base0 + 64 * (j) : base1 + 64 * ((j) - n0))
#define SLOAD(i, j) do { const size_t ko_ = (size_t)KROW(j) * NIN; sr_[i].vs0 = *reinterpret_cast<const bf16x8*>(Vg + ko_); sr_[i].vs1 = *reinterpret_cast<const bf16x8*>(Vg + ko_ + (size_t)32 * NIN); \
    sr_[i].ks0 = *reinterpret_cast<const bf16x8*>(Kg + ko_); sr_[i].ks1 = *reinterpret_cast<const bf16x8*>(Kg + ko_ + (size_t)32 * NIN); } while (0)
#define SWRITE(b, i) do { *(bf16x8*)(V_lds + (b) * SHM_V + vst0) = sr_[i].vs0;          \
    *(bf16x8*)(V_lds + (b) * SHM_V + vst1) = sr_[i].vs1; int kc = sc * 2;               \
    *(bf16x8*)(K_lds + (b) * SHM_K + KSWZ(sr, kc)) = sr_[i].ks0;                       \
    *(bf16x8*)(K_lds + (b) * SHM_K + KSWZ(32 + sr, kc)) = sr_[i].ks1; } while (0)
#define SWAIT() do { if constexpr (SD == 2) asm volatile("s_waitcnt vmcnt(4)" ::: "memory"); else asm volatile("s_waitcnt vmcnt(0)" ::: "memory"); } while (0)
#define RESC(a) do { if (__any((a) < 1.f)) { if (hi == 0) al_l[r32] = (a); asm volatile("s_waitcnt lgkmcnt(0)" ::: "memory"); \
    _Pragma("unroll") for (int d = 0; d < 4; ++d) _Pragma("unroll") for (int r = 0; r < 16; ++r) o[d][r] *= al_l[crow(r, hi)]; } } while (0)
#define HOOK(P0, P1, j) do { if (MODE == 1) { if ((j) >= n0) na_hook(P0, P1, (base1 >> 6) + (j) - n0, qgr, ((wid & 1) << 5) + r32, hi, rpbh); } } while (0)
  f32x16 pA0, pA1, pB0, pB1; float mnA, mnB, alA, alB; bf16x8 pa0, pa1, pa2, pa3;
  constexpr int SE = 0, SO = SD - 1;
  SLOAD(SE, 0); asm volatile("s_waitcnt vmcnt(0)" ::: "memory"); SWRITE(0, SE); __syncthreads();
  qkt(pA0, pA1, K_lds, qr, r32, hi); HOOK(pA0, pA1, 0); partialSM(pA0, pA1, m_reg, mnA, alA);
  SLOAD(SO, 1); if constexpr (SD == 2) { if (2 < NT) SLOAD(SE, 2); }
  SWAIT(); SWRITE(1, SO); __syncthreads();
  for (int j = 1; j + 1 < NT; j += 2) {
    SBAR(); qkt(pB0, pB1, K_lds + SHM_K, qr, r32, hi); HOOK(pB0, pB1, j);
    finishSM(pA0, pA1, alA, l_reg, pa0, pa1, pa2, pa3); SBAR();
    SLOAD(SO, j + SD); SBAR();
    pv_d0(o, vb0, pa0, pa1, pa2, pa3); partialSM(pB0, pB1, m_reg, mnB, alB);
    __syncthreads(); SWAIT(); SWRITE(0, SE);
    RESC(alB); __syncthreads();
    SBAR(); qkt(pA0, pA1, K_lds, qr, r32, hi); HOOK(pA0, pA1, j + 1);
    finishSM(pB0, pB1, alB, l_reg, pa0, pa1, pa2, pa3); SBAR();
    if (SD == 1 || j + 3 < NT) SLOAD(SE, j + 1 + SD); SBAR();
    pv_d0(o, vb0 + SHM_V, pa0, pa1, pa2, pa3); partialSM(pA0, pA1, m_reg, mnA, alA);
    __syncthreads(); SWAIT(); SWRITE(1, SO);
    RESC(alA); __syncthreads();
  }
  SBAR(); qkt(pB0, pB1, K_lds + SHM_K, qr, r32, hi); HOOK(pB0, pB1, NT - 1);
  finishSM(pA0, pA1, alA, l_reg, pa0, pa1, pa2, pa3); SBAR();
  pv_d0(o, vb0, pa0, pa1, pa2, pa3); partialSM(pB0, pB1, m_reg, mnB, alB);
  __syncthreads(); RESC(alB);
  finishSM(pB0, pB1, alB, l_reg, pa0, pa1, pa2, pa3); SBAR();
  pv_d0(o, vb0 + SHM_V, pa0, pa1, pa2, pa3);
  if (hi == 0) li_l[r32] = l_reg; asm volatile("s_waitcnt lgkmcnt(0)" ::: "memory");
  float rli[16];
#pragma unroll
  for (int r = 0; r < 16; ++r) rli[r] = __builtin_amdgcn_rcpf(li_l[crow(r, hi)]);
  if (DIRECT) {
    bf16_t* Ow = Obf + (size_t)(wid * 32) * DM;
#pragma unroll
    for (int r = 0; r < 16; ++r) { const int orow = crow(r, hi);
#pragma unroll
      for (int d0 = 0; d0 < 4; ++d0) Ow[(size_t)orow * DM + d0 * 32 + r32] = (bf16_t)f2bf(o[d0][r] * rli[r]); }
  } else {
    float* Ow = Opart + (size_t)(wid * 32) * 512;
#pragma unroll
    for (int r = 0; r < 16; ++r) { const int orow = crow(r, hi);
#pragma unroll
      for (int d0 = 0; d0 < 4; ++d0) Ow[(size_t)orow * 512 + d0 * 32 + r32] = o[d0][r] * rli[r]; }
    if (hi == 0) LSE[(size_t)(wid * 32 + r32) * 4] = m_reg * (SCALE * 1.4426950408889634f) + log2f(l_reg);
  }
  __syncthreads();
#undef KROW
#undef SLOAD
#undef SWRITE
#undef SWAIT
#undef RESC
#undef HOOK
}
__device__ __forceinline__ void attn_unit_na(const bf16_t* __restrict__ PL, int qrow0, int qcol, int kcol, int vcol, int R0, const float* rpbh, bf16_t* Obf, char* lds) {
  const int tid = otid(), wid = tid >> 6, lane = tid & 63, r32 = lane & 31, hi = lane >> 5;
  constexpr int NT = 16, n0 = 4;
  char* V_lds = lds; char* K_lds = lds + 2 * SHM_V;
  float* wsf = (float*)(lds + 2 * SHM_V + 2 * SHM_K) + wid * 64; float* li_l = wsf; float* al_l = wsf + 32;
  float m_reg = -1e30f, l_reg = 0; f32x16 o[4] = {}; bf16x8 qr[8];
  const bf16_t* Qw = PL + (size_t)(qrow0 + wid * 32 + r32) * NIN + qcol + hi * 8;
#pragma unroll
  for (int d0 = 0; d0 < 8; ++d0) qr[d0] = *reinterpret_cast<const bf16x8*>(Qw + d0 * 16);
  const int qgr = (qrow0 + wid * 32) >> 6, qgc = ((wid & 1) << 5) + r32;
  const int sr = tid >> 4, sc = (tid & 15) * 8, vst0 = v_st(sr, sc), vst1 = v_st(32 + sr, sc);
  const int vb0 = (int)(uintptr_t)V_lds + v_rd_base(lane);
  const bf16_t* Kg = PL + (size_t)sr * NIN + kcol + sc; const bf16_t* Vg = PL + (size_t)sr * NIN + vcol + sc;
  bf16x8 vs0, vs1, ks0, ks1;
#define KROW(j) ((j) < n0 ? SEQ + 64 * (j) : (R0 + (j) - n0) * 64)
#define SLOAD(j) do { const size_t ko_ = (size_t)KROW(j) * NIN; vs0 = *reinterpret_cast<const bf16x8*>(Vg + ko_); vs1 = *reinterpret_cast<const bf16x8*>(Vg + ko_ + (size_t)32 * NIN); \
    ks0 = *reinterpret_cast<const bf16x8*>(Kg + ko_); ks1 = *reinterpret_cast<const bf16x8*>(Kg + ko_ + (size_t)32 * NIN); } while (0)
  SLOAD(0);
  for (int j = 0; j < NT; ++j) {
    asm volatile("s_waitcnt vmcnt(0)" ::: "memory");
    *(bf16x8*)(V_lds + vst0) = vs0; *(bf16x8*)(V_lds + vst1) = vs1;
    *(bf16x8*)(K_lds + KSWZ(sr, sc * 2)) = ks0; *(bf16x8*)(K_lds + KSWZ(32 + sr, sc * 2)) = ks1;
    __syncthreads();
    if (j + 1 < NT) SLOAD(j + 1);
    f32x16 p0, p1; float mn, al; bf16x8 pa0, pa1, pa2, pa3;
    qkt(p0, p1, K_lds, qr, r32, hi);
    if (j >= n0) na_hook(p0, p1, R0 + j - n0, qgr, qgc, hi, rpbh);
    partialSM(p0, p1, m_reg, mn, al);
    if (__any(al < 1.f)) { if (hi == 0) al_l[r32] = al; asm volatile("s_waitcnt lgkmcnt(0)" ::: "memory");
#pragma unroll
      for (int d = 0; d < 4; ++d)
#pragma unroll
        for (int r = 0; r < 16; ++r) o[d][r] *= al_l[crow(r, hi)]; }
    finishSM(p0, p1, al, l_reg, pa0, pa1, pa2, pa3); SBAR();
    pv_d0(o, vb0, pa0, pa1, pa2, pa3);
    __syncthreads();
  }
  if (hi == 0) li_l[r32] = l_reg; asm volatile("s_waitcnt lgkmcnt(0)" ::: "memory");
  bf16_t* Ow = Obf + (size_t)(wid * 32) * DM;
#pragma unroll
  for (int r = 0; r < 16; ++r) { const int orow = crow(r, hi); const float rl = __builtin_amdgcn_rcpf(li_l[orow]);
#pragma unroll
    for (int d0 = 0; d0 < 4; ++d0) Ow[(size_t)orow * DM + d0 * 32 + r32] = (bf16_t)f2bf(o[d0][r] * rl); }
  __syncthreads();
#undef KROW
#undef SLOAD
}
}

__device__ __forceinline__ void phase_small(const Args& a, unsigned char* lds, int vcu, int G, int layer, bool last) {
    const int tid = otid(), wave = tid >> 6, lane = tid & 63;
    const int gw = vcu * NWAVE + wave, NGW = G * NWAVE;
    const int nrows = last ? SEQ : MR;
    for (int row = gw; row < MR; row += NGW) qk_prep_row(a, layer, row, lane);
    for (int row = gw; row < nrows; row += NGW) dlt_row(a, row, lane);
    const int nunits = (nrows / 128) * 4;
    for (int u = G - 1 - vcu; u < nunits; u += G) cmix_unit(a, layer, u, lds);
    const bf16_t* PL = (const bf16_t*)(a.ws + WS_PL); bf16_t* OD = (bf16_t*)(a.ws + WS_OUTS) + 3 * 512;
    const float* rpb = a.in[I_RPB] + layer * 4 * 15 * 31;
    const int nu = 128 + (last ? 0 : 4);
    for (int u = vcu; u < nu; u += G) {
        if (u < 128) { const int h = u & 3, i = u >> 2, R0 = min(max(4 * i - 4, 0), 120);
            att::attn_unit_na(PL, i * 256, D_Q0 + h * HD, D_K0 + h * HD, D_V0 + h * HD, R0, rpb + h * 465, OD + (size_t)(i * 256) * DM + h * HD, (char*)lds); }
        else { const int h = u - 128;
            att::attn_unit<0, true>(PL, SEQ, D_Q0 + h * HD, D_K0 + h * HD, D_V0 + h * HD, 4, SEQ, 4, 0, nullptr, OD + (size_t)SEQ * DM + h * HD, nullptr, nullptr, (char*)lds); }
    }
}
constexpr size_t OPART_LSE = (size_t)2 * SEQ * 512 * 4;
__device__ __forceinline__ void phase_attn_a(const Args& a, unsigned char* lds, int vcu, int G, bool last) {
    const bf16_t* PL = (const bf16_t*)(a.ws + WS_PL); bf16_t* OA = (bf16_t*)(a.ws + WS_OUTS);
    float* Opart = (float*)(a.ws + WS_MRG); float* LSE = (float*)(a.ws + WS_MRG + OPART_LSE);
    const int nu = 256 + (last ? 0 : 4);
    for (int u = vcu; u < nu; u += G) {
        if (u < 256) { const int half = u >> 7, h = (u >> 5) & 3, qb = u & 31, kvh = h >> 1;
            att::attn_unit<0, false>(PL, qb * 256, A_Q0 + h * HD, A_K0 + kvh * HD, A_V0 + kvh * HD, 66, half * 4224, 66, 0, nullptr, nullptr,
                                     Opart + ((size_t)half * SEQ + qb * 256) * 512 + h * HD, LSE + ((size_t)half * SEQ + qb * 256) * 4 + h, (char*)lds); }
        else { const int h = u - 256, kvh = h >> 1;
            att::attn_unit<0, true>(PL, SEQ, A_Q0 + h * HD, A_K0 + kvh * HD, A_V0 + kvh * HD, 4, SEQ, 4, 0, nullptr, OA + (size_t)SEQ * DM + h * HD, nullptr, nullptr, (char*)lds); }
    }
}
__device__ __forceinline__ void phase_combine_a(const Args& a, int vcu, int G) {
    const int tid = otid(), wave = tid >> 6, lane = tid & 63;
    const int gw = vcu * NWAVE + wave, NGW = G * NWAVE;
    const float* Opart = (const float*)(a.ws + WS_MRG); const float* LSE = (const float*)(a.ws + WS_MRG + OPART_LSE); bf16_t* OA = (bf16_t*)(a.ws + WS_OUTS);
    for (int row = gw; row < SEQ; row += NGW) {
        const float l0 = LSE[(size_t)row * 4 + (lane >> 4)], l1 = LSE[((size_t)SEQ + row) * 4 + (lane >> 4)];
        const float mx = fmaxf(l0, l1), w0 = exp2f(l0 - mx), w1 = exp2f(l1 - mx), inv = 1.f / (w0 + w1), c0 = w0 * inv, c1 = w1 * inv;
        const float* p0 = Opart + (size_t)row * 512 + lane * 8; const float* p1 = p0 + (size_t)SEQ * 512;
        const f32x4 a0 = *(const f32x4*)p0, a1 = *(const f32x4*)(p0 + 4), b0 = *(const f32x4*)p1, b1 = *(const f32x4*)(p1 + 4);
        const f32x4 r0 = a0 * c0 + b0 * c1, r1 = a1 * c0 + b1 * c1;
        u32x4 w; w.x = pk2(r0[0], r0[1]); w.y = pk2(r0[2], r0[3]); w.z = pk2(r1[0], r1[1]); w.w = pk2(r1[2], r1[3]);
        *(u32x4*)(OA + (size_t)row * DM + lane * 8) = w;
    }
}

constexpr int NPHASE = 22;
__global__ void __launch_bounds__(NTHR, 2) fwd(Args a) {
    extern __shared__ __attribute__((aligned(16))) unsigned char lds[];
    const int G = gridDim.x, bx = blockIdx.x;
    const int vcu = (G % 8 == 0) ? (bx % 8) * (G / 8) + bx / 8 : bx;
    unsigned char* ws = a.ws;
    const float* MOD = (const float*)(ws + WS_CTL + CTL_MOD);
#if MK_COOP
    cg::grid_group grid = cg::this_grid();
#define SEAM(p) do { if (lo <= (p) && (p) + 1 < hi) grid.sync(); } while (0)
#else
#define SEAM(p) do { } while (0)
#endif
    const int lo = a.ph_lo, hi = a.ph_hi;
#ifndef PHMASK
#define PHMASK 0xffffffu
#endif
#define IN(p) (lo <= (p) && (p) < hi && ((PHMASK >> ((p) < 2 ? (p) : 2 + ((p) - 2) % 10)) & 1u))
    if (IN(0)) { phase_prologue(a, lds, vcu, G); } SEAM(0);
    if (IN(1)) { phase_rows<0>(a, vcu, G, MR, nullptr, nullptr, 0, a.in[I_NPRE_MIX], MOD, 0); } SEAM(1);
    {
        constexpr int l = 0; constexpr bool last = (l == 1); const int pb = 2 + l * 10;
        unsigned char* wb = ws + WS_W + (size_t)l * WPL;
        const float* modl = MOD + (size_t)l * 2 * NIN;
        const int Mrows = last ? SEQ : MR;
        if (IN(pb + 0)) {
            Gemm g{(const bf16_t*)(ws + WS_XN), (const bf16_t*)(wb + W_IN), DM, DM, DM}; StaticOrder S; S.init(MR, NIN, G, bx);
            EpiIn E{(bf16_t*)(ws + WS_PL)}; gemm_phase((PG8_LAS unsigned char*)lds, g, S, E);
        } SEAM(pb + 0);
        if (IN(pb + 1)) { phase_small(a, lds, vcu, G, l, last); } SEAM(pb + 1);
        if (IN(pb + 2)) { phase_attn_a(a, lds, vcu, G, last); } SEAM(pb + 2);
        if (IN(pb + 3)) {
            phase_combine_a(a, vcu, G);
            Gemm g{(const bf16_t*)(ws + WS_DLT), (const bf16_t*)(wb + W_B), 512, 512, 512}; StaticOrder S; S.init(Mrows, 512, G, bx);
            EpiScale E{(bf16_t*)(ws + WS_OUTS) + 512, DM, a.in[I_BSCALE] + l * 512}; gemm_phase((PG8_LAS unsigned char*)lds, g, S, E);
        } SEAM(pb + 3);
        if (IN(pb + 4)) {
            Gemm g{(const bf16_t*)(ws + WS_OUTS), (const bf16_t*)(wb + W_BR), DM, DM, DM}; StaticOrder S; S.init(Mrows, DM, G, bx);
            EpiMerge E{(const bf16_t*)(ws + WS_PL), (bf16_t*)(ws + WS_MRGB)}; gemm_phase((PG8_LAS unsigned char*)lds, g, S, E);
        } SEAM(pb + 4);
        if (IN(pb + 5)) {
            Gemm g{(const bf16_t*)(ws + WS_MRGB), (const bf16_t*)(wb + W_O), DM, DM, DM}; StaticOrder S; S.init(Mrows, DM, G, bx);
            EpiF32 E{(float*)(ws + WS_MRG), DM}; gemm_phase((PG8_LAS unsigned char*)lds, g, S, E);
        } SEAM(pb + 5);
        if (IN(pb + 6)) { phase_rows<1>(a, vcu, G, Mrows, a.in[I_NPOST_MIX] + l * DM, modl, 2, a.in[I_NPRE_FFN] + l * DM, modl, 3); } SEAM(pb + 6);
        if (IN(pb + 7)) {
            Gemm g{(const bf16_t*)(ws + WS_XN), (const bf16_t*)(wb + W_GU), DM, DM, DM}; StaticOrder S; S.init(Mrows, 2 * FF, G, bx);
            EpiSwiglu E{(bf16_t*)(ws + WS_H)}; gemm_phase((PG8_LAS unsigned char*)lds, g, S, E);
        } SEAM(pb + 7);
        if (IN(pb + 8)) {
            Gemm g{(const bf16_t*)(ws + WS_H), (const bf16_t*)(wb + W_D), FF, FF, FF}; StaticOrder S; S.init(Mrows, DM, G, bx);
            EpiF32 E{(float*)(ws + WS_MRG), DM}; gemm_phase((PG8_LAS unsigned char*)lds, g, S, E);
            if (bx >= 8) convert_layer(a, lds, 1, (bx - 8) * NWAVE + (otid() >> 6), (G - 8) * NWAVE);
        } SEAM(pb + 8);
        if (IN(pb + 9)) {
            if (!last) phase_rows<1>(a, vcu, G, MR, a.in[I_NPOST_FFN] + l * DM, modl, 5, a.in[I_NPRE_MIX] + (l + 1) * DM, MOD + (size_t)(l + 1) * 2 * NIN, 0);
            else phase_rows<2>(a, vcu, G, SEQ, a.in[I_NPOST_FFN] + l * DM, modl, 5, nullptr, nullptr, 0);
        }
        if (!last) SEAM(pb + 9);
        }
    {
        constexpr int l = 1; constexpr bool last = (l == 1); const int pb = 2 + l * 10;
        unsigned char* wb = ws + WS_W + (size_t)l * WPL;
        const float* modl = MOD + (size_t)l * 2 * NIN;
        const int Mrows = last ? SEQ : MR;
        if (IN(pb + 0)) {
            Gemm g{(const bf16_t*)(ws + WS_XN), (const bf16_t*)(wb + W_IN), DM, DM, DM}; StaticOrder S; S.init(MR, NIN, G, bx);
            EpiIn E{(bf16_t*)(ws + WS_PL)}; gemm_phase((PG8_LAS unsigned char*)lds, g, S, E);
        } SEAM(pb + 0);
        if (IN(pb + 1)) { phase_small(a, lds, vcu, G, l, last); } SEAM(pb + 1);
        if (IN(pb + 2)) { phase_attn_a(a, lds, vcu, G, last); } SEAM(pb + 2);
        if (IN(pb + 3)) {
            phase_combine_a(a, vcu, G);
            Gemm g{(const bf16_t*)(ws + WS_DLT), (const bf16_t*)(wb + W_B), 512, 512, 512}; StaticOrder S; S.init(Mrows, 512, G, bx);
            EpiScale E{(bf16_t*)(ws + WS_OUTS) + 512, DM, a.in[I_BSCALE] + l * 512}; gemm_phase((PG8_LAS unsigned char*)lds, g, S, E);
        } SEAM(pb + 3);
        if (IN(pb + 4)) {
            Gemm g{(const bf16_t*)(ws + WS_OUTS), (const bf16_t*)(wb + W_BR), DM, DM, DM}; StaticOrder S; S.init(Mrows, DM, G, bx);
            EpiMerge E{(const bf16_t*)(ws + WS_PL), (bf16_t*)(ws + WS_MRGB)}; gemm_phase((PG8_LAS unsigned char*)lds, g, S, E);
        } SEAM(pb + 4);
        if (IN(pb + 5)) {
            Gemm g{(const bf16_t*)(ws + WS_MRGB), (const bf16_t*)(wb + W_O), DM, DM, DM}; StaticOrder S; S.init(Mrows, DM, G, bx);
            EpiF32 E{(float*)(ws + WS_MRG), DM}; gemm_phase((PG8_LAS unsigned char*)lds, g, S, E);
        } SEAM(pb + 5);
        if (IN(pb + 6)) { phase_rows<1>(a, vcu, G, Mrows, a.in[I_NPOST_MIX] + l * DM, modl, 2, a.in[I_NPRE_FFN] + l * DM, modl, 3); } SEAM(pb + 6);
        if (IN(pb + 7)) {
            Gemm g{(const bf16_t*)(ws + WS_XN), (const bf16_t*)(wb + W_GU), DM, DM, DM}; StaticOrder S; S.init(Mrows, 2 * FF, G, bx);
            EpiSwiglu E{(bf16_t*)(ws + WS_H)}; gemm_phase((PG8_LAS unsigned char*)lds, g, S, E);
        } SEAM(pb + 7);
        if (IN(pb + 8)) {
            Gemm g{(const bf16_t*)(ws + WS_H), (const bf16_t*)(wb + W_D), FF, FF, FF}; StaticOrder S; S.init(Mrows, DM, G, bx);
            EpiF32 E{(float*)(ws + WS_MRG), DM}; gemm_phase((PG8_LAS unsigned char*)lds, g, S, E);
        } SEAM(pb + 8);
        if (IN(pb + 9)) {
            if (!last) phase_rows<1>(a, vcu, G, MR, a.in[I_NPOST_FFN] + l * DM, modl, 5, a.in[I_NPRE_MIX] + (l + 1) * DM, MOD + (size_t)(l + 1) * 2 * NIN, 0);
            else phase_rows<2>(a, vcu, G, SEQ, a.in[I_NPOST_FFN] + l * DM, modl, 5, nullptr, nullptr, 0);
        }
        if (!last) SEAM(pb + 9);
        }
#undef IN
#undef SEAM
}

extern "C" void kernel_launch(void* const* d_in, const int* in_sizes, int n_in, void* d_out, int out_size, void* d_ws, size_t ws_size, hipStream_t stream) {
    static int grid = 0;
    if (grid == 0) {
        if (n_in != N_IN || out_size != SEQ * DM || ws_size < WS_END) { fprintf(stderr, "kernel_launch: unexpected shapes (n_in %d out %d ws %zu)\n", n_in, out_size, ws_size); grid = -1; return; }
        if (hipFuncSetAttribute((const void*)fwd, hipFuncAttributeMaxDynamicSharedMemorySize, LDS_BYTES) != hipSuccess) { fprintf(stderr, "kernel_launch: hipFuncSetAttribute failed\n"); grid = -1; return; }
        int dev = 0, cus = 0, per_cu = 0;
        hipGetDevice(&dev); hipDeviceGetAttribute(&cus, hipDeviceAttributeMultiprocessorCount, dev);
        hipOccupancyMaxActiveBlocksPerMultiprocessor(&per_cu, (const void*)fwd, NTHR, LDS_BYTES);
        if (per_cu < 1) { fprintf(stderr, "kernel_launch: occupancy query says %d blocks per CU\n", per_cu); per_cu = 1; }
        (void)hipGetLastError();
        grid = cus * per_cu;
        fprintf(stderr, "kernel_launch: grid %d (cus %d x %d)\n", grid, cus, per_cu);
    }
    if (grid < 0) return;
    hipMemsetAsync((char*)d_ws + WS_CTL, 0, CTL_BYTES, stream);
    Args a{};
    for (int i = 0; i < N_IN; ++i) a.in[i] = (const float*)d_in[i];
    a.out = (float*)d_out; a.ws = (unsigned char*)d_ws;
#if MK_COOP
    a.ph_lo = 0; a.ph_hi = NPHASE;
    void* params[] = {&a};
    hipError_t e = hipLaunchCooperativeKernel((const void*)fwd, dim3(grid), dim3(NTHR), params, LDS_BYTES, stream);
    if (e != hipSuccess) fprintf(stderr, "kernel_launch: cooperative launch failed: %s (grid %d)\n", hipGetErrorString(e), grid);
#else
    for (int p = 0; p < NPHASE; ++p) {
        a.ph_lo = p; a.ph_hi = p + 1;
        hipLaunchKernelGGL(fwd, dim3(grid), dim3(NTHR), LDS_BYTES, stream, a);
    }
#endif
}
```

```cpp
#include <hip/hip_runtime.h>
#include <hip/hip_cooperative_groups.h>
#include <cstdio>
#include <cstdint>
namespace cg = cooperative_groups;

#ifndef MK_COOP
#define MK_COOP 1
#endif

typedef unsigned short bf16_t;
typedef short bf16x8 __attribute__((ext_vector_type(8)));
typedef float f32x4 __attribute__((ext_vector_type(4)));
typedef unsigned u32x4 __attribute__((ext_vector_type(4)));
typedef unsigned u32x2 __attribute__((ext_vector_type(2)));

constexpr int DM = 2048, SEQ = 8192, CTXL = 256, MR = SEQ + CTXL, NIN = 12288, FF = 5632, HD = 128, GW = 64;
constexpr int A_Q0 = 0, A_K0 = 512, A_V0 = 768, B0 = 1024, C_U0 = 1536, C_V0 = 2048, D_Q0 = 2560, D_K0 = 3072, D_V0 = 3584, G0 = 4096;
constexpr float EPS = 1e-6f;
constexpr int NTHR = 512, NWAVE = 8;
constexpr int LDS_BYTES = 147456;

enum { I_X = 0, I_C, I_CTX, I_CCTX, I_ADAW, I_ADAB, I_NPRE_MIX, I_NPOST_MIX, I_NPRE_FFN, I_NPOST_FFN, I_WIN, I_AQN, I_AKN, I_BW, I_BSCALE,
       I_CNG, I_CNB, I_CWS, I_CBS, I_RPB, I_WBR, I_WO, I_WG, I_WU, I_WD, N_IN };

constexpr size_t MiB = 1u << 20;
constexpr size_t WS_CTL = 0, CTL_BYTES = 1 * MiB;
constexpr int CW_BAR = 4096;
constexpr size_t CTL_MOD = 256 * 1024;
constexpr size_t WS_W = 2 * MiB, WPL = 131 * MiB;
constexpr size_t W_IN = 0, W_BR = 48 * MiB, W_O = 56 * MiB, W_GU = 64 * MiB, W_D = 108 * MiB, W_B = 130 * MiB;
constexpr size_t WS_X = 264 * MiB;
constexpr size_t WS_XN = 330 * MiB;
constexpr size_t WS_PL = 363 * MiB;
constexpr size_t WS_H = WS_PL;
constexpr size_t WS_OUTS = 561 * MiB;
constexpr size_t WS_DLT = 594 * MiB;
constexpr size_t WS_MRG = 603 * MiB;
constexpr size_t WS_MRGB = 669 * MiB;
constexpr size_t WS_END = 702 * MiB;

struct Args { const float* in[N_IN]; float* out; unsigned char* ws; int ph_lo, ph_hi; };

__device__ __forceinline__ unsigned f2bf(float f) { unsigned u = __builtin_bit_cast(unsigned, f); return (u + 0x7fffu + ((u >> 16) & 1u)) >> 16; }
__device__ __forceinline__ unsigned pk2(float lo, float hi) { return f2bf(lo) | (f2bf(hi) << 16); }
__device__ __forceinline__ float bflo(unsigned w) { return __builtin_bit_cast(float, w << 16); }
__device__ __forceinline__ float bfhi(unsigned w) { return __builtin_bit_cast(float, w & 0xffff0000u); }
__device__ __forceinline__ float bf2f(bf16_t h) { return __builtin_bit_cast(float, (unsigned)h << 16); }
__device__ __forceinline__ float wave_sum(float v) {
#pragma unroll
    for (int o = 32; o >= 1; o >>= 1) v += __shfl_xor(v, o);
    return v;
}
__device__ __forceinline__ int otid() { int t = threadIdx.x; asm volatile("" : "+v"(t)); return t; }
__device__ __forceinline__ float sigmoidf_(float x) { return __builtin_amdgcn_rcpf(1.f + __expf(-x)); }
__device__ __forceinline__ float siluf_(float x) { return x * __builtin_amdgcn_rcpf(1.f + __expf(-x)); }

struct Unit { int pm, pn; };
struct Gemm { const bf16_t* A; const bf16_t* Bt; int lda, ldb, K; };
constexpr int NXCD = 8, WGM = 8;
struct StaticOrder {
    int nM, nN, nwg, G, c;
    __device__ void init(int M, int N, int G_, int c_) { nM = M / 256; nN = N / 256; nwg = nM * nN; G = G_; c = c_; }
    __device__ bool next(int i, Unit& u) const {
        const long L = (long)i * G + c; if (L >= nwg) return false;
        int wgid = (int)L; { const int q = nwg / NXCD, r = nwg % NXCD, xcd = wgid % NXCD, off = wgid / NXCD; wgid = (xcd < r ? xcd * (q + 1) : r * (q + 1) + (xcd - r) * q) + off; }
        const int nig = WGM * nN, gid = wgid / nig, fm = gid * WGM, gsz = (nM - fm) < WGM ? (nM - fm) : WGM;
        u.pm = fm + ((wgid % nig) % gsz); u.pn = (wgid % nig) / gsz; return true;
    }
    __device__ __forceinline__ void a_ready(const Unit&) const {}
    __device__ __forceinline__ void done(const Unit&) const {}
};
struct MergeOrder {
    StaticOrder base;
    __device__ bool next(int i, Unit& u) const { Unit t; if (!base.next(i >> 2, t)) return false; const int pass = i & 3; u.pm = pass * 33 + t.pm; u.pn = pass * 8 + t.pn; return true; }
    __device__ __forceinline__ void a_ready(const Unit&) const {}
    __device__ __forceinline__ void done(const Unit&) const {}
};

struct EpiIn {
    static constexpr bool PERM = true, AFTER_DRAIN = false, KHOOK = false;
    bf16_t* PL;
    __device__ __forceinline__ void operator()(const f32x4 (&acc)[2][2][4][2], const Unit& u, int wr, int wc, int fr, int fq) const {
        const bool gate = u.pn >= (G0 / 256);
#pragma unroll
        for (int ai = 0; ai < 2; ++ai)
#pragma unroll
            for (int m = 0; m < 4; ++m) {
                const int row = u.pm * 256 + ai * 128 + wr * 64 + m * 16 + fr;
#pragma unroll
                for (int bj = 0; bj < 2; ++bj) {
                    const int col = u.pn * 256 + bj * 128 + wc * 32 + 8 * fq;
                    f32x4 v0 = acc[ai][bj][m][0], v1 = acc[ai][bj][m][1];
                    if (gate) {
#pragma unroll
                        for (int e = 0; e < 4; ++e) { v0[e] = sigmoidf_(v0[e]); v1[e] = sigmoidf_(v1[e]); }
                    }
                    u32x4 w; w.x = pk2(v0[0], v0[1]); w.y = pk2(v0[2], v0[3]); w.z = pk2(v1[0], v1[1]); w.w = pk2(v1[2], v1[3]);
                    *(u32x4*)(PL + (size_t)row * NIN + col) = w;
                }
            }
    }
};
struct EpiScale {
    static constexpr bool PERM = true, AFTER_DRAIN = false, KHOOK = false;
    bf16_t* O; int ldc; const float* scale;
    __device__ __forceinline__ void operator()(const f32x4 (&acc)[2][2][4][2], const Unit& u, int wr, int wc, int fr, int fq) const {
#pragma unroll
        for (int bj = 0; bj < 2; ++bj) {
            const int col = u.pn * 256 + bj * 128 + wc * 32 + 8 * fq;
            const f32x4 s0 = *(const f32x4*)(scale + col), s1 = *(const f32x4*)(scale + col + 4);
#pragma unroll
            for (int ai = 0; ai < 2; ++ai)
#pragma unroll
                for (int m = 0; m < 4; ++m) {
                    const int row = u.pm * 256 + ai * 128 + wr * 64 + m * 16 + fr;
                    const f32x4 v0 = acc[ai][bj][m][0] * s0, v1 = acc[ai][bj][m][1] * s1;
                    u32x4 w; w.x = pk2(v0[0], v0[1]); w.y = pk2(v0[2], v0[3]); w.z = pk2(v1[0], v1[1]); w.w = pk2(v1[2], v1[3]);
                    *(u32x4*)(O + (size_t)row * ldc + col) = w;
                }
        }
    }
};
struct EpiMerge {
    static constexpr bool PERM = true, AFTER_DRAIN = false, KHOOK = true;
    const bf16_t* PL; bf16_t* MRGB;
    __device__ __forceinline__ void khook(f32x4 (&acc)[2][2][4][2], const Unit& u, int s, int wr, int wc, int fr, int fq) const {
#pragma unroll
        for (int ai = 0; ai < 2; ++ai)
#pragma unroll
            for (int m = 0; m < 4; ++m) {
                const int row = u.pm * 256 + ai * 128 + wr * 64 + m * 16 + fr;
#pragma unroll
                for (int bj = 0; bj < 2; ++bj) {
                    const int col = u.pn * 256 + bj * 128 + wc * 32 + 8 * fq;
                    const bf16_t* gp = PL + (size_t)row * NIN + G0 + (s - 1) * DM + col;
                    const u32x4 ga = *(const u32x4*)gp, gb = *(const u32x4*)(gp + DM);
                    f32x4& v0 = acc[ai][bj][m][0]; f32x4& v1 = acc[ai][bj][m][1];
                    v0[0] *= bflo(ga.x) * __builtin_amdgcn_rcpf(fmaxf(bflo(gb.x), 1e-30f)); v0[1] *= bfhi(ga.x) * __builtin_amdgcn_rcpf(fmaxf(bfhi(gb.x), 1e-30f));
                    v0[2] *= bflo(ga.y) * __builtin_amdgcn_rcpf(fmaxf(bflo(gb.y), 1e-30f)); v0[3] *= bfhi(ga.y) * __builtin_amdgcn_rcpf(fmaxf(bfhi(gb.y), 1e-30f));
                    v1[0] *= bflo(ga.z) * __builtin_amdgcn_rcpf(fmaxf(bflo(gb.z), 1e-30f)); v1[1] *= bfhi(ga.z) * __builtin_amdgcn_rcpf(fmaxf(bfhi(gb.z), 1e-30f));
                    v1[2] *= bflo(ga.w) * __builtin_amdgcn_rcpf(fmaxf(bflo(gb.w), 1e-30f)); v1[3] *= bfhi(ga.w) * __builtin_amdgcn_rcpf(fmaxf(bfhi(gb.w), 1e-30f));
                }
            }
        asm volatile("s_waitcnt vmcnt(0)" ::: "memory");
    }
    __device__ __forceinline__ void operator()(const f32x4 (&acc)[2][2][4][2], const Unit& u, int wr, int wc, int fr, int fq) const {
#pragma unroll
        for (int ai = 0; ai < 2; ++ai)
#pragma unroll
            for (int m = 0; m < 4; ++m) {
                const int row = u.pm * 256 + ai * 128 + wr * 64 + m * 16 + fr;
#pragma unroll
                for (int bj = 0; bj < 2; ++bj) {
                    const int col = u.pn * 256 + bj * 128 + wc * 32 + 8 * fq;
                    const u32x4 gw = *(const u32x4*)(PL + (size_t)row * NIN + G0 + 3 * DM + col);
                    f32x4 v0 = acc[ai][bj][m][0], v1 = acc[ai][bj][m][1];
                    v0[0] *= bflo(gw.x); v0[1] *= bfhi(gw.x); v0[2] *= bflo(gw.y); v0[3] *= bfhi(gw.y);
                    v1[0] *= bflo(gw.z); v1[1] *= bfhi(gw.z); v1[2] *= bflo(gw.w); v1[3] *= bfhi(gw.w);
                    u32x4 w; w.x = pk2(v0[0], v0[1]); w.y = pk2(v0[2], v0[3]); w.z = pk2(v1[0], v1[1]); w.w = pk2(v1[2], v1[3]);
                    *(u32x4*)(MRGB + (size_t)row * DM + col) = w;
                }
            }
    }
};
struct EpiF32 {
    static constexpr bool PERM = true, AFTER_DRAIN = false, KHOOK = false;
    float* Y; int ldc;
    __device__ __forceinline__ void operator()(const f32x4 (&acc)[2][2][4][2], const Unit& u, int wr, int wc, int fr, int fq) const {
#pragma unroll
        for (int ai = 0; ai < 2; ++ai)
#pragma unroll
            for (int m = 0; m < 4; ++m) {
                const int row = u.pm * 256 + ai * 128 + wr * 64 + m * 16 + fr;
#pragma unroll
                for (int bj = 0; bj < 2; ++bj) {
                    const int col = u.pn * 256 + bj * 128 + wc * 32 + 8 * fq;
                    float* yp = Y + (size_t)row * ldc + col;
                    *(f32x4*)yp = acc[ai][bj][m][0]; *(f32x4*)(yp + 4) = acc[ai][bj][m][1];
                }
            }
    }
};
struct EpiSwiglu {
    static constexpr bool PERM = true, AFTER_DRAIN = false, KHOOK = false;
    bf16_t* H;
    __device__ __forceinline__ void operator()(const f32x4 (&acc)[2][2][4][2], const Unit& u, int wr, int wc, int fr, int fq) const {
#pragma unroll
        for (int ai = 0; ai < 2; ++ai)
#pragma unroll
            for (int m = 0; m < 4; ++m) {
                const int row = u.pm * 256 + ai * 128 + wr * 64 + m * 16 + fr;
                const int col = u.pn * 128 + wc * 32 + 8 * fq;
                f32x4 h0, h1;
#pragma unroll
                for (int e = 0; e < 4; ++e) { h0[e] = siluf_(acc[ai][0][m][0][e]) * acc[ai][1][m][0][e]; h1[e] = siluf_(acc[ai][0][m][1][e]) * acc[ai][1][m][1][e]; }
                u32x4 w; w.x = pk2(h0[0], h0[1]); w.y = pk2(h0[2], h0[3]); w.z = pk2(h1[0], h1[1]); w.w = pk2(h1[2], h1[3]);
                *(u32x4*)(H + (size_t)row * FF + col) = w;
            }
    }
};

#define PG8_LAS __attribute__((address_space(3)))
constexpr int BM = 256, BK = 64, HALF = 128, HTB = HALF * BK * 2, STAGE_BYTES = 8 * HTB;
__device__ __forceinline__ int lds_byte(int r, int c) { const int st = (r >> 4) * 2 + (c >> 5), rr = r & 15, cc = c & 31, ob = rr * 64 + cc * 2; return st * 1024 + (ob ^ (((ob >> 9) & 1) << 5)); }
__device__ __forceinline__ void stage_rc(int b, int& R, int& C) { const int st = b / 1024, sb = b % 1024, swz = sb ^ (((sb >> 9) & 1) << 5); R = (st >> 1) * 16 + swz / 64; C = (st & 1) * 32 + (swz % 64) / 2; }
__device__ __forceinline__ int perm32(int rho) { const int n = rho >> 4, i = rho & 15; return 8 * (i >> 2) + 4 * n + (i & 3); }
template <class Epi, class Sched, bool ALIGN_EPI = true, bool SP2 = true>
__device__ __forceinline__ void gemm_phase(PG8_LAS unsigned char* lds, const Gemm g, const Sched& S, const Epi& E) {
    const int tid = otid(), wid = __builtin_amdgcn_readfirstlane(tid >> 6), lane = tid & 63, wr = wid >> 2, wc = wid & 3, fr = lane & 15, fq = lane >> 4;
    const int K = g.K, nt = K / BK;
    unsigned voffA[2], voffB[2];
#pragma unroll
    for (int i = 0; i < 2; ++i) { int R, C; stage_rc(tid * 16 + i * 8192, R, C); const int Rb = Epi::PERM ? ((R & ~31) + perm32(R & 31)) : R;
        voffA[i] = (unsigned)(R * g.lda + C) * 2u; voffB[i] = (unsigned)(Rb * g.ldb + C) * 2u; }
    const size_t kstep = (size_t)(BK * 2);
    const size_t hstepA = (size_t)HALF * g.lda * 2, hstepB = (size_t)HALF * g.ldb * 2;
    const size_t tstepA = 2 * hstepA, tstepB = 2 * hstepB;
    const unsigned ldsw = (unsigned)wid * 1024u;
    const int aoff = lds_byte(wr * 64 + fr, fq * 8), boff = lds_byte(wc * 32 + fr, fq * 8);
#define PG8_SA(b, h) (((b) * 2 + (h)) * HTB)
#define PG8_SB(b, h) ((4 + (b) * 2 + (h)) * HTB)
#define PG8_STAGE(bufoff, gbase, voff) do { _Pragma("unroll") for (int _i = 0; _i < 2; ++_i) \
        __builtin_amdgcn_global_load_lds((const unsigned*)((const char*)(gbase) + (voff)[_i]), (PG8_LAS unsigned*)(lds + (bufoff) + ldsw + _i * 8192), 16, 0, 0); } while (0)
#define PG8_LDA(dst, b, h) do { _Pragma("unroll") for (int m = 0; m < 4; ++m) _Pragma("unroll") for (int k = 0; k < 2; ++k) dst[m][k] = *(const PG8_LAS bf16x8*)(lds + PG8_SA(b, h) + aoff + m * 2048 + k * 1024); } while (0)
#define PG8_LDB(dst, b, h) do { _Pragma("unroll") for (int n = 0; n < 2; ++n) _Pragma("unroll") for (int k = 0; k < 2; ++k) dst[n][k] = *(const PG8_LAS bf16x8*)(lds + PG8_SB(b, h) + boff + n * 2048 + k * 1024); } while (0)
#define PG8_MMA(ai, bj, At, Bt) do { __builtin_amdgcn_s_setprio(1); _Pragma("unroll") for (int m = 0; m < 4; ++m) _Pragma("unroll") for (int n = 0; n < 2; ++n) _Pragma("unroll") for (int k = 0; k < 2; ++k) \
        acc[ai][bj][m][n] = __builtin_amdgcn_mfma_f32_16x16x32_bf16(Bt[n][k], At[m][k], acc[ai][bj][m][n], 0, 0, 0); __builtin_amdgcn_s_setprio(0); } while (0)
#define PG8_WAIT_V(n) asm volatile("s_waitcnt vmcnt(" #n ")" ::: "memory")
#define PG8_WAIT_L(n) asm volatile("s_waitcnt lgkmcnt(" #n ")" ::: "memory")
#define PG8_BAR __builtin_amdgcn_s_barrier()
#define PG8_SCHED __builtin_amdgcn_sched_barrier(0)
    Unit cur, nxt; int ui = 0;
    if (!S.next(0, cur)) return;
    f32x4 acc[2][2][4][2];
#pragma unroll
    for (int a = 0; a < 2; ++a)
#pragma unroll
        for (int b = 0; b < 2; ++b)
#pragma unroll
            for (int m = 0; m < 4; ++m)
#pragma unroll
                for (int n = 0; n < 2; ++n) acc[a][b][m][n] = (f32x4){0.f, 0.f, 0.f, 0.f};
    bf16x8 At[4][2], B0[2][2], B1[2][2];
    const char* cA = (const char*)g.A + (size_t)cur.pm * tstepA; const char* cB = (const char*)g.Bt + (size_t)cur.pn * tstepB;
    S.a_ready(cur);
    if constexpr (SP2) {
        PG8_STAGE(PG8_SB(0, 0), cB, voffB); PG8_STAGE(PG8_SB(0, 1), cB + hstepB, voffB); PG8_STAGE(PG8_SA(0, 0), cA, voffA); PG8_STAGE(PG8_SA(0, 1), cA + hstepA, voffA);
        if (wr == 1) PG8_BAR;
        PG8_WAIT_V(2); PG8_BAR;
        PG8_STAGE(PG8_SB(1, 0), cB + kstep, voffB); PG8_STAGE(PG8_SA(1, 0), cA + kstep, voffA); PG8_STAGE(PG8_SB(1, 1), cB + hstepB + kstep, voffB);
        PG8_WAIT_V(6); PG8_BAR;
    } else {
        PG8_STAGE(PG8_SB(0, 0), cB, voffB); PG8_STAGE(PG8_SA(0, 0), cA, voffA); PG8_STAGE(PG8_SB(0, 1), cB + hstepB, voffB); PG8_STAGE(PG8_SA(0, 1), cA + hstepA, voffA);
        if (wr == 1) PG8_BAR;
        PG8_WAIT_V(4); PG8_BAR;
        PG8_STAGE(PG8_SB(1, 0), cB + kstep, voffB); PG8_STAGE(PG8_SA(1, 0), cA + kstep, voffA); PG8_STAGE(PG8_SB(1, 1), cB + hstepB + kstep, voffB);
        PG8_WAIT_V(6); PG8_BAR;
    }
    for (;;) {
        const bool has_next = S.next(ui + 1, nxt);
        const char* nA = has_next ? (const char*)g.A + (size_t)nxt.pm * tstepA : cA; const char* nB = has_next ? (const char*)g.Bt + (size_t)nxt.pn * tstepB : cB;
        for (int t = 0; t < nt; t += 2) {
            if constexpr (Epi::KHOOK) { if (t > 0 && (t & 7) == 0) E.khook(acc, cur, t >> 3, wr, wc, fr, fq); }
            const bool last = (t == nt - 2);
            const char* a1 = cA + (size_t)(t + 1) * kstep;
            const char* a2 = last ? nA : cA + (size_t)(t + 2) * kstep; const char* b2 = last ? nB : cB + (size_t)(t + 2) * kstep;
            const char* a3 = a2 + kstep; const char* b3 = b2 + kstep;
            if (last && has_next) S.a_ready(nxt);
            if constexpr (SP2) {
            PG8_LDB(B0, 0, 0); PG8_LDB(B1, 0, 1); PG8_SCHED; PG8_LDA(At, 0, 0); PG8_STAGE(PG8_SA(1, 1), a1 + hstepA, voffA);
            PG8_WAIT_V(8); PG8_WAIT_L(0); PG8_BAR; PG8_MMA(0, 0, At, B0); PG8_MMA(0, 1, At, B1); PG8_BAR; PG8_SCHED;
            PG8_LDA(At, 0, 1); PG8_STAGE(PG8_SB(0, 0), b2, voffB); PG8_STAGE(PG8_SB(0, 1), b2 + hstepB, voffB); PG8_STAGE(PG8_SA(0, 0), a2, voffA);
            PG8_WAIT_V(8); PG8_WAIT_L(0); PG8_BAR; PG8_MMA(1, 0, At, B0); PG8_MMA(1, 1, At, B1); PG8_BAR; PG8_SCHED;
            PG8_LDB(B0, 1, 0); PG8_LDB(B1, 1, 1); PG8_SCHED; PG8_LDA(At, 1, 0); PG8_STAGE(PG8_SA(0, 1), a2 + hstepA, voffA);
            PG8_WAIT_V(8); PG8_WAIT_L(0); PG8_BAR; PG8_MMA(0, 0, At, B0); PG8_MMA(0, 1, At, B1); PG8_BAR; PG8_SCHED;
            PG8_LDA(At, 1, 1); PG8_STAGE(PG8_SB(1, 0), b3, voffB); PG8_STAGE(PG8_SB(1, 1), b3 + hstepB, voffB); PG8_STAGE(PG8_SA(1, 0), a3, voffA);
            PG8_WAIT_V(8); PG8_WAIT_L(0); PG8_BAR; PG8_MMA(1, 0, At, B0); PG8_MMA(1, 1, At, B1); PG8_BAR; PG8_SCHED;
            } else {
            PG8_LDB(B0, 0, 0); PG8_SCHED; PG8_LDA(At, 0, 0); PG8_STAGE(PG8_SA(1, 1), a1 + hstepA, voffA);
            PG8_WAIT_L(8); PG8_BAR; PG8_WAIT_L(0); PG8_MMA(0, 0, At, B0); PG8_BAR; PG8_SCHED;
            PG8_LDB(B1, 0, 1); PG8_STAGE(PG8_SB(0, 0), b2, voffB);
            PG8_BAR; PG8_WAIT_L(0); PG8_MMA(0, 1, At, B1); PG8_BAR;
            PG8_LDA(At, 0, 1); PG8_STAGE(PG8_SA(0, 0), a2, voffA);
            PG8_BAR; PG8_WAIT_L(0); PG8_MMA(1, 0, At, B0); PG8_BAR; PG8_SCHED;
            PG8_STAGE(PG8_SB(0, 1), b2 + hstepB, voffB);
            PG8_WAIT_V(6); PG8_BAR; PG8_MMA(1, 1, At, B1); PG8_BAR;
            PG8_LDB(B0, 1, 0); PG8_SCHED; PG8_LDA(At, 1, 0); PG8_STAGE(PG8_SA(0, 1), a2 + hstepA, voffA);
            PG8_WAIT_L(8); PG8_BAR; PG8_WAIT_L(0); PG8_MMA(0, 0, At, B0); PG8_BAR; PG8_SCHED;
            PG8_LDB(B1, 1, 1); PG8_STAGE(PG8_SB(1, 0), b3, voffB);
            PG8_BAR; PG8_WAIT_L(0); PG8_MMA(0, 1, At, B1); PG8_BAR;
            PG8_LDA(At, 1, 1); PG8_STAGE(PG8_SA(1, 0), a3, voffA);
            PG8_BAR; PG8_WAIT_L(0); PG8_MMA(1, 0, At, B0); PG8_BAR; PG8_SCHED;
            PG8_STAGE(PG8_SB(1, 1), b3 + hstepB, voffB);
            PG8_WAIT_V(6); PG8_BAR; PG8_MMA(1, 1, At, B1); PG8_BAR;
            }
        }
        if constexpr (ALIGN_EPI) { if (wr == 0) PG8_BAR; }
        if constexpr (!Epi::AFTER_DRAIN) { E(acc, cur, wr, wc, fr, fq); S.done(cur); }
        if (!has_next) break;
#pragma unroll
        for (int a = 0; a < 2; ++a)
#pragma unroll
            for (int b = 0; b < 2; ++b)
#pragma unroll
                for (int m = 0; m < 4; ++m)
#pragma unroll
                    for (int n = 0; n < 2; ++n) acc[a][b][m][n] = (f32x4){0.f, 0.f, 0.f, 0.f};
        cur = nxt; cA = nA; cB = nB; ++ui;
        if constexpr (ALIGN_EPI) { if (wr == 1) PG8_BAR; }
    }
    PG8_WAIT_V(0);
    if constexpr (!ALIGN_EPI) { if (wr == 0) PG8_BAR; }
    PG8_BAR;
    if constexpr (Epi::AFTER_DRAIN) { E.fused(acc, cur, wr, wc, fr, fq, lds, wid, lane); S.done(cur); }
#undef PG8_SA
#undef PG8_SB
#undef PG8_STAGE
#undef PG8_LDA
#undef PG8_LDB
#undef PG8_MMA
#undef PG8_WAIT_V
#undef PG8_WAIT_L
#undef PG8_BAR
#undef PG8_SCHED
}

__device__ __forceinline__ void tr_item(const float* src, int ldn, int k0, int n0, bf16_t* dst, int dld, int drow0, int dk0, float* scr, int lane) {
    const float* sp = src + (size_t)k0 * ldn + n0 + lane;
    float t[64];
#pragma unroll
    for (int i = 0; i < 64; ++i) t[i] = __builtin_nontemporal_load(sp + (size_t)i * ldn);
#pragma unroll
    for (int i = 0; i < 64; ++i) scr[i * 65 + lane] = t[i];
    __builtin_amdgcn_s_waitcnt(0); asm volatile("" ::: "memory");
    const int c = lane & 7;
#pragma unroll
    for (int j = 0; j < 8; ++j) {
        const int n = (lane >> 3) + 8 * j; const float* s = scr + (8 * c) * 65 + n;
        u32x4 o; o.x = pk2(s[0], s[65]); o.y = pk2(s[2 * 65], s[3 * 65]); o.z = pk2(s[4 * 65], s[5 * 65]); o.w = pk2(s[6 * 65], s[7 * 65]);
        *(u32x4*)(dst + (size_t)(drow0 + n) * dld + dk0 + 8 * c) = o;
    }
    __builtin_amdgcn_s_waitcnt(0); asm volatile("" ::: "memory");
}

__device__ __forceinline__ void convert_layer(const Args& a, unsigned char* lds, int l, int widx, int nw) {
    const int tid = otid(), wave = tid >> 6, lane = tid & 63;
    float* scr = (float*)(lds + wave * 16640);
    constexpr int I_IN = 32 * 192, I_BR = 4 * 8 * 32, I_O = 32 * 32, I_G = 32 * 88, I_D = 88 * 32, I_B = 16;
    constexpr int PLI = I_IN + I_BR + I_O + 2 * I_G + I_D + I_B;
    unsigned char* wb = a.ws + WS_W + (size_t)l * WPL;
    for (int it = widx; it < PLI; it += nw) {
        int r = it;
        if (r < I_IN) { const int kb = r / 192, nb = r % 192; tr_item(a.in[I_WIN] + (size_t)l * DM * NIN, NIN, kb * 64, nb * 64, (bf16_t*)(wb + W_IN), DM, nb * 64, kb * 64, scr, lane); continue; } r -= I_IN;
        if (r < I_BR) { const int i = r >> 8, rr = r & 255, kb = rr >> 5, nb = rr & 31;
            tr_item(a.in[I_WBR] + (size_t)(l * 4 + i) * 512 * DM, DM, kb * 64, nb * 64, (bf16_t*)(wb + W_BR), DM, nb * 64, i * 512 + kb * 64, scr, lane); continue; } r -= I_BR;
        if (r < I_O) { const int kb = r >> 5, nb = r & 31; tr_item(a.in[I_WO] + (size_t)l * DM * DM, DM, kb * 64, nb * 64, (bf16_t*)(wb + W_O), DM, nb * 64, kb * 64, scr, lane); continue; } r -= I_O;
        if (r < I_G) { const int kb = r / 88, nb = r % 88, n0 = nb * 64; tr_item(a.in[I_WG] + (size_t)l * DM * FF, FF, kb * 64, n0, (bf16_t*)(wb + W_GU), DM, (n0 >> 7) * 256 + (n0 & 127), kb * 64, scr, lane); continue; } r -= I_G;
        if (r < I_G) { const int kb = r / 88, nb = r % 88, n0 = nb * 64; tr_item(a.in[I_WU] + (size_t)l * DM * FF, FF, kb * 64, n0, (bf16_t*)(wb + W_GU), DM, (n0 >> 7) * 256 + 128 + (n0 & 127), kb * 64, scr, lane); continue; } r -= I_G;
        if (r < I_D) { const int kb = r >> 5, nb = r & 31; tr_item(a.in[I_WD] + (size_t)l * FF * DM, DM, kb * 64, nb * 64, (bf16_t*)(wb + W_D), FF, nb * 64, kb * 64, scr, lane); continue; } r -= I_D;
        { const int g = r >> 2, kb = (r >> 1) & 1, nb = r & 1;
          tr_item(a.in[I_BW] + (size_t)(l * 4 + g) * 128 * 128, 128, kb * 64, nb * 64, (bf16_t*)(wb + W_B), 512, g * 128 + nb * 64, g * 128 + kb * 64, scr, lane); }
    }
}
__device__ __forceinline__ void phase_prologue(const Args& a, unsigned char* lds, int vcu, int G) {
    const int tid = otid(), wave = tid >> 6;
    convert_layer(a, lds, 0, vcu * NWAVE + wave, G * NWAVE);
    for (int i = vcu * NTHR + tid; i < 2 * 32768; i += G * NTHR) {
        const int l = i >> 15, j = i & 32767, n = j >> 6, kc = j & 63;
        if ((n >> 7) != (kc >> 4)) *(u32x4*)((bf16_t*)(a.ws + WS_W + (size_t)l * WPL + W_B) + (size_t)n * 512 + kc * 8) = (u32x4){0u, 0u, 0u, 0u};
    }
    float* MOD = (float*)(a.ws + WS_CTL + CTL_MOD);
    for (int it = vcu; it < 768; it += G) {
        const int l = it / 384, r = it % 384, cb = r >> 6, kc = r & 63;
        const int col = cb * 2048 + tid * 4;
        f32x4 al = {0.f, 0.f, 0.f, 0.f}, ac = {0.f, 0.f, 0.f, 0.f};
        const float* wp = a.in[I_ADAW] + ((size_t)l * DM + kc * 32) * NIN + col;
#pragma unroll 8
        for (int k = 0; k < 32; ++k) {
            const float sl = siluf_(a.in[I_C][kc * 32 + k]), sc = siluf_(a.in[I_CCTX][kc * 32 + k]);
            const f32x4 w = *(const f32x4*)(wp + (size_t)k * NIN);
            al += sl * w; ac += sc * w;
        }
        if (kc == 0) { const f32x4 b = *(const f32x4*)(a.in[I_ADAB] + (size_t)l * NIN + col); al += b; ac += b; }
        float* ml = MOD + (size_t)(l * 2 + 0) * NIN + col; float* mc = MOD + (size_t)(l * 2 + 1) * NIN + col;
#pragma unroll
        for (int e = 0; e < 4; ++e) { unsafeAtomicAdd(ml + e, al[e]); unsafeAtomicAdd(mc + e, ac[e]); }
    }
}

template <int MODE>
__device__ __forceinline__ void phase_rows(const Args& a, int vcu, int G, int nrows, const float* gpost, const float* modcur, int gate_idx,
                                           const float* gnext, const float* modnext, int sh_idx) {
    const int tid = otid(), wave = tid >> 6, lane = tid & 63;
    const int gw = vcu * NWAVE + wave, NGW = G * NWAVE;
    float* X = (float*)(a.ws + WS_X); const float* Y = (const float*)(a.ws + WS_MRG); bf16_t* XN = (bf16_t*)(a.ws + WS_XN);
    for (int row = gw; row < nrows; row += NGW) {
        const int isctx = row >= SEQ ? 1 : 0;
        f32x4 x[8];
        if (MODE == 0) {
            const float* src = isctx ? a.in[I_CTX] + (size_t)(row - SEQ) * DM : a.in[I_X] + (size_t)row * DM;
#pragma unroll
            for (int j = 0; j < 8; ++j) x[j] = *(const f32x4*)(src + 4 * lane + 256 * j);
        } else {
            f32x4 y[8]; float ss = 0.f;
#pragma unroll
            for (int j = 0; j < 8; ++j) { x[j] = *(const f32x4*)(X + (size_t)row * DM + 4 * lane + 256 * j); y[j] = *(const f32x4*)(Y + (size_t)row * DM + 4 * lane + 256 * j);
                ss += (y[j][0] * y[j][0] + y[j][1] * y[j][1]) + (y[j][2] * y[j][2] + y[j][3] * y[j][3]); }
            const float rstd = 1.0f / sqrtf(wave_sum(ss) * (1.f / DM) + EPS);
            const float* gate = modcur + (size_t)isctx * NIN + gate_idx * DM;
#pragma unroll
            for (int j = 0; j < 8; ++j) { const int col = 4 * lane + 256 * j; const f32x4 gp = *(const f32x4*)(gpost + col), gt = *(const f32x4*)(gate + col);
                x[j] += gt * (y[j] * rstd * gp); }
        }
        if (MODE == 2) {
#pragma unroll
            for (int j = 0; j < 8; ++j) *(f32x4*)(a.out + (size_t)row * DM + 4 * lane + 256 * j) = x[j];
            continue;
        }
        float ss = 0.f;
#pragma unroll
        for (int j = 0; j < 8; ++j) { *(f32x4*)(X + (size_t)row * DM + 4 * lane + 256 * j) = x[j];
            ss += (x[j][0] * x[j][0] + x[j][1] * x[j][1]) + (x[j][2] * x[j][2] + x[j][3] * x[j][3]); }
        const float rstd = 1.0f / sqrtf(wave_sum(ss) * (1.f / DM) + EPS);
        const float* sh = modnext + (size_t)isctx * NIN + sh_idx * DM; const float* sc = sh + DM;
#pragma unroll
        for (int j = 0; j < 8; ++j) { const int col = 4 * lane + 256 * j; const f32x4 gn = *(const f32x4*)(gnext + col), s1 = *(const f32x4*)(sc + col), s0 = *(const f32x4*)(sh + col);
            const f32x4 h = (x[j] * rstd * gn) * (1.f + s1) + s0;
            u32x2 w; w.x = pk2(h[0], h[1]); w.y = pk2(h[2], h[3]); *(u32x2*)(XN + (size_t)row * DM + col) = w; }
    }
}

__device__ __forceinline__ void qk_prep_row(const Args& a, int layer, int row, int lane) {
    bf16_t* p = (bf16_t*)(a.ws + WS_PL) + (size_t)row * NIN;
    const int ax = lane >> 5, f = lane & 31, d1 = ax * 64 + f, d2 = d1 + 32;
    float cs = 1.f, sn = 0.f;
    if (row < SEQ) { const float pos = (float)(ax == 0 ? (row >> 6) : (row & 63)); const float inv = exp2f(-(float)f * (13.287712379549449f / 32.f)); const float ang = pos * inv; cs = cosf(ang); sn = sinf(ang); }
#pragma unroll
    for (int h = 0; h < 6; ++h) {
        const float* gn = (h < 4 ? a.in[I_AQN] : a.in[I_AKN]) + layer * HD;
        bf16_t* hp = p + h * HD;
        float x1 = bf2f(hp[d1]), x2 = bf2f(hp[d2]);
        const float rstd = 1.0f / sqrtf(wave_sum(x1 * x1 + x2 * x2) * (1.f / HD) + EPS);
        x1 = x1 * rstd * gn[d1]; x2 = x2 * rstd * gn[d2];
        hp[d1] = (bf16_t)f2bf(x1 * cs - x2 * sn); hp[d2] = (bf16_t)f2bf(x2 * cs + x1 * sn);
    }
}
__device__ __forceinline__ void dlt_row(const Args& a, int row, int lane) {
    const bf16_t* PL = (const bf16_t*)(a.ws + WS_PL); bf16_t* DLT = (bf16_t*)(a.ws + WS_DLT);
    const int base = row < SEQ ? 0 : SEQ, n = row < SEQ ? SEQ : CTXL, t = row - base, half = 1 << (lane >> 4);
    const int lo = max(t - half, 0), hi = min(t + half, n);
    float s[8];
#pragma unroll
    for (int e = 0; e < 8; ++e) s[e] = 0.f;
    for (int r = lo; r < hi; ++r) { const u32x4 w = *(const u32x4*)(PL + (size_t)(base + r) * NIN + B0 + lane * 8);
        s[0] += bflo(w.x); s[1] += bfhi(w.x); s[2] += bflo(w.y); s[3] += bfhi(w.y); s[4] += bflo(w.z); s[5] += bfhi(w.z); s[6] += bflo(w.w); s[7] += bfhi(w.w); }
    const float inv = 1.f / (float)(hi - lo);
    const u32x4 w = *(const u32x4*)(PL + (size_t)row * NIN + B0 + lane * 8);
    u32x4 o; o.x = pk2(s[0] * inv - bflo(w.x), s[1] * inv - bfhi(w.x)); o.y = pk2(s[2] * inv - bflo(w.y), s[3] * inv - bfhi(w.y));
    o.z = pk2(s[4] * inv - bflo(w.z), s[5] * inv - bfhi(w.z)); o.w = pk2(s[6] * inv - bflo(w.w), s[7] * inv - bfhi(w.w));
    *(u32x4*)(DLT + (size_t)row * 512 + lane * 8) = o;
}
constexpr int CP = 136;
__device__ __forceinline__ void cmix_unit(const Args& a, int layer, int unit, unsigned char* lds) {
    const int tid = otid(), wave = tid >> 6, lane = tid & 63, chunk = unit >> 2, g = unit & 3;
    const bf16_t* PL = (const bf16_t*)(a.ws + WS_PL); bf16_t* OUT = (bf16_t*)(a.ws + WS_OUTS) + 2 * 512;
    bf16_t* vT = (bf16_t*)lds;
    bf16_t* wsL = (bf16_t*)(lds + 128 * CP * 2);
    float* st = (float*)(lds + 2 * 128 * CP * 2);
    const int t0 = chunk * 128;
    for (int i = 0; i < 16; ++i) {
        const int q = wave * 16 + i;
        const u32x4 w = *(const u32x4*)(PL + (size_t)(t0 + q) * NIN + C_V0 + lane * 8);
        float x[8] = {bflo(w.x), bfhi(w.x), bflo(w.y), bfhi(w.y), bflo(w.z), bfhi(w.z), bflo(w.w), bfhi(w.w)};
        float s = 0.f;
#pragma unroll
        for (int e = 0; e < 8; ++e) s += x[e];
        const float mean = wave_sum(s) * (1.f / 512.f); float q2 = 0.f;
#pragma unroll
        for (int e = 0; e < 8; ++e) { const float d = x[e] - mean; q2 += d * d; }
        const float rstd = 1.0f / sqrtf(wave_sum(q2) * (1.f / 512.f) + EPS);
        if (lane == 0) { st[2 * q] = mean; st[2 * q + 1] = rstd; }
    }
    __syncthreads();
    {
        const int q = tid & 127, cb = tid >> 7; const float mean = st[2 * q], rstd = st[2 * q + 1];
        const float* lg = a.in[I_CNG] + layer * 512 + g * 128 + cb * 32; const float* lb = a.in[I_CNB] + layer * 512 + g * 128 + cb * 32;
        const bf16_t* vp = PL + (size_t)(t0 + q) * NIN + C_V0 + g * 128 + cb * 32;
#pragma unroll
        for (int j = 0; j < 4; ++j) { const u32x4 w = *(const u32x4*)(vp + j * 8);
            const float x[8] = {bflo(w.x), bfhi(w.x), bflo(w.y), bfhi(w.y), bflo(w.z), bfhi(w.z), bflo(w.w), bfhi(w.w)};
#pragma unroll
            for (int e = 0; e < 8; ++e) { const int c = j * 8 + e; vT[(cb * 32 + c) * CP + q] = (bf16_t)f2bf((x[e] - mean) * rstd * lg[c] + lb[c]); } }
        const int p = tid >> 2, qb = (tid & 3) * 32; const float* wp = a.in[I_CWS] + ((size_t)(layer * 4 + g) * 128 + p) * 128 + qb;
#pragma unroll
        for (int j = 0; j < 8; ++j) { const f32x4 w = *(const f32x4*)(wp + j * 4); u32x2 o; o.x = pk2(w[0], w[1]); o.y = pk2(w[2], w[3]); *(u32x2*)(wsL + p * CP + qb + j * 4) = o; }
    }
    __syncthreads();
    {
        const int fr = lane & 15, fq = lane >> 4;
        f32x4 acc[8];
#pragma unroll
        for (int nb = 0; nb < 8; ++nb) acc[nb] = (f32x4){0.f, 0.f, 0.f, 0.f};
#pragma unroll
        for (int ks = 0; ks < 4; ++ks) {
            const bf16x8 wf = *(const bf16x8*)(wsL + (wave * 16 + fr) * CP + ks * 32 + fq * 8);
#pragma unroll
            for (int nb = 0; nb < 8; ++nb) { const bf16x8 vf = *(const bf16x8*)(vT + (nb * 16 + fr) * CP + ks * 32 + fq * 8);
                acc[nb] = __builtin_amdgcn_mfma_f32_16x16x32_bf16(vf, wf, acc[nb], 0, 0, 0); }
        }
        const int p = wave * 16 + fr; const float bs = a.in[I_CBS][(layer * 4 + g) * 128 + p];
        const bf16_t* up = PL + (size_t)(t0 + p) * NIN + C_U0 + g * 128; bf16_t* op = OUT + (size_t)(t0 + p) * DM + g * 128;
#pragma unroll
        for (int nb = 0; nb < 8; ++nb) { const int c = nb * 16 + 4 * fq; const u32x2 uw = *(const u32x2*)(up + c);
            u32x2 o; o.x = pk2((acc[nb][0] + bs) * bflo(uw.x), (acc[nb][1] + bs) * bfhi(uw.x)); o.y = pk2((acc[nb][2] + bs) * bflo(uw.y), (acc[nb][3] + bs) * bfhi(uw.y));
            *(u32x2*)(op + c) = o; }
    }
    __syncthreads();
}

template <int MODE>
__device__ __forceinline__ void attn_simple_item(const bf16_t* PL, int qcol, int kcol, int vcol, bf16_t* O, int qrow, int h, int kvh, int kbeg, int kend, const float* rpb, int lane) {
    constexpr float C = 0.088388347648318440f * 1.4426950408889634f;
    const int part = lane & 3;
    float q[32], o[32];
    { const bf16_t* qp = PL + (size_t)qrow * NIN + qcol + h * HD + part * 32;
#pragma unroll
      for (int j = 0; j < 4; ++j) { const u32x4 w = *(const u32x4*)(qp + j * 8);
          q[j * 8 + 0] = bflo(w.x) * C; q[j * 8 + 1] = bfhi(w.x) * C; q[j * 8 + 2] = bflo(w.y) * C; q[j * 8 + 3] = bfhi(w.y) * C;
          q[j * 8 + 4] = bflo(w.z) * C; q[j * 8 + 5] = bfhi(w.z) * C; q[j * 8 + 6] = bflo(w.w) * C; q[j * 8 + 7] = bfhi(w.w) * C; } }
#pragma unroll
    for (int d = 0; d < 32; ++d) o[d] = 0.f;
    float mrun = -1e30f, l = 0.f;
    const int r = qrow >> 6, c = qrow & 63, r0 = min(max(r - 4, 0), 120), c0 = min(max(c - 8, 0), 48);
    const int nk = MODE == 0 ? (kend - kbeg) : 384;
    for (int idx = 0; idx < nk; ++idx) {
        int krow; float bias = 0.f;
        if (MODE == 0) krow = kbeg + idx;
        else if (idx < 128) { const int i = idx >> 4, j = idx & 15; krow = (r0 + i) * GW + c0 + j; bias = rpb[(h * 15 + (r0 + i - r + 7)) * 31 + (c0 + j - c + 15)] * 1.4426950408889634f; }
        else krow = SEQ + idx - 128;
        const bf16_t* kp = PL + (size_t)krow * NIN + kcol + kvh * HD + part * 32;
        float s = 0.f;
#pragma unroll
        for (int j = 0; j < 4; ++j) { const u32x4 w = *(const u32x4*)(kp + j * 8);
            s += q[j * 8 + 0] * bflo(w.x) + q[j * 8 + 1] * bfhi(w.x) + q[j * 8 + 2] * bflo(w.y) + q[j * 8 + 3] * bfhi(w.y)
               + q[j * 8 + 4] * bflo(w.z) + q[j * 8 + 5] * bfhi(w.z) + q[j * 8 + 6] * bflo(w.w) + q[j * 8 + 7] * bfhi(w.w); }
        s += __shfl_xor(s, 1); s += __shfl_xor(s, 2);
        s += bias;
        const float mn = fmaxf(mrun, s), alpha = exp2f(mrun - mn), p = exp2f(s - mn);
        l = l * alpha + p; mrun = mn;
        const bf16_t* vp = PL + (size_t)krow * NIN + vcol + kvh * HD + part * 32;
#pragma unroll
        for (int j = 0; j < 4; ++j) { const u32x4 w = *(const u32x4*)(vp + j * 8);
            o[j * 8 + 0] = o[j * 8 + 0] * alpha + p * bflo(w.x); o[j * 8 + 1] = o[j * 8 + 1] * alpha + p * bfhi(w.x);
            o[j * 8 + 2] = o[j * 8 + 2] * alpha + p * bflo(w.y); o[j * 8 + 3] = o[j * 8 + 3] * alpha + p * bfhi(w.y);
            o[j * 8 + 4] = o[j * 8 + 4] * alpha + p * bflo(w.z); o[j * 8 + 5] = o[j * 8 + 5] * alpha + p * bfhi(w.z);
            o[j * 8 + 6] = o[j * 8 + 6] * alpha + p * bflo(w.w); o[j * 8 + 7] = o[j * 8 + 7] * alpha + p * bfhi(w.w); }
    }
    const float il = 1.f / l;
    bf16_t* op = O + (size_t)qrow * 512 + h * HD + part * 32;
#pragma unroll
    for (int j = 0; j < 4; ++j) { u32x4 w; w.x = pk2(o[j * 8 + 0] * il, o[j * 8 + 1] * il); w.y = pk2(o[j * 8 + 2] * il, o[j * 8 + 3] * il);
        w.z = pk2(o[j * 8 + 4] * il, o[j * 8 + 5] * il); w.w = pk2(o[j * 8 + 6] * il, o[j * 8 + 7] * il); *(u32x4*)(op + j * 8) = w; }
}


namespace att {
using s16x4 = __attribute__((ext_vector_type(4))) short;
using f32x16 = __attribute__((ext_vector_type(16))) float;
constexpr int KVBLK = 64;
constexpr float SCALE = 0.088388347648318440f, THR = 8.f;
constexpr int SHM_V = KVBLK * HD * 2, SHM_K = KVBLK * HD * 2, SHM_ATTN = 2 * SHM_V + 2 * SHM_K + NWAVE * 64 * 4;
#define KSWZ(row, colB) ((row) * 256 + ((colB) ^ (((row) & 7) << 4)))
#define SBAR() __builtin_amdgcn_sched_barrier(0)
__device__ __forceinline__ int crow(int r, int hi) { return (r & 3) + 8 * (r >> 2) + 4 * hi; }
__device__ __forceinline__ unsigned cvtpk(float lo, float hi) { unsigned r; asm volatile("v_cvt_pk_bf16_f32 %0, %1, %2" : "=v"(r) : "v"(lo), "v"(hi)); return r; }
__device__ __forceinline__ void partialSM(f32x16& p0, f32x16& p1, float& m_reg, float& mn, float& alpha) {
  constexpr float C = SCALE * 1.4426950408889634f;
  float pmax = p0[0];
#pragma unroll
  for (int r = 1; r < 16; ++r) pmax = fmaxf(pmax, p0[r]);
#pragma unroll
  for (int r = 0; r < 16; ++r) pmax = fmaxf(pmax, p1[r]);
  { auto rr = __builtin_amdgcn_permlane32_swap(__float_as_uint(pmax), __float_as_uint(pmax), false, false);
    pmax = fmaxf(__uint_as_float(rr[0]), __uint_as_float(rr[1])); }
  if (__builtin_expect(__all(pmax - m_reg <= THR / SCALE), 1)) { mn = m_reg; alpha = 1.f; }
  else { mn = fmaxf(m_reg, pmax); alpha = __builtin_amdgcn_exp2f((m_reg - mn) * C); m_reg = mn; }
  float mnC = -mn * C;
#pragma unroll
  for (int r = 0; r < 16; ++r) p0[r] = fmaf(p0[r], C, mnC);
#pragma unroll
  for (int r = 0; r < 16; ++r) p1[r] = fmaf(p1[r], C, mnC);
#pragma unroll
  for (int r = 0; r < 16; ++r) p0[r] = __builtin_amdgcn_exp2f(p0[r]);
}
__device__ __forceinline__ void finishSM(f32x16& p0, f32x16& p1, float alpha, float& l_reg, bf16x8& pa0, bf16x8& pa1, bf16x8& pa2, bf16x8& pa3) {
#pragma unroll
  for (int r = 0; r < 16; ++r) p1[r] = __builtin_amdgcn_exp2f(p1[r]);
  float ps = 0;
#pragma unroll
  for (int r = 0; r < 16; ++r) ps += p0[r];
#pragma unroll
  for (int r = 0; r < 16; ++r) ps += p1[r];
  { auto rr = __builtin_amdgcn_permlane32_swap(__float_as_uint(ps), __float_as_uint(ps), false, false);
    ps = __uint_as_float(rr[0]) + __uint_as_float(rr[1]); }
  l_reg = l_reg * alpha + ps;
#define PK4(P, BASE, OUT) do { unsigned a0 = cvtpk(P[BASE + 0], P[BASE + 1]), a1 = cvtpk(P[BASE + 2], P[BASE + 3]);   \
    unsigned b0 = cvtpk(P[BASE + 4], P[BASE + 5]), b1 = cvtpk(P[BASE + 6], P[BASE + 7]);                              \
    auto r0 = __builtin_amdgcn_permlane32_swap(a0, b0, false, false); auto r1 = __builtin_amdgcn_permlane32_swap(a1, b1, false, false); \
    u32x4 w = {r0[0], r1[0], r0[1], r1[1]}; OUT = *reinterpret_cast<bf16x8*>(&w); } while (0)
  PK4(p0, 0, pa0); PK4(p0, 8, pa1); PK4(p1, 0, pa2); PK4(p1, 8, pa3);
#undef PK4
}
__device__ __forceinline__ void qkt(f32x16& p0, f32x16& p1, const char* Ks, const bf16x8* qr, int r32, int hi) {
  p0 = f32x16{}; p1 = f32x16{};
#pragma unroll
  for (int d0 = 0; d0 < 8; ++d0) { int cb = (d0 * 16 + hi * 8) * 2;
    bf16x8 b0 = *reinterpret_cast<const bf16x8*>(Ks + KSWZ(r32, cb));
    bf16x8 b1 = *reinterpret_cast<const bf16x8*>(Ks + KSWZ(32 + r32, cb));
    p0 = __builtin_amdgcn_mfma_f32_32x32x16_bf16(b0, qr[d0], p0, 0, 0, 0);
    p1 = __builtin_amdgcn_mfma_f32_32x32x16_bf16(b1, qr[d0], p1, 0, 0, 0); }
}
__device__ __forceinline__ int v_st(int k, int c) { const int kk = (k & ~0xC) | ((k & 4) << 1) | ((k & 8) >> 1); return ((kk >> 3) * 4 + (c >> 5)) * 512 + ((kk & 7) * 32 + (c & 31)) * 2; }
__device__ __forceinline__ int v_rd_base(int lane) { return ((lane & 3) << 3) | (((lane >> 2) & 3) << 6) | (((lane >> 4) & 1) << 5) | (((lane >> 5) & 1) << 8); }
constexpr int v_rd_off(int d0, int ks, int half) { return d0 * 512 + ks * 4096 + half * 2048; }
template <int OFF> __device__ __forceinline__ s16x4 tr_read(int vb) {
  s16x4 r; asm volatile("ds_read_b64_tr_b16 %0, %1 offset:%2" : "=&v"(r) : "v"(vb), "i"(OFF) : "memory"); return r;
}
template <int D0> __device__ __forceinline__ void pv_one(f32x16& od, int vb, bf16x8 pa0, bf16x8 pa1, bf16x8 pa2, bf16x8 pa3) {
  const s16x4 l0 = tr_read<v_rd_off(D0, 0, 0)>(vb), h0 = tr_read<v_rd_off(D0, 0, 1)>(vb), l1 = tr_read<v_rd_off(D0, 1, 0)>(vb), h1 = tr_read<v_rd_off(D0, 1, 1)>(vb);
  const s16x4 l2 = tr_read<v_rd_off(D0, 2, 0)>(vb), h2 = tr_read<v_rd_off(D0, 2, 1)>(vb), l3 = tr_read<v_rd_off(D0, 3, 0)>(vb), h3 = tr_read<v_rd_off(D0, 3, 1)>(vb);
  asm volatile("s_waitcnt lgkmcnt(0)" ::: "memory"); SBAR();
#define PK(L, H) (bf16x8){L[0], L[1], L[2], L[3], H[0], H[1], H[2], H[3]}
  od = __builtin_amdgcn_mfma_f32_32x32x16_bf16(pa0, PK(l0, h0), od, 0, 0, 0);
  od = __builtin_amdgcn_mfma_f32_32x32x16_bf16(pa1, PK(l1, h1), od, 0, 0, 0);
  od = __builtin_amdgcn_mfma_f32_32x32x16_bf16(pa2, PK(l2, h2), od, 0, 0, 0);
  od = __builtin_amdgcn_mfma_f32_32x32x16_bf16(pa3, PK(l3, h3), od, 0, 0, 0);
#undef PK
}
__device__ __forceinline__ void pv_d0(f32x16* o, int vb, bf16x8 pa0, bf16x8 pa1, bf16x8 pa2, bf16x8 pa3) {
  pv_one<0>(o[0], vb, pa0, pa1, pa2, pa3); pv_one<1>(o[1], vb, pa0, pa1, pa2, pa3); pv_one<2>(o[2], vb, pa0, pa1, pa2, pa3); pv_one<3>(o[3], vb, pa0, pa1, pa2, pa3);
}
__device__ __forceinline__ void na_hook(f32x16& p0, f32x16& p1, int kr, int qr, int qc, int hi, const float* rpbh) {
  const int r0 = min(max(qr - 4, 0), 120), c0 = min(max(qc - 8, 0), 48);
  if (kr < r0 || kr >= r0 + 8) {
#pragma unroll
    for (int r = 0; r < 16; ++r) { p0[r] = -1e30f; p1[r] = -1e30f; }
  } else {
    const float* bp = rpbh + (kr - qr + 7) * 31 + 15 - qc;
#pragma unroll
    for (int r = 0; r < 16; ++r) {
      const int kc0 = crow(r, hi), kc1 = 32 + kc0;
      const bool v0 = (unsigned)(kc0 - c0) < 16u, v1 = (unsigned)(kc1 - c0) < 16u;
      const float b0 = v0 ? bp[kc0] : 0.f, b1 = v1 ? bp[kc1] : 0.f;
      p0[r] = v0 ? fmaf(b0, 1.f / SCALE, p0[r]) : -1e30f;
      p1[r] = v1 ? fmaf(b1, 1.f / SCALE, p1[r]) : -1e30f;
      if ((r & 3) == 3) SBAR();
    }
  }
}
template <int MODE, bool DIRECT>
__device__ __forceinline__ void attn_unit(const bf16_t* __restrict__ PL, int qrow0, int qcol, int kcol, int vcol, int NT, int base0, int n0, int base1,
                                          const float* rpbh, bf16_t* Obf, float* Opart, float* LSE, char* lds) {
  const int tid = otid(), wid = tid >> 6, lane = tid & 63, r32 = lane & 31, hi = lane >> 5;
  char* V_lds = lds; char* K_lds = lds + 2 * SHM_V;
  float* wsf = (float*)(lds + 2 * SHM_V + 2 * SHM_K) + wid * 64; float* li_l = wsf; float* al_l = wsf + 32;
  float m_reg = -1e30f, l_reg = 0; f32x16 o[4] = {}; bf16x8 qr[8];
  const bf16_t* Qw = PL + (size_t)(qrow0 + wid * 32 + r32) * NIN + qcol + hi * 8;
#pragma unroll
  for (int d0 = 0; d0 < 8; ++d0) qr[d0] = *reinterpret_cast<const bf16x8*>(Qw + d0 * 16);
  const int qgr = __builtin_amdgcn_readfirstlane((qrow0 + wid * 32) >> 6);
  const int sr = tid >> 4, sc = (tid & 15) * 8, vst0 = v_st(sr, sc), vst1 = v_st(32 + sr, sc);
  const int vb0 = (int)(uintptr_t)V_lds + v_rd_base(lane);
  const bf16_t* Kg = PL + (size_t)sr * NIN + kcol + sc; const bf16_t* Vg = PL + (size_t)sr * NIN + vcol + sc;
  constexpr int SD = 1;
  struct { bf16x8 vs0, vs1, ks0, ks1; } sr_[SD];
#define KROW(j) ((j) < n0 ? base0 + 64 * (j) : base1 + 64 * ((j) - n0))
#define SLOAD(i, j) do { const size_t ko_ = (size_t)KROW(j) * NIN; sr_[i].vs0 = *reinterpret_cast<const bf16x8*>(Vg + ko_); sr_[i].vs1 = *reinterpret_cast<const bf16x8*>(Vg + ko_ + (size_t)32 * NIN); \
    sr_[i].ks0 = *reinterpret_cast<const bf16x8*>(Kg + ko_); sr_[i].ks1 = *reinterpret_cast<const bf16x8*>(Kg + ko_ + (size_t)32 * NIN); } while (0)
#define SWRITE(b, i) do { *(bf16x8*)(V_lds + (b) * SHM_V + vst0) = sr_[i].vs0;          \
    *(bf16x8*)(V_lds + (b) * SHM_V + vst1) = sr_[i].vs1; int kc = sc * 2;               \
    *(bf16x8*)(K_lds + (b) * SHM_K + KSWZ(sr, kc)) = sr_[i].ks0;                       \
    *(bf16x8*)(K_lds + (b) * SHM_K + KSWZ(32 + sr, kc)) = sr_[i].ks1; } while (0)
#define SWAIT() do { if constexpr (SD == 2) asm volatile("s_waitcnt vmcnt(4)" ::: "memory"); else asm volatile("s_waitcnt vmcnt(0)" ::: "memory"); } while (0)
#define RESC(a) do { if (__any((a) < 1.f)) { if (hi == 0) al_l[r32] = (a); asm volatile("s_waitcnt lgkmcnt(0)" ::: "memory"); \
    _Pragma("unroll") for (int d = 0; d < 4; ++d) _Pragma("unroll") for (int r = 0; r < 16; ++r) o[d][r] *= al_l[crow(r, hi)]; } } while (0)
#define HOOK(P0, P1, j) do { if (MODE == 1) { if ((j) >= n0) na_hook(P0, P1, (base1 >> 6) + (j) - n0, qgr, ((wid & 1) << 5) + r32, hi, rpbh); } } while (0)
  f32x16 pA0, pA1, pB0, pB1; float mnA, mnB, alA, alB; bf16x8 pa0, pa1, pa2, pa3;
  constexpr int SE = 0, SO = SD - 1;
  SLOAD(SE, 0); asm volatile("s_waitcnt vmcnt(0)" ::: "memory"); SWRITE(0, SE); __syncthreads();
  qkt(pA0, pA1, K_lds, qr, r32, hi); HOOK(pA0, pA1, 0); partialSM(pA0, pA1, m_reg, mnA, alA);
  SLOAD(SO, 1); if constexpr (SD == 2) { if (2 < NT) SLOAD(SE, 2); }
  SWAIT(); SWRITE(1, SO); __syncthreads();
  for (int j = 1; j + 1 < NT; j += 2) {
    SBAR(); qkt(pB0, pB1, K_lds + SHM_K, qr, r32, hi); HOOK(pB0, pB1, j);
    finishSM(pA0, pA1, alA, l_reg, pa0, pa1, pa2, pa3); SBAR();
    SLOAD(SO, j + SD); SBAR();
    pv_d0(o, vb0, pa0, pa1, pa2, pa3); partialSM(pB0, pB1, m_reg, mnB, alB);
    __syncthreads(); SWAIT(); SWRITE(0, SE);
    RESC(alB); __syncthreads();
    SBAR(); qkt(pA0, pA1, K_lds, qr, r32, hi); HOOK(pA0, pA1, j + 1);
    finishSM(pB0, pB1, alB, l_reg, pa0, pa1, pa2, pa3); SBAR();
    if (SD == 1 || j + 3 < NT) SLOAD(SE, j + 1 + SD); SBAR();
    pv_d0(o, vb0 + SHM_V, pa0, pa1, pa2, pa3); partialSM(pA0, pA1, m_reg, mnA, alA);
    __syncthreads(); SWAIT(); SWRITE(1, SO);
    RESC(alA); __syncthreads();
  }
  SBAR(); qkt(pB0, pB1, K_lds + SHM_K, qr, r32, hi); HOOK(pB0, pB1, NT - 1);
  finishSM(pA0, pA1, alA, l_reg, pa0, pa1, pa2, pa3); SBAR();
  pv_d0(o, vb0, pa0, pa1, pa2, pa3); partialSM(pB0, pB1, m_reg, mnB, alB);
  __syncthreads(); RESC(alB);
  finishSM(pB0, pB1, alB, l_reg, pa0, pa1, pa2, pa3); SBAR();
  pv_d0(o, vb0 + SHM_V, pa0, pa1, pa2, pa3);
  if (hi == 0) li_l[r32] = l_reg; asm volatile("s_waitcnt lgkmcnt(0)" ::: "memory");
  float rli[16];
#pragma unroll
  for (int r = 0; r < 16; ++r) rli[r] = __builtin_amdgcn_rcpf(li_l[crow(r, hi)]);
  if (DIRECT) {
    bf16_t* Ow = Obf + (size_t)(wid * 32) * DM;
#pragma unroll
    for (int r = 0; r < 16; ++r) { const int orow = crow(r, hi);
#pragma unroll
      for (int d0 = 0; d0 < 4; ++d0) Ow[(size_t)orow * DM + d0 * 32 + r32] = (bf16_t)f2bf(o[d0][r] * rli[r]); }
  } else {
    float* Ow = Opart + (size_t)(wid * 32) * 512;
#pragma unroll
    for (int r = 0; r < 16; ++r) { const int orow = crow(r, hi);
#pragma unroll
      for (int d0 = 0; d0 < 4; ++d0) Ow[(size_t)orow * 512 + d0 * 32 + r32] = o[d0][r] * rli[r]; }
    if (hi == 0) LSE[(size_t)(wid * 32 + r32) * 4] = m_reg * (SCALE * 1.4426950408889634f) + log2f(l_reg);
  }
  __syncthreads();
#undef KROW
#undef SLOAD
#undef SWRITE
#undef SWAIT
#undef RESC
#undef HOOK
}
__device__ __forceinline__ void attn_unit_na(const bf16_t* __restrict__ PL, int qrow0, int qcol, int kcol, int vcol, int R0, const float* rpbh, bf16_t* Obf, char* lds) {
  const int tid = otid(), wid = tid >> 6, lane = tid & 63, r32 = lane & 31, hi = lane >> 5;
  constexpr int NT = 16, n0 = 4;
  char* V_lds = lds; char* K_lds = lds + 2 * SHM_V;
  float* wsf = (float*)(lds + 2 * SHM_V + 2 * SHM_K) + wid * 64; float* li_l = wsf; float* al_l = wsf + 32;
  float m_reg = -1e30f, l_reg = 0; f32x16 o[4] = {}; bf16x8 qr[8];
  const bf16_t* Qw = PL + (size_t)(qrow0 + wid * 32 + r32) * NIN + qcol + hi * 8;
#pragma unroll
  for (int d0 = 0; d0 < 8; ++d0) qr[d0] = *reinterpret_cast<const bf16x8*>(Qw + d0 * 16);
  const int qgr = (qrow0 + wid * 32) >> 6, qgc = ((wid & 1) << 5) + r32;
  const int sr = tid >> 4, sc = (tid & 15) * 8, vst0 = v_st(sr, sc), vst1 = v_st(32 + sr, sc);
  const int vb0 = (int)(uintptr_t)V_lds + v_rd_base(lane);
  const bf16_t* Kg = PL + (size_t)sr * NIN + kcol + sc; const bf16_t* Vg = PL + (size_t)sr * NIN + vcol + sc;
  bf16x8 vs0, vs1, ks0, ks1;
#define KROW(j) ((j) < n0 ? SEQ + 64 * (j) : (R0 + (j) - n0) * 64)
#define SLOAD(j) do { const size_t ko_ = (size_t)KROW(j) * NIN; vs0 = *reinterpret_cast<const bf16x8*>(Vg + ko_); vs1 = *reinterpret_cast<const bf16x8*>(Vg + ko_ + (size_t)32 * NIN); \
    ks0 = *reinterpret_cast<const bf16x8*>(Kg + ko_); ks1 = *reinterpret_cast<const bf16x8*>(Kg + ko_ + (size_t)32 * NIN); } while (0)
  SLOAD(0);
  for (int j = 0; j < NT; ++j) {
    asm volatile("s_waitcnt vmcnt(0)" ::: "memory");
    *(bf16x8*)(V_lds + vst0) = vs0; *(bf16x8*)(V_lds + vst1) = vs1;
    *(bf16x8*)(K_lds + KSWZ(sr, sc * 2)) = ks0; *(bf16x8*)(K_lds + KSWZ(32 + sr, sc * 2)) = ks1;
    __syncthreads();
    if (j + 1 < NT) SLOAD(j + 1);
    f32x16 p0, p1; float mn, al; bf16x8 pa0, pa1, pa2, pa3;
    qkt(p0, p1, K_lds, qr, r32, hi);
    if (j >= n0) na_hook(p0, p1, R0 + j - n0, qgr, qgc, hi, rpbh);
    partialSM(p0, p1, m_reg, mn, al);
    if (__any(al < 1.f)) { if (hi == 0) al_l[r32] = al; asm volatile("s_waitcnt lgkmcnt(0)" ::: "memory");
#pragma unroll
      for (int d = 0; d < 4; ++d)
#pragma unroll
        for (int r = 0; r < 16; ++r) o[d][r] *= al_l[crow(r, hi)]; }
    finishSM(p0, p1, al, l_reg, pa0, pa1, pa2, pa3); SBAR();
    pv_d0(o, vb0, pa0, pa1, pa2, pa3);
    __syncthreads();
  }
  if (hi == 0) li_l[r32] = l_reg; asm volatile("s_waitcnt lgkmcnt(0)" ::: "memory");
  bf16_t* Ow = Obf + (size_t)(wid * 32) * DM;
#pragma unroll
  for (int r = 0; r < 16; ++r) { const int orow = crow(r, hi); const float rl = __builtin_amdgcn_rcpf(li_l[orow]);
#pragma unroll
    for (int d0 = 0; d0 < 4; ++d0) Ow[(size_t)orow * DM + d0 * 32 + r32] = (bf16_t)f2bf(o[d0][r] * rl); }
  __syncthreads();
#undef KROW
#undef SLOAD
}
}

__device__ __forceinline__ void phase_small(const Args& a, unsigned char* lds, int vcu, int G, int layer, bool last) {
    const int tid = otid(), wave = tid >> 6, lane = tid & 63;
    const int gw = vcu * NWAVE + wave, NGW = G * NWAVE;
    const int nrows = last ? SEQ : MR;
    for (int row = gw; row < MR; row += NGW) qk_prep_row(a, layer, row, lane);
    for (int row = gw; row < nrows; row += NGW) dlt_row(a, row, lane);
    const int nunits = (nrows / 128) * 4;
    for (int u = G - 1 - vcu; u < nunits; u += G) cmix_unit(a, layer, u, lds);
    const bf16_t* PL = (const bf16_t*)(a.ws + WS_PL); bf16_t* OD = (bf16_t*)(a.ws + WS_OUTS) + 3 * 512;
    const float* rpb = a.in[I_RPB] + layer * 4 * 15 * 31;
    const int nu = 128 + (last ? 0 : 4);
    for (int u = vcu; u < nu; u += G) {
        if (u < 128) { const int h = u & 3, i = u >> 2, R0 = min(max(4 * i - 4, 0), 120);
            att::attn_unit_na(PL, i * 256, D_Q0 + h * HD, D_K0 + h * HD, D_V0 + h * HD, R0, rpb + h * 465, OD + (size_t)(i * 256) * DM + h * HD, (char*)lds); }
        else { const int h = u - 128;
            att::attn_unit<0, true>(PL, SEQ, D_Q0 + h * HD, D_K0 + h * HD, D_V0 + h * HD, 4, SEQ, 4, 0, nullptr, OD + (size_t)SEQ * DM + h * HD, nullptr, nullptr, (char*)lds); }
    }
}
constexpr size_t OPART_LSE = (size_t)2 * SEQ * 512 * 4;
__device__ __forceinline__ void phase_attn_a(const Args& a, unsigned char* lds, int vcu, int G, bool last) {
    const bf16_t* PL = (const bf16_t*)(a.ws + WS_PL); bf16_t* OA = (bf16_t*)(a.ws + WS_OUTS);
    float* Opart = (float*)(a.ws + WS_MRG); float* LSE = (float*)(a.ws + WS_MRG + OPART_LSE);
    const int nu = 256 + (last ? 0 : 4);
    for (int u = vcu; u < nu; u += G) {
        if (u < 256) { const int half = u >> 7, h = (u >> 5) & 3, qb = u & 31, kvh = h >> 1;
            att::attn_unit<0, false>(PL, qb * 256, A_Q0 + h * HD, A_K0 + kvh * HD, A_V0 + kvh * HD, 66, half * 4224, 66, 0, nullptr, nullptr,
                                     Opart + ((size_t)half * SEQ + qb * 256) * 512 + h * HD, LSE + ((size_t)half * SEQ + qb * 256) * 4 + h, (char*)lds); }
        else { const int h = u - 256, kvh = h >> 1;
            att::attn_unit<0, true>(PL, SEQ, A_Q0 + h * HD, A_K0 + kvh * HD, A_V0 + kvh * HD, 4, SEQ, 4, 0, nullptr, OA + (size_t)SEQ * DM + h * HD, nullptr, nullptr, (char*)lds); }
    }
}
__device__ __forceinline__ void phase_combine_a(const Args& a, int vcu, int G) {
    const int tid = otid(), wave = tid >> 6, lane = tid & 63;
    const int gw = vcu * NWAVE + wave, NGW = G * NWAVE;
    const float* Opart = (const float*)(a.ws + WS_MRG); const float* LSE = (const float*)(a.ws + WS_MRG + OPART_LSE); bf16_t* OA = (bf16_t*)(a.ws + WS_OUTS);
    for (int row = gw; row < SEQ; row += NGW) {
        const float l0 = LSE[(size_t)row * 4 + (lane >> 4)], l1 = LSE[((size_t)SEQ + row) * 4 + (lane >> 4)];
        const float mx = fmaxf(l0, l1), w0 = exp2f(l0 - mx), w1 = exp2f(l1 - mx), inv = 1.f / (w0 + w1), c0 = w0 * inv, c1 = w1 * inv;
        const float* p0 = Opart + (size_t)row * 512 + lane * 8; const float* p1 = p0 + (size_t)SEQ * 512;
        const f32x4 a0 = *(const f32x4*)p0, a1 = *(const f32x4*)(p0 + 4), b0 = *(const f32x4*)p1, b1 = *(const f32x4*)(p1 + 4);
        const f32x4 r0 = a0 * c0 + b0 * c1, r1 = a1 * c0 + b1 * c1;
        u32x4 w; w.x = pk2(r0[0], r0[1]); w.y = pk2(r0[2], r0[3]); w.z = pk2(r1[0], r1[1]); w.w = pk2(r1[2], r1[3]);
        *(u32x4*)(OA + (size_t)row * DM + lane * 8) = w;
    }
}

#define XB_TMO      128
#define XB_XCNT(j)  (256  + 64 * (j))
#define XB_XSUB(j)  (1280 + 64 * (j))
#define XB_XGEN(j)  (2304 + 64 * (j))
#define XB_TOP      3328
#define XB_TOPGEN   3392
#define XCD_BAR_WORDS 3456
#define XB_SPIN_CAP (1u << 18)

__device__ __forceinline__ unsigned xb_ld(unsigned* p)              { return __hip_atomic_load(p, __ATOMIC_RELAXED, __HIP_MEMORY_SCOPE_AGENT); }
__device__ __forceinline__ unsigned xb_add(unsigned* p, unsigned v) { return __hip_atomic_fetch_add(p, v, __ATOMIC_RELAXED, __HIP_MEMORY_SCOPE_AGENT); }
__device__ __forceinline__ unsigned xb_xcc_id() { return (unsigned)__builtin_amdgcn_s_getreg((3 << 11) | 20) & 0xFu; }
#define XB_SPIN(cond, bar) do { unsigned _sp = 0; while (cond) { __builtin_amdgcn_s_sleep(1); \
    if ((++_sp & 255u) == 0u) { if (xb_ld(&(bar)[XB_TMO])) break; if (_sp > XB_SPIN_CAP) { atomicAdd(&(bar)[XB_TMO], 1u); break; } } } } while (0)

struct XcdBarrier {
    unsigned* bar; unsigned x;
    volatile __attribute__((address_space(3))) unsigned* st;
};

__device__ __forceinline__ XcdBarrier xcd_barrier_post(unsigned* bar, volatile __attribute__((address_space(3))) unsigned* st) {
    XcdBarrier b; b.bar = bar; b.x = xb_xcc_id(); b.st = st;
    if (threadIdx.x == 0) (void)xb_add(&bar[XB_XCNT(b.x)], 1u);
    return b;
}
__device__ __forceinline__ void xcd_barrier_complete(unsigned* bar, unsigned x, unsigned& nloc, unsigned& nx) {
    const unsigned G = gridDim.x * gridDim.y * gridDim.z;
    unsigned sum, cnt, mine, sp = 0u;
    for (;;) {
        sum = 0u; cnt = 0u; mine = 0u;
#pragma unroll
        for (unsigned j = 0; j < 16; ++j) { const unsigned c = xb_ld(&bar[XB_XCNT(j)]); sum += c; cnt += (c > 0u) ? 1u : 0u; mine = (j == x) ? c : mine; }
        if (sum == G) break;
        __builtin_amdgcn_s_sleep(1);
        if ((++sp & 255u) == 0u) { if (xb_ld(&bar[XB_TMO])) break; if (sp > XB_SPIN_CAP) { atomicAdd(&bar[XB_TMO], 1u); break; } }
    }
    nloc = mine > 0u ? mine : 1u; nx = cnt > 0u ? cnt : 1u;
}

__device__ __forceinline__ void xcd_barrier(const XcdBarrier& b) {
    asm volatile("s_waitcnt vmcnt(0)" ::: "memory");
    __syncthreads();
    if (threadIdx.x == 0) {
        unsigned* bar = b.bar;
        __builtin_amdgcn_s_waitcnt(0);
        unsigned nloc = b.st[0], nx = b.st[1];
        if (nloc == 0u) { xcd_barrier_complete(bar, b.x, nloc, nx); b.st[0] = nloc; b.st[1] = nx; }
        const unsigned old = xb_add(&bar[XB_XSUB(b.x)], 1u);
        const unsigned gen = old / nloc;
        if (old + 1u == (gen + 1u) * nloc) {
            __builtin_amdgcn_fence(__ATOMIC_RELEASE, "agent");
            asm volatile("s_waitcnt vmcnt(0)" ::: "memory");
            const unsigned og = xb_add(&bar[XB_TOP], 1u);
            const unsigned tg = og / nx;
            if (og + 1u == (tg + 1u) * nx) xb_add(&bar[XB_TOPGEN], 1u);
            else XB_SPIN(xb_ld(&bar[XB_TOPGEN]) == tg, bar);
            __builtin_amdgcn_fence(__ATOMIC_ACQUIRE, "agent");
            xb_add(&bar[XB_XGEN(b.x)], 1u);
            asm volatile("s_waitcnt vmcnt(0)" ::: "memory");
        } else {
            XB_SPIN(xb_ld(&bar[XB_XGEN(b.x)]) == gen, bar);
            __builtin_amdgcn_fence(__ATOMIC_ACQUIRE, "agent");
            asm volatile("s_waitcnt vmcnt(0)" ::: "memory");
        }
    }
    __syncthreads();
}

constexpr int NPHASE = 22;
__global__ void __launch_bounds__(NTHR, 2) fwd(Args a) {
    extern __shared__ __attribute__((aligned(16))) unsigned char lds[];
    const int G = gridDim.x, bx = blockIdx.x;
    const int vcu = (G % 8 == 0) ? (bx % 8) * (G / 8) + bx / 8 : bx;
    unsigned char* ws = a.ws;
    const float* MOD = (const float*)(ws + WS_CTL + CTL_MOD);
#if MK_COOP
    cg::grid_group grid = cg::this_grid();
    volatile __attribute__((address_space(3))) unsigned* MISC = (volatile __attribute__((address_space(3))) unsigned*)((__attribute__((address_space(3))) unsigned char*)lds + (LDS_BYTES - 64));
    if (threadIdx.x < 2) MISC[threadIdx.x] = 0u;
    __syncthreads();
    const XcdBarrier xbar = xcd_barrier_post((unsigned*)(ws + WS_CTL) + CW_BAR, MISC);
#define SEAM(p) do { if (lo <= (p) && (p) + 1 < hi) { if ((p) == 0) grid.sync(); else xcd_barrier(xbar); } } while (0)
#else
#define SEAM(p) do { } while (0)
#endif
    const int lo = a.ph_lo, hi = a.ph_hi;
#ifndef PHMASK
#define PHMASK 0xffffffu
#endif
#define IN(p) (lo <= (p) && (p) < hi && ((PHMASK >> ((p) < 2 ? (p) : 2 + ((p) - 2) % 10)) & 1u))
    if (IN(0)) { phase_prologue(a, lds, vcu, G); } SEAM(0);
    if (IN(1)) { phase_rows<0>(a, vcu, G, MR, nullptr, nullptr, 0, a.in[I_NPRE_MIX], MOD, 0); } SEAM(1);
    {
        constexpr int l = 0; constexpr bool last = (l == 1); const int pb = 2 + l * 10;
        unsigned char* wb = ws + WS_W + (size_t)l * WPL;
        const float* modl = MOD + (size_t)l * 2 * NIN;
        const int Mrows = last ? SEQ : MR;
        if (IN(pb + 0)) {
            Gemm g{(const bf16_t*)(ws + WS_XN), (const bf16_t*)(wb + W_IN), DM, DM, DM}; StaticOrder S; S.init(MR, NIN, G, bx);
            EpiIn E{(bf16_t*)(ws + WS_PL)}; gemm_phase((PG8_LAS unsigned char*)lds, g, S, E);
        } SEAM(pb + 0);
        if (IN(pb + 1)) { phase_small(a, lds, vcu, G, l, last); } SEAM(pb + 1);
        if (IN(pb + 2)) { phase_attn_a(a, lds, vcu, G, last); } SEAM(pb + 2);
        if (IN(pb + 3)) {
            phase_combine_a(a, vcu, G);
            Gemm g{(const bf16_t*)(ws + WS_DLT), (const bf16_t*)(wb + W_B), 512, 512, 512}; StaticOrder S; S.init(Mrows, 512, G, bx);
            EpiScale E{(bf16_t*)(ws + WS_OUTS) + 512, DM, a.in[I_BSCALE] + l * 512}; gemm_phase((PG8_LAS unsigned char*)lds, g, S, E);
        } SEAM(pb + 3);
        if (IN(pb + 4)) {
            Gemm g{(const bf16_t*)(ws + WS_OUTS), (const bf16_t*)(wb + W_BR), DM, DM, DM}; StaticOrder S; S.init(Mrows, DM, G, bx);
            EpiMerge E{(const bf16_t*)(ws + WS_PL), (bf16_t*)(ws + WS_MRGB)}; gemm_phase((PG8_LAS unsigned char*)lds, g, S, E);
        } SEAM(pb + 4);
        if (IN(pb + 5)) {
            Gemm g{(const bf16_t*)(ws + WS_MRGB), (const bf16_t*)(wb + W_O), DM, DM, DM}; StaticOrder S; S.init(Mrows, DM, G, bx);
            EpiF32 E{(float*)(ws + WS_MRG), DM}; gemm_phase((PG8_LAS unsigned char*)lds, g, S, E);
        } SEAM(pb + 5);
        if (IN(pb + 6)) { phase_rows<1>(a, vcu, G, Mrows, a.in[I_NPOST_MIX] + l * DM, modl, 2, a.in[I_NPRE_FFN] + l * DM, modl, 3); } SEAM(pb + 6);
        if (IN(pb + 7)) {
            Gemm g{(const bf16_t*)(ws + WS_XN), (const bf16_t*)(wb + W_GU), DM, DM, DM}; StaticOrder S; S.init(Mrows, 2 * FF, G, bx);
            EpiSwiglu E{(bf16_t*)(ws + WS_H)}; gemm_phase((PG8_LAS unsigned char*)lds, g, S, E);
        } SEAM(pb + 7);
        if (IN(pb + 8)) {
            Gemm g{(const bf16_t*)(ws + WS_H), (const bf16_t*)(wb + W_D), FF, FF, FF}; StaticOrder S; S.init(Mrows, DM, G, bx);
            EpiF32 E{(float*)(ws + WS_MRG), DM}; gemm_phase((PG8_LAS unsigned char*)lds, g, S, E);
            if (bx >= 8) convert_layer(a, lds, 1, (bx - 8) * NWAVE + (otid() >> 6), (G - 8) * NWAVE);
        } SEAM(pb + 8);
        if (IN(pb + 9)) {
            if (!last) phase_rows<1>(a, vcu, G, MR, a.in[I_NPOST_FFN] + l * DM, modl, 5, a.in[I_NPRE_MIX] + (l + 1) * DM, MOD + (size_t)(l + 1) * 2 * NIN, 0);
            else phase_rows<2>(a, vcu, G, SEQ, a.in[I_NPOST_FFN] + l * DM, modl, 5, nullptr, nullptr, 0);
        }
        if (!last) SEAM(pb + 9);
        }
    {
        constexpr int l = 1; constexpr bool last = (l == 1); const int pb = 2 + l * 10;
        unsigned char* wb = ws + WS_W + (size_t)l * WPL;
        const float* modl = MOD + (size_t)l * 2 * NIN;
        const int Mrows = last ? SEQ : MR;
        if (IN(pb + 0)) {
            Gemm g{(const bf16_t*)(ws + WS_XN), (const bf16_t*)(wb + W_IN), DM, DM, DM}; StaticOrder S; S.init(MR, NIN, G, bx);
            EpiIn E{(bf16_t*)(ws + WS_PL)}; gemm_phase((PG8_LAS unsigned char*)lds, g, S, E);
        } SEAM(pb + 0);
        if (IN(pb + 1)) { phase_small(a, lds, vcu, G, l, last); } SEAM(pb + 1);
        if (IN(pb + 2)) { phase_attn_a(a, lds, vcu, G, last); } SEAM(pb + 2);
        if (IN(pb + 3)) {
            phase_combine_a(a, vcu, G);
            Gemm g{(const bf16_t*)(ws + WS_DLT), (const bf16_t*)(wb + W_B), 512, 512, 512}; StaticOrder S; S.init(Mrows, 512, G, bx);
            EpiScale E{(bf16_t*)(ws + WS_OUTS) + 512, DM, a.in[I_BSCALE] + l * 512}; gemm_phase((PG8_LAS unsigned char*)lds, g, S, E);
        } SEAM(pb + 3);
        if (IN(pb + 4)) {
            Gemm g{(const bf16_t*)(ws + WS_OUTS), (const bf16_t*)(wb + W_BR), DM, DM, DM}; StaticOrder S; S.init(Mrows, DM, G, bx);
            EpiMerge E{(const bf16_t*)(ws + WS_PL), (bf16_t*)(ws + WS_MRGB)}; gemm_phase((PG8_LAS unsigned char*)lds, g, S, E);
        } SEAM(pb + 4);
        if (IN(pb + 5)) {
            Gemm g{(const bf16_t*)(ws + WS_MRGB), (const bf16_t*)(wb + W_O), DM, DM, DM}; StaticOrder S; S.init(Mrows, DM, G, bx);
            EpiF32 E{(float*)(ws + WS_MRG), DM}; gemm_phase((PG8_LAS unsigned char*)lds, g, S, E);
        } SEAM(pb + 5);
        if (IN(pb + 6)) { phase_rows<1>(a, vcu, G, Mrows, a.in[I_NPOST_MIX] + l * DM, modl, 2, a.in[I_NPRE_FFN] + l * DM, modl, 3); } SEAM(pb + 6);
        if (IN(pb + 7)) {
            Gemm g{(const bf16_t*)(ws + WS_XN), (const bf16_t*)(wb + W_GU), DM, DM, DM}; StaticOrder S; S.init(Mrows, 2 * FF, G, bx);
            EpiSwiglu E{(bf16_t*)(ws + WS_H)}; gemm_phase((PG8_LAS unsigned char*)lds, g, S, E);
        } SEAM(pb + 7);
        if (IN(pb + 8)) {
            Gemm g{(const bf16_t*)(ws + WS_H), (const bf16_t*)(wb + W_D), FF, FF, FF}; StaticOrder S; S.init(Mrows, DM, G, bx);
            EpiF32 E{(float*)(ws + WS_MRG), DM}; gemm_phase((PG8_LAS unsigned char*)lds, g, S, E);
        } SEAM(pb + 8);
        if (IN(pb + 9)) {
            if (!last) phase_rows<1>(a, vcu, G, MR, a.in[I_NPOST_FFN] + l * DM, modl, 5, a.in[I_NPRE_MIX] + (l + 1) * DM, MOD + (size_t)(l + 1) * 2 * NIN, 0);
            else phase_rows<2>(a, vcu, G, SEQ, a.in[I_NPOST_FFN] + l * DM, modl, 5, nullptr, nullptr, 0);
        }
        if (!last) SEAM(pb + 9);
        }
#undef IN
#undef SEAM
}

extern "C" void kernel_launch(void* const* d_in, const int* in_sizes, int n_in, void* d_out, int out_size, void* d_ws, size_t ws_size, hipStream_t stream) {
    static int grid = 0;
    if (grid == 0) {
        if (n_in != N_IN || out_size != SEQ * DM || ws_size < WS_END) { fprintf(stderr, "kernel_launch: unexpected shapes (n_in %d out %d ws %zu)\n", n_in, out_size, ws_size); grid = -1; return; }
        if (hipFuncSetAttribute((const void*)fwd, hipFuncAttributeMaxDynamicSharedMemorySize, LDS_BYTES) != hipSuccess) { fprintf(stderr, "kernel_launch: hipFuncSetAttribute failed\n"); grid = -1; return; }
        int dev = 0, cus = 0, per_cu = 0;
        hipGetDevice(&dev); hipDeviceGetAttribute(&cus, hipDeviceAttributeMultiprocessorCount, dev);
        hipOccupancyMaxActiveBlocksPerMultiprocessor(&per_cu, (const void*)fwd, NTHR, LDS_BYTES);
        if (per_cu < 1) { fprintf(stderr, "kernel_launch: occupancy query says %d blocks per CU\n", per_cu); per_cu = 1; }
        (void)hipGetLastError();
        grid = cus * per_cu;
        fprintf(stderr, "kernel_launch: grid %d (cus %d x %d)\n", grid, cus, per_cu);
    }
    if (grid < 0) return;
    hipMemsetAsync((char*)d_ws + WS_CTL, 0, CTL_BYTES, stream);
    Args a{};
    for (int i = 0; i < N_IN; ++i) a.in[i] = (const float*)d_in[i];
    a.out = (float*)d_out; a.ws = (unsigned char*)d_ws;
#if MK_COOP
    a.ph_lo = 0; a.ph_hi = NPHASE;
    void* params[] = {&a};
    hipError_t e = hipLaunchCooperativeKernel((const void*)fwd, dim3(grid), dim3(NTHR), params, LDS_BYTES, stream);
    if (e != hipSuccess) fprintf(stderr, "kernel_launch: cooperative launch failed: %s (grid %d)\n", hipGetErrorString(e), grid);
#else
    for (int p = 0; p < NPHASE; ++p) {
        a.ph_lo = p; a.ph_hi = p + 1;
        hipLaunchKernelGGL(fwd, dim3(grid), dim3(NTHR), LDS_BYTES, stream, a);
    }
#endif
}
```

```cpp
#include <hip/hip_runtime.h>
#include <hip/hip_cooperative_groups.h>
#include <cstdio>
#include <cstdint>
namespace cg = cooperative_groups;

#ifndef MK_COOP
#define MK_COOP 1
#endif

typedef unsigned short bf16_t;
typedef short bf16x8 __attribute__((ext_vector_type(8)));
typedef float f32x4 __attribute__((ext_vector_type(4)));
typedef unsigned u32x4 __attribute__((ext_vector_type(4)));
typedef unsigned u32x2 __attribute__((ext_vector_type(2)));

constexpr int DM = 2048, SEQ = 8192, CTXL = 256, MR = SEQ + CTXL, NIN = 12288, FF = 5632, HD = 128, GW = 64;
constexpr int A_Q0 = 0, A_K0 = 512, A_V0 = 768, B0 = 1024, C_U0 = 1536, C_V0 = 2048, D_Q0 = 2560, D_K0 = 3072, D_V0 = 3584, G0 = 4096;
constexpr float EPS = 1e-6f;
constexpr int NTHR = 512, NWAVE = 8;
constexpr int LDS_BYTES = 147456;

enum { I_X = 0, I_C, I_CTX, I_CCTX, I_ADAW, I_ADAB, I_NPRE_MIX, I_NPOST_MIX, I_NPRE_FFN, I_NPOST_FFN, I_WIN, I_AQN, I_AKN, I_BW, I_BSCALE,
       I_CNG, I_CNB, I_CWS, I_CBS, I_RPB, I_WBR, I_WO, I_WG, I_WU, I_WD, N_IN };

constexpr size_t MiB = 1u << 20;
constexpr size_t WS_CTL = 0, CTL_BYTES = 1 * MiB;
constexpr int CW_BAR = 4096;
constexpr size_t CTL_MOD = 256 * 1024;
constexpr size_t WS_W = 2 * MiB, WPL = 131 * MiB;
constexpr size_t W_IN = 0, W_BR = 48 * MiB, W_O = 56 * MiB, W_GU = 64 * MiB, W_D = 108 * MiB, W_B = 130 * MiB;
constexpr size_t WS_X = 264 * MiB;
constexpr size_t WS_XN = 330 * MiB;
constexpr size_t WS_PL = 363 * MiB;
constexpr size_t WS_H = WS_PL;
constexpr size_t WS_OUTS = 561 * MiB;
constexpr size_t WS_DLT = 594 * MiB;
constexpr size_t WS_MRG = 603 * MiB;
constexpr size_t WS_MRGB = 669 * MiB;
constexpr size_t WS_END = 702 * MiB;

struct Args { const float* in[N_IN]; float* out; unsigned char* ws; int ph_lo, ph_hi; };

__device__ __forceinline__ unsigned f2bf(float f) { unsigned u = __builtin_bit_cast(unsigned, f); return (u + 0x7fffu + ((u >> 16) & 1u)) >> 16; }
__device__ __forceinline__ unsigned pk2(float lo, float hi) { return f2bf(lo) | (f2bf(hi) << 16); }
__device__ __forceinline__ float bflo(unsigned w) { return __builtin_bit_cast(float, w << 16); }
__device__ __forceinline__ float bfhi(unsigned w) { return __builtin_bit_cast(float, w & 0xffff0000u); }
__device__ __forceinline__ float bf2f(bf16_t h) { return __builtin_bit_cast(float, (unsigned)h << 16); }
__device__ __forceinline__ float wave_sum(float v) {
#pragma unroll
    for (int o = 32; o >= 1; o >>= 1) v += __shfl_xor(v, o);
    return v;
}
__device__ __forceinline__ int otid() { int t = threadIdx.x; asm volatile("" : "+v"(t)); return t; }
__device__ __forceinline__ float sigmoidf_(float x) { return __builtin_amdgcn_rcpf(1.f + __expf(-x)); }
__device__ __forceinline__ float siluf_(float x) { return x * __builtin_amdgcn_rcpf(1.f + __expf(-x)); }

struct Unit { int pm, pn; };
struct Gemm { const bf16_t* A; const bf16_t* Bt; int lda, ldb, K; };
constexpr int NXCD = 8, WGM = 8;
struct StaticOrder {
    int nM, nN, nwg, G, c;
    __device__ void init(int M, int N, int G_, int c_) { nM = M / 256; nN = N / 256; nwg = nM * nN; G = G_; c = c_; }
    __device__ bool next(int i, Unit& u) const {
        const long L = (long)i * G + c; if (L >= nwg) return false;
        int wgid = (int)L; { const int q = nwg / NXCD, r = nwg % NXCD, xcd = wgid % NXCD, off = wgid / NXCD; wgid = (xcd < r ? xcd * (q + 1) : r * (q + 1) + (xcd - r) * q) + off; }
        const int nig = WGM * nN, gid = wgid / nig, fm = gid * WGM, gsz = (nM - fm) < WGM ? (nM - fm) : WGM;
        u.pm = fm + ((wgid % nig) % gsz); u.pn = (wgid % nig) / gsz; return true;
    }
    __device__ __forceinline__ void a_ready(const Unit&) const {}
    __device__ __forceinline__ void done(const Unit&) const {}
};
struct MergeOrder {
    StaticOrder base;
    __device__ bool next(int i, Unit& u) const { Unit t; if (!base.next(i >> 2, t)) return false; const int pass = i & 3; u.pm = pass * 33 + t.pm; u.pn = pass * 8 + t.pn; return true; }
    __device__ __forceinline__ void a_ready(const Unit&) const {}
    __device__ __forceinline__ void done(const Unit&) const {}
};

struct EpiIn {
    static constexpr bool PERM = true, AFTER_DRAIN = false, KHOOK = false;
    bf16_t* PL;
    __device__ __forceinline__ void operator()(const f32x4 (&acc)[2][2][4][2], const Unit& u, int wr, int wc, int fr, int fq) const {
        const bool gate = u.pn >= (G0 / 256);
#pragma unroll
        for (int ai = 0; ai < 2; ++ai)
#pragma unroll
            for (int m = 0; m < 4; ++m) {
                const int row = u.pm * 256 + ai * 128 + wr * 64 + m * 16 + fr;
#pragma unroll
                for (int bj = 0; bj < 2; ++bj) {
                    const int col = u.pn * 256 + bj * 128 + wc * 32 + 8 * fq;
                    f32x4 v0 = acc[ai][bj][m][0], v1 = acc[ai][bj][m][1];
                    if (gate) {
#pragma unroll
                        for (int e = 0; e < 4; ++e) { v0[e] = sigmoidf_(v0[e]); v1[e] = sigmoidf_(v1[e]); }
                    }
                    u32x4 w; w.x = pk2(v0[0], v0[1]); w.y = pk2(v0[2], v0[3]); w.z = pk2(v1[0], v1[1]); w.w = pk2(v1[2], v1[3]);
                    *(u32x4*)(PL + (size_t)row * NIN + col) = w;
                }
            }
    }
};
struct EpiScale {
    static constexpr bool PERM = true, AFTER_DRAIN = false, KHOOK = false;
    bf16_t* O; int ldc; const float* scale;
    __device__ __forceinline__ void operator()(const f32x4 (&acc)[2][2][4][2], const Unit& u, int wr, int wc, int fr, int fq) const {
#pragma unroll
        for (int bj = 0; bj < 2; ++bj) {
            const int col = u.pn * 256 + bj * 128 + wc * 32 + 8 * fq;
            const f32x4 s0 = *(const f32x4*)(scale + col), s1 = *(const f32x4*)(scale + col + 4);
#pragma unroll
            for (int ai = 0; ai < 2; ++ai)
#pragma unroll
                for (int m = 0; m < 4; ++m) {
                    const int row = u.pm * 256 + ai * 128 + wr * 64 + m * 16 + fr;
                    const f32x4 v0 = acc[ai][bj][m][0] * s0, v1 = acc[ai][bj][m][1] * s1;
                    u32x4 w; w.x = pk2(v0[0], v0[1]); w.y = pk2(v0[2], v0[3]); w.z = pk2(v1[0], v1[1]); w.w = pk2(v1[2], v1[3]);
                    *(u32x4*)(O + (size_t)row * ldc + col) = w;
                }
        }
    }
};
struct EpiMerge {
    static constexpr bool PERM = true, AFTER_DRAIN = false, KHOOK = true;
    const bf16_t* PL; bf16_t* MRGB;
    __device__ __forceinline__ void khook(f32x4 (&acc)[2][2][4][2], const Unit& u, int s, int wr, int wc, int fr, int fq) const {
#pragma unroll
        for (int ai = 0; ai < 2; ++ai)
#pragma unroll
            for (int mh = 0; mh < 2; ++mh) {
                size_t off = ((size_t)(u.pm * 256 + ai * 128 + wr * 64 + mh * 32 + fr) * NIN + G0 + (s - 1) * DM + u.pn * 256 + wc * 32 + 8 * fq) * 2;
                asm volatile("" : "+v"(off));
                const char* gp = (const char*)PL + off;
                u32x4 ga[2][2], gb[2][2];
#pragma unroll
                for (int mm = 0; mm < 2; ++mm)
#pragma unroll
                    for (int bj = 0; bj < 2; ++bj) { const char* p = gp + (size_t)mm * 16 * NIN * 2 + bj * 256; ga[mm][bj] = *(const u32x4*)p; gb[mm][bj] = *(const u32x4*)(p + DM * 2); }
                __builtin_amdgcn_sched_barrier(0);
#pragma unroll
                for (int mm = 0; mm < 2; ++mm)
#pragma unroll
                    for (int bj = 0; bj < 2; ++bj) {
                        const u32x4 a_ = ga[mm][bj], b_ = gb[mm][bj];
                        f32x4& v0 = acc[ai][bj][mh * 2 + mm][0]; f32x4& v1 = acc[ai][bj][mh * 2 + mm][1];
                        v0[0] *= bflo(a_.x) * __builtin_amdgcn_rcpf(fmaxf(bflo(b_.x), 1e-30f)); v0[1] *= bfhi(a_.x) * __builtin_amdgcn_rcpf(fmaxf(bfhi(b_.x), 1e-30f));
                        v0[2] *= bflo(a_.y) * __builtin_amdgcn_rcpf(fmaxf(bflo(b_.y), 1e-30f)); v0[3] *= bfhi(a_.y) * __builtin_amdgcn_rcpf(fmaxf(bfhi(b_.y), 1e-30f));
                        v1[0] *= bflo(a_.z) * __builtin_amdgcn_rcpf(fmaxf(bflo(b_.z), 1e-30f)); v1[1] *= bfhi(a_.z) * __builtin_amdgcn_rcpf(fmaxf(bfhi(b_.z), 1e-30f));
                        v1[2] *= bflo(a_.w) * __builtin_amdgcn_rcpf(fmaxf(bflo(b_.w), 1e-30f)); v1[3] *= bfhi(a_.w) * __builtin_amdgcn_rcpf(fmaxf(bfhi(b_.w), 1e-30f));
                    }
                __builtin_amdgcn_sched_barrier(0);
            }
        asm volatile("s_waitcnt vmcnt(0)" ::: "memory");
    }
    __device__ __forceinline__ void operator()(const f32x4 (&acc)[2][2][4][2], const Unit& u, int wr, int wc, int fr, int fq) const {
#pragma unroll
        for (int ai = 0; ai < 2; ++ai)
#pragma unroll
            for (int m = 0; m < 4; ++m) {
                const int row = u.pm * 256 + ai * 128 + wr * 64 + m * 16 + fr;
#pragma unroll
                for (int bj = 0; bj < 2; ++bj) {
                    const int col = u.pn * 256 + bj * 128 + wc * 32 + 8 * fq;
                    const u32x4 gw = *(const u32x4*)(PL + (size_t)row * NIN + G0 + 3 * DM + col);
                    f32x4 v0 = acc[ai][bj][m][0], v1 = acc[ai][bj][m][1];
                    v0[0] *= bflo(gw.x); v0[1] *= bfhi(gw.x); v0[2] *= bflo(gw.y); v0[3] *= bfhi(gw.y);
                    v1[0] *= bflo(gw.z); v1[1] *= bfhi(gw.z); v1[2] *= bflo(gw.w); v1[3] *= bfhi(gw.w);
                    u32x4 w; w.x = pk2(v0[0], v0[1]); w.y = pk2(v0[2], v0[3]); w.z = pk2(v1[0], v1[1]); w.w = pk2(v1[2], v1[3]);
                    *(u32x4*)(MRGB + (size_t)row * DM + col) = w;
                }
            }
    }
};
struct EpiF32 {
    static constexpr bool PERM = true, AFTER_DRAIN = false, KHOOK = false;
    float* Y; int ldc;
    __device__ __forceinline__ void operator()(const f32x4 (&acc)[2][2][4][2], const Unit& u, int wr, int wc, int fr, int fq) const {
#pragma unroll
        for (int ai = 0; ai < 2; ++ai)
#pragma unroll
            for (int m = 0; m < 4; ++m) {
                const int row = u.pm * 256 + ai * 128 + wr * 64 + m * 16 + fr;
#pragma unroll
                for (int bj = 0; bj < 2; ++bj) {
                    const int col = u.pn * 256 + bj * 128 + wc * 32 + 8 * fq;
                    float* yp = Y + (size_t)row * ldc + col;
                    *(f32x4*)yp = acc[ai][bj][m][0]; *(f32x4*)(yp + 4) = acc[ai][bj][m][1];
                }
            }
    }
};
struct EpiSwiglu {
    static constexpr bool PERM = true, AFTER_DRAIN = false, KHOOK = false;
    bf16_t* H;
    __device__ __forceinline__ void operator()(const f32x4 (&acc)[2][2][4][2], const Unit& u, int wr, int wc, int fr, int fq) const {
#pragma unroll
        for (int ai = 0; ai < 2; ++ai)
#pragma unroll
            for (int m = 0; m < 4; ++m) {
                const int row = u.pm * 256 + ai * 128 + wr * 64 + m * 16 + fr;
                const int col = u.pn * 128 + wc * 32 + 8 * fq;
                f32x4 h0, h1;
#pragma unroll
                for (int e = 0; e < 4; ++e) { h0[e] = siluf_(acc[ai][0][m][0][e]) * acc[ai][1][m][0][e]; h1[e] = siluf_(acc[ai][0][m][1][e]) * acc[ai][1][m][1][e]; }
                u32x4 w; w.x = pk2(h0[0], h0[1]); w.y = pk2(h0[2], h0[3]); w.z = pk2(h1[0], h1[1]); w.w = pk2(h1[2], h1[3]);
                *(u32x4*)(H + (size_t)row * FF + col) = w;
            }
    }
};

#define PG8_LAS __attribute__((address_space(3)))
constexpr int BM = 256, BK = 64, HALF = 128, HTB = HALF * BK * 2, STAGE_BYTES = 8 * HTB;
__device__ __forceinline__ int lds_byte(int r, int c) { const int st = (r >> 4) * 2 + (c >> 5), rr = r & 15, cc = c & 31, ob = rr * 64 + cc * 2; return st * 1024 + (ob ^ (((ob >> 9) & 1) << 5)); }
__device__ __forceinline__ void stage_rc(int b, int& R, int& C) { const int st = b / 1024, sb = b % 1024, swz = sb ^ (((sb >> 9) & 1) << 5); R = (st >> 1) * 16 + swz / 64; C = (st & 1) * 32 + (swz % 64) / 2; }
__device__ __forceinline__ int perm32(int rho) { const int n = rho >> 4, i = rho & 15; return 8 * (i >> 2) + 4 * n + (i & 3); }
template <class Epi, class Sched, bool ALIGN_EPI = true, bool SP2 = true>
__device__ __forceinline__ void gemm_phase(PG8_LAS unsigned char* lds, const Gemm g, const Sched& S, const Epi& E) {
    const int tid = otid(), wid = __builtin_amdgcn_readfirstlane(tid >> 6), lane = tid & 63, wr = wid >> 2, wc = wid & 3, fr = lane & 15, fq = lane >> 4;
    const int K = g.K, nt = K / BK;
    unsigned voffA[2], voffB[2];
#pragma unroll
    for (int i = 0; i < 2; ++i) { int R, C; stage_rc(tid * 16 + i * 8192, R, C); const int Rb = Epi::PERM ? ((R & ~31) + perm32(R & 31)) : R;
        voffA[i] = (unsigned)(R * g.lda + C) * 2u; voffB[i] = (unsigned)(Rb * g.ldb + C) * 2u; }
    const size_t kstep = (size_t)(BK * 2);
    const size_t hstepA = (size_t)HALF * g.lda * 2, hstepB = (size_t)HALF * g.ldb * 2;
    const size_t tstepA = 2 * hstepA, tstepB = 2 * hstepB;
    const unsigned ldsw = (unsigned)wid * 1024u;
    const int aoff = lds_byte(wr * 64 + fr, fq * 8), boff = lds_byte(wc * 32 + fr, fq * 8);
#define PG8_SA(b, h) (((b) * 2 + (h)) * HTB)
#define PG8_SB(b, h) ((4 + (b) * 2 + (h)) * HTB)
#define PG8_STAGE(bufoff, gbase, voff) do { _Pragma("unroll") for (int _i = 0; _i < 2; ++_i) \
        __builtin_amdgcn_global_load_lds((const unsigned*)((const char*)(gbase) + (voff)[_i]), (PG8_LAS unsigned*)(lds + (bufoff) + ldsw + _i * 8192), 16, 0, 0); } while (0)
#define PG8_LDA(dst, b, h) do { _Pragma("unroll") for (int m = 0; m < 4; ++m) _Pragma("unroll") for (int k = 0; k < 2; ++k) dst[m][k] = *(const PG8_LAS bf16x8*)(lds + PG8_SA(b, h) + aoff + m * 2048 + k * 1024); } while (0)
#define PG8_LDB(dst, b, h) do { _Pragma("unroll") for (int n = 0; n < 2; ++n) _Pragma("unroll") for (int k = 0; k < 2; ++k) dst[n][k] = *(const PG8_LAS bf16x8*)(lds + PG8_SB(b, h) + boff + n * 2048 + k * 1024); } while (0)
#define PG8_MMA(ai, bj, At, Bt) do { __builtin_amdgcn_s_setprio(1); _Pragma("unroll") for (int m = 0; m < 4; ++m) _Pragma("unroll") for (int n = 0; n < 2; ++n) _Pragma("unroll") for (int k = 0; k < 2; ++k) \
        acc[ai][bj][m][n] = __builtin_amdgcn_mfma_f32_16x16x32_bf16(Bt[n][k], At[m][k], acc[ai][bj][m][n], 0, 0, 0); __builtin_amdgcn_s_setprio(0); } while (0)
#define PG8_WAIT_V(n) asm volatile("s_waitcnt vmcnt(" #n ")" ::: "memory")
#define PG8_WAIT_L(n) asm volatile("s_waitcnt lgkmcnt(" #n ")" ::: "memory")
#define PG8_BAR __builtin_amdgcn_s_barrier()
#define PG8_SCHED __builtin_amdgcn_sched_barrier(0)
    Unit cur, nxt; int ui = 0;
    if (!S.next(0, cur)) return;
    f32x4 acc[2][2][4][2];
#pragma unroll
    for (int a = 0; a < 2; ++a)
#pragma unroll
        for (int b = 0; b < 2; ++b)
#pragma unroll
            for (int m = 0; m < 4; ++m)
#pragma unroll
                for (int n = 0; n < 2; ++n) acc[a][b][m][n] = (f32x4){0.f, 0.f, 0.f, 0.f};
    bf16x8 At[4][2], B0[2][2], B1[2][2];
    const char* cA = (const char*)g.A + (size_t)cur.pm * tstepA; const char* cB = (const char*)g.Bt + (size_t)cur.pn * tstepB;
    S.a_ready(cur);
    if constexpr (SP2) {
        PG8_STAGE(PG8_SB(0, 0), cB, voffB); PG8_STAGE(PG8_SB(0, 1), cB + hstepB, voffB); PG8_STAGE(PG8_SA(0, 0), cA, voffA); PG8_STAGE(PG8_SA(0, 1), cA + hstepA, voffA);
        if (wr == 1) PG8_BAR;
        PG8_WAIT_V(2); PG8_BAR;
        PG8_STAGE(PG8_SB(1, 0), cB + kstep, voffB); PG8_STAGE(PG8_SA(1, 0), cA + kstep, voffA); PG8_STAGE(PG8_SB(1, 1), cB + hstepB + kstep, voffB);
        PG8_WAIT_V(6); PG8_BAR;
    } else {
        PG8_STAGE(PG8_SB(0, 0), cB, voffB); PG8_STAGE(PG8_SA(0, 0), cA, voffA); PG8_STAGE(PG8_SB(0, 1), cB + hstepB, voffB); PG8_STAGE(PG8_SA(0, 1), cA + hstepA, voffA);
        if (wr == 1) PG8_BAR;
        PG8_WAIT_V(4); PG8_BAR;
        PG8_STAGE(PG8_SB(1, 0), cB + kstep, voffB); PG8_STAGE(PG8_SA(1, 0), cA + kstep, voffA); PG8_STAGE(PG8_SB(1, 1), cB + hstepB + kstep, voffB);
        PG8_WAIT_V(6); PG8_BAR;
    }
    for (;;) {
        const bool has_next = S.next(ui + 1, nxt);
        const char* nA = has_next ? (const char*)g.A + (size_t)nxt.pm * tstepA : cA; const char* nB = has_next ? (const char*)g.Bt + (size_t)nxt.pn * tstepB : cB;
        for (int t = 0; t < nt; t += 2) {
            if constexpr (Epi::KHOOK) { if (t > 0 && (t & 7) == 0) E.khook(acc, cur, t >> 3, wr, wc, fr, fq); }
            const bool last = (t == nt - 2);
            const char* a1 = cA + (size_t)(t + 1) * kstep;
            const char* a2 = last ? nA : cA + (size_t)(t + 2) * kstep; const char* b2 = last ? nB : cB + (size_t)(t + 2) * kstep;
            const char* a3 = a2 + kstep; const char* b3 = b2 + kstep;
            if (last && has_next) S.a_ready(nxt);
            if constexpr (SP2) {
            PG8_LDB(B0, 0, 0); PG8_LDB(B1, 0, 1); PG8_SCHED; PG8_LDA(At, 0, 0); PG8_STAGE(PG8_SA(1, 1), a1 + hstepA, voffA);
            PG8_WAIT_V(8); PG8_WAIT_L(0); PG8_BAR; PG8_MMA(0, 0, At, B0); PG8_MMA(0, 1, At, B1); PG8_BAR; PG8_SCHED;
            PG8_LDA(At, 0, 1); PG8_STAGE(PG8_SB(0, 0), b2, voffB); PG8_STAGE(PG8_SB(0, 1), b2 + hstepB, voffB); PG8_STAGE(PG8_SA(0, 0), a2, voffA);
            PG8_WAIT_V(8); PG8_WAIT_L(0); PG8_BAR; PG8_MMA(1, 0, At, B0); PG8_MMA(1, 1, At, B1); PG8_BAR; PG8_SCHED;
            PG8_LDB(B0, 1, 0); PG8_LDB(B1, 1, 1); PG8_SCHED; PG8_LDA(At, 1, 0); PG8_STAGE(PG8_SA(0, 1), a2 + hstepA, voffA);
            PG8_WAIT_V(8); PG8_WAIT_L(0); PG8_BAR; PG8_MMA(0, 0, At, B0); PG8_MMA(0, 1, At, B1); PG8_BAR; PG8_SCHED;
            PG8_LDA(At, 1, 1); PG8_STAGE(PG8_SB(1, 0), b3, voffB); PG8_STAGE(PG8_SB(1, 1), b3 + hstepB, voffB); PG8_STAGE(PG8_SA(1, 0), a3, voffA);
            PG8_WAIT_V(8); PG8_WAIT_L(0); PG8_BAR; PG8_MMA(1, 0, At, B0); PG8_MMA(1, 1, At, B1); PG8_BAR; PG8_SCHED;
            } else {
            PG8_LDB(B0, 0, 0); PG8_SCHED; PG8_LDA(At, 0, 0); PG8_STAGE(PG8_SA(1, 1), a1 + hstepA, voffA);
            PG8_WAIT_L(8); PG8_BAR; PG8_WAIT_L(0); PG8_MMA(0, 0, At, B0); PG8_BAR; PG8_SCHED;
            PG8_LDB(B1, 0, 1); PG8_STAGE(PG8_SB(0, 0), b2, voffB);
            PG8_BAR; PG8_WAIT_L(0); PG8_MMA(0, 1, At, B1); PG8_BAR;
            PG8_LDA(At, 0, 1); PG8_STAGE(PG8_SA(0, 0), a2, voffA);
            PG8_BAR; PG8_WAIT_L(0); PG8_MMA(1, 0, At, B0); PG8_BAR; PG8_SCHED;
            PG8_STAGE(PG8_SB(0, 1), b2 + hstepB, voffB);
            PG8_WAIT_V(6); PG8_BAR; PG8_MMA(1, 1, At, B1); PG8_BAR;
            PG8_LDB(B0, 1, 0); PG8_SCHED; PG8_LDA(At, 1, 0); PG8_STAGE(PG8_SA(0, 1), a2 + hstepA, voffA);
            PG8_WAIT_L(8); PG8_BAR; PG8_WAIT_L(0); PG8_MMA(0, 0, At, B0); PG8_BAR; PG8_SCHED;
            PG8_LDB(B1, 1, 1); PG8_STAGE(PG8_SB(1, 0), b3, voffB);
            PG8_BAR; PG8_WAIT_L(0); PG8_MMA(0, 1, At, B1); PG8_BAR;
            PG8_LDA(At, 1, 1); PG8_STAGE(PG8_SA(1, 0), a3, voffA);
            PG8_BAR; PG8_WAIT_L(0); PG8_MMA(1, 0, At, B0); PG8_BAR; PG8_SCHED;
            PG8_STAGE(PG8_SB(1, 1), b3 + hstepB, voffB);
            PG8_WAIT_V(6); PG8_BAR; PG8_MMA(1, 1, At, B1); PG8_BAR;
            }
        }
        if constexpr (ALIGN_EPI) { if (wr == 0) PG8_BAR; }
        if constexpr (!Epi::AFTER_DRAIN) { E(acc, cur, wr, wc, fr, fq); S.done(cur); }
        if (!has_next) break;
#pragma unroll
        for (int a = 0; a < 2; ++a)
#pragma unroll
            for (int b = 0; b < 2; ++b)
#pragma unroll
                for (int m = 0; m < 4; ++m)
#pragma unroll
                    for (int n = 0; n < 2; ++n) acc[a][b][m][n] = (f32x4){0.f, 0.f, 0.f, 0.f};
        cur = nxt; cA = nA; cB = nB; ++ui;
        if constexpr (ALIGN_EPI) { if (wr == 1) PG8_BAR; }
    }
    PG8_WAIT_V(0);
    if constexpr (!ALIGN_EPI) { if (wr == 0) PG8_BAR; }
    PG8_BAR;
    if constexpr (Epi::AFTER_DRAIN) { E.fused(acc, cur, wr, wc, fr, fq, lds, wid, lane); S.done(cur); }
#undef PG8_SA
#undef PG8_SB
#undef PG8_STAGE
#undef PG8_LDA
#undef PG8_LDB
#undef PG8_MMA
#undef PG8_WAIT_V
#undef PG8_WAIT_L
#undef PG8_BAR
#undef PG8_SCHED
}

__device__ __forceinline__ void tr_item(const float* src, int ldn, int k0, int n0, bf16_t* dst, int dld, int drow0, int dk0, float* scr, int lane) {
    const float* sp = src + (size_t)k0 * ldn + n0 + lane;
    float t[64];
#pragma unroll
    for (int i = 0; i < 64; ++i) t[i] = __builtin_nontemporal_load(sp + (size_t)i * ldn);
#pragma unroll
    for (int i = 0; i < 64; ++i) scr[i * 65 + lane] = t[i];
    __builtin_amdgcn_s_waitcnt(0); asm volatile("" ::: "memory");
    const int c = lane & 7;
#pragma unroll
    for (int j = 0; j < 8; ++j) {
        const int n = (lane >> 3) + 8 * j; const float* s = scr + (8 * c) * 65 + n;
        u32x4 o; o.x = pk2(s[0], s[65]); o.y = pk2(s[2 * 65], s[3 * 65]); o.z = pk2(s[4 * 65], s[5 * 65]); o.w = pk2(s[6 * 65], s[7 * 65]);
        *(u32x4*)(dst + (size_t)(drow0 + n) * dld + dk0 + 8 * c) = o;
    }
    __builtin_amdgcn_s_waitcnt(0); asm volatile("" ::: "memory");
}

__device__ __forceinline__ void convert_layer(const Args& a, unsigned char* lds, int l, int widx, int nw) {
    const int tid = otid(), wave = tid >> 6, lane = tid & 63;
    float* scr = (float*)(lds + wave * 16640);
    constexpr int I_IN = 32 * 192, I_BR = 4 * 8 * 32, I_O = 32 * 32, I_G = 32 * 88, I_D = 88 * 32, I_B = 16;
    constexpr int PLI = I_IN + I_BR + I_O + 2 * I_G + I_D + I_B;
    unsigned char* wb = a.ws + WS_W + (size_t)l * WPL;
    for (int it = widx; it < PLI; it += nw) {
        int r = it;
        if (r < I_IN) { const int kb = r / 192, nb = r % 192; tr_item(a.in[I_WIN] + (size_t)l * DM * NIN, NIN, kb * 64, nb * 64, (bf16_t*)(wb + W_IN), DM, nb * 64, kb * 64, scr, lane); continue; } r -= I_IN;
        if (r < I_BR) { const int i = r >> 8, rr = r & 255, kb = rr >> 5, nb = rr & 31;
            tr_item(a.in[I_WBR] + (size_t)(l * 4 + i) * 512 * DM, DM, kb * 64, nb * 64, (bf16_t*)(wb + W_BR), DM, nb * 64, i * 512 + kb * 64, scr, lane); continue; } r -= I_BR;
        if (r < I_O) { const int kb = r >> 5, nb = r & 31; tr_item(a.in[I_WO] + (size_t)l * DM * DM, DM, kb * 64, nb * 64, (bf16_t*)(wb + W_O), DM, nb * 64, kb * 64, scr, lane); continue; } r -= I_O;
        if (r < I_G) { const int kb = r / 88, nb = r % 88, n0 = nb * 64; tr_item(a.in[I_WG] + (size_t)l * DM * FF, FF, kb * 64, n0, (bf16_t*)(wb + W_GU), DM, (n0 >> 7) * 256 + (n0 & 127), kb * 64, scr, lane); continue; } r -= I_G;
        if (r < I_G) { const int kb = r / 88, nb = r % 88, n0 = nb * 64; tr_item(a.in[I_WU] + (size_t)l * DM * FF, FF, kb * 64, n0, (bf16_t*)(wb + W_GU), DM, (n0 >> 7) * 256 + 128 + (n0 & 127), kb * 64, scr, lane); continue; } r -= I_G;
        if (r < I_D) { const int kb = r >> 5, nb = r & 31; tr_item(a.in[I_WD] + (size_t)l * FF * DM, DM, kb * 64, nb * 64, (bf16_t*)(wb + W_D), FF, nb * 64, kb * 64, scr, lane); continue; } r -= I_D;
        { const int g = r >> 2, kb = (r >> 1) & 1, nb = r & 1;
          tr_item(a.in[I_BW] + (size_t)(l * 4 + g) * 128 * 128, 128, kb * 64, nb * 64, (bf16_t*)(wb + W_B), 512, g * 128 + nb * 64, g * 128 + kb * 64, scr, lane); }
    }
}
__device__ __forceinline__ void phase_prologue(const Args& a, unsigned char* lds, int vcu, int G) {
    const int tid = otid(), wave = tid >> 6;
    convert_layer(a, lds, 0, vcu * NWAVE + wave, G * NWAVE);
    for (int i = vcu * NTHR + tid; i < 2 * 32768; i += G * NTHR) {
        const int l = i >> 15, j = i & 32767, n = j >> 6, kc = j & 63;
        if ((n >> 7) != (kc >> 4)) *(u32x4*)((bf16_t*)(a.ws + WS_W + (size_t)l * WPL + W_B) + (size_t)n * 512 + kc * 8) = (u32x4){0u, 0u, 0u, 0u};
    }
    float* MOD = (float*)(a.ws + WS_CTL + CTL_MOD);
    for (int it = vcu; it < 768; it += G) {
        const int l = it / 384, r = it % 384, cb = r >> 6, kc = r & 63;
        const int col = cb * 2048 + tid * 4;
        f32x4 al = {0.f, 0.f, 0.f, 0.f}, ac = {0.f, 0.f, 0.f, 0.f};
        const float* wp = a.in[I_ADAW] + ((size_t)l * DM + kc * 32) * NIN + col;
#pragma unroll 8
        for (int k = 0; k < 32; ++k) {
            const float sl = siluf_(a.in[I_C][kc * 32 + k]), sc = siluf_(a.in[I_CCTX][kc * 32 + k]);
            const f32x4 w = *(const f32x4*)(wp + (size_t)k * NIN);
            al += sl * w; ac += sc * w;
        }
        if (kc == 0) { const f32x4 b = *(const f32x4*)(a.in[I_ADAB] + (size_t)l * NIN + col); al += b; ac += b; }
        float* ml = MOD + (size_t)(l * 2 + 0) * NIN + col; float* mc = MOD + (size_t)(l * 2 + 1) * NIN + col;
#pragma unroll
        for (int e = 0; e < 4; ++e) { unsafeAtomicAdd(ml + e, al[e]); unsafeAtomicAdd(mc + e, ac[e]); }
    }
}

template <int MODE>
__device__ __forceinline__ void phase_rows(const Args& a, int vcu, int G, int nrows, const float* gpost, const float* modcur, int gate_idx,
                                           const float* gnext, const float* modnext, int sh_idx) {
    const int tid = otid(), wave = tid >> 6, lane = tid & 63;
    const int gw = vcu * NWAVE + wave, NGW = G * NWAVE;
    float* X = (float*)(a.ws + WS_X); const float* Y = (const float*)(a.ws + WS_MRG); bf16_t* XN = (bf16_t*)(a.ws + WS_XN);
    for (int row = gw; row < nrows; row += NGW) {
        const int isctx = row >= SEQ ? 1 : 0;
        f32x4 x[8];
        if (MODE == 0) {
            const float* src = isctx ? a.in[I_CTX] + (size_t)(row - SEQ) * DM : a.in[I_X] + (size_t)row * DM;
#pragma unroll
            for (int j = 0; j < 8; ++j) x[j] = *(const f32x4*)(src + 4 * lane + 256 * j);
        } else {
            f32x4 y[8]; float ss = 0.f;
#pragma unroll
            for (int j = 0; j < 8; ++j) { x[j] = *(const f32x4*)(X + (size_t)row * DM + 4 * lane + 256 * j); y[j] = *(const f32x4*)(Y + (size_t)row * DM + 4 * lane + 256 * j);
                ss += (y[j][0] * y[j][0] + y[j][1] * y[j][1]) + (y[j][2] * y[j][2] + y[j][3] * y[j][3]); }
            const float rstd = 1.0f / sqrtf(wave_sum(ss) * (1.f / DM) + EPS);
            const float* gate = modcur + (size_t)isctx * NIN + gate_idx * DM;
#pragma unroll
            for (int j = 0; j < 8; ++j) { const int col = 4 * lane + 256 * j; const f32x4 gp = *(const f32x4*)(gpost + col), gt = *(const f32x4*)(gate + col);
                x[j] += gt * (y[j] * rstd * gp); }
        }
        if (MODE == 2) {
#pragma unroll
            for (int j = 0; j < 8; ++j) *(f32x4*)(a.out + (size_t)row * DM + 4 * lane + 256 * j) = x[j];
            continue;
        }
        float ss = 0.f;
#pragma unroll
        for (int j = 0; j < 8; ++j) { *(f32x4*)(X + (size_t)row * DM + 4 * lane + 256 * j) = x[j];
            ss += (x[j][0] * x[j][0] + x[j][1] * x[j][1]) + (x[j][2] * x[j][2] + x[j][3] * x[j][3]); }
        const float rstd = 1.0f / sqrtf(wave_sum(ss) * (1.f / DM) + EPS);
        const float* sh = modnext + (size_t)isctx * NIN + sh_idx * DM; const float* sc = sh + DM;
#pragma unroll
        for (int j = 0; j < 8; ++j) { const int col = 4 * lane + 256 * j; const f32x4 gn = *(const f32x4*)(gnext + col), s1 = *(const f32x4*)(sc + col), s0 = *(const f32x4*)(sh + col);
            const f32x4 h = (x[j] * rstd * gn) * (1.f + s1) + s0;
            u32x2 w; w.x = pk2(h[0], h[1]); w.y = pk2(h[2], h[3]); *(u32x2*)(XN + (size_t)row * DM + col) = w; }
    }
}

__device__ __forceinline__ void qk_prep_row(const Args& a, int layer, int row, int lane) {
    bf16_t* p = (bf16_t*)(a.ws + WS_PL) + (size_t)row * NIN;
    const int ax = lane >> 5, f = lane & 31, d1 = ax * 64 + f, d2 = d1 + 32;
    float cs = 1.f, sn = 0.f;
    if (row < SEQ) { const float pos = (float)(ax == 0 ? (row >> 6) : (row & 63)); const float inv = exp2f(-(float)f * (13.287712379549449f / 32.f)); const float ang = pos * inv; cs = cosf(ang); sn = sinf(ang); }
#pragma unroll
    for (int h = 0; h < 6; ++h) {
        const float* gn = (h < 4 ? a.in[I_AQN] : a.in[I_AKN]) + layer * HD;
        bf16_t* hp = p + h * HD;
        float x1 = bf2f(hp[d1]), x2 = bf2f(hp[d2]);
        const float rstd = 1.0f / sqrtf(wave_sum(x1 * x1 + x2 * x2) * (1.f / HD) + EPS);
        x1 = x1 * rstd * gn[d1]; x2 = x2 * rstd * gn[d2];
        hp[d1] = (bf16_t)f2bf(x1 * cs - x2 * sn); hp[d2] = (bf16_t)f2bf(x2 * cs + x1 * sn);
    }
}
__device__ __forceinline__ void dlt_row(const Args& a, int row, int lane) {
    const bf16_t* PL = (const bf16_t*)(a.ws + WS_PL); bf16_t* DLT = (bf16_t*)(a.ws + WS_DLT);
    const int base = row < SEQ ? 0 : SEQ, n = row < SEQ ? SEQ : CTXL, t = row - base, half = 1 << (lane >> 4);
    const int lo = max(t - half, 0), hi = min(t + half, n);
    float s[8];
#pragma unroll
    for (int e = 0; e < 8; ++e) s[e] = 0.f;
    u32x4 w[16];
#pragma unroll
    for (int i = 0; i < 16; ++i) { const int r = min(max(t - 8 + i, 0), n - 1); w[i] = *(const u32x4*)(PL + (size_t)(base + r) * NIN + B0 + lane * 8); }
#pragma unroll
    for (int i = 0; i < 16; ++i) { const int r = t - 8 + i; const float m = (r >= lo && r < hi) ? 1.f : 0.f;
        s[0] += m * bflo(w[i].x); s[1] += m * bfhi(w[i].x); s[2] += m * bflo(w[i].y); s[3] += m * bfhi(w[i].y); s[4] += m * bflo(w[i].z); s[5] += m * bfhi(w[i].z); s[6] += m * bflo(w[i].w); s[7] += m * bfhi(w[i].w); }
    const float inv = 1.f / (float)(hi - lo);
    const u32x4 c = w[8];
    u32x4 o; o.x = pk2(s[0] * inv - bflo(c.x), s[1] * inv - bfhi(c.x)); o.y = pk2(s[2] * inv - bflo(c.y), s[3] * inv - bfhi(c.y));
    o.z = pk2(s[4] * inv - bflo(c.z), s[5] * inv - bfhi(c.z)); o.w = pk2(s[6] * inv - bflo(c.w), s[7] * inv - bfhi(c.w));
    *(u32x4*)(DLT + (size_t)row * 512 + lane * 8) = o;
}
constexpr int CP = 136;
__device__ __forceinline__ void cmix_unit(const Args& a, int layer, int unit, unsigned char* lds) {
    const int tid = otid(), wave = tid >> 6, lane = tid & 63, chunk = unit >> 2, g = unit & 3;
    const bf16_t* PL = (const bf16_t*)(a.ws + WS_PL); bf16_t* OUT = (bf16_t*)(a.ws + WS_OUTS) + 2 * 512;
    bf16_t* vT = (bf16_t*)lds;
    bf16_t* wsL = (bf16_t*)(lds + 128 * CP * 2);
    float* st = (float*)(lds + 2 * 128 * CP * 2);
    const int t0 = chunk * 128;
    for (int i = 0; i < 16; ++i) {
        const int q = wave * 16 + i;
        const u32x4 w = *(const u32x4*)(PL + (size_t)(t0 + q) * NIN + C_V0 + lane * 8);
        float x[8] = {bflo(w.x), bfhi(w.x), bflo(w.y), bfhi(w.y), bflo(w.z), bfhi(w.z), bflo(w.w), bfhi(w.w)};
        float s = 0.f;
#pragma unroll
        for (int e = 0; e < 8; ++e) s += x[e];
        const float mean = wave_sum(s) * (1.f / 512.f); float q2 = 0.f;
#pragma unroll
        for (int e = 0; e < 8; ++e) { const float d = x[e] - mean; q2 += d * d; }
        const float rstd = 1.0f / sqrtf(wave_sum(q2) * (1.f / 512.f) + EPS);
        if (lane == 0) { st[2 * q] = mean; st[2 * q + 1] = rstd; }
    }
    __syncthreads();
    {
        const int q = tid & 127, cb = tid >> 7; const float mean = st[2 * q], rstd = st[2 * q + 1];
        const float* lg = a.in[I_CNG] + layer * 512 + g * 128 + cb * 32; const float* lb = a.in[I_CNB] + layer * 512 + g * 128 + cb * 32;
        const bf16_t* vp = PL + (size_t)(t0 + q) * NIN + C_V0 + g * 128 + cb * 32;
#pragma unroll
        for (int j = 0; j < 4; ++j) { const u32x4 w = *(const u32x4*)(vp + j * 8);
            const float x[8] = {bflo(w.x), bfhi(w.x), bflo(w.y), bfhi(w.y), bflo(w.z), bfhi(w.z), bflo(w.w), bfhi(w.w)};
#pragma unroll
            for (int e = 0; e < 8; ++e) { const int c = j * 8 + e; vT[(cb * 32 + c) * CP + q] = (bf16_t)f2bf((x[e] - mean) * rstd * lg[c] + lb[c]); } }
        const int p = tid >> 2, qb = (tid & 3) * 32; const float* wp = a.in[I_CWS] + ((size_t)(layer * 4 + g) * 128 + p) * 128 + qb;
#pragma unroll
        for (int j = 0; j < 8; ++j) { const f32x4 w = *(const f32x4*)(wp + j * 4); u32x2 o; o.x = pk2(w[0], w[1]); o.y = pk2(w[2], w[3]); *(u32x2*)(wsL + p * CP + qb + j * 4) = o; }
    }
    __syncthreads();
    {
        const int fr = lane & 15, fq = lane >> 4;
        f32x4 acc[8];
#pragma unroll
        for (int nb = 0; nb < 8; ++nb) acc[nb] = (f32x4){0.f, 0.f, 0.f, 0.f};
#pragma unroll
        for (int ks = 0; ks < 4; ++ks) {
            const bf16x8 wf = *(const bf16x8*)(wsL + (wave * 16 + fr) * CP + ks * 32 + fq * 8);
#pragma unroll
            for (int nb = 0; nb < 8; ++nb) { const bf16x8 vf = *(const bf16x8*)(vT + (nb * 16 + fr) * CP + ks * 32 + fq * 8);
                acc[nb] = __builtin_amdgcn_mfma_f32_16x16x32_bf16(vf, wf, acc[nb], 0, 0, 0); }
        }
        const int p = wave * 16 + fr; const float bs = a.in[I_CBS][(layer * 4 + g) * 128 + p];
        const bf16_t* up = PL + (size_t)(t0 + p) * NIN + C_U0 + g * 128; bf16_t* op = OUT + (size_t)(t0 + p) * DM + g * 128;
#pragma unroll
        for (int nb = 0; nb < 8; ++nb) { const int c = nb * 16 + 4 * fq; const u32x2 uw = *(const u32x2*)(up + c);
            u32x2 o; o.x = pk2((acc[nb][0] + bs) * bflo(uw.x), (acc[nb][1] + bs) * bfhi(uw.x)); o.y = pk2((acc[nb][2] + bs) * bflo(uw.y), (acc[nb][3] + bs) * bfhi(uw.y));
            *(u32x2*)(op + c) = o; }
    }
    __syncthreads();
}

template <int MODE>
__device__ __forceinline__ void attn_simple_item(const bf16_t* PL, int qcol, int kcol, int vcol, bf16_t* O, int qrow, int h, int kvh, int kbeg, int kend, const float* rpb, int lane) {
    constexpr float C = 0.088388347648318440f * 1.4426950408889634f;
    const int part = lane & 3;
    float q[32], o[32];
    { const bf16_t* qp = PL + (size_t)qrow * NIN + qcol + h * HD + part * 32;
#pragma unroll
      for (int j = 0; j < 4; ++j) { const u32x4 w = *(const u32x4*)(qp + j * 8);
          q[j * 8 + 0] = bflo(w.x) * C; q[j * 8 + 1] = bfhi(w.x) * C; q[j * 8 + 2] = bflo(w.y) * C; q[j * 8 + 3] = bfhi(w.y) * C;
          q[j * 8 + 4] = bflo(w.z) * C; q[j * 8 + 5] = bfhi(w.z) * C; q[j * 8 + 6] = bflo(w.w) * C; q[j * 8 + 7] = bfhi(w.w) * C; } }
#pragma unroll
    for (int d = 0; d < 32; ++d) o[d] = 0.f;
    float mrun = -1e30f, l = 0.f;
    const int r = qrow >> 6, c = qrow & 63, r0 = min(max(r - 4, 0), 120), c0 = min(max(c - 8, 0), 48);
    const int nk = MODE == 0 ? (kend - kbeg) : 384;
    for (int idx = 0; idx < nk; ++idx) {
        int krow; float bias = 0.f;
        if (MODE == 0) krow = kbeg + idx;
        else if (idx < 128) { const int i = idx >> 4, j = idx & 15; krow = (r0 + i) * GW + c0 + j; bias = rpb[(h * 15 + (r0 + i - r + 7)) * 31 + (c0 + j - c + 15)] * 1.4426950408889634f; }
        else krow = SEQ + idx - 128;
        const bf16_t* kp = PL + (size_t)krow * NIN + kcol + kvh * HD + part * 32;
        float s = 0.f;
#pragma unroll
        for (int j = 0; j < 4; ++j) { const u32x4 w = *(const u32x4*)(kp + j * 8);
            s += q[j * 8 + 0] * bflo(w.x) + q[j * 8 + 1] * bfhi(w.x) + q[j * 8 + 2] * bflo(w.y) + q[j * 8 + 3] * bfhi(w.y)
               + q[j * 8 + 4] * bflo(w.z) + q[j * 8 + 5] * bfhi(w.z) + q[j * 8 + 6] * bflo(w.w) + q[j * 8 + 7] * bfhi(w.w); }
        s += __shfl_xor(s, 1); s += __shfl_xor(s, 2);
        s += bias;
        const float mn = fmaxf(mrun, s), alpha = exp2f(mrun - mn), p = exp2f(s - mn);
        l = l * alpha + p; mrun = mn;
        const bf16_t* vp = PL + (size_t)krow * NIN + vcol + kvh * HD + part * 32;
#pragma unroll
        for (int j = 0; j < 4; ++j) { const u32x4 w = *(const u32x4*)(vp + j * 8);
            o[j * 8 + 0] = o[j * 8 + 0] * alpha + p * bflo(w.x); o[j * 8 + 1] = o[j * 8 + 1] * alpha + p * bfhi(w.x);
            o[j * 8 + 2] = o[j * 8 + 2] * alpha + p * bflo(w.y); o[j * 8 + 3] = o[j * 8 + 3] * alpha + p * bfhi(w.y);
            o[j * 8 + 4] = o[j * 8 + 4] * alpha + p * bflo(w.z); o[j * 8 + 5] = o[j * 8 + 5] * alpha + p * bfhi(w.z);
            o[j * 8 + 6] = o[j * 8 + 6] * alpha + p * bflo(w.w); o[j * 8 + 7] = o[j * 8 + 7] * alpha + p * bfhi(w.w); }
    }
    const float il = 1.f / l;
    bf16_t* op = O + (size_t)qrow * 512 + h * HD + part * 32;
#pragma unroll
    for (int j = 0; j < 4; ++j) { u32x4 w; w.x = pk2(o[j * 8 + 0] * il, o[j * 8 + 1] * il); w.y = pk2(o[j * 8 + 2] * il, o[j * 8 + 3] * il);
        w.z = pk2(o[j * 8 + 4] * il, o[j * 8 + 5] * il); w.w = pk2(o[j * 8 + 6] * il, o[j * 8 + 7] * il); *(u32x4*)(op + j * 8) = w; }
}


namespace att {
using s16x4 = __attribute__((ext_vector_type(4))) short;
using f32x16 = __attribute__((ext_vector_type(16))) float;
constexpr int KVBLK = 64;
constexpr float SCALE = 0.088388347648318440f, THR = 8.f;
constexpr int SHM_V = KVBLK * HD * 2, SHM_K = KVBLK * HD * 2, SHM_ATTN = 2 * SHM_V + 2 * SHM_K + NWAVE * 64 * 4;
#define KSWZ(row, colB) ((row) * 256 + ((colB) ^ (((row) & 7) << 4)))
#define SBAR() __builtin_amdgcn_sched_barrier(0)
__device__ __forceinline__ int crow(int r, int hi) { return (r & 3) + 8 * (r >> 2) + 4 * hi; }
__device__ __forceinline__ unsigned cvtpk(float lo, float hi) { unsigned r; asm volatile("v_cvt_pk_bf16_f32 %0, %1, %2" : "=v"(r) : "v"(lo), "v"(hi)); return r; }
__device__ __forceinline__ void partialSM(f32x16& p0, f32x16& p1, float& m_reg, float& mn, float& alpha) {
  constexpr float C = SCALE * 1.4426950408889634f;
  float pmax = p0[0];
#pragma unroll
  for (int r = 1; r < 16; ++r) pmax = fmaxf(pmax, p0[r]);
#pragma unroll
  for (int r = 0; r < 16; ++r) pmax = fmaxf(pmax, p1[r]);
  { auto rr = __builtin_amdgcn_permlane32_swap(__float_as_uint(pmax), __float_as_uint(pmax), false, false);
    pmax = fmaxf(__uint_as_float(rr[0]), __uint_as_float(rr[1])); }
  if (__builtin_expect(__all(pmax - m_reg <= THR / SCALE), 1)) { mn = m_reg; alpha = 1.f; }
  else { mn = fmaxf(m_reg, pmax); alpha = __builtin_amdgcn_exp2f((m_reg - mn) * C); m_reg = mn; }
  float mnC = -mn * C;
#pragma unroll
  for (int r = 0; r < 16; ++r) p0[r] = fmaf(p0[r], C, mnC);
#pragma unroll
  for (int r = 0; r < 16; ++r) p1[r] = fmaf(p1[r], C, mnC);
#pragma unroll
  for (int r = 0; r < 16; ++r) p0[r] = __builtin_amdgcn_exp2f(p0[r]);
}
__device__ __forceinline__ void finishSM(f32x16& p0, f32x16& p1, float alpha, float& l_reg, bf16x8& pa0, bf16x8& pa1, bf16x8& pa2, bf16x8& pa3) {
#pragma unroll
  for (int r = 0; r < 16; ++r) p1[r] = __builtin_amdgcn_exp2f(p1[r]);
  float ps = 0;
#pragma unroll
  for (int r = 0; r < 16; ++r) ps += p0[r];
#pragma unroll
  for (int r = 0; r < 16; ++r) ps += p1[r];
  { auto rr = __builtin_amdgcn_permlane32_swap(__float_as_uint(ps), __float_as_uint(ps), false, false);
    ps = __uint_as_float(rr[0]) + __uint_as_float(rr[1]); }
  l_reg = l_reg * alpha + ps;
#define PK4(P, BASE, OUT) do { unsigned a0 = cvtpk(P[BASE + 0], P[BASE + 1]), a1 = cvtpk(P[BASE + 2], P[BASE + 3]);   \
    unsigned b0 = cvtpk(P[BASE + 4], P[BASE + 5]), b1 = cvtpk(P[BASE + 6], P[BASE + 7]);                              \
    auto r0 = __builtin_amdgcn_permlane32_swap(a0, b0, false, false); auto r1 = __builtin_amdgcn_permlane32_swap(a1, b1, false, false); \
    u32x4 w = {r0[0], r1[0], r0[1], r1[1]}; OUT = *reinterpret_cast<bf16x8*>(&w); } while (0)
  PK4(p0, 0, pa0); PK4(p0, 8, pa1); PK4(p1, 0, pa2); PK4(p1, 8, pa3);
#undef PK4
}
__device__ __forceinline__ void qkt(f32x16& p0, f32x16& p1, const char* Ks, const bf16x8* qr, int r32, int hi) {
  p0 = f32x16{}; p1 = f32x16{};
#pragma unroll
  for (int d0 = 0; d0 < 8; ++d0) { int cb = (d0 * 16 + hi * 8) * 2;
    bf16x8 b0 = *reinterpret_cast<const bf16x8*>(Ks + KSWZ(r32, cb));
    bf16x8 b1 = *reinterpret_cast<const bf16x8*>(Ks + KSWZ(32 + r32, cb));
    p0 = __builtin_amdgcn_mfma_f32_32x32x16_bf16(b0, qr[d0], p0, 0, 0, 0);
    p1 = __builtin_amdgcn_mfma_f32_32x32x16_bf16(b1, qr[d0], p1, 0, 0, 0); }
}
__device__ __forceinline__ int v_st(int k, int c) { const int kk = (k & ~0xC) | ((k & 4) << 1) | ((k & 8) >> 1); return ((kk >> 3) * 4 + (c >> 5)) * 512 + ((kk & 7) * 32 + (c & 31)) * 2; }
__device__ __forceinline__ int v_rd_base(int lane) { return ((lane & 3) << 3) | (((lane >> 2) & 3) << 6) | (((lane >> 4) & 1) << 5) | (((lane >> 5) & 1) << 8); }
constexpr int v_rd_off(int d0, int ks, int half) { return d0 * 512 + ks * 4096 + half * 2048; }
template <int OFF> __device__ __forceinline__ s16x4 tr_read(int vb) {
  s16x4 r; asm volatile("ds_read_b64_tr_b16 %0, %1 offset:%2" : "=&v"(r) : "v"(vb), "i"(OFF) : "memory"); return r;
}
template <int D0> __device__ __forceinline__ void pv_one(f32x16& od, int vb, bf16x8 pa0, bf16x8 pa1, bf16x8 pa2, bf16x8 pa3) {
  const s16x4 l0 = tr_read<v_rd_off(D0, 0, 0)>(vb), h0 = tr_read<v_rd_off(D0, 0, 1)>(vb), l1 = tr_read<v_rd_off(D0, 1, 0)>(vb), h1 = tr_read<v_rd_off(D0, 1, 1)>(vb);
  const s16x4 l2 = tr_read<v_rd_off(D0, 2, 0)>(vb), h2 = tr_read<v_rd_off(D0, 2, 1)>(vb), l3 = tr_read<v_rd_off(D0, 3, 0)>(vb), h3 = tr_read<v_rd_off(D0, 3, 1)>(vb);
  asm volatile("s_waitcnt lgkmcnt(0)" ::: "memory"); SBAR();
#define PK(L, H) (bf16x8){L[0], L[1], L[2], L[3], H[0], H[1], H[2], H[3]}
  od = __builtin_amdgcn_mfma_f32_32x32x16_bf16(pa0, PK(l0, h0), od, 0, 0, 0);
  od = __builtin_amdgcn_mfma_f32_32x32x16_bf16(pa1, PK(l1, h1), od, 0, 0, 0);
  od = __builtin_amdgcn_mfma_f32_32x32x16_bf16(pa2, PK(l2, h2), od, 0, 0, 0);
  od = __builtin_amdgcn_mfma_f32_32x32x16_bf16(pa3, PK(l3, h3), od, 0, 0, 0);
#undef PK
}
__device__ __forceinline__ void pv_d0(f32x16* o, int vb, bf16x8 pa0, bf16x8 pa1, bf16x8 pa2, bf16x8 pa3) {
  pv_one<0>(o[0], vb, pa0, pa1, pa2, pa3); pv_one<1>(o[1], vb, pa0, pa1, pa2, pa3); pv_one<2>(o[2], vb, pa0, pa1, pa2, pa3); pv_one<3>(o[3], vb, pa0, pa1, pa2, pa3);
}
__device__ __forceinline__ void na_hook(f32x16& p0, f32x16& p1, int kr, int qr, int qc, int hi, const float* rpbh) {
  const int r0 = min(max(qr - 4, 0), 120), c0 = min(max(qc - 8, 0), 48);
  if (kr < r0 || kr >= r0 + 8) {
#pragma unroll
    for (int r = 0; r < 16; ++r) { p0[r] = -1e30f; p1[r] = -1e30f; }
  } else {
    const float* bp = rpbh + (kr - qr + 7) * 31 + 15 - qc;
#pragma unroll
    for (int r = 0; r < 16; ++r) {
      const int kc0 = crow(r, hi), kc1 = 32 + kc0;
      const bool v0 = (unsigned)(kc0 - c0) < 16u, v1 = (unsigned)(kc1 - c0) < 16u;
      const float b0 = v0 ? bp[kc0] : 0.f, b1 = v1 ? bp[kc1] : 0.f;
      p0[r] = v0 ? fmaf(b0, 1.f / SCALE, p0[r]) : -1e30f;
      p1[r] = v1 ? fmaf(b1, 1.f / SCALE, p1[r]) : -1e30f;
      if ((r & 3) == 3) SBAR();
    }
  }
}
template <int MODE, bool DIRECT>
__device__ __forceinline__ void attn_unit(const bf16_t* __restrict__ PL, int qrow0, int qcol, int kcol, int vcol, int NT, int base0, int n0, int base1,
                                          const float* rpbh, bf16_t* Obf, float* Opart, float* LSE, char* lds) {
  const int tid = otid(), wid = tid >> 6, lane = tid & 63, r32 = lane & 31, hi = lane >> 5;
  char* V_lds = lds; char* K_lds = lds + 2 * SHM_V;
  float* wsf = (float*)(lds + 2 * SHM_V + 2 * SHM_K) + wid * 64; float* li_l = wsf; float* al_l = wsf + 32;
  float m_reg = -1e30f, l_reg = 0; f32x16 o[4] = {}; bf16x8 qr[8];
  const bf16_t* Qw = PL + (size_t)(qrow0 + wid * 32 + r32) * NIN + qcol + hi * 8;
#pragma unroll
  for (int d0 = 0; d0 < 8; ++d0) qr[d0] = *reinterpret_cast<const bf16x8*>(Qw + d0 * 16);
  const int qgr = __builtin_amdgcn_readfirstlane((qrow0 + wid * 32) >> 6);
  const int sr = tid >> 4, sc = (tid & 15) * 8, vst0 = v_st(sr, sc), vst1 = v_st(32 + sr, sc);
  const int vb0 = (int)(uintptr_t)V_lds + v_rd_base(lane);
  const bf16_t* Kg = PL + (size_t)sr * NIN + kcol + sc; const bf16_t* Vg = PL + (size_t)sr * NIN + vcol + sc;
  constexpr int SD = 1;
  struct { bf16x8 vs0, vs1, ks0, ks1; } sr_[SD];
#define KROW(j) ((j) < n0 ? base0 + 64 * (j) : base1 + 64 * ((j) - n0))
#define SLOAD(i, j) do { const size_t ko_ = (size_t)KROW(j) * NIN; sr_[i].vs0 = *reinterpret_cast<const bf16x8*>(Vg + ko_); sr_[i].vs1 = *reinterpret_cast<const bf16x8*>(Vg + ko_ + (size_t)32 * NIN); \
    sr_[i].ks0 = *reinterpret_cast<const bf16x8*>(Kg + ko_); sr_[i].ks1 = *reinterpret_cast<const bf16x8*>(Kg + ko_ + (size_t)32 * NIN); } while (0)
#define SWRITE(b, i) do { *(bf16x8*)(V_lds + (b) * SHM_V + vst0) = sr_[i].vs0;          \
    *(bf16x8*)(V_lds + (b) * SHM_V + vst1) = sr_[i].vs1; int kc = sc * 2;               \
    *(bf16x8*)(K_lds + (b) * SHM_K + KSWZ(sr, kc)) = sr_[i].ks0;                       \
    *(bf16x8*)(K_lds + (b) * SHM_K + KSWZ(32 + sr, kc)) = sr_[i].ks1; } while (0)
#define SWAIT() do { if constexpr (SD == 2) asm volatile("s_waitcnt vmcnt(4)" ::: "memory"); else asm volatile("s_waitcnt vmcnt(0)" ::: "memory"); } while (0)
#define RESC(a) do { if (__any((a) < 1.f)) { if (hi == 0) al_l[r32] = (a); asm volatile("s_waitcnt lgkmcnt(0)" ::: "memory"); \
    _Pragma("unroll") for (int d = 0; d < 4; ++d) _Pragma("unroll") for (int r = 0; r < 16; ++r) o[d][r] *= al_l[crow(r, hi)]; } } while (0)
#define HOOK(P0, P1, j) do { if (MODE == 1) { if ((j) >= n0) na_hook(P0, P1, (base1 >> 6) + (j) - n0, qgr, ((wid & 1) << 5) + r32, hi, rpbh); } } while (0)
  f32x16 pA0, pA1, pB0, pB1; float mnA, mnB, alA, alB; bf16x8 pa0, pa1, pa2, pa3;
  constexpr int SE = 0, SO = SD - 1;
  SLOAD(SE, 0); asm volatile("s_waitcnt vmcnt(0)" ::: "memory"); SWRITE(0, SE); __syncthreads();
  qkt(pA0, pA1, K_lds, qr, r32, hi); HOOK(pA0, pA1, 0); partialSM(pA0, pA1, m_reg, mnA, alA);
  SLOAD(SO, 1); if constexpr (SD == 2) { if (2 < NT) SLOAD(SE, 2); }
  SWAIT(); SWRITE(1, SO); __syncthreads();
  for (int j = 1; j + 1 < NT; j += 2) {
    SBAR(); qkt(pB0, pB1, K_lds + SHM_K, qr, r32, hi); HOOK(pB0, pB1, j);
    finishSM(pA0, pA1, alA, l_reg, pa0, pa1, pa2, pa3); SBAR();
    SLOAD(SO, j + SD); SBAR();
    pv_d0(o, vb0, pa0, pa1, pa2, pa3); partialSM(pB0, pB1, m_reg, mnB, alB);
    __syncthreads(); SWAIT(); SWRITE(0, SE);
    RESC(alB); __syncthreads();
    SBAR(); qkt(pA0, pA1, K_lds, qr, r32, hi); HOOK(pA0, pA1, j + 1);
    finishSM(pB0, pB1, alB, l_reg, pa0, pa1, pa2, pa3); SBAR();
    if (SD == 1 || j + 3 < NT) SLOAD(SE, j + 1 + SD); SBAR();
    pv_d0(o, vb0 + SHM_V, pa0, pa1, pa2, pa3); partialSM(pA0, pA1, m_reg, mnA, alA);
    __syncthreads(); SWAIT(); SWRITE(1, SO);
    RESC(alA); __syncthreads();
  }
  SBAR(); qkt(pB0, pB1, K_lds + SHM_K, qr, r32, hi); HOOK(pB0, pB1, NT - 1);
  finishSM(pA0, pA1, alA, l_reg, pa0, pa1, pa2, pa3); SBAR();
  pv_d0(o, vb0, pa0, pa1, pa2, pa3); partialSM(pB0, pB1, m_reg, mnB, alB);
  __syncthreads(); RESC(alB);
  finishSM(pB0, pB1, alB, l_reg, pa0, pa1, pa2, pa3); SBAR();
  pv_d0(o, vb0 + SHM_V, pa0, pa1, pa2, pa3);
  if (hi == 0) li_l[r32] = l_reg; asm volatile("s_waitcnt lgkmcnt(0)" ::: "memory");
  float rli[16];
#pragma unroll
  for (int r = 0; r < 16; ++r) rli[r] = __builtin_amdgcn_rcpf(li_l[crow(r, hi)]);
  if (DIRECT) {
    bf16_t* Ow = Obf + (size_t)(wid * 32) * DM;
#pragma unroll
    for (int r = 0; r < 16; ++r) { const int orow = crow(r, hi);
#pragma unroll
      for (int d0 = 0; d0 < 4; ++d0) Ow[(size_t)orow * DM + d0 * 32 + r32] = (bf16_t)f2bf(o[d0][r] * rli[r]); }
  } else {
    float* Ow = Opart + (size_t)(wid * 32) * 512;
#pragma unroll
    for (int r = 0; r < 16; ++r) { const int orow = crow(r, hi);
#pragma unroll
      for (int d0 = 0; d0 < 4; ++d0) Ow[(size_t)orow * 512 + d0 * 32 + r32] = o[d0][r] * rli[r]; }
    if (hi == 0) LSE[(size_t)(wid * 32 + r32) * 4] = m_reg * (SCALE * 1.4426950408889634f) + log2f(l_reg);
  }
  __syncthreads();
#undef KROW
#undef SLOAD
#undef SWRITE
#undef SWAIT
#undef RESC
#undef HOOK
}
__device__ __forceinline__ void attn_unit_na(const bf16_t* __restrict__ PL, int qrow0, int qcol, int kcol, int vcol, int R0, const float* rpbh, bf16_t* Obf, char* lds) {
  const int tid = otid(), wid = tid >> 6, lane = tid & 63, r32 = lane & 31, hi = lane >> 5;
  constexpr int NT = 16, n0 = 4;
  char* V_lds = lds; char* K_lds = lds + 2 * SHM_V;
  float* wsf = (float*)(lds + 2 * SHM_V + 2 * SHM_K) + wid * 64; float* li_l = wsf; float* al_l = wsf + 32;
  float m_reg = -1e30f, l_reg = 0; f32x16 o[4] = {}; bf16x8 qr[8];
  const bf16_t* Qw = PL + (size_t)(qrow0 + wid * 32 + r32) * NIN + qcol + hi * 8;
#pragma unroll
  for (int d0 = 0; d0 < 8; ++d0) qr[d0] = *reinterpret_cast<const bf16x8*>(Qw + d0 * 16);
  const int qgr = (qrow0 + wid * 32) >> 6, qgc = ((wid & 1) << 5) + r32;
  const int sr = tid >> 4, sc = (tid & 15) * 8, vst0 = v_st(sr, sc), vst1 = v_st(32 + sr, sc);
  const int vb0 = (int)(uintptr_t)V_lds + v_rd_base(lane);
  const bf16_t* Kg = PL + (size_t)sr * NIN + kcol + sc; const bf16_t* Vg = PL + (size_t)sr * NIN + vcol + sc;
  bf16x8 vs0, vs1, ks0, ks1;
#define KROW(j) ((j) < n0 ? SEQ + 64 * (j) : (R0 + (j) - n0) * 64)
#define SLOAD(j) do { const size_t ko_ = (size_t)KROW(j) * NIN; vs0 = *reinterpret_cast<const bf16x8*>(Vg + ko_); vs1 = *reinterpret_cast<const bf16x8*>(Vg + ko_ + (size_t)32 * NIN); \
    ks0 = *reinterpret_cast<const bf16x8*>(Kg + ko_); ks1 = *reinterpret_cast<const bf16x8*>(Kg + ko_ + (size_t)32 * NIN); } while (0)
  SLOAD(0);
  for (int j = 0; j < NT; ++j) {
    asm volatile("s_waitcnt vmcnt(0)" ::: "memory");
    *(bf16x8*)(V_lds + vst0) = vs0; *(bf16x8*)(V_lds + vst1) = vs1;
    *(bf16x8*)(K_lds + KSWZ(sr, sc * 2)) = ks0; *(bf16x8*)(K_lds + KSWZ(32 + sr, sc * 2)) = ks1;
    __syncthreads();
    if (j + 1 < NT) SLOAD(j + 1);
    f32x16 p0, p1; float mn, al; bf16x8 pa0, pa1, pa2, pa3;
    qkt(p0, p1, K_lds, qr, r32, hi);
    if (j >= n0) na_hook(p0, p1, R0 + j - n0, qgr, qgc, hi, rpbh);
    partialSM(p0, p1, m_reg, mn, al);
    if (__any(al < 1.f)) { if (hi == 0) al_l[r32] = al; asm volatile("s_waitcnt lgkmcnt(0)" ::: "memory");
#pragma unroll
      for (int d = 0; d < 4; ++d)
#pragma unroll
        for (int r = 0; r < 16; ++r) o[d][r] *= al_l[crow(r, hi)]; }
    finishSM(p0, p1, al, l_reg, pa0, pa1, pa2, pa3); SBAR();
    pv_d0(o, vb0, pa0, pa1, pa2, pa3);
    __syncthreads();
  }
  if (hi == 0) li_l[r32] = l_reg; asm volatile("s_waitcnt lgkmcnt(0)" ::: "memory");
  bf16_t* Ow = Obf + (size_t)(wid * 32) * DM;
#pragma unroll
  for (int r = 0; r < 16; ++r) { const int orow = crow(r, hi); const float rl = __builtin_amdgcn_rcpf(li_l[orow]);
#pragma unroll
    for (int d0 = 0; d0 < 4; ++d0) Ow[(size_t)orow * DM + d0 * 32 + r32] = (bf16_t)f2bf(o[d0][r] * rl); }
  __syncthreads();
#undef KROW
#undef SLOAD
}
}

__device__ __forceinline__ void phase_small(const Args& a, unsigned char* lds, int vcu, int G, int layer, bool last) {
    const int tid = otid(), wave = tid >> 6, lane = tid & 63;
    const int gw = vcu * NWAVE + wave, NGW = G * NWAVE;
    const int nrows = last ? SEQ : MR;
    for (int row = gw; row < MR; row += NGW) qk_prep_row(a, layer, row, lane);
    for (int row = gw; row < nrows; row += NGW) dlt_row(a, row, lane);
    const int nunits = (nrows / 128) * 4;
    for (int u = G - 1 - vcu; u < nunits; u += G) cmix_unit(a, layer, u, lds);
    const bf16_t* PL = (const bf16_t*)(a.ws + WS_PL); bf16_t* OD = (bf16_t*)(a.ws + WS_OUTS) + 3 * 512;
    const float* rpb = a.in[I_RPB] + layer * 4 * 15 * 31;
    const int nu = 128 + (last ? 0 : 4);
    for (int u = vcu; u < nu; u += G) {
        if (u < 128) { const int h = u & 3, i = u >> 2, R0 = min(max(4 * i - 4, 0), 120);
            att::attn_unit_na(PL, i * 256, D_Q0 + h * HD, D_K0 + h * HD, D_V0 + h * HD, R0, rpb + h * 465, OD + (size_t)(i * 256) * DM + h * HD, (char*)lds); }
        else { const int h = u - 128;
            att::attn_unit<0, true>(PL, SEQ, D_Q0 + h * HD, D_K0 + h * HD, D_V0 + h * HD, 4, SEQ, 4, 0, nullptr, OD + (size_t)SEQ * DM + h * HD, nullptr, nullptr, (char*)lds); }
    }
}
constexpr size_t OPART_LSE = (size_t)2 * SEQ * 512 * 4;
__device__ __forceinline__ void phase_attn_a(const Args& a, unsigned char* lds, int vcu, int G, bool last) {
    const bf16_t* PL = (const bf16_t*)(a.ws + WS_PL); bf16_t* OA = (bf16_t*)(a.ws + WS_OUTS);
    float* Opart = (float*)(a.ws + WS_MRG); float* LSE = (float*)(a.ws + WS_MRG + OPART_LSE);
    const int nu = 256 + (last ? 0 : 4);
    for (int u = vcu; u < nu; u += G) {
        if (u < 256) { const int half = u >> 7, h = (u >> 5) & 3, qb = u & 31, kvh = h >> 1;
            att::attn_unit<0, false>(PL, qb * 256, A_Q0 + h * HD, A_K0 + kvh * HD, A_V0 + kvh * HD, 66, half * 4224, 66, 0, nullptr, nullptr,
                                     Opart + ((size_t)half * SEQ + qb * 256) * 512 + h * HD, LSE + ((size_t)half * SEQ + qb * 256) * 4 + h, (char*)lds); }
        else { const int h = u - 256, kvh = h >> 1;
            att::attn_unit<0, true>(PL, SEQ, A_Q0 + h * HD, A_K0 + kvh * HD, A_V0 + kvh * HD, 4, SEQ, 4, 0, nullptr, OA + (size_t)SEQ * DM + h * HD, nullptr, nullptr, (char*)lds); }
    }
}
__device__ __forceinline__ void phase_combine_a(const Args& a, int vcu, int G) {
    const int tid = otid(), wave = tid >> 6, lane = tid & 63;
    const int gw = vcu * NWAVE + wave, NGW = G * NWAVE;
    const float* Opart = (const float*)(a.ws + WS_MRG); const float* LSE = (const float*)(a.ws + WS_MRG + OPART_LSE); bf16_t* OA = (bf16_t*)(a.ws + WS_OUTS);
    for (int row = gw; row < SEQ; row += NGW) {
        const float l0 = LSE[(size_t)row * 4 + (lane >> 4)], l1 = LSE[((size_t)SEQ + row) * 4 + (lane >> 4)];
        const float mx = fmaxf(l0, l1), w0 = exp2f(l0 - mx), w1 = exp2f(l1 - mx), inv = 1.f / (w0 + w1), c0 = w0 * inv, c1 = w1 * inv;
        const float* p0 = Opart + (size_t)row * 512 + lane * 8; const float* p1 = p0 + (size_t)SEQ * 512;
        const f32x4 a0 = *(const f32x4*)p0, a1 = *(const f32x4*)(p0 + 4), b0 = *(const f32x4*)p1, b1 = *(const f32x4*)(p1 + 4);
        const f32x4 r0 = a0 * c0 + b0 * c1, r1 = a1 * c0 + b1 * c1;
        u32x4 w; w.x = pk2(r0[0], r0[1]); w.y = pk2(r0[2], r0[3]); w.z = pk2(r1[0], r1[1]); w.w = pk2(r1[2], r1[3]);
        *(u32x4*)(OA + (size_t)row * DM + lane * 8) = w;
    }
}

#define XB_TMO      128
#define XB_XCNT(j)  (256  + 64 * (j))
#define XB_XSUB(j)  (1280 + 64 * (j))
#define XB_XGEN(j)  (2304 + 64 * (j))
#define XB_TOP      3328
#define XB_TOPGEN   3392
#define XCD_BAR_WORDS 3456
#define XB_SPIN_CAP (1u << 18)

__device__ __forceinline__ unsigned xb_ld(unsigned* p)              { return __hip_atomic_load(p, __ATOMIC_RELAXED, __HIP_MEMORY_SCOPE_AGENT); }
__device__ __forceinline__ unsigned xb_add(unsigned* p, unsigned v) { return __hip_atomic_fetch_add(p, v, __ATOMIC_RELAXED, __HIP_MEMORY_SCOPE_AGENT); }
__device__ __forceinline__ unsigned xb_xcc_id() { return (unsigned)__builtin_amdgcn_s_getreg((3 << 11) | 20) & 0xFu; }
#define XB_SPIN(cond, bar) do { unsigned _sp = 0; while (cond) { __builtin_amdgcn_s_sleep(1); \
    if ((++_sp & 255u) == 0u) { if (xb_ld(&(bar)[XB_TMO])) break; if (_sp > XB_SPIN_CAP) { atomicAdd(&(bar)[XB_TMO], 1u); break; } } } } while (0)

struct XcdBarrier {
    unsigned* bar; unsigned x;
    volatile __attribute__((address_space(3))) unsigned* st;
};

__device__ __forceinline__ XcdBarrier xcd_barrier_post(unsigned* bar, volatile __attribute__((address_space(3))) unsigned* st) {
    XcdBarrier b; b.bar = bar; b.x = xb_xcc_id(); b.st = st;
    if (threadIdx.x == 0) (void)xb_add(&bar[XB_XCNT(b.x)], 1u);
    return b;
}
__device__ __forceinline__ void xcd_barrier_complete(unsigned* bar, unsigned x, unsigned& nloc, unsigned& nx) {
    const unsigned G = gridDim.x * gridDim.y * gridDim.z;
    unsigned sum, cnt, mine, sp = 0u;
    for (;;) {
        sum = 0u; cnt = 0u; mine = 0u;
#pragma unroll
        for (unsigned j = 0; j < 16; ++j) { const unsigned c = xb_ld(&bar[XB_XCNT(j)]); sum += c; cnt += (c > 0u) ? 1u : 0u; mine = (j == x) ? c : mine; }
        if (sum == G) break;
        __builtin_amdgcn_s_sleep(1);
        if ((++sp & 255u) == 0u) { if (xb_ld(&bar[XB_TMO])) break; if (sp > XB_SPIN_CAP) { atomicAdd(&bar[XB_TMO], 1u); break; } }
    }
    nloc = mine > 0u ? mine : 1u; nx = cnt > 0u ? cnt : 1u;
}

__device__ __forceinline__ void xcd_barrier(const XcdBarrier& b) {
    asm volatile("s_waitcnt vmcnt(0)" ::: "memory");
    __syncthreads();
    if (threadIdx.x == 0) {
        unsigned* bar = b.bar;
        __builtin_amdgcn_s_waitcnt(0);
        unsigned nloc = b.st[0], nx = b.st[1];
        if (nloc == 0u) { xcd_barrier_complete(bar, b.x, nloc, nx); b.st[0] = nloc; b.st[1] = nx; }
        const unsigned old = xb_add(&bar[XB_XSUB(b.x)], 1u);
        const unsigned gen = old / nloc;
        if (old + 1u == (gen + 1u) * nloc) {
            __builtin_amdgcn_fence(__ATOMIC_RELEASE, "agent");
            asm volatile("s_waitcnt vmcnt(0)" ::: "memory");
            const unsigned og = xb_add(&bar[XB_TOP], 1u);
            const unsigned tg = og / nx;
            if (og + 1u == (tg + 1u) * nx) xb_add(&bar[XB_TOPGEN], 1u);
            else XB_SPIN(xb_ld(&bar[XB_TOPGEN]) == tg, bar);
            __builtin_amdgcn_fence(__ATOMIC_ACQUIRE, "agent");
            xb_add(&bar[XB_XGEN(b.x)], 1u);
            asm volatile("s_waitcnt vmcnt(0)" ::: "memory");
        } else {
            XB_SPIN(xb_ld(&bar[XB_XGEN(b.x)]) == gen, bar);
            __builtin_amdgcn_fence(__ATOMIC_ACQUIRE, "agent");
            asm volatile("s_waitcnt vmcnt(0)" ::: "memory");
        }
    }
    __syncthreads();
}

constexpr int NPHASE = 22;
__global__ void __launch_bounds__(NTHR, 2) fwd(Args a) {
    extern __shared__ __attribute__((aligned(16))) unsigned char lds[];
    const int G = gridDim.x, bx = blockIdx.x;
    const int vcu = (G % 8 == 0) ? (bx % 8) * (G / 8) + bx / 8 : bx;
    unsigned char* ws = a.ws;
    const float* MOD = (const float*)(ws + WS_CTL + CTL_MOD);
#if MK_COOP
    cg::grid_group grid = cg::this_grid();
    volatile __attribute__((address_space(3))) unsigned* MISC = (volatile __attribute__((address_space(3))) unsigned*)((__attribute__((address_space(3))) unsigned char*)lds + (LDS_BYTES - 64));
    if (threadIdx.x < 2) MISC[threadIdx.x] = 0u;
    __syncthreads();
    const XcdBarrier xbar = xcd_barrier_post((unsigned*)(ws + WS_CTL) + CW_BAR, MISC);
#define SEAM(p) do { if (lo <= (p) && (p) + 1 < hi) { if ((p) == 0) grid.sync(); else xcd_barrier(xbar); } } while (0)
#else
#define SEAM(p) do { } while (0)
#endif
    const int lo = a.ph_lo, hi = a.ph_hi;
#ifndef PHMASK
#define PHMASK 0xffffffu
#endif
#define IN(p) (lo <= (p) && (p) < hi && ((PHMASK >> ((p) < 2 ? (p) : 2 + ((p) - 2) % 10)) & 1u))
    if (IN(0)) { phase_prologue(a, lds, vcu, G); } SEAM(0);
    if (IN(1)) { phase_rows<0>(a, vcu, G, MR, nullptr, nullptr, 0, a.in[I_NPRE_MIX], MOD, 0); } SEAM(1);
    {
        constexpr int l = 0; constexpr bool last = (l == 1); const int pb = 2 + l * 10;
        unsigned char* wb = ws + WS_W + (size_t)l * WPL;
        const float* modl = MOD + (size_t)l * 2 * NIN;
        const int Mrows = last ? SEQ : MR;
        if (IN(pb + 0)) {
            Gemm g{(const bf16_t*)(ws + WS_XN), (const bf16_t*)(wb + W_IN), DM, DM, DM}; StaticOrder S; S.init(MR, NIN, G, bx);
            EpiIn E{(bf16_t*)(ws + WS_PL)}; gemm_phase((PG8_LAS unsigned char*)lds, g, S, E);
        } SEAM(pb + 0);
        if (IN(pb + 1)) { phase_small(a, lds, vcu, G, l, last); } SEAM(pb + 1);
        if (IN(pb + 2)) { phase_attn_a(a, lds, vcu, G, last); } SEAM(pb + 2);
        if (IN(pb + 3)) {
            phase_combine_a(a, vcu, G);
            Gemm g{(const bf16_t*)(ws + WS_DLT), (const bf16_t*)(wb + W_B), 512, 512, 512}; StaticOrder S; S.init(Mrows, 512, G, bx);
            EpiScale E{(bf16_t*)(ws + WS_OUTS) + 512, DM, a.in[I_BSCALE] + l * 512}; gemm_phase((PG8_LAS unsigned char*)lds, g, S, E);
        } SEAM(pb + 3);
        if (IN(pb + 4)) {
            Gemm g{(const bf16_t*)(ws + WS_OUTS), (const bf16_t*)(wb + W_BR), DM, DM, DM}; StaticOrder S; S.init(Mrows, DM, G, bx);
            EpiMerge E{(const bf16_t*)(ws + WS_PL), (bf16_t*)(ws + WS_MRGB)}; gemm_phase((PG8_LAS unsigned char*)lds, g, S, E);
        } SEAM(pb + 4);
        if (IN(pb + 5)) {
            Gemm g{(const bf16_t*)(ws + WS_MRGB), (const bf16_t*)(wb + W_O), DM, DM, DM}; StaticOrder S; S.init(Mrows, DM, G, bx);
            EpiF32 E{(float*)(ws + WS_MRG), DM}; gemm_phase((PG8_LAS unsigned char*)lds, g, S, E);
        } SEAM(pb + 5);
        if (IN(pb + 6)) { phase_rows<1>(a, vcu, G, Mrows, a.in[I_NPOST_MIX] + l * DM, modl, 2, a.in[I_NPRE_FFN] + l * DM, modl, 3); } SEAM(pb + 6);
        if (IN(pb + 7)) {
            Gemm g{(const bf16_t*)(ws + WS_XN), (const bf16_t*)(wb + W_GU), DM, DM, DM}; StaticOrder S; S.init(Mrows, 2 * FF, G, bx);
            EpiSwiglu E{(bf16_t*)(ws + WS_H)}; gemm_phase((PG8_LAS unsigned char*)lds, g, S, E);
        } SEAM(pb + 7);
        if (IN(pb + 8)) {
            Gemm g{(const bf16_t*)(ws + WS_H), (const bf16_t*)(wb + W_D), FF, FF, FF}; StaticOrder S; S.init(Mrows, DM, G, bx);
            EpiF32 E{(float*)(ws + WS_MRG), DM}; gemm_phase((PG8_LAS unsigned char*)lds, g, S, E);
            if (bx >= 8) convert_layer(a, lds, 1, (bx - 8) * NWAVE + (otid() >> 6), (G - 8) * NWAVE);
        } SEAM(pb + 8);
        if (IN(pb + 9)) {
            if (!last) phase_rows<1>(a, vcu, G, MR, a.in[I_NPOST_FFN] + l * DM, modl, 5, a.in[I_NPRE_MIX] + (l + 1) * DM, MOD + (size_t)(l + 1) * 2 * NIN, 0);
            else phase_rows<2>(a, vcu, G, SEQ, a.in[I_NPOST_FFN] + l * DM, modl, 5, nullptr, nullptr, 0);
        }
        if (!last) SEAM(pb + 9);
        }
    {
        constexpr int l = 1; constexpr bool last = (l == 1); const int pb = 2 + l * 10;
        unsigned char* wb = ws + WS_W + (size_t)l * WPL;
        const float* modl = MOD + (size_t)l * 2 * NIN;
        const int Mrows = last ? SEQ : MR;
        if (IN(pb + 0)) {
            Gemm g{(const bf16_t*)(ws + WS_XN), (const bf16_t*)(wb + W_IN), DM, DM, DM}; StaticOrder S; S.init(MR, NIN, G, bx);
            EpiIn E{(bf16_t*)(ws + WS_PL)}; gemm_phase((PG8_LAS unsigned char*)lds, g, S, E);
        } SEAM(pb + 0);
        if (IN(pb + 1)) { phase_small(a, lds, vcu, G, l, last); } SEAM(pb + 1);
        if (IN(pb + 2)) { phase_attn_a(a, lds, vcu, G, last); } SEAM(pb + 2);
        if (IN(pb + 3)) {
            phase_combine_a(a, vcu, G);
            Gemm g{(const bf16_t*)(ws + WS_DLT), (const bf16_t*)(wb + W_B), 512, 512, 512}; StaticOrder S; S.init(Mrows, 512, G, bx);
            EpiScale E{(bf16_t*)(ws + WS_OUTS) + 512, DM, a.in[I_BSCALE] + l * 512}; gemm_phase((PG8_LAS unsigned char*)lds, g, S, E);
        } SEAM(pb + 3);
        if (IN(pb + 4)) {
            Gemm g{(const bf16_t*)(ws + WS_OUTS), (const bf16_t*)(wb + W_BR), DM, DM, DM}; StaticOrder S; S.init(Mrows, DM, G, bx);
            EpiMerge E{(const bf16_t*)(ws + WS_PL), (bf16_t*)(ws + WS_MRGB)}; gemm_phase((PG8_LAS unsigned char*)lds, g, S, E);
        } SEAM(pb + 4);
        if (IN(pb + 5)) {
            Gemm g{(const bf16_t*)(ws + WS_MRGB), (const bf16_t*)(wb + W_O), DM, DM, DM}; StaticOrder S; S.init(Mrows, DM, G, bx);
            EpiF32 E{(float*)(ws + WS_MRG), DM}; gemm_phase((PG8_LAS unsigned char*)lds, g, S, E);
        } SEAM(pb + 5);
        if (IN(pb + 6)) { phase_rows<1>(a, vcu, G, Mrows, a.in[I_NPOST_MIX] + l * DM, modl, 2, a.in[I_NPRE_FFN] + l * DM, modl, 3); } SEAM(pb + 6);
        if (IN(pb + 7)) {
            Gemm g{(const bf16_t*)(ws + WS_XN), (const bf16_t*)(wb + W_GU), DM, DM, DM}; StaticOrder S; S.init(Mrows, 2 * FF, G, bx);
            EpiSwiglu E{(bf16_t*)(ws + WS_H)}; gemm_phase((PG8_LAS unsigned char*)lds, g, S, E);
        } SEAM(pb + 7);
        if (IN(pb + 8)) {
            Gemm g{(const bf16_t*)(ws + WS_H), (const bf16_t*)(wb + W_D), FF, FF, FF}; StaticOrder S; S.init(Mrows, DM, G, bx);
            EpiF32 E{(float*)(ws + WS_MRG), DM}; gemm_phase((PG8_LAS unsigned char*)lds, g, S, E);
        } SEAM(pb + 8);
        if (IN(pb + 9)) {
            if (!last) phase_rows<1>(a, vcu, G, MR, a.in[I_NPOST_FFN] + l * DM, modl, 5, a.in[I_NPRE_MIX] + (l + 1) * DM, MOD + (size_t)(l + 1) * 2 * NIN, 0);
            else phase_rows<2>(a, vcu, G, SEQ, a.in[I_NPOST_FFN] + l * DM, modl, 5, nullptr, nullptr, 0);
        }
        if (!last) SEAM(pb + 9);
        }
#undef IN
#undef SEAM
}

extern "C" void kernel_launch(void* const* d_in, const int* in_sizes, int n_in, void* d_out, int out_size, void* d_ws, size_t ws_size, hipStream_t stream) {
    static int grid = 0;
    if (grid == 0) {
        if (n_in != N_IN || out_size != SEQ * DM || ws_size < WS_END) { fprintf(stderr, "kernel_launch: unexpected shapes (n_in %d out %d ws %zu)\n", n_in, out_size, ws_size); grid = -1; return; }
        if (hipFuncSetAttribute((const void*)fwd, hipFuncAttributeMaxDynamicSharedMemorySize, LDS_BYTES) != hipSuccess) { fprintf(stderr, "kernel_launch: hipFuncSetAttribute failed\n"); grid = -1; return; }
        int dev = 0, cus = 0, per_cu = 0;
        hipGetDevice(&dev); hipDeviceGetAttribute(&cus, hipDeviceAttributeMultiprocessorCount, dev);
        hipOccupancyMaxActiveBlocksPerMultiprocessor(&per_cu, (const void*)fwd, NTHR, LDS_BYTES);
        if (per_cu < 1) { fprintf(stderr, "kernel_launch: occupancy query says %d blocks per CU\n", per_cu); per_cu = 1; }
        (void)hipGetLastError();
        grid = cus * per_cu;
        fprintf(stderr, "kernel_launch: grid %d (cus %d x %d)\n", grid, cus, per_cu);
    }
    if (grid < 0) return;
    hipMemsetAsync((char*)d_ws + WS_CTL, 0, CTL_BYTES, stream);
    Args a{};
    for (int i = 0; i < N_IN; ++i) a.in[i] = (const float*)d_in[i];
    a.out = (float*)d_out; a.ws = (unsigned char*)d_ws;
#if MK_COOP
    a.ph_lo = 0; a.ph_hi = NPHASE;
    void* params[] = {&a};
    hipError_t e = hipLaunchCooperativeKernel((const void*)fwd, dim3(grid), dim3(NTHR), params, LDS_BYTES, stream);
    if (e != hipSuccess) fprintf(stderr, "kernel_launch: cooperative launch failed: %s (grid %d)\n", hipGetErrorString(e), grid);
#else
    for (int p = 0; p < NPHASE; ++p) {
        a.ph_lo = p; a.ph_hi = p + 1;
        hipLaunchKernelGGL(fwd, dim3(grid), dim3(NTHR), LDS_BYTES, stream, a);
    }
#endif
}
```

```cpp
#include <hip/hip_runtime.h>
#include <hip/hip_cooperative_groups.h>
#include <cstdio>
#include <cstdint>
namespace cg = cooperative_groups;

#ifndef MK_COOP
#define MK_COOP 1
#endif

typedef unsigned short bf16_t;
typedef short bf16x8 __attribute__((ext_vector_type(8)));
typedef float f32x4 __attribute__((ext_vector_type(4)));
typedef unsigned u32x4 __attribute__((ext_vector_type(4)));
typedef unsigned u32x2 __attribute__((ext_vector_type(2)));

constexpr int DM = 2048, SEQ = 8192, CTXL = 256, MR = SEQ + CTXL, NIN = 12288, FF = 5632, HD = 128, GW = 64;
constexpr int A_Q0 = 0, A_K0 = 512, A_V0 = 768, B0 = 1024, C_U0 = 1536, C_V0 = 2048, D_Q0 = 2560, D_K0 = 3072, D_V0 = 3584, G0 = 4096;
constexpr float EPS = 1e-6f;
constexpr int NTHR = 512, NWAVE = 8;
constexpr int LDS_BYTES = 147456;

enum { I_X = 0, I_C, I_CTX, I_CCTX, I_ADAW, I_ADAB, I_NPRE_MIX, I_NPOST_MIX, I_NPRE_FFN, I_NPOST_FFN, I_WIN, I_AQN, I_AKN, I_BW, I_BSCALE,
       I_CNG, I_CNB, I_CWS, I_CBS, I_RPB, I_WBR, I_WO, I_WG, I_WU, I_WD, N_IN };

constexpr size_t MiB = 1u << 20;
constexpr size_t WS_CTL = 0, CTL_BYTES = 1 * MiB;
constexpr int CW_BAR = 4096;
constexpr size_t CTL_MOD = 256 * 1024;
constexpr size_t WS_W = 2 * MiB, WPL = 131 * MiB;
constexpr size_t W_IN = 0, W_BR = 48 * MiB, W_O = 56 * MiB, W_GU = 64 * MiB, W_D = 108 * MiB, W_B = 130 * MiB;
constexpr size_t WS_X = 264 * MiB;
constexpr size_t WS_XN = 330 * MiB;
constexpr size_t WS_PL = 363 * MiB;
constexpr size_t WS_H = WS_PL;
constexpr size_t WS_OUTS = 561 * MiB;
constexpr size_t WS_DLT = 594 * MiB;
constexpr size_t WS_MRG = 603 * MiB;
constexpr size_t WS_MRGB = 669 * MiB;
constexpr size_t WS_END = 702 * MiB;

struct Args { const float* in[N_IN]; float* out; unsigned char* ws; int ph_lo, ph_hi; };

__device__ __forceinline__ unsigned f2bf(float f) { unsigned u = __builtin_bit_cast(unsigned, f); return (u + 0x7fffu + ((u >> 16) & 1u)) >> 16; }
__device__ __forceinline__ unsigned pk2(float lo, float hi) { return f2bf(lo) | (f2bf(hi) << 16); }
__device__ __forceinline__ float bflo(unsigned w) { return __builtin_bit_cast(float, w << 16); }
__device__ __forceinline__ float bfhi(unsigned w) { return __builtin_bit_cast(float, w & 0xffff0000u); }
__device__ __forceinline__ float bf2f(bf16_t h) { return __builtin_bit_cast(float, (unsigned)h << 16); }
__device__ __forceinline__ float wave_sum(float v) {
#pragma unroll
    for (int o = 32; o >= 1; o >>= 1) v += __shfl_xor(v, o);
    return v;
}
__device__ __forceinline__ int otid() { int t = threadIdx.x; asm volatile("" : "+v"(t)); return t; }
__device__ __forceinline__ float sigmoidf_(float x) { return __builtin_amdgcn_rcpf(1.f + __expf(-x)); }
__device__ __forceinline__ float siluf_(float x) { return x * __builtin_amdgcn_rcpf(1.f + __expf(-x)); }

struct Unit { int pm, pn; };
struct Gemm { const bf16_t* A; const bf16_t* Bt; int lda, ldb, K; };
constexpr int NXCD = 8, WGM = 8;
struct StaticOrder {
    int nM, nN, nwg, G, c;
    __device__ void init(int M, int N, int G_, int c_) { nM = M / 256; nN = N / 256; nwg = nM * nN; G = G_; c = c_; }
    __device__ bool next(int i, Unit& u) const {
        const long L = (long)i * G + c; if (L >= nwg) return false;
        int wgid = (int)L; { const int q = nwg / NXCD, r = nwg % NXCD, xcd = wgid % NXCD, off = wgid / NXCD; wgid = (xcd < r ? xcd * (q + 1) : r * (q + 1) + (xcd - r) * q) + off; }
        const int nig = WGM * nN, gid = wgid / nig, fm = gid * WGM, gsz = (nM - fm) < WGM ? (nM - fm) : WGM;
        u.pm = fm + ((wgid % nig) % gsz); u.pn = (wgid % nig) / gsz; return true;
    }
    __device__ __forceinline__ void a_ready(const Unit&) const {}
    __device__ __forceinline__ void done(const Unit&) const {}
};
struct ListOrder {
    int j, n, nM, pn0;
    __device__ bool next(int i, Unit& u) const { if (i > 0 || j < 0 || j >= n) return false; u.pm = j % nM; u.pn = pn0 + j / nM; return true; }
    __device__ __forceinline__ void a_ready(const Unit&) const {}
    __device__ __forceinline__ void done(const Unit&) const {}
};
struct MergeOrder {
    StaticOrder base;
    __device__ bool next(int i, Unit& u) const { Unit t; if (!base.next(i >> 2, t)) return false; const int pass = i & 3; u.pm = pass * 33 + t.pm; u.pn = pass * 8 + t.pn; return true; }
    __device__ __forceinline__ void a_ready(const Unit&) const {}
    __device__ __forceinline__ void done(const Unit&) const {}
};

struct EpiIn {
    static constexpr bool PERM = true, AFTER_DRAIN = false, KHOOK = false;
    bf16_t* PL;
    __device__ __forceinline__ void operator()(const f32x4 (&acc)[2][2][4][2], const Unit& u, int wr, int wc, int fr, int fq) const {
        const bool gate = u.pn >= (G0 / 256);
#pragma unroll
        for (int ai = 0; ai < 2; ++ai)
#pragma unroll
            for (int m = 0; m < 4; ++m) {
                const int row = u.pm * 256 + ai * 128 + wr * 64 + m * 16 + fr;
#pragma unroll
                for (int bj = 0; bj < 2; ++bj) {
                    const int col = u.pn * 256 + bj * 128 + wc * 32 + 8 * fq;
                    f32x4 v0 = acc[ai][bj][m][0], v1 = acc[ai][bj][m][1];
                    if (gate) {
#pragma unroll
                        for (int e = 0; e < 4; ++e) { v0[e] = sigmoidf_(v0[e]); v1[e] = sigmoidf_(v1[e]); }
                    }
                    u32x4 w; w.x = pk2(v0[0], v0[1]); w.y = pk2(v0[2], v0[3]); w.z = pk2(v1[0], v1[1]); w.w = pk2(v1[2], v1[3]);
                    *(u32x4*)(PL + (size_t)row * NIN + col) = w;
                }
            }
    }
};
struct EpiScale {
    static constexpr bool PERM = true, AFTER_DRAIN = false, KHOOK = false;
    bf16_t* O; int ldc; const float* scale;
    __device__ __forceinline__ void operator()(const f32x4 (&acc)[2][2][4][2], const Unit& u, int wr, int wc, int fr, int fq) const {
#pragma unroll
        for (int bj = 0; bj < 2; ++bj) {
            const int col = u.pn * 256 + bj * 128 + wc * 32 + 8 * fq;
            const f32x4 s0 = *(const f32x4*)(scale + col), s1 = *(const f32x4*)(scale + col + 4);
#pragma unroll
            for (int ai = 0; ai < 2; ++ai)
#pragma unroll
                for (int m = 0; m < 4; ++m) {
                    const int row = u.pm * 256 + ai * 128 + wr * 64 + m * 16 + fr;
                    const f32x4 v0 = acc[ai][bj][m][0] * s0, v1 = acc[ai][bj][m][1] * s1;
                    u32x4 w; w.x = pk2(v0[0], v0[1]); w.y = pk2(v0[2], v0[3]); w.z = pk2(v1[0], v1[1]); w.w = pk2(v1[2], v1[3]);
                    *(u32x4*)(O + (size_t)row * ldc + col) = w;
                }
        }
    }
};
struct EpiMerge {
    static constexpr bool PERM = true, AFTER_DRAIN = false, KHOOK = true;
    const bf16_t* PL; bf16_t* MRGB;
    __device__ __forceinline__ void khook(f32x4 (&acc)[2][2][4][2], const Unit& u, int s, int wr, int wc, int fr, int fq) const {
#pragma unroll
        for (int ai = 0; ai < 2; ++ai)
#pragma unroll
            for (int mh = 0; mh < 2; ++mh) {
                size_t off = ((size_t)(u.pm * 256 + ai * 128 + wr * 64 + mh * 32 + fr) * NIN + G0 + (s - 1) * DM + u.pn * 256 + wc * 32 + 8 * fq) * 2;
                asm volatile("" : "+v"(off));
                const char* gp = (const char*)PL + off;
                u32x4 ga[2][2], gb[2][2];
#pragma unroll
                for (int mm = 0; mm < 2; ++mm)
#pragma unroll
                    for (int bj = 0; bj < 2; ++bj) { const char* p = gp + (size_t)mm * 16 * NIN * 2 + bj * 256; ga[mm][bj] = *(const u32x4*)p; gb[mm][bj] = *(const u32x4*)(p + DM * 2); }
                __builtin_amdgcn_sched_barrier(0);
#pragma unroll
                for (int mm = 0; mm < 2; ++mm)
#pragma unroll
                    for (int bj = 0; bj < 2; ++bj) {
                        const u32x4 a_ = ga[mm][bj], b_ = gb[mm][bj];
                        f32x4& v0 = acc[ai][bj][mh * 2 + mm][0]; f32x4& v1 = acc[ai][bj][mh * 2 + mm][1];
                        v0[0] *= bflo(a_.x) * __builtin_amdgcn_rcpf(fmaxf(bflo(b_.x), 1e-30f)); v0[1] *= bfhi(a_.x) * __builtin_amdgcn_rcpf(fmaxf(bfhi(b_.x), 1e-30f));
                        v0[2] *= bflo(a_.y) * __builtin_amdgcn_rcpf(fmaxf(bflo(b_.y), 1e-30f)); v0[3] *= bfhi(a_.y) * __builtin_amdgcn_rcpf(fmaxf(bfhi(b_.y), 1e-30f));
                        v1[0] *= bflo(a_.z) * __builtin_amdgcn_rcpf(fmaxf(bflo(b_.z), 1e-30f)); v1[1] *= bfhi(a_.z) * __builtin_amdgcn_rcpf(fmaxf(bfhi(b_.z), 1e-30f));
                        v1[2] *= bflo(a_.w) * __builtin_amdgcn_rcpf(fmaxf(bflo(b_.w), 1e-30f)); v1[3] *= bfhi(a_.w) * __builtin_amdgcn_rcpf(fmaxf(bfhi(b_.w), 1e-30f));
                    }
                __builtin_amdgcn_sched_barrier(0);
            }
        asm volatile("s_waitcnt vmcnt(0)" ::: "memory");
    }
    __device__ __forceinline__ void operator()(const f32x4 (&acc)[2][2][4][2], const Unit& u, int wr, int wc, int fr, int fq) const {
#pragma unroll
        for (int ai = 0; ai < 2; ++ai)
#pragma unroll
            for (int m = 0; m < 4; ++m) {
                const int row = u.pm * 256 + ai * 128 + wr * 64 + m * 16 + fr;
#pragma unroll
                for (int bj = 0; bj < 2; ++bj) {
                    const int col = u.pn * 256 + bj * 128 + wc * 32 + 8 * fq;
                    const u32x4 gw = *(const u32x4*)(PL + (size_t)row * NIN + G0 + 3 * DM + col);
                    f32x4 v0 = acc[ai][bj][m][0], v1 = acc[ai][bj][m][1];
                    v0[0] *= bflo(gw.x); v0[1] *= bfhi(gw.x); v0[2] *= bflo(gw.y); v0[3] *= bfhi(gw.y);
                    v1[0] *= bflo(gw.z); v1[1] *= bfhi(gw.z); v1[2] *= bflo(gw.w); v1[3] *= bfhi(gw.w);
                    u32x4 w; w.x = pk2(v0[0], v0[1]); w.y = pk2(v0[2], v0[3]); w.z = pk2(v1[0], v1[1]); w.w = pk2(v1[2], v1[3]);
                    *(u32x4*)(MRGB + (size_t)row * DM + col) = w;
                }
            }
    }
};
struct EpiF32 {
    static constexpr bool PERM = true, AFTER_DRAIN = false, KHOOK = false;
    float* Y; int ldc;
    __device__ __forceinline__ void operator()(const f32x4 (&acc)[2][2][4][2], const Unit& u, int wr, int wc, int fr, int fq) const {
#pragma unroll
        for (int ai = 0; ai < 2; ++ai)
#pragma unroll
            for (int m = 0; m < 4; ++m) {
                const int row = u.pm * 256 + ai * 128 + wr * 64 + m * 16 + fr;
#pragma unroll
                for (int bj = 0; bj < 2; ++bj) {
                    const int col = u.pn * 256 + bj * 128 + wc * 32 + 8 * fq;
                    float* yp = Y + (size_t)row * ldc + col;
                    *(f32x4*)yp = acc[ai][bj][m][0]; *(f32x4*)(yp + 4) = acc[ai][bj][m][1];
                }
            }
    }
};
struct EpiSwiglu {
    static constexpr bool PERM = true, AFTER_DRAIN = false, KHOOK = false;
    bf16_t* H;
    __device__ __forceinline__ void operator()(const f32x4 (&acc)[2][2][4][2], const Unit& u, int wr, int wc, int fr, int fq) const {
#pragma unroll
        for (int ai = 0; ai < 2; ++ai)
#pragma unroll
            for (int m = 0; m < 4; ++m) {
                const int row = u.pm * 256 + ai * 128 + wr * 64 + m * 16 + fr;
                const int col = u.pn * 128 + wc * 32 + 8 * fq;
                f32x4 h0, h1;
#pragma unroll
                for (int e = 0; e < 4; ++e) { h0[e] = siluf_(acc[ai][0][m][0][e]) * acc[ai][1][m][0][e]; h1[e] = siluf_(acc[ai][0][m][1][e]) * acc[ai][1][m][1][e]; }
                u32x4 w; w.x = pk2(h0[0], h0[1]); w.y = pk2(h0[2], h0[3]); w.z = pk2(h1[0], h1[1]); w.w = pk2(h1[2], h1[3]);
                *(u32x4*)(H + (size_t)row * FF + col) = w;
            }
    }
};

#define PG8_LAS __attribute__((address_space(3)))
constexpr int BM = 256, BK = 64, HALF = 128, HTB = HALF * BK * 2, STAGE_BYTES = 8 * HTB;
__device__ __forceinline__ int lds_byte(int r, int c) { const int st = (r >> 4) * 2 + (c >> 5), rr = r & 15, cc = c & 31, ob = rr * 64 + cc * 2; return st * 1024 + (ob ^ (((ob >> 9) & 1) << 5)); }
__device__ __forceinline__ void stage_rc(int b, int& R, int& C) { const int st = b / 1024, sb = b % 1024, swz = sb ^ (((sb >> 9) & 1) << 5); R = (st >> 1) * 16 + swz / 64; C = (st & 1) * 32 + (swz % 64) / 2; }
__device__ __forceinline__ int perm32(int rho) { const int n = rho >> 4, i = rho & 15; return 8 * (i >> 2) + 4 * n + (i & 3); }
template <class Epi, class Sched, bool ALIGN_EPI = true, bool SP2 = true>
__device__ __forceinline__ void gemm_phase(PG8_LAS unsigned char* lds, const Gemm g, const Sched& S, const Epi& E) {
    const int tid = otid(), wid = __builtin_amdgcn_readfirstlane(tid >> 6), lane = tid & 63, wr = wid >> 2, wc = wid & 3, fr = lane & 15, fq = lane >> 4;
    const int K = g.K, nt = K / BK;
    unsigned voffA[2], voffB[2];
#pragma unroll
    for (int i = 0; i < 2; ++i) { int R, C; stage_rc(tid * 16 + i * 8192, R, C); const int Rb = Epi::PERM ? ((R & ~31) + perm32(R & 31)) : R;
        voffA[i] = (unsigned)(R * g.lda + C) * 2u; voffB[i] = (unsigned)(Rb * g.ldb + C) * 2u; }
    const size_t kstep = (size_t)(BK * 2);
    const size_t hstepA = (size_t)HALF * g.lda * 2, hstepB = (size_t)HALF * g.ldb * 2;
    const size_t tstepA = 2 * hstepA, tstepB = 2 * hstepB;
    const unsigned ldsw = (unsigned)wid * 1024u;
    const int aoff = lds_byte(wr * 64 + fr, fq * 8), boff = lds_byte(wc * 32 + fr, fq * 8);
#define PG8_SA(b, h) (((b) * 2 + (h)) * HTB)
#define PG8_SB(b, h) ((4 + (b) * 2 + (h)) * HTB)
#define PG8_STAGE(bufoff, gbase, voff) do { _Pragma("unroll") for (int _i = 0; _i < 2; ++_i) \
        __builtin_amdgcn_global_load_lds((const unsigned*)((const char*)(gbase) + (voff)[_i]), (PG8_LAS unsigned*)(lds + (bufoff) + ldsw + _i * 8192), 16, 0, 0); } while (0)
#define PG8_LDA(dst, b, h) do { _Pragma("unroll") for (int m = 0; m < 4; ++m) _Pragma("unroll") for (int k = 0; k < 2; ++k) dst[m][k] = *(const PG8_LAS bf16x8*)(lds + PG8_SA(b, h) + aoff + m * 2048 + k * 1024); } while (0)
#define PG8_LDB(dst, b, h) do { _Pragma("unroll") for (int n = 0; n < 2; ++n) _Pragma("unroll") for (int k = 0; k < 2; ++k) dst[n][k] = *(const PG8_LAS bf16x8*)(lds + PG8_SB(b, h) + boff + n * 2048 + k * 1024); } while (0)
#define PG8_MMA(ai, bj, At, Bt) do { __builtin_amdgcn_s_setprio(1); _Pragma("unroll") for (int m = 0; m < 4; ++m) _Pragma("unroll") for (int n = 0; n < 2; ++n) _Pragma("unroll") for (int k = 0; k < 2; ++k) \
        acc[ai][bj][m][n] = __builtin_amdgcn_mfma_f32_16x16x32_bf16(Bt[n][k], At[m][k], acc[ai][bj][m][n], 0, 0, 0); __builtin_amdgcn_s_setprio(0); } while (0)
#define PG8_WAIT_V(n) asm volatile("s_waitcnt vmcnt(" #n ")" ::: "memory")
#define PG8_WAIT_L(n) asm volatile("s_waitcnt lgkmcnt(" #n ")" ::: "memory")
#define PG8_BAR __builtin_amdgcn_s_barrier()
#define PG8_SCHED __builtin_amdgcn_sched_barrier(0)
    Unit cur, nxt; int ui = 0;
    if (!S.next(0, cur)) return;
    f32x4 acc[2][2][4][2];
#pragma unroll
    for (int a = 0; a < 2; ++a)
#pragma unroll
        for (int b = 0; b < 2; ++b)
#pragma unroll
            for (int m = 0; m < 4; ++m)
#pragma unroll
                for (int n = 0; n < 2; ++n) acc[a][b][m][n] = (f32x4){0.f, 0.f, 0.f, 0.f};
    bf16x8 At[4][2], B0[2][2], B1[2][2];
    const char* cA = (const char*)g.A + (size_t)cur.pm * tstepA; const char* cB = (const char*)g.Bt + (size_t)cur.pn * tstepB;
    S.a_ready(cur);
    if constexpr (SP2) {
        PG8_STAGE(PG8_SB(0, 0), cB, voffB); PG8_STAGE(PG8_SB(0, 1), cB + hstepB, voffB); PG8_STAGE(PG8_SA(0, 0), cA, voffA); PG8_STAGE(PG8_SA(0, 1), cA + hstepA, voffA);
        if (wr == 1) PG8_BAR;
        PG8_WAIT_V(2); PG8_BAR;
        PG8_STAGE(PG8_SB(1, 0), cB + kstep, voffB); PG8_STAGE(PG8_SA(1, 0), cA + kstep, voffA); PG8_STAGE(PG8_SB(1, 1), cB + hstepB + kstep, voffB);
        PG8_WAIT_V(6); PG8_BAR;
    } else {
        PG8_STAGE(PG8_SB(0, 0), cB, voffB); PG8_STAGE(PG8_SA(0, 0), cA, voffA); PG8_STAGE(PG8_SB(0, 1), cB + hstepB, voffB); PG8_STAGE(PG8_SA(0, 1), cA + hstepA, voffA);
        if (wr == 1) PG8_BAR;
        PG8_WAIT_V(4); PG8_BAR;
        PG8_STAGE(PG8_SB(1, 0), cB + kstep, voffB); PG8_STAGE(PG8_SA(1, 0), cA + kstep, voffA); PG8_STAGE(PG8_SB(1, 1), cB + hstepB + kstep, voffB);
        PG8_WAIT_V(6); PG8_BAR;
    }
    for (;;) {
        const bool has_next = S.next(ui + 1, nxt);
        const char* nA = has_next ? (const char*)g.A + (size_t)nxt.pm * tstepA : cA; const char* nB = has_next ? (const char*)g.Bt + (size_t)nxt.pn * tstepB : cB;
        for (int t = 0; t < nt; t += 2) {
            if constexpr (Epi::KHOOK) { if (t > 0 && (t & 7) == 0) E.khook(acc, cur, t >> 3, wr, wc, fr, fq); }
            const bool last = (t == nt - 2);
            const char* a1 = cA + (size_t)(t + 1) * kstep;
            const char* a2 = last ? nA : cA + (size_t)(t + 2) * kstep; const char* b2 = last ? nB : cB + (size_t)(t + 2) * kstep;
            const char* a3 = a2 + kstep; const char* b3 = b2 + kstep;
            if (last && has_next) S.a_ready(nxt);
            if constexpr (SP2) {
            PG8_LDB(B0, 0, 0); PG8_LDB(B1, 0, 1); PG8_SCHED; PG8_LDA(At, 0, 0); PG8_STAGE(PG8_SA(1, 1), a1 + hstepA, voffA);
            PG8_WAIT_V(8); PG8_WAIT_L(0); PG8_BAR; PG8_MMA(0, 0, At, B0); PG8_MMA(0, 1, At, B1); PG8_BAR; PG8_SCHED;
            PG8_LDA(At, 0, 1); PG8_STAGE(PG8_SB(0, 0), b2, voffB); PG8_STAGE(PG8_SB(0, 1), b2 + hstepB, voffB); PG8_STAGE(PG8_SA(0, 0), a2, voffA);
            PG8_WAIT_V(8); PG8_WAIT_L(0); PG8_BAR; PG8_MMA(1, 0, At, B0); PG8_MMA(1, 1, At, B1); PG8_BAR; PG8_SCHED;
            PG8_LDB(B0, 1, 0); PG8_LDB(B1, 1, 1); PG8_SCHED; PG8_LDA(At, 1, 0); PG8_STAGE(PG8_SA(0, 1), a2 + hstepA, voffA);
            PG8_WAIT_V(8); PG8_WAIT_L(0); PG8_BAR; PG8_MMA(0, 0, At, B0); PG8_MMA(0, 1, At, B1); PG8_BAR; PG8_SCHED;
            PG8_LDA(At, 1, 1); PG8_STAGE(PG8_SB(1, 0), b3, voffB); PG8_STAGE(PG8_SB(1, 1), b3 + hstepB, voffB); PG8_STAGE(PG8_SA(1, 0), a3, voffA);
            PG8_WAIT_V(8); PG8_WAIT_L(0); PG8_BAR; PG8_MMA(1, 0, At, B0); PG8_MMA(1, 1, At, B1); PG8_BAR; PG8_SCHED;
            } else {
            PG8_LDB(B0, 0, 0); PG8_SCHED; PG8_LDA(At, 0, 0); PG8_STAGE(PG8_SA(1, 1), a1 + hstepA, voffA);
            PG8_WAIT_L(8); PG8_BAR; PG8_WAIT_L(0); PG8_MMA(0, 0, At, B0); PG8_BAR; PG8_SCHED;
            PG8_LDB(B1, 0, 1); PG8_STAGE(PG8_SB(0, 0), b2, voffB);
            PG8_BAR; PG8_WAIT_L(0); PG8_MMA(0, 1, At, B1); PG8_BAR;
            PG8_LDA(At, 0, 1); PG8_STAGE(PG8_SA(0, 0), a2, voffA);
            PG8_BAR; PG8_WAIT_L(0); PG8_MMA(1, 0, At, B0); PG8_BAR; PG8_SCHED;
            PG8_STAGE(PG8_SB(0, 1), b2 + hstepB, voffB);
            PG8_WAIT_V(6); PG8_BAR; PG8_MMA(1, 1, At, B1); PG8_BAR;
            PG8_LDB(B0, 1, 0); PG8_SCHED; PG8_LDA(At, 1, 0); PG8_STAGE(PG8_SA(0, 1), a2 + hstepA, voffA);
            PG8_WAIT_L(8); PG8_BAR; PG8_WAIT_L(0); PG8_MMA(0, 0, At, B0); PG8_BAR; PG8_SCHED;
            PG8_LDB(B1, 1, 1); PG8_STAGE(PG8_SB(1, 0), b3, voffB);
            PG8_BAR; PG8_WAIT_L(0); PG8_MMA(0, 1, At, B1); PG8_BAR;
            PG8_LDA(At, 1, 1); PG8_STAGE(PG8_SA(1, 0), a3, voffA);
            PG8_BAR; PG8_WAIT_L(0); PG8_MMA(1, 0, At, B0); PG8_BAR; PG8_SCHED;
            PG8_STAGE(PG8_SB(1, 1), b3 + hstepB, voffB);
            PG8_WAIT_V(6); PG8_BAR; PG8_MMA(1, 1, At, B1); PG8_BAR;
            }
        }
        if constexpr (ALIGN_EPI) { if (wr == 0) PG8_BAR; }
        if constexpr (!Epi::AFTER_DRAIN) { E(acc, cur, wr, wc, fr, fq); S.done(cur); }
        if (!has_next) break;
#pragma unroll
        for (int a = 0; a < 2; ++a)
#pragma unroll
            for (int b = 0; b < 2; ++b)
#pragma unroll
                for (int m = 0; m < 4; ++m)
#pragma unroll
                    for (int n = 0; n < 2; ++n) acc[a][b][m][n] = (f32x4){0.f, 0.f, 0.f, 0.f};
        cur = nxt; cA = nA; cB = nB; ++ui;
        if constexpr (ALIGN_EPI) { if (wr == 1) PG8_BAR; }
    }
    PG8_WAIT_V(0);
    if constexpr (!ALIGN_EPI) { if (wr == 0) PG8_BAR; }
    PG8_BAR;
    if constexpr (Epi::AFTER_DRAIN) { E.fused(acc, cur, wr, wc, fr, fq, lds, wid, lane); S.done(cur); }
#undef PG8_SA
#undef PG8_SB
#undef PG8_STAGE
#undef PG8_LDA
#undef PG8_LDB
#undef PG8_MMA
#undef PG8_WAIT_V
#undef PG8_WAIT_L
#undef PG8_BAR
#undef PG8_SCHED
}

__device__ __forceinline__ void tr_item(const float* src, int ldn, int k0, int n0, bf16_t* dst, int dld, int drow0, int dk0, float* scr, int lane) {
    const float* sp = src + (size_t)k0 * ldn + n0 + lane;
    float t[64];
#pragma unroll
    for (int i = 0; i < 64; ++i) t[i] = __builtin_nontemporal_load(sp + (size_t)i * ldn);
#pragma unroll
    for (int i = 0; i < 64; ++i) scr[i * 65 + lane] = t[i];
    __builtin_amdgcn_s_waitcnt(0); asm volatile("" ::: "memory");
    const int c = lane & 7;
#pragma unroll
    for (int j = 0; j < 8; ++j) {
        const int n = (lane >> 3) + 8 * j; const float* s = scr + (8 * c) * 65 + n;
        u32x4 o; o.x = pk2(s[0], s[65]); o.y = pk2(s[2 * 65], s[3 * 65]); o.z = pk2(s[4 * 65], s[5 * 65]); o.w = pk2(s[6 * 65], s[7 * 65]);
        *(u32x4*)(dst + (size_t)(drow0 + n) * dld + dk0 + 8 * c) = o;
    }
    __builtin_amdgcn_s_waitcnt(0); asm volatile("" ::: "memory");
}

__device__ __forceinline__ void convert_layer(const Args& a, unsigned char* lds, int l, int widx, int nw) {
    const int tid = otid(), wave = tid >> 6, lane = tid & 63;
    float* scr = (float*)(lds + wave * 16640);
    constexpr int I_IN = 32 * 192, I_BR = 4 * 8 * 32, I_O = 32 * 32, I_G = 32 * 88, I_D = 88 * 32, I_B = 16;
    constexpr int PLI = I_IN + I_BR + I_O + 2 * I_G + I_D + I_B;
    unsigned char* wb = a.ws + WS_W + (size_t)l * WPL;
    for (int it = widx; it < PLI; it += nw) {
        int r = it;
        if (r < I_IN) { const int kb = r / 192, nb = r % 192; tr_item(a.in[I_WIN] + (size_t)l * DM * NIN, NIN, kb * 64, nb * 64, (bf16_t*)(wb + W_IN), DM, nb * 64, kb * 64, scr, lane); continue; } r -= I_IN;
        if (r < I_BR) { const int i = r >> 8, rr = r & 255, kb = rr >> 5, nb = rr & 31;
            tr_item(a.in[I_WBR] + (size_t)(l * 4 + i) * 512 * DM, DM, kb * 64, nb * 64, (bf16_t*)(wb + W_BR), DM, nb * 64, i * 512 + kb * 64, scr, lane); continue; } r -= I_BR;
        if (r < I_O) { const int kb = r >> 5, nb = r & 31; tr_item(a.in[I_WO] + (size_t)l * DM * DM, DM, kb * 64, nb * 64, (bf16_t*)(wb + W_O), DM, nb * 64, kb * 64, scr, lane); continue; } r -= I_O;
        if (r < I_G) { const int kb = r / 88, nb = r % 88, n0 = nb * 64; tr_item(a.in[I_WG] + (size_t)l * DM * FF, FF, kb * 64, n0, (bf16_t*)(wb + W_GU), DM, (n0 >> 7) * 256 + (n0 & 127), kb * 64, scr, lane); continue; } r -= I_G;
        if (r < I_G) { const int kb = r / 88, nb = r % 88, n0 = nb * 64; tr_item(a.in[I_WU] + (size_t)l * DM * FF, FF, kb * 64, n0, (bf16_t*)(wb + W_GU), DM, (n0 >> 7) * 256 + 128 + (n0 & 127), kb * 64, scr, lane); continue; } r -= I_G;
        if (r < I_D) { const int kb = r >> 5, nb = r & 31; tr_item(a.in[I_WD] + (size_t)l * FF * DM, DM, kb * 64, nb * 64, (bf16_t*)(wb + W_D), FF, nb * 64, kb * 64, scr, lane); continue; } r -= I_D;
        { const int g = r >> 2, kb = (r >> 1) & 1, nb = r & 1;
          tr_item(a.in[I_BW] + (size_t)(l * 4 + g) * 128 * 128, 128, kb * 64, nb * 64, (bf16_t*)(wb + W_B), 512, g * 128 + nb * 64, g * 128 + kb * 64, scr, lane); }
    }
}
__device__ __forceinline__ void phase_prologue(const Args& a, unsigned char* lds, int vcu, int G) {
    const int tid = otid(), wave = tid >> 6;
    convert_layer(a, lds, 0, vcu * NWAVE + wave, G * NWAVE);
    for (int i = vcu * NTHR + tid; i < 2 * 32768; i += G * NTHR) {
        const int l = i >> 15, j = i & 32767, n = j >> 6, kc = j & 63;
        if ((n >> 7) != (kc >> 4)) *(u32x4*)((bf16_t*)(a.ws + WS_W + (size_t)l * WPL + W_B) + (size_t)n * 512 + kc * 8) = (u32x4){0u, 0u, 0u, 0u};
    }
    float* MOD = (float*)(a.ws + WS_CTL + CTL_MOD);
    for (int it = vcu; it < 768; it += G) {
        const int l = it / 384, r = it % 384, cb = r >> 6, kc = r & 63;
        const int col = cb * 2048 + tid * 4;
        f32x4 al = {0.f, 0.f, 0.f, 0.f}, ac = {0.f, 0.f, 0.f, 0.f};
        const float* wp = a.in[I_ADAW] + ((size_t)l * DM + kc * 32) * NIN + col;
#pragma unroll 8
        for (int k = 0; k < 32; ++k) {
            const float sl = siluf_(a.in[I_C][kc * 32 + k]), sc = siluf_(a.in[I_CCTX][kc * 32 + k]);
            const f32x4 w = *(const f32x4*)(wp + (size_t)k * NIN);
            al += sl * w; ac += sc * w;
        }
        if (kc == 0) { const f32x4 b = *(const f32x4*)(a.in[I_ADAB] + (size_t)l * NIN + col); al += b; ac += b; }
        float* ml = MOD + (size_t)(l * 2 + 0) * NIN + col; float* mc = MOD + (size_t)(l * 2 + 1) * NIN + col;
#pragma unroll
        for (int e = 0; e < 4; ++e) { unsafeAtomicAdd(ml + e, al[e]); unsafeAtomicAdd(mc + e, ac[e]); }
    }
}

template <int MODE>
__device__ __forceinline__ void phase_rows(const Args& a, int vcu, int G, int nrows, const float* gpost, const float* modcur, int gate_idx,
                                           const float* gnext, const float* modnext, int sh_idx) {
    const int tid = otid(), wave = tid >> 6, lane = tid & 63;
    const int gw = vcu * NWAVE + wave, NGW = G * NWAVE;
    float* X = (float*)(a.ws + WS_X); const float* Y = (const float*)(a.ws + WS_MRG); bf16_t* XN = (bf16_t*)(a.ws + WS_XN);
    for (int row = gw; row < nrows; row += NGW) {
        const int isctx = row >= SEQ ? 1 : 0;
        f32x4 x[8];
        if (MODE == 0) {
            const float* src = isctx ? a.in[I_CTX] + (size_t)(row - SEQ) * DM : a.in[I_X] + (size_t)row * DM;
#pragma unroll
            for (int j = 0; j < 8; ++j) x[j] = *(const f32x4*)(src + 4 * lane + 256 * j);
        } else {
            f32x4 y[8]; float ss = 0.f;
#pragma unroll
            for (int j = 0; j < 8; ++j) { x[j] = *(const f32x4*)(X + (size_t)row * DM + 4 * lane + 256 * j); y[j] = *(const f32x4*)(Y + (size_t)row * DM + 4 * lane + 256 * j);
                ss += (y[j][0] * y[j][0] + y[j][1] * y[j][1]) + (y[j][2] * y[j][2] + y[j][3] * y[j][3]); }
            const float rstd = 1.0f / sqrtf(wave_sum(ss) * (1.f / DM) + EPS);
            const float* gate = modcur + (size_t)isctx * NIN + gate_idx * DM;
#pragma unroll
            for (int j = 0; j < 8; ++j) { const int col = 4 * lane + 256 * j; const f32x4 gp = *(const f32x4*)(gpost + col), gt = *(const f32x4*)(gate + col);
                x[j] += gt * (y[j] * rstd * gp); }
        }
        if (MODE == 2) {
#pragma unroll
            for (int j = 0; j < 8; ++j) *(f32x4*)(a.out + (size_t)row * DM + 4 * lane + 256 * j) = x[j];
            continue;
        }
        float ss = 0.f;
#pragma unroll
        for (int j = 0; j < 8; ++j) { *(f32x4*)(X + (size_t)row * DM + 4 * lane + 256 * j) = x[j];
            ss += (x[j][0] * x[j][0] + x[j][1] * x[j][1]) + (x[j][2] * x[j][2] + x[j][3] * x[j][3]); }
        const float rstd = 1.0f / sqrtf(wave_sum(ss) * (1.f / DM) + EPS);
        const float* sh = modnext + (size_t)isctx * NIN + sh_idx * DM; const float* sc = sh + DM;
#pragma unroll
        for (int j = 0; j < 8; ++j) { const int col = 4 * lane + 256 * j; const f32x4 gn = *(const f32x4*)(gnext + col), s1 = *(const f32x4*)(sc + col), s0 = *(const f32x4*)(sh + col);
            const f32x4 h = (x[j] * rstd * gn) * (1.f + s1) + s0;
            u32x2 w; w.x = pk2(h[0], h[1]); w.y = pk2(h[2], h[3]); *(u32x2*)(XN + (size_t)row * DM + col) = w; }
    }
}

__device__ __forceinline__ void qk_prep_row(const Args& a, int layer, int row, int lane) {
    bf16_t* p = (bf16_t*)(a.ws + WS_PL) + (size_t)row * NIN;
    const int ax = lane >> 5, f = lane & 31, d1 = ax * 64 + f, d2 = d1 + 32;
    float cs = 1.f, sn = 0.f;
    if (row < SEQ) { const float pos = (float)(ax == 0 ? (row >> 6) : (row & 63)); const float inv = exp2f(-(float)f * (13.287712379549449f / 32.f)); const float ang = pos * inv; cs = cosf(ang); sn = sinf(ang); }
#pragma unroll
    for (int h = 0; h < 6; ++h) {
        const float* gn = (h < 4 ? a.in[I_AQN] : a.in[I_AKN]) + layer * HD;
        bf16_t* hp = p + h * HD;
        float x1 = bf2f(hp[d1]), x2 = bf2f(hp[d2]);
        const float rstd = 1.0f / sqrtf(wave_sum(x1 * x1 + x2 * x2) * (1.f / HD) + EPS);
        x1 = x1 * rstd * gn[d1]; x2 = x2 * rstd * gn[d2];
        hp[d1] = (bf16_t)f2bf(x1 * cs - x2 * sn); hp[d2] = (bf16_t)f2bf(x2 * cs + x1 * sn);
    }
}
__device__ __forceinline__ void dlt_row(const Args& a, int row, int lane) {
    const bf16_t* PL = (const bf16_t*)(a.ws + WS_PL); bf16_t* DLT = (bf16_t*)(a.ws + WS_DLT);
    const int base = row < SEQ ? 0 : SEQ, n = row < SEQ ? SEQ : CTXL, t = row - base, half = 1 << (lane >> 4);
    const int lo = max(t - half, 0), hi = min(t + half, n);
    float s[8];
#pragma unroll
    for (int e = 0; e < 8; ++e) s[e] = 0.f;
    u32x4 w[16];
#pragma unroll
    for (int i = 0; i < 16; ++i) { const int r = min(max(t - 8 + i, 0), n - 1); w[i] = *(const u32x4*)(PL + (size_t)(base + r) * NIN + B0 + lane * 8); }
#pragma unroll
    for (int i = 0; i < 16; ++i) { const int r = t - 8 + i; const float m = (r >= lo && r < hi) ? 1.f : 0.f;
        s[0] += m * bflo(w[i].x); s[1] += m * bfhi(w[i].x); s[2] += m * bflo(w[i].y); s[3] += m * bfhi(w[i].y); s[4] += m * bflo(w[i].z); s[5] += m * bfhi(w[i].z); s[6] += m * bflo(w[i].w); s[7] += m * bfhi(w[i].w); }
    const float inv = 1.f / (float)(hi - lo);
    const u32x4 c = w[8];
    u32x4 o; o.x = pk2(s[0] * inv - bflo(c.x), s[1] * inv - bfhi(c.x)); o.y = pk2(s[2] * inv - bflo(c.y), s[3] * inv - bfhi(c.y));
    o.z = pk2(s[4] * inv - bflo(c.z), s[5] * inv - bfhi(c.z)); o.w = pk2(s[6] * inv - bflo(c.w), s[7] * inv - bfhi(c.w));
    *(u32x4*)(DLT + (size_t)row * 512 + lane * 8) = o;
}
constexpr int CP = 136;
__device__ __forceinline__ void cmix_unit(const Args& a, int layer, int unit, unsigned char* lds) {
    const int tid = otid(), wave = tid >> 6, lane = tid & 63, chunk = unit >> 2, g = unit & 3;
    const bf16_t* PL = (const bf16_t*)(a.ws + WS_PL); bf16_t* OUT = (bf16_t*)(a.ws + WS_OUTS) + 2 * 512;
    bf16_t* vT = (bf16_t*)lds;
    bf16_t* wsL = (bf16_t*)(lds + 128 * CP * 2);
    float* st = (float*)(lds + 2 * 128 * CP * 2);
    const int t0 = chunk * 128;
    for (int i = 0; i < 16; ++i) {
        const int q = wave * 16 + i;
        const u32x4 w = *(const u32x4*)(PL + (size_t)(t0 + q) * NIN + C_V0 + lane * 8);
        float x[8] = {bflo(w.x), bfhi(w.x), bflo(w.y), bfhi(w.y), bflo(w.z), bfhi(w.z), bflo(w.w), bfhi(w.w)};
        float s = 0.f;
#pragma unroll
        for (int e = 0; e < 8; ++e) s += x[e];
        const float mean = wave_sum(s) * (1.f / 512.f); float q2 = 0.f;
#pragma unroll
        for (int e = 0; e < 8; ++e) { const float d = x[e] - mean; q2 += d * d; }
        const float rstd = 1.0f / sqrtf(wave_sum(q2) * (1.f / 512.f) + EPS);
        if (lane == 0) { st[2 * q] = mean; st[2 * q + 1] = rstd; }
    }
    __syncthreads();
    {
        const int q = tid & 127, cb = tid >> 7; const float mean = st[2 * q], rstd = st[2 * q + 1];
        const float* lg = a.in[I_CNG] + layer * 512 + g * 128 + cb * 32; const float* lb = a.in[I_CNB] + layer * 512 + g * 128 + cb * 32;
        const bf16_t* vp = PL + (size_t)(t0 + q) * NIN + C_V0 + g * 128 + cb * 32;
#pragma unroll
        for (int j = 0; j < 4; ++j) { const u32x4 w = *(const u32x4*)(vp + j * 8);
            const float x[8] = {bflo(w.x), bfhi(w.x), bflo(w.y), bfhi(w.y), bflo(w.z), bfhi(w.z), bflo(w.w), bfhi(w.w)};
#pragma unroll
            for (int e = 0; e < 8; ++e) { const int c = j * 8 + e; vT[(cb * 32 + c) * CP + q] = (bf16_t)f2bf((x[e] - mean) * rstd * lg[c] + lb[c]); } }
        const int p = tid >> 2, qb = (tid & 3) * 32; const float* wp = a.in[I_CWS] + ((size_t)(layer * 4 + g) * 128 + p) * 128 + qb;
#pragma unroll
        for (int j = 0; j < 8; ++j) { const f32x4 w = *(const f32x4*)(wp + j * 4); u32x2 o; o.x = pk2(w[0], w[1]); o.y = pk2(w[2], w[3]); *(u32x2*)(wsL + p * CP + qb + j * 4) = o; }
    }
    __syncthreads();
    {
        const int fr = lane & 15, fq = lane >> 4;
        f32x4 acc[8];
#pragma unroll
        for (int nb = 0; nb < 8; ++nb) acc[nb] = (f32x4){0.f, 0.f, 0.f, 0.f};
#pragma unroll
        for (int ks = 0; ks < 4; ++ks) {
            const bf16x8 wf = *(const bf16x8*)(wsL + (wave * 16 + fr) * CP + ks * 32 + fq * 8);
#pragma unroll
            for (int nb = 0; nb < 8; ++nb) { const bf16x8 vf = *(const bf16x8*)(vT + (nb * 16 + fr) * CP + ks * 32 + fq * 8);
                acc[nb] = __builtin_amdgcn_mfma_f32_16x16x32_bf16(vf, wf, acc[nb], 0, 0, 0); }
        }
        const int p = wave * 16 + fr; const float bs = a.in[I_CBS][(layer * 4 + g) * 128 + p];
        const bf16_t* up = PL + (size_t)(t0 + p) * NIN + C_U0 + g * 128; bf16_t* op = OUT + (size_t)(t0 + p) * DM + g * 128;
#pragma unroll
        for (int nb = 0; nb < 8; ++nb) { const int c = nb * 16 + 4 * fq; const u32x2 uw = *(const u32x2*)(up + c);
            u32x2 o; o.x = pk2((acc[nb][0] + bs) * bflo(uw.x), (acc[nb][1] + bs) * bfhi(uw.x)); o.y = pk2((acc[nb][2] + bs) * bflo(uw.y), (acc[nb][3] + bs) * bfhi(uw.y));
            *(u32x2*)(op + c) = o; }
    }
    __syncthreads();
}

template <int MODE>
__device__ __forceinline__ void attn_simple_item(const bf16_t* PL, int qcol, int kcol, int vcol, bf16_t* O, int qrow, int h, int kvh, int kbeg, int kend, const float* rpb, int lane) {
    constexpr float C = 0.088388347648318440f * 1.4426950408889634f;
    const int part = lane & 3;
    float q[32], o[32];
    { const bf16_t* qp = PL + (size_t)qrow * NIN + qcol + h * HD + part * 32;
#pragma unroll
      for (int j = 0; j < 4; ++j) { const u32x4 w = *(const u32x4*)(qp + j * 8);
          q[j * 8 + 0] = bflo(w.x) * C; q[j * 8 + 1] = bfhi(w.x) * C; q[j * 8 + 2] = bflo(w.y) * C; q[j * 8 + 3] = bfhi(w.y) * C;
          q[j * 8 + 4] = bflo(w.z) * C; q[j * 8 + 5] = bfhi(w.z) * C; q[j * 8 + 6] = bflo(w.w) * C; q[j * 8 + 7] = bfhi(w.w) * C; } }
#pragma unroll
    for (int d = 0; d < 32; ++d) o[d] = 0.f;
    float mrun = -1e30f, l = 0.f;
    const int r = qrow >> 6, c = qrow & 63, r0 = min(max(r - 4, 0), 120), c0 = min(max(c - 8, 0), 48);
    const int nk = MODE == 0 ? (kend - kbeg) : 384;
    for (int idx = 0; idx < nk; ++idx) {
        int krow; float bias = 0.f;
        if (MODE == 0) krow = kbeg + idx;
        else if (idx < 128) { const int i = idx >> 4, j = idx & 15; krow = (r0 + i) * GW + c0 + j; bias = rpb[(h * 15 + (r0 + i - r + 7)) * 31 + (c0 + j - c + 15)] * 1.4426950408889634f; }
        else krow = SEQ + idx - 128;
        const bf16_t* kp = PL + (size_t)krow * NIN + kcol + kvh * HD + part * 32;
        float s = 0.f;
#pragma unroll
        for (int j = 0; j < 4; ++j) { const u32x4 w = *(const u32x4*)(kp + j * 8);
            s += q[j * 8 + 0] * bflo(w.x) + q[j * 8 + 1] * bfhi(w.x) + q[j * 8 + 2] * bflo(w.y) + q[j * 8 + 3] * bfhi(w.y)
               + q[j * 8 + 4] * bflo(w.z) + q[j * 8 + 5] * bfhi(w.z) + q[j * 8 + 6] * bflo(w.w) + q[j * 8 + 7] * bfhi(w.w); }
        s += __shfl_xor(s, 1); s += __shfl_xor(s, 2);
        s += bias;
        const float mn = fmaxf(mrun, s), alpha = exp2f(mrun - mn), p = exp2f(s - mn);
        l = l * alpha + p; mrun = mn;
        const bf16_t* vp = PL + (size_t)krow * NIN + vcol + kvh * HD + part * 32;
#pragma unroll
        for (int j = 0; j < 4; ++j) { const u32x4 w = *(const u32x4*)(vp + j * 8);
            o[j * 8 + 0] = o[j * 8 + 0] * alpha + p * bflo(w.x); o[j * 8 + 1] = o[j * 8 + 1] * alpha + p * bfhi(w.x);
            o[j * 8 + 2] = o[j * 8 + 2] * alpha + p * bflo(w.y); o[j * 8 + 3] = o[j * 8 + 3] * alpha + p * bfhi(w.y);
            o[j * 8 + 4] = o[j * 8 + 4] * alpha + p * bflo(w.z); o[j * 8 + 5] = o[j * 8 + 5] * alpha + p * bfhi(w.z);
            o[j * 8 + 6] = o[j * 8 + 6] * alpha + p * bflo(w.w); o[j * 8 + 7] = o[j * 8 + 7] * alpha + p * bfhi(w.w); }
    }
    const float il = 1.f / l;
    bf16_t* op = O + (size_t)qrow * 512 + h * HD + part * 32;
#pragma unroll
    for (int j = 0; j < 4; ++j) { u32x4 w; w.x = pk2(o[j * 8 + 0] * il, o[j * 8 + 1] * il); w.y = pk2(o[j * 8 + 2] * il, o[j * 8 + 3] * il);
        w.z = pk2(o[j * 8 + 4] * il, o[j * 8 + 5] * il); w.w = pk2(o[j * 8 + 6] * il, o[j * 8 + 7] * il); *(u32x4*)(op + j * 8) = w; }
}


namespace att {
using s16x4 = __attribute__((ext_vector_type(4))) short;
using f32x16 = __attribute__((ext_vector_type(16))) float;
constexpr int KVBLK = 64;
constexpr float SCALE = 0.088388347648318440f, THR = 8.f;
constexpr int SHM_V = KVBLK * HD * 2, SHM_K = KVBLK * HD * 2, SHM_ATTN = 2 * SHM_V + 2 * SHM_K + NWAVE * 64 * 4;
#define KSWZ(row, colB) ((row) * 256 + ((colB) ^ (((row) & 7) << 4)))
#define SBAR() __builtin_amdgcn_sched_barrier(0)
__device__ __forceinline__ int crow(int r, int hi) { return (r & 3) + 8 * (r >> 2) + 4 * hi; }
__device__ __forceinline__ unsigned cvtpk(float lo, float hi) { unsigned r; asm volatile("v_cvt_pk_bf16_f32 %0, %1, %2" : "=v"(r) : "v"(lo), "v"(hi)); return r; }
__device__ __forceinline__ void partialSM(f32x16& p0, f32x16& p1, float& m_reg, float& mn, float& alpha) {
  constexpr float C = SCALE * 1.4426950408889634f;
  float pmax = p0[0];
#pragma unroll
  for (int r = 1; r < 16; ++r) pmax = fmaxf(pmax, p0[r]);
#pragma unroll
  for (int r = 0; r < 16; ++r) pmax = fmaxf(pmax, p1[r]);
  { auto rr = __builtin_amdgcn_permlane32_swap(__float_as_uint(pmax), __float_as_uint(pmax), false, false);
    pmax = fmaxf(__uint_as_float(rr[0]), __uint_as_float(rr[1])); }
  if (__builtin_expect(__all(pmax - m_reg <= THR / SCALE), 1)) { mn = m_reg; alpha = 1.f; }
  else { mn = fmaxf(m_reg, pmax); alpha = __builtin_amdgcn_exp2f((m_reg - mn) * C); m_reg = mn; }
  float mnC = -mn * C;
#pragma unroll
  for (int r = 0; r < 16; ++r) p0[r] = fmaf(p0[r], C, mnC);
#pragma unroll
  for (int r = 0; r < 16; ++r) p1[r] = fmaf(p1[r], C, mnC);
#pragma unroll
  for (int r = 0; r < 16; ++r) p0[r] = __builtin_amdgcn_exp2f(p0[r]);
}
__device__ __forceinline__ void finishSM(f32x16& p0, f32x16& p1, float alpha, float& l_reg, bf16x8& pa0, bf16x8& pa1, bf16x8& pa2, bf16x8& pa3) {
#pragma unroll
  for (int r = 0; r < 16; ++r) p1[r] = __builtin_amdgcn_exp2f(p1[r]);
  float ps = 0;
#pragma unroll
  for (int r = 0; r < 16; ++r) ps += p0[r];
#pragma unroll
  for (int r = 0; r < 16; ++r) ps += p1[r];
  { auto rr = __builtin_amdgcn_permlane32_swap(__float_as_uint(ps), __float_as_uint(ps), false, false);
    ps = __uint_as_float(rr[0]) + __uint_as_float(rr[1]); }
  l_reg = l_reg * alpha + ps;
#define PK4(P, BASE, OUT) do { unsigned a0 = cvtpk(P[BASE + 0], P[BASE + 1]), a1 = cvtpk(P[BASE + 2], P[BASE + 3]);   \
    unsigned b0 = cvtpk(P[BASE + 4], P[BASE + 5]), b1 = cvtpk(P[BASE + 6], P[BASE + 7]);                              \
    auto r0 = __builtin_amdgcn_permlane32_swap(a0, b0, false, false); auto r1 = __builtin_amdgcn_permlane32_swap(a1, b1, false, false); \
    u32x4 w = {r0[0], r1[0], r0[1], r1[1]}; OUT = *reinterpret_cast<bf16x8*>(&w); } while (0)
  PK4(p0, 0, pa0); PK4(p0, 8, pa1); PK4(p1, 0, pa2); PK4(p1, 8, pa3);
#undef PK4
}
__device__ __forceinline__ void qkt(f32x16& p0, f32x16& p1, const char* Ks, const bf16x8* qr, int r32, int hi) {
  p0 = f32x16{}; p1 = f32x16{};
#pragma unroll
  for (int d0 = 0; d0 < 8; ++d0) { int cb = (d0 * 16 + hi * 8) * 2;
    bf16x8 b0 = *reinterpret_cast<const bf16x8*>(Ks + KSWZ(r32, cb));
    bf16x8 b1 = *reinterpret_cast<const bf16x8*>(Ks + KSWZ(32 + r32, cb));
    p0 = __builtin_amdgcn_mfma_f32_32x32x16_bf16(b0, qr[d0], p0, 0, 0, 0);
    p1 = __builtin_amdgcn_mfma_f32_32x32x16_bf16(b1, qr[d0], p1, 0, 0, 0); }
}
__device__ __forceinline__ int v_st(int k, int c) { const int kk = (k & ~0xC) | ((k & 4) << 1) | ((k & 8) >> 1); return ((kk >> 3) * 4 + (c >> 5)) * 512 + ((kk & 7) * 32 + (c & 31)) * 2; }
__device__ __forceinline__ int v_rd_base(int lane) { return ((lane & 3) << 3) | (((lane >> 2) & 3) << 6) | (((lane >> 4) & 1) << 5) | (((lane >> 5) & 1) << 8); }
constexpr int v_rd_off(int d0, int ks, int half) { return d0 * 512 + ks * 4096 + half * 2048; }
template <int OFF> __device__ __forceinline__ s16x4 tr_read(int vb) {
  s16x4 r; asm volatile("ds_read_b64_tr_b16 %0, %1 offset:%2" : "=&v"(r) : "v"(vb), "i"(OFF) : "memory"); return r;
}
template <int D0> __device__ __forceinline__ void pv_one(f32x16& od, int vb, bf16x8 pa0, bf16x8 pa1, bf16x8 pa2, bf16x8 pa3) {
  const s16x4 l0 = tr_read<v_rd_off(D0, 0, 0)>(vb), h0 = tr_read<v_rd_off(D0, 0, 1)>(vb), l1 = tr_read<v_rd_off(D0, 1, 0)>(vb), h1 = tr_read<v_rd_off(D0, 1, 1)>(vb);
  const s16x4 l2 = tr_read<v_rd_off(D0, 2, 0)>(vb), h2 = tr_read<v_rd_off(D0, 2, 1)>(vb), l3 = tr_read<v_rd_off(D0, 3, 0)>(vb), h3 = tr_read<v_rd_off(D0, 3, 1)>(vb);
  asm volatile("s_waitcnt lgkmcnt(0)" ::: "memory"); SBAR();
#define PK(L, H) (bf16x8){L[0], L[1], L[2], L[3], H[0], H[1], H[2], H[3]}
  od = __builtin_amdgcn_mfma_f32_32x32x16_bf16(pa0, PK(l0, h0), od, 0, 0, 0);
  od = __builtin_amdgcn_mfma_f32_32x32x16_bf16(pa1, PK(l1, h1), od, 0, 0, 0);
  od = __builtin_amdgcn_mfma_f32_32x32x16_bf16(pa2, PK(l2, h2), od, 0, 0, 0);
  od = __builtin_amdgcn_mfma_f32_32x32x16_bf16(pa3, PK(l3, h3), od, 0, 0, 0);
#undef PK
}
__device__ __forceinline__ void pv_d0(f32x16* o, int vb, bf16x8 pa0, bf16x8 pa1, bf16x8 pa2, bf16x8 pa3) {
  pv_one<0>(o[0], vb, pa0, pa1, pa2, pa3); pv_one<1>(o[1], vb, pa0, pa1, pa2, pa3); pv_one<2>(o[2], vb, pa0, pa1, pa2, pa3); pv_one<3>(o[3], vb, pa0, pa1, pa2, pa3);
}
__device__ __forceinline__ void na_hook(f32x16& p0, f32x16& p1, int kr, int qr, int qc, int hi, const float* rpbh) {
  const int r0 = min(max(qr - 4, 0), 120), c0 = min(max(qc - 8, 0), 48);
  if (kr < r0 || kr >= r0 + 8) {
#pragma unroll
    for (int r = 0; r < 16; ++r) { p0[r] = -1e30f; p1[r] = -1e30f; }
  } else {
    const float* bp = rpbh + (kr - qr + 7) * 31 + 15 - qc;
#pragma unroll
    for (int r = 0; r < 16; ++r) {
      const int kc0 = crow(r, hi), kc1 = 32 + kc0;
      const bool v0 = (unsigned)(kc0 - c0) < 16u, v1 = (unsigned)(kc1 - c0) < 16u;
      const float b0 = v0 ? bp[kc0] : 0.f, b1 = v1 ? bp[kc1] : 0.f;
      p0[r] = v0 ? fmaf(b0, 1.f / SCALE, p0[r]) : -1e30f;
      p1[r] = v1 ? fmaf(b1, 1.f / SCALE, p1[r]) : -1e30f;
      if ((r & 3) == 3) SBAR();
    }
  }
}
template <int MODE, bool DIRECT>
__device__ __forceinline__ void attn_unit(const bf16_t* __restrict__ PL, int qrow0, int qcol, int kcol, int vcol, int NT, int base0, int n0, int base1,
                                          const float* rpbh, bf16_t* Obf, float* Opart, float* LSE, char* lds) {
  const int tid = otid(), wid = tid >> 6, lane = tid & 63, r32 = lane & 31, hi = lane >> 5;
  char* V_lds = lds; char* K_lds = lds + 2 * SHM_V;
  float* wsf = (float*)(lds + 2 * SHM_V + 2 * SHM_K) + wid * 64; float* li_l = wsf; float* al_l = wsf + 32;
  float m_reg = -1e30f, l_reg = 0; f32x16 o[4] = {}; bf16x8 qr[8];
  const bf16_t* Qw = PL + (size_t)(qrow0 + wid * 32 + r32) * NIN + qcol + hi * 8;
#pragma unroll
  for (int d0 = 0; d0 < 8; ++d0) qr[d0] = *reinterpret_cast<const bf16x8*>(Qw + d0 * 16);
  const int qgr = __builtin_amdgcn_readfirstlane((qrow0 + wid * 32) >> 6);
  const int sr = tid >> 4, sc = (tid & 15) * 8, vst0 = v_st(sr, sc), vst1 = v_st(32 + sr, sc);
  const int vb0 = (int)(uintptr_t)V_lds + v_rd_base(lane);
  const bf16_t* Kg = PL + (size_t)sr * NIN + kcol + sc; const bf16_t* Vg = PL + (size_t)sr * NIN + vcol + sc;
  constexpr int SD = 1;
  struct { bf16x8 vs0, vs1, ks0, ks1; } sr_[SD];
#define KROW(j) ((j) < n0 ? base0 + 64 * (j) : base1 + 64 * ((j) - n0))
#define SLOAD(i, j) do { const size_t ko_ = (size_t)KROW(j) * NIN; sr_[i].vs0 = *reinterpret_cast<const bf16x8*>(Vg + ko_); sr_[i].vs1 = *reinterpret_cast<const bf16x8*>(Vg + ko_ + (size_t)32 * NIN); \
    sr_[i].ks0 = *reinterpret_cast<const bf16x8*>(Kg + ko_); sr_[i].ks1 = *reinterpret_cast<const bf16x8*>(Kg + ko_ + (size_t)32 * NIN); } while (0)
#define SWRITE(b, i) do { *(bf16x8*)(V_lds + (b) * SHM_V + vst0) = sr_[i].vs0;          \
    *(bf16x8*)(V_lds + (b) * SHM_V + vst1) = sr_[i].vs1; int kc = sc * 2;               \
    *(bf16x8*)(K_lds + (b) * SHM_K + KSWZ(sr, kc)) = sr_[i].ks0;                       \
    *(bf16x8*)(K_lds + (b) * SHM_K + KSWZ(32 + sr, kc)) = sr_[i].ks1; } while (0)
#define SWAIT() do { if constexpr (SD == 2) asm volatile("s_waitcnt vmcnt(4)" ::: "memory"); else asm volatile("s_waitcnt vmcnt(0)" ::: "memory"); } while (0)
#define RESC(a) do { if (__any((a) < 1.f)) { if (hi == 0) al_l[r32] = (a); asm volatile("s_waitcnt lgkmcnt(0)" ::: "memory"); \
    _Pragma("unroll") for (int d = 0; d < 4; ++d) _Pragma("unroll") for (int r = 0; r < 16; ++r) o[d][r] *= al_l[crow(r, hi)]; } } while (0)
#define HOOK(P0, P1, j) do { if (MODE == 1) { if ((j) >= n0) na_hook(P0, P1, (base1 >> 6) + (j) - n0, qgr, ((wid & 1) << 5) + r32, hi, rpbh); } } while (0)
  f32x16 pA0, pA1, pB0, pB1; float mnA, mnB, alA, alB; bf16x8 pa0, pa1, pa2, pa3;
  constexpr int SE = 0, SO = SD - 1;
  SLOAD(SE, 0); asm volatile("s_waitcnt vmcnt(0)" ::: "memory"); SWRITE(0, SE); __syncthreads();
  qkt(pA0, pA1, K_lds, qr, r32, hi); HOOK(pA0, pA1, 0); partialSM(pA0, pA1, m_reg, mnA, alA);
  SLOAD(SO, 1); if constexpr (SD == 2) { if (2 < NT) SLOAD(SE, 2); }
  SWAIT(); SWRITE(1, SO); __syncthreads();
  for (int j = 1; j + 1 < NT; j += 2) {
    SBAR(); qkt(pB0, pB1, K_lds + SHM_K, qr, r32, hi); HOOK(pB0, pB1, j);
    finishSM(pA0, pA1, alA, l_reg, pa0, pa1, pa2, pa3); SBAR();
    SLOAD(SO, j + SD); SBAR();
    pv_d0(o, vb0, pa0, pa1, pa2, pa3); partialSM(pB0, pB1, m_reg, mnB, alB);
    __syncthreads(); SWAIT(); SWRITE(0, SE);
    RESC(alB); __syncthreads();
    SBAR(); qkt(pA0, pA1, K_lds, qr, r32, hi); HOOK(pA0, pA1, j + 1);
    finishSM(pB0, pB1, alB, l_reg, pa0, pa1, pa2, pa3); SBAR();
    if (SD == 1 || j + 3 < NT) SLOAD(SE, j + 1 + SD); SBAR();
    pv_d0(o, vb0 + SHM_V, pa0, pa1, pa2, pa3); partialSM(pA0, pA1, m_reg, mnA, alA);
    __syncthreads(); SWAIT(); SWRITE(1, SO);
    RESC(alA); __syncthreads();
  }
  SBAR(); qkt(pB0, pB1, K_lds + SHM_K, qr, r32, hi); HOOK(pB0, pB1, NT - 1);
  finishSM(pA0, pA1, alA, l_reg, pa0, pa1, pa2, pa3); SBAR();
  pv_d0(o, vb0, pa0, pa1, pa2, pa3); partialSM(pB0, pB1, m_reg, mnB, alB);
  __syncthreads(); RESC(alB);
  finishSM(pB0, pB1, alB, l_reg, pa0, pa1, pa2, pa3); SBAR();
  pv_d0(o, vb0 + SHM_V, pa0, pa1, pa2, pa3);
  if (hi == 0) li_l[r32] = l_reg; asm volatile("s_waitcnt lgkmcnt(0)" ::: "memory");
  float rli[16];
#pragma unroll
  for (int r = 0; r < 16; ++r) rli[r] = __builtin_amdgcn_rcpf(li_l[crow(r, hi)]);
  if (DIRECT) {
    bf16_t* Ow = Obf + (size_t)(wid * 32) * DM;
#pragma unroll
    for (int r = 0; r < 16; ++r) { const int orow = crow(r, hi);
#pragma unroll
      for (int d0 = 0; d0 < 4; ++d0) Ow[(size_t)orow * DM + d0 * 32 + r32] = (bf16_t)f2bf(o[d0][r] * rli[r]); }
  } else {
    float* Ow = Opart + (size_t)(wid * 32) * 512;
#pragma unroll
    for (int r = 0; r < 16; ++r) { const int orow = crow(r, hi);
#pragma unroll
      for (int d0 = 0; d0 < 4; ++d0) Ow[(size_t)orow * 512 + d0 * 32 + r32] = o[d0][r] * rli[r]; }
    if (hi == 0) LSE[(size_t)(wid * 32 + r32) * 4] = m_reg * (SCALE * 1.4426950408889634f) + log2f(l_reg);
  }
  __syncthreads();
#undef KROW
#undef SLOAD
#undef SWRITE
#undef SWAIT
#undef RESC
#undef HOOK
}
__device__ __forceinline__ void attn_unit_na(const bf16_t* __restrict__ PL, int qrow0, int qcol, int kcol, int vcol, int R0, const float* rpbh, bf16_t* Obf, char* lds) {
  const int tid = otid(), wid = tid >> 6, lane = tid & 63, r32 = lane & 31, hi = lane >> 5;
  constexpr int NT = 16, n0 = 4;
  char* V_lds = lds; char* K_lds = lds + 2 * SHM_V;
  float* wsf = (float*)(lds + 2 * SHM_V + 2 * SHM_K) + wid * 64; float* li_l = wsf; float* al_l = wsf + 32;
  float m_reg = -1e30f, l_reg = 0; f32x16 o[4] = {}; bf16x8 qr[8];
  const bf16_t* Qw = PL + (size_t)(qrow0 + wid * 32 + r32) * NIN + qcol + hi * 8;
#pragma unroll
  for (int d0 = 0; d0 < 8; ++d0) qr[d0] = *reinterpret_cast<const bf16x8*>(Qw + d0 * 16);
  const int qgr = (qrow0 + wid * 32) >> 6, qgc = ((wid & 1) << 5) + r32;
  const int sr = tid >> 4, sc = (tid & 15) * 8, vst0 = v_st(sr, sc), vst1 = v_st(32 + sr, sc);
  const int vb0 = (int)(uintptr_t)V_lds + v_rd_base(lane);
  const bf16_t* Kg = PL + (size_t)sr * NIN + kcol + sc; const bf16_t* Vg = PL + (size_t)sr * NIN + vcol + sc;
  bf16x8 vs0, vs1, ks0, ks1;
#define KROW(j) ((j) < n0 ? SEQ + 64 * (j) : (R0 + (j) - n0) * 64)
#define SLOAD(j) do { const size_t ko_ = (size_t)KROW(j) * NIN; vs0 = *reinterpret_cast<const bf16x8*>(Vg + ko_); vs1 = *reinterpret_cast<const bf16x8*>(Vg + ko_ + (size_t)32 * NIN); \
    ks0 = *reinterpret_cast<const bf16x8*>(Kg + ko_); ks1 = *reinterpret_cast<const bf16x8*>(Kg + ko_ + (size_t)32 * NIN); } while (0)
  SLOAD(0);
  for (int j = 0; j < NT; ++j) {
    asm volatile("s_waitcnt vmcnt(0)" ::: "memory");
    *(bf16x8*)(V_lds + vst0) = vs0; *(bf16x8*)(V_lds + vst1) = vs1;
    *(bf16x8*)(K_lds + KSWZ(sr, sc * 2)) = ks0; *(bf16x8*)(K_lds + KSWZ(32 + sr, sc * 2)) = ks1;
    __syncthreads();
    if (j + 1 < NT) SLOAD(j + 1);
    f32x16 p0, p1; float mn, al; bf16x8 pa0, pa1, pa2, pa3;
    qkt(p0, p1, K_lds, qr, r32, hi);
    if (j >= n0) na_hook(p0, p1, R0 + j - n0, qgr, qgc, hi, rpbh);
    partialSM(p0, p1, m_reg, mn, al);
    if (__any(al < 1.f)) { if (hi == 0) al_l[r32] = al; asm volatile("s_waitcnt lgkmcnt(0)" ::: "memory");
#pragma unroll
      for (int d = 0; d < 4; ++d)
#pragma unroll
        for (int r = 0; r < 16; ++r) o[d][r] *= al_l[crow(r, hi)]; }
    finishSM(p0, p1, al, l_reg, pa0, pa1, pa2, pa3); SBAR();
    pv_d0(o, vb0, pa0, pa1, pa2, pa3);
    __syncthreads();
  }
  if (hi == 0) li_l[r32] = l_reg; asm volatile("s_waitcnt lgkmcnt(0)" ::: "memory");
  bf16_t* Ow = Obf + (size_t)(wid * 32) * DM;
#pragma unroll
  for (int r = 0; r < 16; ++r) { const int orow = crow(r, hi); const float rl = __builtin_amdgcn_rcpf(li_l[orow]);
#pragma unroll
    for (int d0 = 0; d0 < 4; ++d0) Ow[(size_t)orow * DM + d0 * 32 + r32] = (bf16_t)f2bf(o[d0][r] * rl); }
  __syncthreads();
#undef KROW
#undef SLOAD
}
}

__device__ __forceinline__ void phase_small(const Args& a, unsigned char* lds, int vcu, int G, int layer, bool last) {
    const int tid = otid(), wave = tid >> 6, lane = tid & 63;
    const int gw = vcu * NWAVE + wave, NGW = G * NWAVE;
    const int nrows = last ? SEQ : MR;
    for (int row = gw; row < MR; row += NGW) qk_prep_row(a, layer, row, lane);
    for (int row = gw; row < nrows; row += NGW) dlt_row(a, row, lane);
    const int nunits = (nrows / 128) * 4;
    for (int u = G - 1 - vcu; u < nunits; u += G) cmix_unit(a, layer, u, lds);
    const bf16_t* PL = (const bf16_t*)(a.ws + WS_PL); bf16_t* OD = (bf16_t*)(a.ws + WS_OUTS) + 3 * 512;
    const float* rpb = a.in[I_RPB] + layer * 4 * 15 * 31;
    const int nu = 128 + (last ? 0 : 4);
    for (int u = vcu; u < nu; u += G) {
        if (u < 128) { const int h = u & 3, i = u >> 2, R0 = min(max(4 * i - 4, 0), 120);
            att::attn_unit_na(PL, i * 256, D_Q0 + h * HD, D_K0 + h * HD, D_V0 + h * HD, R0, rpb + h * 465, OD + (size_t)(i * 256) * DM + h * HD, (char*)lds); }
        else { const int h = u - 128;
            att::attn_unit<0, true>(PL, SEQ, D_Q0 + h * HD, D_K0 + h * HD, D_V0 + h * HD, 4, SEQ, 4, 0, nullptr, OD + (size_t)SEQ * DM + h * HD, nullptr, nullptr, (char*)lds); }
    }
}
constexpr size_t OPART_LSE = (size_t)2 * SEQ * 512 * 4;
__device__ __forceinline__ void phase_attn_a(const Args& a, unsigned char* lds, int vcu, int G, bool last) {
    const bf16_t* PL = (const bf16_t*)(a.ws + WS_PL); bf16_t* OA = (bf16_t*)(a.ws + WS_OUTS);
    float* Opart = (float*)(a.ws + WS_MRG); float* LSE = (float*)(a.ws + WS_MRG + OPART_LSE);
    const int nu = 256 + (last ? 0 : 4);
    for (int u = vcu; u < nu; u += G) {
        if (u < 256) { const int half = u >> 7, h = (u >> 5) & 3, qb = u & 31, kvh = h >> 1;
            att::attn_unit<0, false>(PL, qb * 256, A_Q0 + h * HD, A_K0 + kvh * HD, A_V0 + kvh * HD, 66, half * 4224, 66, 0, nullptr, nullptr,
                                     Opart + ((size_t)half * SEQ + qb * 256) * 512 + h * HD, LSE + ((size_t)half * SEQ + qb * 256) * 4 + h, (char*)lds); }
        else { const int h = u - 256, kvh = h >> 1;
            att::attn_unit<0, true>(PL, SEQ, A_Q0 + h * HD, A_K0 + kvh * HD, A_V0 + kvh * HD, 4, SEQ, 4, 0, nullptr, OA + (size_t)SEQ * DM + h * HD, nullptr, nullptr, (char*)lds); }
    }
}
__device__ __forceinline__ void phase_combine_a(const Args& a, int vcu, int G) {
    const int tid = otid(), wave = tid >> 6, lane = tid & 63;
    const int gw = vcu * NWAVE + wave, NGW = G * NWAVE;
    const float* Opart = (const float*)(a.ws + WS_MRG); const float* LSE = (const float*)(a.ws + WS_MRG + OPART_LSE); bf16_t* OA = (bf16_t*)(a.ws + WS_OUTS);
    for (int row = gw; row < SEQ; row += NGW) {
        const float l0 = LSE[(size_t)row * 4 + (lane >> 4)], l1 = LSE[((size_t)SEQ + row) * 4 + (lane >> 4)];
        const float mx = fmaxf(l0, l1), w0 = exp2f(l0 - mx), w1 = exp2f(l1 - mx), inv = 1.f / (w0 + w1), c0 = w0 * inv, c1 = w1 * inv;
        const float* p0 = Opart + (size_t)row * 512 + lane * 8; const float* p1 = p0 + (size_t)SEQ * 512;
        const f32x4 a0 = *(const f32x4*)p0, a1 = *(const f32x4*)(p0 + 4), b0 = *(const f32x4*)p1, b1 = *(const f32x4*)(p1 + 4);
        const f32x4 r0 = a0 * c0 + b0 * c1, r1 = a1 * c0 + b1 * c1;
        u32x4 w; w.x = pk2(r0[0], r0[1]); w.y = pk2(r0[2], r0[3]); w.z = pk2(r1[0], r1[1]); w.w = pk2(r1[2], r1[3]);
        *(u32x4*)(OA + (size_t)row * DM + lane * 8) = w;
    }
}

#define XB_TMO      128
#define XB_XCNT(j)  (256  + 64 * (j))
#define XB_XSUB(j)  (1280 + 64 * (j))
#define XB_XGEN(j)  (2304 + 64 * (j))
#define XB_TOP      3328
#define XB_TOPGEN   3392
#define XCD_BAR_WORDS 3456
#define XB_SPIN_CAP (1u << 18)

__device__ __forceinline__ unsigned xb_ld(unsigned* p)              { return __hip_atomic_load(p, __ATOMIC_RELAXED, __HIP_MEMORY_SCOPE_AGENT); }
__device__ __forceinline__ unsigned xb_add(unsigned* p, unsigned v) { return __hip_atomic_fetch_add(p, v, __ATOMIC_RELAXED, __HIP_MEMORY_SCOPE_AGENT); }
__device__ __forceinline__ unsigned xb_xcc_id() { return (unsigned)__builtin_amdgcn_s_getreg((3 << 11) | 20) & 0xFu; }
#define XB_SPIN(cond, bar) do { unsigned _sp = 0; while (cond) { __builtin_amdgcn_s_sleep(1); \
    if ((++_sp & 255u) == 0u) { if (xb_ld(&(bar)[XB_TMO])) break; if (_sp > XB_SPIN_CAP) { atomicAdd(&(bar)[XB_TMO], 1u); break; } } } } while (0)

struct XcdBarrier {
    unsigned* bar; unsigned x;
    volatile __attribute__((address_space(3))) unsigned* st;
};

__device__ __forceinline__ XcdBarrier xcd_barrier_post(unsigned* bar, volatile __attribute__((address_space(3))) unsigned* st) {
    XcdBarrier b; b.bar = bar; b.x = xb_xcc_id(); b.st = st;
    if (threadIdx.x == 0) (void)xb_add(&bar[XB_XCNT(b.x)], 1u);
    return b;
}
__device__ __forceinline__ void xcd_barrier_complete(unsigned* bar, unsigned x, unsigned& nloc, unsigned& nx) {
    const unsigned G = gridDim.x * gridDim.y * gridDim.z;
    unsigned sum, cnt, mine, sp = 0u;
    for (;;) {
        sum = 0u; cnt = 0u; mine = 0u;
#pragma unroll
        for (unsigned j = 0; j < 16; ++j) { const unsigned c = xb_ld(&bar[XB_XCNT(j)]); sum += c; cnt += (c > 0u) ? 1u : 0u; mine = (j == x) ? c : mine; }
        if (sum == G) break;
        __builtin_amdgcn_s_sleep(1);
        if ((++sp & 255u) == 0u) { if (xb_ld(&bar[XB_TMO])) break; if (sp > XB_SPIN_CAP) { atomicAdd(&bar[XB_TMO], 1u); break; } }
    }
    nloc = mine > 0u ? mine : 1u; nx = cnt > 0u ? cnt : 1u;
}

__device__ __forceinline__ void xcd_barrier(const XcdBarrier& b) {
    asm volatile("s_waitcnt vmcnt(0)" ::: "memory");
    __syncthreads();
    if (threadIdx.x == 0) {
        unsigned* bar = b.bar;
        __builtin_amdgcn_s_waitcnt(0);
        unsigned nloc = b.st[0], nx = b.st[1];
        if (nloc == 0u) { xcd_barrier_complete(bar, b.x, nloc, nx); b.st[0] = nloc; b.st[1] = nx; }
        const unsigned old = xb_add(&bar[XB_XSUB(b.x)], 1u);
        const unsigned gen = old / nloc;
        if (old + 1u == (gen + 1u) * nloc) {
            __builtin_amdgcn_fence(__ATOMIC_RELEASE, "agent");
            asm volatile("s_waitcnt vmcnt(0)" ::: "memory");
            const unsigned og = xb_add(&bar[XB_TOP], 1u);
            const unsigned tg = og / nx;
            if (og + 1u == (tg + 1u) * nx) xb_add(&bar[XB_TOPGEN], 1u);
            else XB_SPIN(xb_ld(&bar[XB_TOPGEN]) == tg, bar);
            __builtin_amdgcn_fence(__ATOMIC_ACQUIRE, "agent");
            xb_add(&bar[XB_XGEN(b.x)], 1u);
            asm volatile("s_waitcnt vmcnt(0)" ::: "memory");
        } else {
            XB_SPIN(xb_ld(&bar[XB_XGEN(b.x)]) == gen, bar);
            __builtin_amdgcn_fence(__ATOMIC_ACQUIRE, "agent");
            asm volatile("s_waitcnt vmcnt(0)" ::: "memory");
        }
    }
    __syncthreads();
}

constexpr int NPHASE = 22;
__global__ void __launch_bounds__(NTHR, 2) fwd(Args a) {
    extern __shared__ __attribute__((aligned(16))) unsigned char lds[];
    const int G = gridDim.x, bx = blockIdx.x;
    const int vcu = (G % 8 == 0) ? (bx % 8) * (G / 8) + bx / 8 : bx;
    unsigned char* ws = a.ws;
    const float* MOD = (const float*)(ws + WS_CTL + CTL_MOD);
#if MK_COOP
    cg::grid_group grid = cg::this_grid();
    volatile __attribute__((address_space(3))) unsigned* MISC = (volatile __attribute__((address_space(3))) unsigned*)((__attribute__((address_space(3))) unsigned char*)lds + (LDS_BYTES - 64));
    if (threadIdx.x < 2) MISC[threadIdx.x] = 0u;
    __syncthreads();
    const XcdBarrier xbar = xcd_barrier_post((unsigned*)(ws + WS_CTL) + CW_BAR, MISC);
#define SEAM(p) do { if (lo <= (p) && (p) + 1 < hi) { if ((p) == 0) grid.sync(); else xcd_barrier(xbar); } } while (0)
#else
#define SEAM(p) do { } while (0)
#endif
    const int lo = a.ph_lo, hi = a.ph_hi;
#ifndef PHMASK
#define PHMASK 0xffffffu
#endif
#define IN(p) (lo <= (p) && (p) < hi && ((PHMASK >> ((p) < 2 ? (p) : 2 + ((p) - 2) % 10)) & 1u))
    if (IN(0)) { phase_prologue(a, lds, vcu, G); } SEAM(0);
    if (IN(1)) { phase_rows<0>(a, vcu, G, MR, nullptr, nullptr, 0, a.in[I_NPRE_MIX], MOD, 0); } SEAM(1);
    {
        constexpr int l = 0; constexpr bool last = (l == 1); const int pb = 2 + l * 10;
        unsigned char* wb = ws + WS_W + (size_t)l * WPL;
        const float* modl = MOD + (size_t)l * 2 * NIN;
        const int Mrows = last ? SEQ : MR;
        if (IN(pb + 0)) {
            Gemm g{(const bf16_t*)(ws + WS_XN), (const bf16_t*)(wb + W_IN), DM, DM, DM}; StaticOrder S; S.init(MR, NIN - 512, G, bx);
            EpiIn E{(bf16_t*)(ws + WS_PL)}; gemm_phase((PG8_LAS unsigned char*)lds, g, S, E);
        } SEAM(pb + 0);
        if (IN(pb + 1)) {
            phase_small(a, lds, vcu, G, l, last);
            Gemm g{(const bf16_t*)(ws + WS_XN), (const bf16_t*)(wb + W_IN), DM, DM, DM}; ListOrder S{vcu - 132, 2 * (Mrows / 256), Mrows / 256, 46};
            EpiIn E{(bf16_t*)(ws + WS_PL)}; gemm_phase((PG8_LAS unsigned char*)lds, g, S, E);
        } SEAM(pb + 1);
        if (IN(pb + 2)) { phase_attn_a(a, lds, vcu, G, last); } SEAM(pb + 2);
        if (IN(pb + 3)) {
            phase_combine_a(a, vcu, G);
            Gemm g{(const bf16_t*)(ws + WS_DLT), (const bf16_t*)(wb + W_B), 512, 512, 512}; StaticOrder S; S.init(Mrows, 512, G, bx);
            EpiScale E{(bf16_t*)(ws + WS_OUTS) + 512, DM, a.in[I_BSCALE] + l * 512}; gemm_phase((PG8_LAS unsigned char*)lds, g, S, E);
        } SEAM(pb + 3);
        if (IN(pb + 4)) {
            Gemm g{(const bf16_t*)(ws + WS_OUTS), (const bf16_t*)(wb + W_BR), DM, DM, DM}; StaticOrder S; S.init(Mrows, DM, G, bx);
            EpiMerge E{(const bf16_t*)(ws + WS_PL), (bf16_t*)(ws + WS_MRGB)}; gemm_phase((PG8_LAS unsigned char*)lds, g, S, E);
        } SEAM(pb + 4);
        if (IN(pb + 5)) {
            Gemm g{(const bf16_t*)(ws + WS_MRGB), (const bf16_t*)(wb + W_O), DM, DM, DM}; StaticOrder S; S.init(Mrows, DM, G, bx);
            EpiF32 E{(float*)(ws + WS_MRG), DM}; gemm_phase((PG8_LAS unsigned char*)lds, g, S, E);
        } SEAM(pb + 5);
        if (IN(pb + 6)) { phase_rows<1>(a, vcu, G, Mrows, a.in[I_NPOST_MIX] + l * DM, modl, 2, a.in[I_NPRE_FFN] + l * DM, modl, 3); } SEAM(pb + 6);
        if (IN(pb + 7)) {
            Gemm g{(const bf16_t*)(ws + WS_XN), (const bf16_t*)(wb + W_GU), DM, DM, DM}; StaticOrder S; S.init(Mrows, 2 * FF, G, bx);
            EpiSwiglu E{(bf16_t*)(ws + WS_H)}; gemm_phase((PG8_LAS unsigned char*)lds, g, S, E);
        } SEAM(pb + 7);
        if (IN(pb + 8)) {
            Gemm g{(const bf16_t*)(ws + WS_H), (const bf16_t*)(wb + W_D), FF, FF, FF}; StaticOrder S; S.init(Mrows, DM, G, bx);
            EpiF32 E{(float*)(ws + WS_MRG), DM}; gemm_phase((PG8_LAS unsigned char*)lds, g, S, E);
            if (bx >= 8) convert_layer(a, lds, 1, (bx - 8) * NWAVE + (otid() >> 6), (G - 8) * NWAVE);
        } SEAM(pb + 8);
        if (IN(pb + 9)) {
            if (!last) phase_rows<1>(a, vcu, G, MR, a.in[I_NPOST_FFN] + l * DM, modl, 5, a.in[I_NPRE_MIX] + (l + 1) * DM, MOD + (size_t)(l + 1) * 2 * NIN, 0);
            else phase_rows<2>(a, vcu, G, SEQ, a.in[I_NPOST_FFN] + l * DM, modl, 5, nullptr, nullptr, 0);
        }
        if (!last) SEAM(pb + 9);
        }
    {
        constexpr int l = 1; constexpr bool last = (l == 1); const int pb = 2 + l * 10;
        unsigned char* wb = ws + WS_W + (size_t)l * WPL;
        const float* modl = MOD + (size_t)l * 2 * NIN;
        const int Mrows = last ? SEQ : MR;
        if (IN(pb + 0)) {
            Gemm g{(const bf16_t*)(ws + WS_XN), (const bf16_t*)(wb + W_IN), DM, DM, DM}; StaticOrder S; S.init(MR, NIN - 512, G, bx);
            EpiIn E{(bf16_t*)(ws + WS_PL)}; gemm_phase((PG8_LAS unsigned char*)lds, g, S, E);
        } SEAM(pb + 0);
        if (IN(pb + 1)) {
            phase_small(a, lds, vcu, G, l, last);
            Gemm g{(const bf16_t*)(ws + WS_XN), (const bf16_t*)(wb + W_IN), DM, DM, DM}; ListOrder S{vcu - 132, 2 * (Mrows / 256), Mrows / 256, 46};
            EpiIn E{(bf16_t*)(ws + WS_PL)}; gemm_phase((PG8_LAS unsigned char*)lds, g, S, E);
        } SEAM(pb + 1);
        if (IN(pb + 2)) { phase_attn_a(a, lds, vcu, G, last); } SEAM(pb + 2);
        if (IN(pb + 3)) {
            phase_combine_a(a, vcu, G);
            Gemm g{(const bf16_t*)(ws + WS_DLT), (const bf16_t*)(wb + W_B), 512, 512, 512}; StaticOrder S; S.init(Mrows, 512, G, bx);
            EpiScale E{(bf16_t*)(ws + WS_OUTS) + 512, DM, a.in[I_BSCALE] + l * 512}; gemm_phase((PG8_LAS unsigned char*)lds, g, S, E);
        } SEAM(pb + 3);
        if (IN(pb + 4)) {
            Gemm g{(const bf16_t*)(ws + WS_OUTS), (const bf16_t*)(wb + W_BR), DM, DM, DM}; StaticOrder S; S.init(Mrows, DM, G, bx);
            EpiMerge E{(const bf16_t*)(ws + WS_PL), (bf16_t*)(ws + WS_MRGB)}; gemm_phase((PG8_LAS unsigned char*)lds, g, S, E);
        } SEAM(pb + 4);
        if (IN(pb + 5)) {
            Gemm g{(const bf16_t*)(ws + WS_MRGB), (const bf16_t*)(wb + W_O), DM, DM, DM}; StaticOrder S; S.init(Mrows, DM, G, bx);
            EpiF32 E{(float*)(ws + WS_MRG), DM}; gemm_phase((PG8_LAS unsigned char*)lds, g, S, E);
        } SEAM(pb + 5);
        if (IN(pb + 6)) { phase_rows<1>(a, vcu, G, Mrows, a.in[I_NPOST_MIX] + l * DM, modl, 2, a.in[I_NPRE_FFN] + l * DM, modl, 3); } SEAM(pb + 6);
        if (IN(pb + 7)) {
            Gemm g{(const bf16_t*)(ws + WS_XN), (const bf16_t*)(wb + W_GU), DM, DM, DM}; StaticOrder S; S.init(Mrows, 2 * FF, G, bx);
            EpiSwiglu E{(bf16_t*)(ws + WS_H)}; gemm_phase((PG8_LAS unsigned char*)lds, g, S, E);
        } SEAM(pb + 7);
        if (IN(pb + 8)) {
            Gemm g{(const bf16_t*)(ws + WS_H), (const bf16_t*)(wb + W_D), FF, FF, FF}; StaticOrder S; S.init(Mrows, DM, G, bx);
            EpiF32 E{(float*)(ws + WS_MRG), DM}; gemm_phase((PG8_LAS unsigned char*)lds, g, S, E);
        } SEAM(pb + 8);
        if (IN(pb + 9)) {
            if (!last) phase_rows<1>(a, vcu, G, MR, a.in[I_NPOST_FFN] + l * DM, modl, 5, a.in[I_NPRE_MIX] + (l + 1) * DM, MOD + (size_t)(l + 1) * 2 * NIN, 0);
            else phase_rows<2>(a, vcu, G, SEQ, a.in[I_NPOST_FFN] + l * DM, modl, 5, nullptr, nullptr, 0);
        }
        if (!last) SEAM(pb + 9);
        }
#undef IN
#undef SEAM
}

extern "C" void kernel_launch(void* const* d_in, const int* in_sizes, int n_in, void* d_out, int out_size, void* d_ws, size_t ws_size, hipStream_t stream) {
    static int grid = 0;
    if (grid == 0) {
        if (n_in != N_IN || out_size != SEQ * DM || ws_size < WS_END) { fprintf(stderr, "kernel_launch: unexpected shapes (n_in %d out %d ws %zu)\n", n_in, out_size, ws_size); grid = -1; return; }
        if (hipFuncSetAttribute((const void*)fwd, hipFuncAttributeMaxDynamicSharedMemorySize, LDS_BYTES) != hipSuccess) { fprintf(stderr, "kernel_launch: hipFuncSetAttribute failed\n"); grid = -1; return; }
        int dev = 0, cus = 0, per_cu = 0;
        hipGetDevice(&dev); hipDeviceGetAttribute(&cus, hipDeviceAttributeMultiprocessorCount, dev);
        hipOccupancyMaxActiveBlocksPerMultiprocessor(&per_cu, (const void*)fwd, NTHR, LDS_BYTES);
        if (per_cu < 1) { fprintf(stderr, "kernel_launch: occupancy query says %d blocks per CU\n", per_cu); per_cu = 1; }
        (void)hipGetLastError();
        grid = cus * per_cu;
        fprintf(stderr, "kernel_launch: grid %d (cus %d x %d)\n", grid, cus, per_cu);
    }
    if (grid < 0) return;
    hipMemsetAsync((char*)d_ws + WS_CTL, 0, CTL_BYTES, stream);
    Args a{};
    for (int i = 0; i < N_IN; ++i) a.in[i] = (const float*)d_in[i];
    a.out = (float*)d_out; a.ws = (unsigned char*)d_ws;
#if MK_COOP
    a.ph_lo = 0; a.ph_hi = NPHASE;
    void* params[] = {&a};
    hipError_t e = hipLaunchCooperativeKernel((const void*)fwd, dim3(grid), dim3(NTHR), params, LDS_BYTES, stream);
    if (e != hipSuccess) fprintf(stderr, "kernel_launch: cooperative launch failed: %s (grid %d)\n", hipGetErrorString(e), grid);
#else
    for (int p = 0; p < NPHASE; ++p) {
        a.ph_lo = p; a.ph_hi = p + 1;
        hipLaunchKernelGGL(fwd, dim3(grid), dim3(NTHR), LDS_BYTES, stream, a);
    }
#endif
}
```

```cpp
#include <hip/hip_runtime.h>
#include <hip/hip_cooperative_groups.h>
#include <cstdio>
#include <cstdint>
namespace cg = cooperative_groups;

#ifndef MK_COOP
#define MK_COOP 1
#endif

typedef unsigned short bf16_t;
typedef short bf16x8 __attribute__((ext_vector_type(8)));
typedef float f32x4 __attribute__((ext_vector_type(4)));
typedef unsigned u32x4 __attribute__((ext_vector_type(4)));
typedef unsigned u32x2 __attribute__((ext_vector_type(2)));

constexpr int DM = 2048, SEQ = 8192, CTXL = 256, MR = SEQ + CTXL, NIN = 12288, FF = 5632, HD = 128, GW = 64;
constexpr int A_Q0 = 0, A_K0 = 512, A_V0 = 768, B0 = 1024, C_U0 = 1536, C_V0 = 2048, D_Q0 = 2560, D_K0 = 3072, D_V0 = 3584, G0 = 4096;
constexpr float EPS = 1e-6f;
constexpr int NTHR = 512, NWAVE = 8;
constexpr int LDS_BYTES = 147456;

enum { I_X = 0, I_C, I_CTX, I_CCTX, I_ADAW, I_ADAB, I_NPRE_MIX, I_NPOST_MIX, I_NPRE_FFN, I_NPOST_FFN, I_WIN, I_AQN, I_AKN, I_BW, I_BSCALE,
       I_CNG, I_CNB, I_CWS, I_CBS, I_RPB, I_WBR, I_WO, I_WG, I_WU, I_WD, N_IN };

constexpr size_t MiB = 1u << 20;
constexpr size_t WS_CTL = 0, CTL_BYTES = 1 * MiB;
constexpr int CW_BAR = 4096;
constexpr size_t CTL_MOD = 256 * 1024;
constexpr size_t WS_W = 2 * MiB, WPL = 131 * MiB;
constexpr size_t W_IN = 0, W_BR = 48 * MiB, W_O = 56 * MiB, W_GU = 64 * MiB, W_D = 108 * MiB, W_B = 130 * MiB;
constexpr size_t WS_X = 264 * MiB;
constexpr size_t WS_XN = 330 * MiB;
constexpr size_t WS_PL = 363 * MiB;
constexpr size_t WS_H = WS_PL;
constexpr size_t WS_OUTS = 561 * MiB;
constexpr size_t WS_DLT = 594 * MiB;
constexpr size_t WS_MRG = 603 * MiB;
constexpr size_t WS_MRGB = 669 * MiB;
constexpr size_t WS_END = 702 * MiB;

struct Args { const float* in[N_IN]; float* out; unsigned char* ws; int ph_lo, ph_hi; };

__device__ __forceinline__ unsigned f2bf(float f) { unsigned u = __builtin_bit_cast(unsigned, f); return (u + 0x7fffu + ((u >> 16) & 1u)) >> 16; }
__device__ __forceinline__ unsigned pk2(float lo, float hi) { return f2bf(lo) | (f2bf(hi) << 16); }
__device__ __forceinline__ float bflo(unsigned w) { return __builtin_bit_cast(float, w << 16); }
__device__ __forceinline__ float bfhi(unsigned w) { return __builtin_bit_cast(float, w & 0xffff0000u); }
__device__ __forceinline__ float bf2f(bf16_t h) { return __builtin_bit_cast(float, (unsigned)h << 16); }
__device__ __forceinline__ float wave_sum(float v) {
#pragma unroll
    for (int o = 32; o >= 1; o >>= 1) v += __shfl_xor(v, o);
    return v;
}
__device__ __forceinline__ int otid() { int t = threadIdx.x; asm volatile("" : "+v"(t)); return t; }
__device__ __forceinline__ float sigmoidf_(float x) { return __builtin_amdgcn_rcpf(1.f + __expf(-x)); }
__device__ __forceinline__ float siluf_(float x) { return x * __builtin_amdgcn_rcpf(1.f + __expf(-x)); }

struct Unit { int pm, pn; };
struct Gemm { const bf16_t* A; const bf16_t* Bt; int lda, ldb, K; };
constexpr int NXCD = 8, WGM = 8;
struct StaticOrder {
    int nM, nN, nwg, G, c;
    __device__ void init(int M, int N, int G_, int c_) { nM = M / 256; nN = N / 256; nwg = nM * nN; G = G_; c = c_; }
    __device__ bool next(int i, Unit& u) const {
        const long L = (long)i * G + c; if (L >= nwg) return false;
        int wgid = (int)L; { const int q = nwg / NXCD, r = nwg % NXCD, xcd = wgid % NXCD, off = wgid / NXCD; wgid = (xcd < r ? xcd * (q + 1) : r * (q + 1) + (xcd - r) * q) + off; }
        const int nig = WGM * nN, gid = wgid / nig, fm = gid * WGM, gsz = (nM - fm) < WGM ? (nM - fm) : WGM;
        u.pm = fm + ((wgid % nig) % gsz); u.pn = (wgid % nig) / gsz; return true;
    }
    __device__ __forceinline__ void a_ready(const Unit&) const {}
    __device__ __forceinline__ void done(const Unit&) const {}
};
struct ListOrder {
    int j, n, nM, pn0;
    __device__ bool next(int i, Unit& u) const { if (i > 0 || j < 0 || j >= n) return false; u.pm = j % nM; u.pn = pn0 + j / nM; return true; }
    __device__ __forceinline__ void a_ready(const Unit&) const {}
    __device__ __forceinline__ void done(const Unit&) const {}
};
struct CtxSplitOrder {
    int j;
    __device__ bool next(int i, Unit& u) const { if (i > 0 || j < 0 || j >= 32) return false; u.pm = 32; u.pn = j & 7; return true; }
    __device__ __forceinline__ void a_ready(const Unit&) const {}
    __device__ __forceinline__ void done(const Unit&) const {}
};
struct MergeOrder {
    StaticOrder base;
    __device__ bool next(int i, Unit& u) const { Unit t; if (!base.next(i >> 2, t)) return false; const int pass = i & 3; u.pm = pass * 33 + t.pm; u.pn = pass * 8 + t.pn; return true; }
    __device__ __forceinline__ void a_ready(const Unit&) const {}
    __device__ __forceinline__ void done(const Unit&) const {}
};

struct EpiIn {
    static constexpr bool PERM = true, AFTER_DRAIN = false, KHOOK = false;
    bf16_t* PL;
    __device__ __forceinline__ void operator()(const f32x4 (&acc)[2][2][4][2], const Unit& u, int wr, int wc, int fr, int fq) const {
        const bool gate = u.pn >= (G0 / 256);
#pragma unroll
        for (int ai = 0; ai < 2; ++ai)
#pragma unroll
            for (int m = 0; m < 4; ++m) {
                const int row = u.pm * 256 + ai * 128 + wr * 64 + m * 16 + fr;
#pragma unroll
                for (int bj = 0; bj < 2; ++bj) {
                    const int col = u.pn * 256 + bj * 128 + wc * 32 + 8 * fq;
                    f32x4 v0 = acc[ai][bj][m][0], v1 = acc[ai][bj][m][1];
                    if (gate) {
#pragma unroll
                        for (int e = 0; e < 4; ++e) { v0[e] = sigmoidf_(v0[e]); v1[e] = sigmoidf_(v1[e]); }
                    }
                    u32x4 w; w.x = pk2(v0[0], v0[1]); w.y = pk2(v0[2], v0[3]); w.z = pk2(v1[0], v1[1]); w.w = pk2(v1[2], v1[3]);
                    *(u32x4*)(PL + (size_t)row * NIN + col) = w;
                }
            }
    }
};
struct EpiScale {
    static constexpr bool PERM = true, AFTER_DRAIN = false, KHOOK = false;
    bf16_t* O; int ldc; const float* scale;
    __device__ __forceinline__ void operator()(const f32x4 (&acc)[2][2][4][2], const Unit& u, int wr, int wc, int fr, int fq) const {
#pragma unroll
        for (int bj = 0; bj < 2; ++bj) {
            const int col = u.pn * 256 + bj * 128 + wc * 32 + 8 * fq;
            const f32x4 s0 = *(const f32x4*)(scale + col), s1 = *(const f32x4*)(scale + col + 4);
#pragma unroll
            for (int ai = 0; ai < 2; ++ai)
#pragma unroll
                for (int m = 0; m < 4; ++m) {
                    const int row = u.pm * 256 + ai * 128 + wr * 64 + m * 16 + fr;
                    const f32x4 v0 = acc[ai][bj][m][0] * s0, v1 = acc[ai][bj][m][1] * s1;
                    u32x4 w; w.x = pk2(v0[0], v0[1]); w.y = pk2(v0[2], v0[3]); w.z = pk2(v1[0], v1[1]); w.w = pk2(v1[2], v1[3]);
                    *(u32x4*)(O + (size_t)row * ldc + col) = w;
                }
        }
    }
};
struct EpiMerge {
    static constexpr bool PERM = true, AFTER_DRAIN = false, KHOOK = true;
    const bf16_t* PL; bf16_t* MRGB;
    __device__ __forceinline__ void khook(f32x4 (&acc)[2][2][4][2], const Unit& u, int s, int wr, int wc, int fr, int fq) const {
#pragma unroll
        for (int ai = 0; ai < 2; ++ai)
#pragma unroll
            for (int mh = 0; mh < 2; ++mh) {
                size_t off = ((size_t)(u.pm * 256 + ai * 128 + wr * 64 + mh * 32 + fr) * NIN + G0 + (s - 1) * DM + u.pn * 256 + wc * 32 + 8 * fq) * 2;
                asm volatile("" : "+v"(off));
                const char* gp = (const char*)PL + off;
                u32x4 ga[2][2], gb[2][2];
#pragma unroll
                for (int mm = 0; mm < 2; ++mm)
#pragma unroll
                    for (int bj = 0; bj < 2; ++bj) { const char* p = gp + (size_t)mm * 16 * NIN * 2 + bj * 256; ga[mm][bj] = *(const u32x4*)p; gb[mm][bj] = *(const u32x4*)(p + DM * 2); }
                __builtin_amdgcn_sched_barrier(0);
#pragma unroll
                for (int mm = 0; mm < 2; ++mm)
#pragma unroll
                    for (int bj = 0; bj < 2; ++bj) {
                        const u32x4 a_ = ga[mm][bj], b_ = gb[mm][bj];
                        f32x4& v0 = acc[ai][bj][mh * 2 + mm][0]; f32x4& v1 = acc[ai][bj][mh * 2 + mm][1];
                        v0[0] *= bflo(a_.x) * __builtin_amdgcn_rcpf(fmaxf(bflo(b_.x), 1e-30f)); v0[1] *= bfhi(a_.x) * __builtin_amdgcn_rcpf(fmaxf(bfhi(b_.x), 1e-30f));
                        v0[2] *= bflo(a_.y) * __builtin_amdgcn_rcpf(fmaxf(bflo(b_.y), 1e-30f)); v0[3] *= bfhi(a_.y) * __builtin_amdgcn_rcpf(fmaxf(bfhi(b_.y), 1e-30f));
                        v1[0] *= bflo(a_.z) * __builtin_amdgcn_rcpf(fmaxf(bflo(b_.z), 1e-30f)); v1[1] *= bfhi(a_.z) * __builtin_amdgcn_rcpf(fmaxf(bfhi(b_.z), 1e-30f));
                        v1[2] *= bflo(a_.w) * __builtin_amdgcn_rcpf(fmaxf(bflo(b_.w), 1e-30f)); v1[3] *= bfhi(a_.w) * __builtin_amdgcn_rcpf(fmaxf(bfhi(b_.w), 1e-30f));
                    }
                __builtin_amdgcn_sched_barrier(0);
            }
        asm volatile("s_waitcnt vmcnt(0)" ::: "memory");
    }
    __device__ __forceinline__ void operator()(const f32x4 (&acc)[2][2][4][2], const Unit& u, int wr, int wc, int fr, int fq) const {
#pragma unroll
        for (int ai = 0; ai < 2; ++ai)
#pragma unroll
            for (int m = 0; m < 4; ++m) {
                const int row = u.pm * 256 + ai * 128 + wr * 64 + m * 16 + fr;
#pragma unroll
                for (int bj = 0; bj < 2; ++bj) {
                    const int col = u.pn * 256 + bj * 128 + wc * 32 + 8 * fq;
                    const u32x4 gw = *(const u32x4*)(PL + (size_t)row * NIN + G0 + 3 * DM + col);
                    f32x4 v0 = acc[ai][bj][m][0], v1 = acc[ai][bj][m][1];
                    v0[0] *= bflo(gw.x); v0[1] *= bfhi(gw.x); v0[2] *= bflo(gw.y); v0[3] *= bfhi(gw.y);
                    v1[0] *= bflo(gw.z); v1[1] *= bfhi(gw.z); v1[2] *= bflo(gw.w); v1[3] *= bfhi(gw.w);
                    u32x4 w; w.x = pk2(v0[0], v0[1]); w.y = pk2(v0[2], v0[3]); w.z = pk2(v1[0], v1[1]); w.w = pk2(v1[2], v1[3]);
                    *(u32x4*)(MRGB + (size_t)row * DM + col) = w;
                }
            }
    }
};
struct EpiF32 {
    static constexpr bool PERM = true, AFTER_DRAIN = false, KHOOK = false;
    float* Y; int ldc;
    __device__ __forceinline__ void operator()(const f32x4 (&acc)[2][2][4][2], const Unit& u, int wr, int wc, int fr, int fq) const {
#pragma unroll
        for (int ai = 0; ai < 2; ++ai)
#pragma unroll
            for (int m = 0; m < 4; ++m) {
                const int row = u.pm * 256 + ai * 128 + wr * 64 + m * 16 + fr;
#pragma unroll
                for (int bj = 0; bj < 2; ++bj) {
                    const int col = u.pn * 256 + bj * 128 + wc * 32 + 8 * fq;
                    float* yp = Y + (size_t)row * ldc + col;
                    *(f32x4*)yp = acc[ai][bj][m][0]; *(f32x4*)(yp + 4) = acc[ai][bj][m][1];
                }
            }
    }
};
struct EpiAtomicF32 {
    static constexpr bool PERM = true, AFTER_DRAIN = false, KHOOK = false;
    float* Y; int ldc;
    __device__ __forceinline__ void operator()(const f32x4 (&acc)[2][2][4][2], const Unit& u, int wr, int wc, int fr, int fq) const {
#pragma unroll
        for (int ai = 0; ai < 2; ++ai)
#pragma unroll
            for (int m = 0; m < 4; ++m) {
                const int row = u.pm * 256 + ai * 128 + wr * 64 + m * 16 + fr;
#pragma unroll
                for (int bj = 0; bj < 2; ++bj) {
                    float* yp = Y + (size_t)row * ldc + u.pn * 256 + bj * 128 + wc * 32 + 8 * fq;
#pragma unroll
                    for (int e = 0; e < 4; ++e) { unsafeAtomicAdd(yp + e, acc[ai][bj][m][0][e]); unsafeAtomicAdd(yp + 4 + e, acc[ai][bj][m][1][e]); }
                }
            }
    }
};
struct EpiSwiglu {
    static constexpr bool PERM = true, AFTER_DRAIN = false, KHOOK = false;
    bf16_t* H;
    __device__ __forceinline__ void operator()(const f32x4 (&acc)[2][2][4][2], const Unit& u, int wr, int wc, int fr, int fq) const {
#pragma unroll
        for (int ai = 0; ai < 2; ++ai)
#pragma unroll
            for (int m = 0; m < 4; ++m) {
                const int row = u.pm * 256 + ai * 128 + wr * 64 + m * 16 + fr;
                const int col = u.pn * 128 + wc * 32 + 8 * fq;
                f32x4 h0, h1;
#pragma unroll
                for (int e = 0; e < 4; ++e) { h0[e] = siluf_(acc[ai][0][m][0][e]) * acc[ai][1][m][0][e]; h1[e] = siluf_(acc[ai][0][m][1][e]) * acc[ai][1][m][1][e]; }
                u32x4 w; w.x = pk2(h0[0], h0[1]); w.y = pk2(h0[2], h0[3]); w.z = pk2(h1[0], h1[1]); w.w = pk2(h1[2], h1[3]);
                *(u32x4*)(H + (size_t)row * FF + col) = w;
            }
    }
};

#define PG8_LAS __attribute__((address_space(3)))
constexpr int BM = 256, BK = 64, HALF = 128, HTB = HALF * BK * 2, STAGE_BYTES = 8 * HTB;
__device__ __forceinline__ int lds_byte(int r, int c) { const int st = (r >> 4) * 2 + (c >> 5), rr = r & 15, cc = c & 31, ob = rr * 64 + cc * 2; return st * 1024 + (ob ^ (((ob >> 9) & 1) << 5)); }
__device__ __forceinline__ void stage_rc(int b, int& R, int& C) { const int st = b / 1024, sb = b % 1024, swz = sb ^ (((sb >> 9) & 1) << 5); R = (st >> 1) * 16 + swz / 64; C = (st & 1) * 32 + (swz % 64) / 2; }
__device__ __forceinline__ int perm32(int rho) { const int n = rho >> 4, i = rho & 15; return 8 * (i >> 2) + 4 * n + (i & 3); }
template <class Epi, class Sched, bool ALIGN_EPI = true, bool SP2 = true>
__device__ __forceinline__ void gemm_phase(PG8_LAS unsigned char* lds, const Gemm g, const Sched& S, const Epi& E) {
    const int tid = otid(), wid = __builtin_amdgcn_readfirstlane(tid >> 6), lane = tid & 63, wr = wid >> 2, wc = wid & 3, fr = lane & 15, fq = lane >> 4;
    const int K = g.K, nt = K / BK;
    unsigned voffA[2], voffB[2];
#pragma unroll
    for (int i = 0; i < 2; ++i) { int R, C; stage_rc(tid * 16 + i * 8192, R, C); const int Rb = Epi::PERM ? ((R & ~31) + perm32(R & 31)) : R;
        voffA[i] = (unsigned)(R * g.lda + C) * 2u; voffB[i] = (unsigned)(Rb * g.ldb + C) * 2u; }
    const size_t kstep = (size_t)(BK * 2);
    const size_t hstepA = (size_t)HALF * g.lda * 2, hstepB = (size_t)HALF * g.ldb * 2;
    const size_t tstepA = 2 * hstepA, tstepB = 2 * hstepB;
    const unsigned ldsw = (unsigned)wid * 1024u;
    const int aoff = lds_byte(wr * 64 + fr, fq * 8), boff = lds_byte(wc * 32 + fr, fq * 8);
#define PG8_SA(b, h) (((b) * 2 + (h)) * HTB)
#define PG8_SB(b, h) ((4 + (b) * 2 + (h)) * HTB)
#define PG8_STAGE(bufoff, gbase, voff) do { _Pragma("unroll") for (int _i = 0; _i < 2; ++_i) \
        __builtin_amdgcn_global_load_lds((const unsigned*)((const char*)(gbase) + (voff)[_i]), (PG8_LAS unsigned*)(lds + (bufoff) + ldsw + _i * 8192), 16, 0, 0); } while (0)
#define PG8_LDA(dst, b, h) do { _Pragma("unroll") for (int m = 0; m < 4; ++m) _Pragma("unroll") for (int k = 0; k < 2; ++k) dst[m][k] = *(const PG8_LAS bf16x8*)(lds + PG8_SA(b, h) + aoff + m * 2048 + k * 1024); } while (0)
#define PG8_LDB(dst, b, h) do { _Pragma("unroll") for (int n = 0; n < 2; ++n) _Pragma("unroll") for (int k = 0; k < 2; ++k) dst[n][k] = *(const PG8_LAS bf16x8*)(lds + PG8_SB(b, h) + boff + n * 2048 + k * 1024); } while (0)
#define PG8_MMA(ai, bj, At, Bt) do { __builtin_amdgcn_s_setprio(1); _Pragma("unroll") for (int m = 0; m < 4; ++m) _Pragma("unroll") for (int n = 0; n < 2; ++n) _Pragma("unroll") for (int k = 0; k < 2; ++k) \
        acc[ai][bj][m][n] = __builtin_amdgcn_mfma_f32_16x16x32_bf16(Bt[n][k], At[m][k], acc[ai][bj][m][n], 0, 0, 0); __builtin_amdgcn_s_setprio(0); } while (0)
#define PG8_WAIT_V(n) asm volatile("s_waitcnt vmcnt(" #n ")" ::: "memory")
#define PG8_WAIT_L(n) asm volatile("s_waitcnt lgkmcnt(" #n ")" ::: "memory")
#define PG8_BAR __builtin_amdgcn_s_barrier()
#define PG8_SCHED __builtin_amdgcn_sched_barrier(0)
    Unit cur, nxt; int ui = 0;
    if (!S.next(0, cur)) return;
    f32x4 acc[2][2][4][2];
#pragma unroll
    for (int a = 0; a < 2; ++a)
#pragma unroll
        for (int b = 0; b < 2; ++b)
#pragma unroll
            for (int m = 0; m < 4; ++m)
#pragma unroll
                for (int n = 0; n < 2; ++n) acc[a][b][m][n] = (f32x4){0.f, 0.f, 0.f, 0.f};
    bf16x8 At[4][2], B0[2][2], B1[2][2];
    const char* cA = (const char*)g.A + (size_t)cur.pm * tstepA; const char* cB = (const char*)g.Bt + (size_t)cur.pn * tstepB;
    S.a_ready(cur);
    if constexpr (SP2) {
        PG8_STAGE(PG8_SB(0, 0), cB, voffB); PG8_STAGE(PG8_SB(0, 1), cB + hstepB, voffB); PG8_STAGE(PG8_SA(0, 0), cA, voffA); PG8_STAGE(PG8_SA(0, 1), cA + hstepA, voffA);
        if (wr == 1) PG8_BAR;
        PG8_WAIT_V(2); PG8_BAR;
        PG8_STAGE(PG8_SB(1, 0), cB + kstep, voffB); PG8_STAGE(PG8_SA(1, 0), cA + kstep, voffA); PG8_STAGE(PG8_SB(1, 1), cB + hstepB + kstep, voffB);
        PG8_WAIT_V(6); PG8_BAR;
    } else {
        PG8_STAGE(PG8_SB(0, 0), cB, voffB); PG8_STAGE(PG8_SA(0, 0), cA, voffA); PG8_STAGE(PG8_SB(0, 1), cB + hstepB, voffB); PG8_STAGE(PG8_SA(0, 1), cA + hstepA, voffA);
        if (wr == 1) PG8_BAR;
        PG8_WAIT_V(4); PG8_BAR;
        PG8_STAGE(PG8_SB(1, 0), cB + kstep, voffB); PG8_STAGE(PG8_SA(1, 0), cA + kstep, voffA); PG8_STAGE(PG8_SB(1, 1), cB + hstepB + kstep, voffB);
        PG8_WAIT_V(6); PG8_BAR;
    }
    for (;;) {
        const bool has_next = S.next(ui + 1, nxt);
        const char* nA = has_next ? (const char*)g.A + (size_t)nxt.pm * tstepA : cA; const char* nB = has_next ? (const char*)g.Bt + (size_t)nxt.pn * tstepB : cB;
        for (int t = 0; t < nt; t += 2) {
            if constexpr (Epi::KHOOK) { if (t > 0 && (t & 7) == 0) E.khook(acc, cur, t >> 3, wr, wc, fr, fq); }
            const bool last = (t == nt - 2);
            const char* a1 = cA + (size_t)(t + 1) * kstep;
            const char* a2 = last ? nA : cA + (size_t)(t + 2) * kstep; const char* b2 = last ? nB : cB + (size_t)(t + 2) * kstep;
            const char* a3 = a2 + kstep; const char* b3 = b2 + kstep;
            if (last && has_next) S.a_ready(nxt);
            if constexpr (SP2) {
            PG8_LDB(B0, 0, 0); PG8_LDB(B1, 0, 1); PG8_SCHED; PG8_LDA(At, 0, 0); PG8_STAGE(PG8_SA(1, 1), a1 + hstepA, voffA);
            PG8_WAIT_V(8); PG8_WAIT_L(0); PG8_BAR; PG8_MMA(0, 0, At, B0); PG8_MMA(0, 1, At, B1); PG8_BAR; PG8_SCHED;
            PG8_LDA(At, 0, 1); PG8_STAGE(PG8_SB(0, 0), b2, voffB); PG8_STAGE(PG8_SB(0, 1), b2 + hstepB, voffB); PG8_STAGE(PG8_SA(0, 0), a2, voffA);
            PG8_WAIT_V(8); PG8_WAIT_L(0); PG8_BAR; PG8_MMA(1, 0, At, B0); PG8_MMA(1, 1, At, B1); PG8_BAR; PG8_SCHED;
            PG8_LDB(B0, 1, 0); PG8_LDB(B1, 1, 1); PG8_SCHED; PG8_LDA(At, 1, 0); PG8_STAGE(PG8_SA(0, 1), a2 + hstepA, voffA);
            PG8_WAIT_V(8); PG8_WAIT_L(0); PG8_BAR; PG8_MMA(0, 0, At, B0); PG8_MMA(0, 1, At, B1); PG8_BAR; PG8_SCHED;
            PG8_LDA(At, 1, 1); PG8_STAGE(PG8_SB(1, 0), b3, voffB); PG8_STAGE(PG8_SB(1, 1), b3 + hstepB, voffB); PG8_STAGE(PG8_SA(1, 0), a3, voffA);
            PG8_WAIT_V(8); PG8_WAIT_L(0); PG8_BAR; PG8_MMA(1, 0, At, B0); PG8_MMA(1, 1, At, B1); PG8_BAR; PG8_SCHED;
            } else {
            PG8_LDB(B0, 0, 0); PG8_SCHED; PG8_LDA(At, 0, 0); PG8_STAGE(PG8_SA(1, 1), a1 + hstepA, voffA);
            PG8_WAIT_L(8); PG8_BAR; PG8_WAIT_L(0); PG8_MMA(0, 0, At, B0); PG8_BAR; PG8_SCHED;
            PG8_LDB(B1, 0, 1); PG8_STAGE(PG8_SB(0, 0), b2, voffB);
            PG8_BAR; PG8_WAIT_L(0); PG8_MMA(0, 1, At, B1); PG8_BAR;
            PG8_LDA(At, 0, 1); PG8_STAGE(PG8_SA(0, 0), a2, voffA);
            PG8_BAR; PG8_WAIT_L(0); PG8_MMA(1, 0, At, B0); PG8_BAR; PG8_SCHED;
            PG8_STAGE(PG8_SB(0, 1), b2 + hstepB, voffB);
            PG8_WAIT_V(6); PG8_BAR; PG8_MMA(1, 1, At, B1); PG8_BAR;
            PG8_LDB(B0, 1, 0); PG8_SCHED; PG8_LDA(At, 1, 0); PG8_STAGE(PG8_SA(0, 1), a2 + hstepA, voffA);
            PG8_WAIT_L(8); PG8_BAR; PG8_WAIT_L(0); PG8_MMA(0, 0, At, B0); PG8_BAR; PG8_SCHED;
            PG8_LDB(B1, 1, 1); PG8_STAGE(PG8_SB(1, 0), b3, voffB);
            PG8_BAR; PG8_WAIT_L(0); PG8_MMA(0, 1, At, B1); PG8_BAR;
            PG8_LDA(At, 1, 1); PG8_STAGE(PG8_SA(1, 0), a3, voffA);
            PG8_BAR; PG8_WAIT_L(0); PG8_MMA(1, 0, At, B0); PG8_BAR; PG8_SCHED;
            PG8_STAGE(PG8_SB(1, 1), b3 + hstepB, voffB);
            PG8_WAIT_V(6); PG8_BAR; PG8_MMA(1, 1, At, B1); PG8_BAR;
            }
        }
        if constexpr (ALIGN_EPI) { if (wr == 0) PG8_BAR; }
        if constexpr (!Epi::AFTER_DRAIN) { E(acc, cur, wr, wc, fr, fq); S.done(cur); }
        if (!has_next) break;
#pragma unroll
        for (int a = 0; a < 2; ++a)
#pragma unroll
            for (int b = 0; b < 2; ++b)
#pragma unroll
                for (int m = 0; m < 4; ++m)
#pragma unroll
                    for (int n = 0; n < 2; ++n) acc[a][b][m][n] = (f32x4){0.f, 0.f, 0.f, 0.f};
        cur = nxt; cA = nA; cB = nB; ++ui;
        if constexpr (ALIGN_EPI) { if (wr == 1) PG8_BAR; }
    }
    PG8_WAIT_V(0);
    if constexpr (!ALIGN_EPI) { if (wr == 0) PG8_BAR; }
    PG8_BAR;
    if constexpr (Epi::AFTER_DRAIN) { E.fused(acc, cur, wr, wc, fr, fq, lds, wid, lane); S.done(cur); }
#undef PG8_SA
#undef PG8_SB
#undef PG8_STAGE
#undef PG8_LDA
#undef PG8_LDB
#undef PG8_MMA
#undef PG8_WAIT_V
#undef PG8_WAIT_L
#undef PG8_BAR
#undef PG8_SCHED
}

__device__ __forceinline__ void tr_item(const float* src, int ldn, int k0, int n0, bf16_t* dst, int dld, int drow0, int dk0, float* scr, int lane) {
    const float* sp = src + (size_t)k0 * ldn + n0 + lane;
    float t[64];
#pragma unroll
    for (int i = 0; i < 64; ++i) t[i] = __builtin_nontemporal_load(sp + (size_t)i * ldn);
#pragma unroll
    for (int i = 0; i < 64; ++i) scr[i * 65 + lane] = t[i];
    __builtin_amdgcn_s_waitcnt(0); asm volatile("" ::: "memory");
    const int c = lane & 7;
#pragma unroll
    for (int j = 0; j < 8; ++j) {
        const int n = (lane >> 3) + 8 * j; const float* s = scr + (8 * c) * 65 + n;
        u32x4 o; o.x = pk2(s[0], s[65]); o.y = pk2(s[2 * 65], s[3 * 65]); o.z = pk2(s[4 * 65], s[5 * 65]); o.w = pk2(s[6 * 65], s[7 * 65]);
        *(u32x4*)(dst + (size_t)(drow0 + n) * dld + dk0 + 8 * c) = o;
    }
    __builtin_amdgcn_s_waitcnt(0); asm volatile("" ::: "memory");
}

__device__ __forceinline__ void convert_layer(const Args& a, unsigned char* lds, int l, int widx, int nw, int it_lo = 0, int it_hi = 1 << 30) {
    const int tid = otid(), wave = tid >> 6, lane = tid & 63;
    float* scr = (float*)(lds + wave * 16640);
    constexpr int I_IN = 32 * 192, I_BR = 4 * 8 * 32, I_O = 32 * 32, I_G = 32 * 88, I_D = 88 * 32, I_B = 16;
    constexpr int PLI = I_IN + I_BR + I_O + 2 * I_G + I_D + I_B;
    unsigned char* wb = a.ws + WS_W + (size_t)l * WPL;
    if (it_hi > PLI) it_hi = PLI;
    for (int it = it_lo + widx; it < it_hi; it += nw) {
        int r = it;
        if (r < I_IN) { const int kb = r / 192, nb = r % 192; tr_item(a.in[I_WIN] + (size_t)l * DM * NIN, NIN, kb * 64, nb * 64, (bf16_t*)(wb + W_IN), DM, nb * 64, kb * 64, scr, lane); continue; } r -= I_IN;
        if (r < I_BR) { const int i = r >> 8, rr = r & 255, kb = rr >> 5, nb = rr & 31;
            tr_item(a.in[I_WBR] + (size_t)(l * 4 + i) * 512 * DM, DM, kb * 64, nb * 64, (bf16_t*)(wb + W_BR), DM, nb * 64, i * 512 + kb * 64, scr, lane); continue; } r -= I_BR;
        if (r < I_O) { const int kb = r >> 5, nb = r & 31; tr_item(a.in[I_WO] + (size_t)l * DM * DM, DM, kb * 64, nb * 64, (bf16_t*)(wb + W_O), DM, nb * 64, kb * 64, scr, lane); continue; } r -= I_O;
        if (r < I_G) { const int kb = r / 88, nb = r % 88, n0 = nb * 64; tr_item(a.in[I_WG] + (size_t)l * DM * FF, FF, kb * 64, n0, (bf16_t*)(wb + W_GU), DM, (n0 >> 7) * 256 + (n0 & 127), kb * 64, scr, lane); continue; } r -= I_G;
        if (r < I_G) { const int kb = r / 88, nb = r % 88, n0 = nb * 64; tr_item(a.in[I_WU] + (size_t)l * DM * FF, FF, kb * 64, n0, (bf16_t*)(wb + W_GU), DM, (n0 >> 7) * 256 + 128 + (n0 & 127), kb * 64, scr, lane); continue; } r -= I_G;
        if (r < I_D) { const int kb = r >> 5, nb = r & 31; tr_item(a.in[I_WD] + (size_t)l * FF * DM, DM, kb * 64, nb * 64, (bf16_t*)(wb + W_D), FF, nb * 64, kb * 64, scr, lane); continue; } r -= I_D;
        { const int g = r >> 2, kb = (r >> 1) & 1, nb = r & 1;
          tr_item(a.in[I_BW] + (size_t)(l * 4 + g) * 128 * 128, 128, kb * 64, nb * 64, (bf16_t*)(wb + W_B), 512, g * 128 + nb * 64, g * 128 + kb * 64, scr, lane); }
    }
}
__device__ __forceinline__ void phase_prologue(const Args& a, unsigned char* lds, int vcu, int G) {
    const int tid = otid(), wave = tid >> 6;
    convert_layer(a, lds, 0, vcu * NWAVE + wave, G * NWAVE);
    for (int i = vcu * NTHR + tid; i < 2 * 32768; i += G * NTHR) {
        const int l = i >> 15, j = i & 32767, n = j >> 6, kc = j & 63;
        if ((n >> 7) != (kc >> 4)) *(u32x4*)((bf16_t*)(a.ws + WS_W + (size_t)l * WPL + W_B) + (size_t)n * 512 + kc * 8) = (u32x4){0u, 0u, 0u, 0u};
    }
    float* MOD = (float*)(a.ws + WS_CTL + CTL_MOD);
    for (int it = vcu; it < 768; it += G) {
        const int l = it / 384, r = it % 384, cb = r >> 6, kc = r & 63;
        const int col = cb * 2048 + tid * 4;
        f32x4 al = {0.f, 0.f, 0.f, 0.f}, ac = {0.f, 0.f, 0.f, 0.f};
        const float* wp = a.in[I_ADAW] + ((size_t)l * DM + kc * 32) * NIN + col;
#pragma unroll 8
        for (int k = 0; k < 32; ++k) {
            const float sl = siluf_(a.in[I_C][kc * 32 + k]), sc = siluf_(a.in[I_CCTX][kc * 32 + k]);
            const f32x4 w = *(const f32x4*)(wp + (size_t)k * NIN);
            al += sl * w; ac += sc * w;
        }
        if (kc == 0) { const f32x4 b = *(const f32x4*)(a.in[I_ADAB] + (size_t)l * NIN + col); al += b; ac += b; }
        float* ml = MOD + (size_t)(l * 2 + 0) * NIN + col; float* mc = MOD + (size_t)(l * 2 + 1) * NIN + col;
#pragma unroll
        for (int e = 0; e < 4; ++e) { unsafeAtomicAdd(ml + e, al[e]); unsafeAtomicAdd(mc + e, ac[e]); }
    }
}

template <int MODE>
__device__ __forceinline__ void phase_rows(const Args& a, int vcu, int G, int nrows, const float* gpost, const float* modcur, int gate_idx,
                                           const float* gnext, const float* modnext, int sh_idx, const float* ypart = nullptr) {
    const int tid = otid(), wave = tid >> 6, lane = tid & 63;
    const int gw = vcu * NWAVE + wave, NGW = G * NWAVE;
    float* X = (float*)(a.ws + WS_X); const float* Y = (const float*)(a.ws + WS_MRG); bf16_t* XN = (bf16_t*)(a.ws + WS_XN);
    for (int row = gw; row < nrows; row += NGW) {
        const int isctx = row >= SEQ ? 1 : 0;
        f32x4 x[8];
        if (MODE == 0) {
            const float* src = isctx ? a.in[I_CTX] + (size_t)(row - SEQ) * DM : a.in[I_X] + (size_t)row * DM;
#pragma unroll
            for (int j = 0; j < 8; ++j) x[j] = *(const f32x4*)(src + 4 * lane + 256 * j);
        } else {
            f32x4 y[8]; float ss = 0.f;
#pragma unroll
            for (int j = 0; j < 8; ++j) { x[j] = *(const f32x4*)(X + (size_t)row * DM + 4 * lane + 256 * j);
                if (ypart && isctx) { const float* yp = ypart + (size_t)(row - SEQ) * DM + 4 * lane + 256 * j;
                    y[j] = (*(const f32x4*)yp + *(const f32x4*)(yp + (size_t)CTXL * DM)) + (*(const f32x4*)(yp + (size_t)2 * CTXL * DM) + *(const f32x4*)(yp + (size_t)3 * CTXL * DM)); }
                else y[j] = *(const f32x4*)(Y + (size_t)row * DM + 4 * lane + 256 * j);
                ss += (y[j][0] * y[j][0] + y[j][1] * y[j][1]) + (y[j][2] * y[j][2] + y[j][3] * y[j][3]); }
            const float rstd = 1.0f / sqrtf(wave_sum(ss) * (1.f / DM) + EPS);
            const float* gate = modcur + (size_t)isctx * NIN + gate_idx * DM;
#pragma unroll
            for (int j = 0; j < 8; ++j) { const int col = 4 * lane + 256 * j; const f32x4 gp = *(const f32x4*)(gpost + col), gt = *(const f32x4*)(gate + col);
                x[j] += gt * (y[j] * rstd * gp); }
        }
        if (MODE == 2) {
#pragma unroll
            for (int j = 0; j < 8; ++j) *(f32x4*)(a.out + (size_t)row * DM + 4 * lane + 256 * j) = x[j];
            continue;
        }
        float ss = 0.f;
#pragma unroll
        for (int j = 0; j < 8; ++j) { *(f32x4*)(X + (size_t)row * DM + 4 * lane + 256 * j) = x[j];
            ss += (x[j][0] * x[j][0] + x[j][1] * x[j][1]) + (x[j][2] * x[j][2] + x[j][3] * x[j][3]); }
        const float rstd = 1.0f / sqrtf(wave_sum(ss) * (1.f / DM) + EPS);
        const float* sh = modnext + (size_t)isctx * NIN + sh_idx * DM; const float* sc = sh + DM;
#pragma unroll
        for (int j = 0; j < 8; ++j) { const int col = 4 * lane + 256 * j; const f32x4 gn = *(const f32x4*)(gnext + col), s1 = *(const f32x4*)(sc + col), s0 = *(const f32x4*)(sh + col);
            const f32x4 h = (x[j] * rstd * gn) * (1.f + s1) + s0;
            u32x2 w; w.x = pk2(h[0], h[1]); w.y = pk2(h[2], h[3]); *(u32x2*)(XN + (size_t)row * DM + col) = w; }
    }
}

__device__ __forceinline__ void qk_prep_row(const Args& a, int layer, int row, int lane) {
    bf16_t* p = (bf16_t*)(a.ws + WS_PL) + (size_t)row * NIN;
    const int ax = lane >> 5, f = lane & 31, d1 = ax * 64 + f, d2 = d1 + 32;
    float cs = 1.f, sn = 0.f;
    if (row < SEQ) { const float pos = (float)(ax == 0 ? (row >> 6) : (row & 63)); const float inv = exp2f(-(float)f * (13.287712379549449f / 32.f)); const float ang = pos * inv; cs = cosf(ang); sn = sinf(ang); }
#pragma unroll
    for (int h = 0; h < 6; ++h) {
        const float* gn = (h < 4 ? a.in[I_AQN] : a.in[I_AKN]) + layer * HD;
        bf16_t* hp = p + h * HD;
        float x1 = bf2f(hp[d1]), x2 = bf2f(hp[d2]);
        const float rstd = 1.0f / sqrtf(wave_sum(x1 * x1 + x2 * x2) * (1.f / HD) + EPS);
        x1 = x1 * rstd * gn[d1]; x2 = x2 * rstd * gn[d2];
        hp[d1] = (bf16_t)f2bf(x1 * cs - x2 * sn); hp[d2] = (bf16_t)f2bf(x2 * cs + x1 * sn);
    }
}
__device__ __forceinline__ void dlt_row(const Args& a, int row, int lane) {
    const bf16_t* PL = (const bf16_t*)(a.ws + WS_PL); bf16_t* DLT = (bf16_t*)(a.ws + WS_DLT);
    const int base = row < SEQ ? 0 : SEQ, n = row < SEQ ? SEQ : CTXL, t = row - base, half = 1 << (lane >> 4);
    const int lo = max(t - half, 0), hi = min(t + half, n);
    float s[8];
#pragma unroll
    for (int e = 0; e < 8; ++e) s[e] = 0.f;
    u32x4 w[16];
#pragma unroll
    for (int i = 0; i < 16; ++i) { const int r = min(max(t - 8 + i, 0), n - 1); w[i] = *(const u32x4*)(PL + (size_t)(base + r) * NIN + B0 + lane * 8); }
#pragma unroll
    for (int i = 0; i < 16; ++i) { const int r = t - 8 + i; const float m = (r >= lo && r < hi) ? 1.f : 0.f;
        s[0] += m * bflo(w[i].x); s[1] += m * bfhi(w[i].x); s[2] += m * bflo(w[i].y); s[3] += m * bfhi(w[i].y); s[4] += m * bflo(w[i].z); s[5] += m * bfhi(w[i].z); s[6] += m * bflo(w[i].w); s[7] += m * bfhi(w[i].w); }
    const float inv = 1.f / (float)(hi - lo);
    const u32x4 c = w[8];
    u32x4 o; o.x = pk2(s[0] * inv - bflo(c.x), s[1] * inv - bfhi(c.x)); o.y = pk2(s[2] * inv - bflo(c.y), s[3] * inv - bfhi(c.y));
    o.z = pk2(s[4] * inv - bflo(c.z), s[5] * inv - bfhi(c.z)); o.w = pk2(s[6] * inv - bflo(c.w), s[7] * inv - bfhi(c.w));
    *(u32x4*)(DLT + (size_t)row * 512 + lane * 8) = o;
}
constexpr int CP = 136;
__device__ __forceinline__ void cmix_unit(const Args& a, int layer, int unit, unsigned char* lds) {
    const int tid = otid(), wave = tid >> 6, lane = tid & 63, chunk = unit >> 2, g = unit & 3;
    const bf16_t* PL = (const bf16_t*)(a.ws + WS_PL); bf16_t* OUT = (bf16_t*)(a.ws + WS_OUTS) + 2 * 512;
    bf16_t* vT = (bf16_t*)lds;
    bf16_t* wsL = (bf16_t*)(lds + 128 * CP * 2);
    float* st = (float*)(lds + 2 * 128 * CP * 2);
    const int t0 = chunk * 128;
    for (int i = 0; i < 16; ++i) {
        const int q = wave * 16 + i;
        const u32x4 w = *(const u32x4*)(PL + (size_t)(t0 + q) * NIN + C_V0 + lane * 8);
        float x[8] = {bflo(w.x), bfhi(w.x), bflo(w.y), bfhi(w.y), bflo(w.z), bfhi(w.z), bflo(w.w), bfhi(w.w)};
        float s = 0.f;
#pragma unroll
        for (int e = 0; e < 8; ++e) s += x[e];
        const float mean = wave_sum(s) * (1.f / 512.f); float q2 = 0.f;
#pragma unroll
        for (int e = 0; e < 8; ++e) { const float d = x[e] - mean; q2 += d * d; }
        const float rstd = 1.0f / sqrtf(wave_sum(q2) * (1.f / 512.f) + EPS);
        if (lane == 0) { st[2 * q] = mean; st[2 * q + 1] = rstd; }
    }
    __syncthreads();
    {
        const int q = tid & 127, cb = tid >> 7; const float mean = st[2 * q], rstd = st[2 * q + 1];
        const float* lg = a.in[I_CNG] + layer * 512 + g * 128 + cb * 32; const float* lb = a.in[I_CNB] + layer * 512 + g * 128 + cb * 32;
        const bf16_t* vp = PL + (size_t)(t0 + q) * NIN + C_V0 + g * 128 + cb * 32;
#pragma unroll
        for (int j = 0; j < 4; ++j) { const u32x4 w = *(const u32x4*)(vp + j * 8);
            const float x[8] = {bflo(w.x), bfhi(w.x), bflo(w.y), bfhi(w.y), bflo(w.z), bfhi(w.z), bflo(w.w), bfhi(w.w)};
#pragma unroll
            for (int e = 0; e < 8; ++e) { const int c = j * 8 + e; vT[(cb * 32 + c) * CP + q] = (bf16_t)f2bf((x[e] - mean) * rstd * lg[c] + lb[c]); } }
        const int p = tid >> 2, qb = (tid & 3) * 32; const float* wp = a.in[I_CWS] + ((size_t)(layer * 4 + g) * 128 + p) * 128 + qb;
#pragma unroll
        for (int j = 0; j < 8; ++j) { const f32x4 w = *(const f32x4*)(wp + j * 4); u32x2 o; o.x = pk2(w[0], w[1]); o.y = pk2(w[2], w[3]); *(u32x2*)(wsL + p * CP + qb + j * 4) = o; }
    }
    __syncthreads();
    {
        const int fr = lane & 15, fq = lane >> 4;
        f32x4 acc[8];
#pragma unroll
        for (int nb = 0; nb < 8; ++nb) acc[nb] = (f32x4){0.f, 0.f, 0.f, 0.f};
#pragma unroll
        for (int ks = 0; ks < 4; ++ks) {
            const bf16x8 wf = *(const bf16x8*)(wsL + (wave * 16 + fr) * CP + ks * 32 + fq * 8);
#pragma unroll
            for (int nb = 0; nb < 8; ++nb) { const bf16x8 vf = *(const bf16x8*)(vT + (nb * 16 + fr) * CP + ks * 32 + fq * 8);
                acc[nb] = __builtin_amdgcn_mfma_f32_16x16x32_bf16(vf, wf, acc[nb], 0, 0, 0); }
        }
        const int p = wave * 16 + fr; const float bs = a.in[I_CBS][(layer * 4 + g) * 128 + p];
        const bf16_t* up = PL + (size_t)(t0 + p) * NIN + C_U0 + g * 128; bf16_t* op = OUT + (size_t)(t0 + p) * DM + g * 128;
#pragma unroll
        for (int nb = 0; nb < 8; ++nb) { const int c = nb * 16 + 4 * fq; const u32x2 uw = *(const u32x2*)(up + c);
            u32x2 o; o.x = pk2((acc[nb][0] + bs) * bflo(uw.x), (acc[nb][1] + bs) * bfhi(uw.x)); o.y = pk2((acc[nb][2] + bs) * bflo(uw.y), (acc[nb][3] + bs) * bfhi(uw.y));
            *(u32x2*)(op + c) = o; }
    }
    __syncthreads();
}

template <int MODE>
__device__ __forceinline__ void attn_simple_item(const bf16_t* PL, int qcol, int kcol, int vcol, bf16_t* O, int qrow, int h, int kvh, int kbeg, int kend, const float* rpb, int lane) {
    constexpr float C = 0.088388347648318440f * 1.4426950408889634f;
    const int part = lane & 3;
    float q[32], o[32];
    { const bf16_t* qp = PL + (size_t)qrow * NIN + qcol + h * HD + part * 32;
#pragma unroll
      for (int j = 0; j < 4; ++j) { const u32x4 w = *(const u32x4*)(qp + j * 8);
          q[j * 8 + 0] = bflo(w.x) * C; q[j * 8 + 1] = bfhi(w.x) * C; q[j * 8 + 2] = bflo(w.y) * C; q[j * 8 + 3] = bfhi(w.y) * C;
          q[j * 8 + 4] = bflo(w.z) * C; q[j * 8 + 5] = bfhi(w.z) * C; q[j * 8 + 6] = bflo(w.w) * C; q[j * 8 + 7] = bfhi(w.w) * C; } }
#pragma unroll
    for (int d = 0; d < 32; ++d) o[d] = 0.f;
    float mrun = -1e30f, l = 0.f;
    const int r = qrow >> 6, c = qrow & 63, r0 = min(max(r - 4, 0), 120), c0 = min(max(c - 8, 0), 48);
    const int nk = MODE == 0 ? (kend - kbeg) : 384;
    for (int idx = 0; idx < nk; ++idx) {
        int krow; float bias = 0.f;
        if (MODE == 0) krow = kbeg + idx;
        else if (idx < 128) { const int i = idx >> 4, j = idx & 15; krow = (r0 + i) * GW + c0 + j; bias = rpb[(h * 15 + (r0 + i - r + 7)) * 31 + (c0 + j - c + 15)] * 1.4426950408889634f; }
        else krow = SEQ + idx - 128;
        const bf16_t* kp = PL + (size_t)krow * NIN + kcol + kvh * HD + part * 32;
        float s = 0.f;
#pragma unroll
        for (int j = 0; j < 4; ++j) { const u32x4 w = *(const u32x4*)(kp + j * 8);
            s += q[j * 8 + 0] * bflo(w.x) + q[j * 8 + 1] * bfhi(w.x) + q[j * 8 + 2] * bflo(w.y) + q[j * 8 + 3] * bfhi(w.y)
               + q[j * 8 + 4] * bflo(w.z) + q[j * 8 + 5] * bfhi(w.z) + q[j * 8 + 6] * bflo(w.w) + q[j * 8 + 7] * bfhi(w.w); }
        s += __shfl_xor(s, 1); s += __shfl_xor(s, 2);
        s += bias;
        const float mn = fmaxf(mrun, s), alpha = exp2f(mrun - mn), p = exp2f(s - mn);
        l = l * alpha + p; mrun = mn;
        const bf16_t* vp = PL + (size_t)krow * NIN + vcol + kvh * HD + part * 32;
#pragma unroll
        for (int j = 0; j < 4; ++j) { const u32x4 w = *(const u32x4*)(vp + j * 8);
            o[j * 8 + 0] = o[j * 8 + 0] * alpha + p * bflo(w.x); o[j * 8 + 1] = o[j * 8 + 1] * alpha + p * bfhi(w.x);
            o[j * 8 + 2] = o[j * 8 + 2] * alpha + p * bflo(w.y); o[j * 8 + 3] = o[j * 8 + 3] * alpha + p * bfhi(w.y);
            o[j * 8 + 4] = o[j * 8 + 4] * alpha + p * bflo(w.z); o[j * 8 + 5] = o[j * 8 + 5] * alpha + p * bfhi(w.z);
            o[j * 8 + 6] = o[j * 8 + 6] * alpha + p * bflo(w.w); o[j * 8 + 7] = o[j * 8 + 7] * alpha + p * bfhi(w.w); }
    }
    const float il = 1.f / l;
    bf16_t* op = O + (size_t)qrow * 512 + h * HD + part * 32;
#pragma unroll
    for (int j = 0; j < 4; ++j) { u32x4 w; w.x = pk2(o[j * 8 + 0] * il, o[j * 8 + 1] * il); w.y = pk2(o[j * 8 + 2] * il, o[j * 8 + 3] * il);
        w.z = pk2(o[j * 8 + 4] * il, o[j * 8 + 5] * il); w.w = pk2(o[j * 8 + 6] * il, o[j * 8 + 7] * il); *(u32x4*)(op + j * 8) = w; }
}


namespace att {
using s16x4 = __attribute__((ext_vector_type(4))) short;
using f32x16 = __attribute__((ext_vector_type(16))) float;
constexpr int KVBLK = 64;
constexpr float SCALE = 0.088388347648318440f, THR = 8.f;
constexpr int SHM_V = KVBLK * HD * 2, SHM_K = KVBLK * HD * 2, SHM_ATTN = 2 * SHM_V + 2 * SHM_K + NWAVE * 64 * 4;
#define KSWZ(row, colB) ((row) * 256 + ((colB) ^ (((row) & 7) << 4)))
#define SBAR() __builtin_amdgcn_sched_barrier(0)
__device__ __forceinline__ int crow(int r, int hi) { return (r & 3) + 8 * (r >> 2) + 4 * hi; }
__device__ __forceinline__ unsigned cvtpk(float lo, float hi) { unsigned r; asm volatile("v_cvt_pk_bf16_f32 %0, %1, %2" : "=v"(r) : "v"(lo), "v"(hi)); return r; }
__device__ __forceinline__ void partialSM(f32x16& p0, f32x16& p1, float& m_reg, float& mn, float& alpha) {
  constexpr float C = SCALE * 1.4426950408889634f;
  float pmax = p0[0];
#pragma unroll
  for (int r = 1; r < 16; ++r) pmax = fmaxf(pmax, p0[r]);
#pragma unroll
  for (int r = 0; r < 16; ++r) pmax = fmaxf(pmax, p1[r]);
  { auto rr = __builtin_amdgcn_permlane32_swap(__float_as_uint(pmax), __float_as_uint(pmax), false, false);
    pmax = fmaxf(__uint_as_float(rr[0]), __uint_as_float(rr[1])); }
  if (__builtin_expect(__all(pmax - m_reg <= THR / SCALE), 1)) { mn = m_reg; alpha = 1.f; }
  else { mn = fmaxf(m_reg, pmax); alpha = __builtin_amdgcn_exp2f((m_reg - mn) * C); m_reg = mn; }
  float mnC = -mn * C;
#pragma unroll
  for (int r = 0; r < 16; ++r) p0[r] = fmaf(p0[r], C, mnC);
#pragma unroll
  for (int r = 0; r < 16; ++r) p1[r] = fmaf(p1[r], C, mnC);
#pragma unroll
  for (int r = 0; r < 16; ++r) p0[r] = __builtin_amdgcn_exp2f(p0[r]);
}
__device__ __forceinline__ void finishSM(f32x16& p0, f32x16& p1, float alpha, float& l_reg, bf16x8& pa0, bf16x8& pa1, bf16x8& pa2, bf16x8& pa3) {
#pragma unroll
  for (int r = 0; r < 16; ++r) p1[r] = __builtin_amdgcn_exp2f(p1[r]);
  float ps = 0;
#pragma unroll
  for (int r = 0; r < 16; ++r) ps += p0[r];
#pragma unroll
  for (int r = 0; r < 16; ++r) ps += p1[r];
  { auto rr = __builtin_amdgcn_permlane32_swap(__float_as_uint(ps), __float_as_uint(ps), false, false);
    ps = __uint_as_float(rr[0]) + __uint_as_float(rr[1]); }
  l_reg = l_reg * alpha + ps;
#define PK4(P, BASE, OUT) do { unsigned a0 = cvtpk(P[BASE + 0], P[BASE + 1]), a1 = cvtpk(P[BASE + 2], P[BASE + 3]);   \
    unsigned b0 = cvtpk(P[BASE + 4], P[BASE + 5]), b1 = cvtpk(P[BASE + 6], P[BASE + 7]);                              \
    auto r0 = __builtin_amdgcn_permlane32_swap(a0, b0, false, false); auto r1 = __builtin_amdgcn_permlane32_swap(a1, b1, false, false); \
    u32x4 w = {r0[0], r1[0], r0[1], r1[1]}; OUT = *reinterpret_cast<bf16x8*>(&w); } while (0)
  PK4(p0, 0, pa0); PK4(p0, 8, pa1); PK4(p1, 0, pa2); PK4(p1, 8, pa3);
#undef PK4
}
__device__ __forceinline__ void qkt(f32x16& p0, f32x16& p1, const char* Ks, const bf16x8* qr, int r32, int hi) {
  p0 = f32x16{}; p1 = f32x16{};
#pragma unroll
  for (int d0 = 0; d0 < 8; ++d0) { int cb = (d0 * 16 + hi * 8) * 2;
    bf16x8 b0 = *reinterpret_cast<const bf16x8*>(Ks + KSWZ(r32, cb));
    bf16x8 b1 = *reinterpret_cast<const bf16x8*>(Ks + KSWZ(32 + r32, cb));
    p0 = __builtin_amdgcn_mfma_f32_32x32x16_bf16(b0, qr[d0], p0, 0, 0, 0);
    p1 = __builtin_amdgcn_mfma_f32_32x32x16_bf16(b1, qr[d0], p1, 0, 0, 0); }
}
__device__ __forceinline__ int v_st(int k, int c) { const int kk = (k & ~0xC) | ((k & 4) << 1) | ((k & 8) >> 1); return ((kk >> 3) * 4 + (c >> 5)) * 512 + ((kk & 7) * 32 + (c & 31)) * 2; }
__device__ __forceinline__ int v_rd_base(int lane) { return ((lane & 3) << 3) | (((lane >> 2) & 3) << 6) | (((lane >> 4) & 1) << 5) | (((lane >> 5) & 1) << 8); }
constexpr int v_rd_off(int d0, int ks, int half) { return d0 * 512 + ks * 4096 + half * 2048; }
template <int OFF> __device__ __forceinline__ s16x4 tr_read(int vb) {
  s16x4 r; asm volatile("ds_read_b64_tr_b16 %0, %1 offset:%2" : "=&v"(r) : "v"(vb), "i"(OFF) : "memory"); return r;
}
template <int D0> __device__ __forceinline__ void pv_one(f32x16& od, int vb, bf16x8 pa0, bf16x8 pa1, bf16x8 pa2, bf16x8 pa3) {
  const s16x4 l0 = tr_read<v_rd_off(D0, 0, 0)>(vb), h0 = tr_read<v_rd_off(D0, 0, 1)>(vb), l1 = tr_read<v_rd_off(D0, 1, 0)>(vb), h1 = tr_read<v_rd_off(D0, 1, 1)>(vb);
  const s16x4 l2 = tr_read<v_rd_off(D0, 2, 0)>(vb), h2 = tr_read<v_rd_off(D0, 2, 1)>(vb), l3 = tr_read<v_rd_off(D0, 3, 0)>(vb), h3 = tr_read<v_rd_off(D0, 3, 1)>(vb);
  asm volatile("s_waitcnt lgkmcnt(0)" ::: "memory"); SBAR();
#define PK(L, H) (bf16x8){L[0], L[1], L[2], L[3], H[0], H[1], H[2], H[3]}
  od = __builtin_amdgcn_mfma_f32_32x32x16_bf16(pa0, PK(l0, h0), od, 0, 0, 0);
  od = __builtin_amdgcn_mfma_f32_32x32x16_bf16(pa1, PK(l1, h1), od, 0, 0, 0);
  od = __builtin_amdgcn_mfma_f32_32x32x16_bf16(pa2, PK(l2, h2), od, 0, 0, 0);
  od = __builtin_amdgcn_mfma_f32_32x32x16_bf16(pa3, PK(l3, h3), od, 0, 0, 0);
#undef PK
}
__device__ __forceinline__ void pv_d0(f32x16* o, int vb, bf16x8 pa0, bf16x8 pa1, bf16x8 pa2, bf16x8 pa3) {
  pv_one<0>(o[0], vb, pa0, pa1, pa2, pa3); pv_one<1>(o[1], vb, pa0, pa1, pa2, pa3); pv_one<2>(o[2], vb, pa0, pa1, pa2, pa3); pv_one<3>(o[3], vb, pa0, pa1, pa2, pa3);
}
__device__ __forceinline__ void na_hook(f32x16& p0, f32x16& p1, int kr, int qr, int qc, int hi, const float* rpbh) {
  const int r0 = min(max(qr - 4, 0), 120), c0 = min(max(qc - 8, 0), 48);
  if (kr < r0 || kr >= r0 + 8) {
#pragma unroll
    for (int r = 0; r < 16; ++r) { p0[r] = -1e30f; p1[r] = -1e30f; }
  } else {
    const float* bp = rpbh + (kr - qr + 7) * 31 + 15 - qc;
#pragma unroll
    for (int r = 0; r < 16; ++r) {
      const int kc0 = crow(r, hi), kc1 = 32 + kc0;
      const bool v0 = (unsigned)(kc0 - c0) < 16u, v1 = (unsigned)(kc1 - c0) < 16u;
      const float b0 = v0 ? bp[kc0] : 0.f, b1 = v1 ? bp[kc1] : 0.f;
      p0[r] = v0 ? fmaf(b0, 1.f / SCALE, p0[r]) : -1e30f;
      p1[r] = v1 ? fmaf(b1, 1.f / SCALE, p1[r]) : -1e30f;
      if ((r & 3) == 3) SBAR();
    }
  }
}
template <int MODE, bool DIRECT>
__device__ __forceinline__ void attn_unit(const bf16_t* __restrict__ PL, int qrow0, int qcol, int kcol, int vcol, int NT, int base0, int n0, int base1,
                                          const float* rpbh, bf16_t* Obf, float* Opart, float* LSE, char* lds) {
  const int tid = otid(), wid = tid >> 6, lane = tid & 63, r32 = lane & 31, hi = lane >> 5;
  char* V_lds = lds; char* K_lds = lds + 2 * SHM_V;
  float* wsf = (float*)(lds + 2 * SHM_V + 2 * SHM_K) + wid * 64; float* li_l = wsf; float* al_l = wsf + 32;
  float m_reg = -1e30f, l_reg = 0; f32x16 o[4] = {}; bf16x8 qr[8];
  const bf16_t* Qw = PL + (size_t)(qrow0 + wid * 32 + r32) * NIN + qcol + hi * 8;
#pragma unroll
  for (int d0 = 0; d0 < 8; ++d0) qr[d0] = *reinterpret_cast<const bf16x8*>(Qw + d0 * 16);
  const int qgr = __builtin_amdgcn_readfirstlane((qrow0 + wid * 32) >> 6);
  const int sr = tid >> 4, sc = (tid & 15) * 8, vst0 = v_st(sr, sc), vst1 = v_st(32 + sr, sc);
  const int vb0 = (int)(uintptr_t)V_lds + v_rd_base(lane);
  const bf16_t* Kg = PL + (size_t)sr * NIN + kcol + sc; const bf16_t* Vg = PL + (size_t)sr * NIN + vcol + sc;
  constexpr int SD = 1;
  struct { bf16x8 vs0, vs1, ks0, ks1; } sr_[SD];
#define KROW(j) ((j) < n0 ? base0 + 64 * (j) : base1 + 64 * ((j) - n0))
#define SLOAD(i, j) do { const size_t ko_ = (size_t)KROW(j) * NIN; sr_[i].vs0 = *reinterpret_cast<const bf16x8*>(Vg + ko_); sr_[i].vs1 = *reinterpret_cast<const bf16x8*>(Vg + ko_ + (size_t)32 * NIN); \
    sr_[i].ks0 = *reinterpret_cast<const bf16x8*>(Kg + ko_); sr_[i].ks1 = *reinterpret_cast<const bf16x8*>(Kg + ko_ + (size_t)32 * NIN); } while (0)
#define SWRITE(b, i) do { *(bf16x8*)(V_lds + (b) * SHM_V + vst0) = sr_[i].vs0;          \
    *(bf16x8*)(V_lds + (b) * SHM_V + vst1) = sr_[i].vs1; int kc = sc * 2;               \
    *(bf16x8*)(K_lds + (b) * SHM_K + KSWZ(sr, kc)) = sr_[i].ks0;                       \
    *(bf16x8*)(K_lds + (b) * SHM_K + KSWZ(32 + sr, kc)) = sr_[i].ks1; } while (0)
#define SWAIT() do { if constexpr (SD == 2) asm volatile("s_waitcnt vmcnt(4)" ::: "memory"); else asm volatile("s_waitcnt vmcnt(0)" ::: "memory"); } while (0)
#define RESC(a) do { if (__any((a) < 1.f)) { if (hi == 0) al_l[r32] = (a); asm volatile("s_waitcnt lgkmcnt(0)" ::: "memory"); \
    _Pragma("unroll") for (int d = 0; d < 4; ++d) _Pragma("unroll") for (int r = 0; r < 16; ++r) o[d][r] *= al_l[crow(r, hi)]; } } while (0)
#define HOOK(P0, P1, j) do { if (MODE == 1) { if ((j) >= n0) na_hook(P0, P1, (base1 >> 6) + (j) - n0, qgr, ((wid & 1) << 5) + r32, hi, rpbh); } } while (0)
  f32x16 pA0, pA1, pB0, pB1; float mnA, mnB, alA, alB; bf16x8 pa0, pa1, pa2, pa3;
  constexpr int SE = 0, SO = SD - 1;
  SLOAD(SE, 0); asm volatile("s_waitcnt vmcnt(0)" ::: "memory"); SWRITE(0, SE); __syncthreads();
  qkt(pA0, pA1, K_lds, qr, r32, hi); HOOK(pA0, pA1, 0); partialSM(pA0, pA1, m_reg, mnA, alA);
  SLOAD(SO, 1); if constexpr (SD == 2) { if (2 < NT) SLOAD(SE, 2); }
  SWAIT(); SWRITE(1, SO); __syncthreads();
  for (int j = 1; j + 1 < NT; j += 2) {
    SBAR(); qkt(pB0, pB1, K_lds + SHM_K, qr, r32, hi); HOOK(pB0, pB1, j);
    finishSM(pA0, pA1, alA, l_reg, pa0, pa1, pa2, pa3); SBAR();
    SLOAD(SO, j + SD); SBAR();
    pv_d0(o, vb0, pa0, pa1, pa2, pa3); partialSM(pB0, pB1, m_reg, mnB, alB);
    __syncthreads(); SWAIT(); SWRITE(0, SE);
    RESC(alB); __syncthreads();
    SBAR(); qkt(pA0, pA1, K_lds, qr, r32, hi); HOOK(pA0, pA1, j + 1);
    finishSM(pB0, pB1, alB, l_reg, pa0, pa1, pa2, pa3); SBAR();
    if (SD == 1 || j + 3 < NT) SLOAD(SE, j + 1 + SD); SBAR();
    pv_d0(o, vb0 + SHM_V, pa0, pa1, pa2, pa3); partialSM(pA0, pA1, m_reg, mnA, alA);
    __syncthreads(); SWAIT(); SWRITE(1, SO);
    RESC(alA); __syncthreads();
  }
  SBAR(); qkt(pB0, pB1, K_lds + SHM_K, qr, r32, hi); HOOK(pB0, pB1, NT - 1);
  finishSM(pA0, pA1, alA, l_reg, pa0, pa1, pa2, pa3); SBAR();
  pv_d0(o, vb0, pa0, pa1, pa2, pa3); partialSM(pB0, pB1, m_reg, mnB, alB);
  __syncthreads(); RESC(alB);
  finishSM(pB0, pB1, alB, l_reg, pa0, pa1, pa2, pa3); SBAR();
  pv_d0(o, vb0 + SHM_V, pa0, pa1, pa2, pa3);
  if (hi == 0) li_l[r32] = l_reg; asm volatile("s_waitcnt lgkmcnt(0)" ::: "memory");
  float rli[16];
#pragma unroll
  for (int r = 0; r < 16; ++r) rli[r] = __builtin_amdgcn_rcpf(li_l[crow(r, hi)]);
  if (DIRECT) {
    bf16_t* Ow = Obf + (size_t)(wid * 32) * DM;
#pragma unroll
    for (int r = 0; r < 16; ++r) { const int orow = crow(r, hi);
#pragma unroll
      for (int d0 = 0; d0 < 4; ++d0) Ow[(size_t)orow * DM + d0 * 32 + r32] = (bf16_t)f2bf(o[d0][r] * rli[r]); }
  } else {
    float* Ow = Opart + (size_t)(wid * 32) * 512;
#pragma unroll
    for (int r = 0; r < 16; ++r) { const int orow = crow(r, hi);
#pragma unroll
      for (int d0 = 0; d0 < 4; ++d0) Ow[(size_t)orow * 512 + d0 * 32 + r32] = o[d0][r] * rli[r]; }
    if (hi == 0) LSE[(size_t)(wid * 32 + r32) * 4] = m_reg * (SCALE * 1.4426950408889634f) + log2f(l_reg);
  }
  __syncthreads();
#undef KROW
#undef SLOAD
#undef SWRITE
#undef SWAIT
#undef RESC
#undef HOOK
}
__device__ __forceinline__ void attn_unit_na(const bf16_t* __restrict__ PL, int qrow0, int qcol, int kcol, int vcol, int R0, const float* rpbh, bf16_t* Obf, char* lds) {
  const int tid = otid(), wid = tid >> 6, lane = tid & 63, r32 = lane & 31, hi = lane >> 5;
  constexpr int NT = 16, n0 = 4;
  char* V_lds = lds; char* K_lds = lds + 2 * SHM_V;
  float* wsf = (float*)(lds + 2 * SHM_V + 2 * SHM_K) + wid * 64; float* li_l = wsf; float* al_l = wsf + 32;
  float m_reg = -1e30f, l_reg = 0; f32x16 o[4] = {}; bf16x8 qr[8];
  const bf16_t* Qw = PL + (size_t)(qrow0 + wid * 32 + r32) * NIN + qcol + hi * 8;
#pragma unroll
  for (int d0 = 0; d0 < 8; ++d0) qr[d0] = *reinterpret_cast<const bf16x8*>(Qw + d0 * 16);
  const int qgr = (qrow0 + wid * 32) >> 6, qgc = ((wid & 1) << 5) + r32;
  const int sr = tid >> 4, sc = (tid & 15) * 8, vst0 = v_st(sr, sc), vst1 = v_st(32 + sr, sc);
  const int vb0 = (int)(uintptr_t)V_lds + v_rd_base(lane);
  const bf16_t* Kg = PL + (size_t)sr * NIN + kcol + sc; const bf16_t* Vg = PL + (size_t)sr * NIN + vcol + sc;
  bf16x8 vs0, vs1, ks0, ks1;
#define KROW(j) ((j) < n0 ? SEQ + 64 * (j) : (R0 + (j) - n0) * 64)
#define SLOAD(j) do { const size_t ko_ = (size_t)KROW(j) * NIN; vs0 = *reinterpret_cast<const bf16x8*>(Vg + ko_); vs1 = *reinterpret_cast<const bf16x8*>(Vg + ko_ + (size_t)32 * NIN); \
    ks0 = *reinterpret_cast<const bf16x8*>(Kg + ko_); ks1 = *reinterpret_cast<const bf16x8*>(Kg + ko_ + (size_t)32 * NIN); } while (0)
  SLOAD(0);
  for (int j = 0; j < NT; ++j) {
    asm volatile("s_waitcnt vmcnt(0)" ::: "memory");
    *(bf16x8*)(V_lds + vst0) = vs0; *(bf16x8*)(V_lds + vst1) = vs1;
    *(bf16x8*)(K_lds + KSWZ(sr, sc * 2)) = ks0; *(bf16x8*)(K_lds + KSWZ(32 + sr, sc * 2)) = ks1;
    __syncthreads();
    if (j + 1 < NT) SLOAD(j + 1);
    f32x16 p0, p1; float mn, al; bf16x8 pa0, pa1, pa2, pa3;
    qkt(p0, p1, K_lds, qr, r32, hi);
    if (j >= n0) na_hook(p0, p1, R0 + j - n0, qgr, qgc, hi, rpbh);
    partialSM(p0, p1, m_reg, mn, al);
    if (__any(al < 1.f)) { if (hi == 0) al_l[r32] = al; asm volatile("s_waitcnt lgkmcnt(0)" ::: "memory");
#pragma unroll
      for (int d = 0; d < 4; ++d)
#pragma unroll
        for (int r = 0; r < 16; ++r) o[d][r] *= al_l[crow(r, hi)]; }
    finishSM(p0, p1, al, l_reg, pa0, pa1, pa2, pa3); SBAR();
    pv_d0(o, vb0, pa0, pa1, pa2, pa3);
    __syncthreads();
  }
  if (hi == 0) li_l[r32] = l_reg; asm volatile("s_waitcnt lgkmcnt(0)" ::: "memory");
  bf16_t* Ow = Obf + (size_t)(wid * 32) * DM;
#pragma unroll
  for (int r = 0; r < 16; ++r) { const int orow = crow(r, hi); const float rl = __builtin_amdgcn_rcpf(li_l[orow]);
#pragma unroll
    for (int d0 = 0; d0 < 4; ++d0) Ow[(size_t)orow * DM + d0 * 32 + r32] = (bf16_t)f2bf(o[d0][r] * rl); }
  __syncthreads();
#undef KROW
#undef SLOAD
}
}

__device__ __forceinline__ void phase_small(const Args& a, unsigned char* lds, int vcu, int G, int layer, bool last) {
    const int tid = otid(), wave = tid >> 6, lane = tid & 63;
    const int gw = vcu * NWAVE + wave, NGW = G * NWAVE;
    const int nrows = last ? SEQ : MR;
    for (int row = gw; row < MR; row += NGW) qk_prep_row(a, layer, row, lane);
    for (int row = gw; row < nrows; row += NGW) dlt_row(a, row, lane);
    const int nunits = (nrows / 128) * 4;
    for (int u = G - 1 - vcu; u < nunits; u += G) cmix_unit(a, layer, u, lds);
    const bf16_t* PL = (const bf16_t*)(a.ws + WS_PL); bf16_t* OD = (bf16_t*)(a.ws + WS_OUTS) + 3 * 512;
    const float* rpb = a.in[I_RPB] + layer * 4 * 15 * 31;
    const int nu = 128 + (last ? 0 : 4);
    for (int u = vcu; u < nu; u += G) {
        if (u < 128) { const int h = u & 3, i = u >> 2, R0 = min(max(4 * i - 4, 0), 120);
            att::attn_unit_na(PL, i * 256, D_Q0 + h * HD, D_K0 + h * HD, D_V0 + h * HD, R0, rpb + h * 465, OD + (size_t)(i * 256) * DM + h * HD, (char*)lds); }
        else { const int h = u - 128;
            att::attn_unit<0, true>(PL, SEQ, D_Q0 + h * HD, D_K0 + h * HD, D_V0 + h * HD, 4, SEQ, 4, 0, nullptr, OD + (size_t)SEQ * DM + h * HD, nullptr, nullptr, (char*)lds); }
    }
}
constexpr size_t OPART_LSE = (size_t)2 * SEQ * 512 * 4;
__device__ __forceinline__ void phase_attn_a(const Args& a, unsigned char* lds, int vcu, int G, bool last) {
    const bf16_t* PL = (const bf16_t*)(a.ws + WS_PL); bf16_t* OA = (bf16_t*)(a.ws + WS_OUTS);
    float* Opart = (float*)(a.ws + WS_MRG); float* LSE = (float*)(a.ws + WS_MRG + OPART_LSE);
    const int nu = 256 + (last ? 0 : 4);
    for (int u = vcu; u < nu; u += G) {
        if (u < 256) { const int half = u >> 7, h = (u >> 5) & 3, qb = u & 31, kvh = h >> 1;
            att::attn_unit<0, false>(PL, qb * 256, A_Q0 + h * HD, A_K0 + kvh * HD, A_V0 + kvh * HD, 66, half * 4224, 66, 0, nullptr, nullptr,
                                     Opart + ((size_t)half * SEQ + qb * 256) * 512 + h * HD, LSE + ((size_t)half * SEQ + qb * 256) * 4 + h, (char*)lds); }
        else { const int h = u - 256, kvh = h >> 1;
            att::attn_unit<0, true>(PL, SEQ, A_Q0 + h * HD, A_K0 + kvh * HD, A_V0 + kvh * HD, 4, SEQ, 4, 0, nullptr, OA + (size_t)SEQ * DM + h * HD, nullptr, nullptr, (char*)lds); }
    }
}
__device__ __forceinline__ void phase_combine_a(const Args& a, int vcu, int G) {
    const int tid = otid(), wave = tid >> 6, lane = tid & 63;
    const int gw = vcu * NWAVE + wave, NGW = G * NWAVE;
    const float* Opart = (const float*)(a.ws + WS_MRG); const float* LSE = (const float*)(a.ws + WS_MRG + OPART_LSE); bf16_t* OA = (bf16_t*)(a.ws + WS_OUTS);
    for (int row = gw; row < SEQ; row += NGW) {
        const float l0 = LSE[(size_t)row * 4 + (lane >> 4)], l1 = LSE[((size_t)SEQ + row) * 4 + (lane >> 4)];
        const float mx = fmaxf(l0, l1), w0 = exp2f(l0 - mx), w1 = exp2f(l1 - mx), inv = 1.f / (w0 + w1), c0 = w0 * inv, c1 = w1 * inv;
        const float* p0 = Opart + (size_t)row * 512 + lane * 8; const float* p1 = p0 + (size_t)SEQ * 512;
        const f32x4 a0 = *(const f32x4*)p0, a1 = *(const f32x4*)(p0 + 4), b0 = *(const f32x4*)p1, b1 = *(const f32x4*)(p1 + 4);
        const f32x4 r0 = a0 * c0 + b0 * c1, r1 = a1 * c0 + b1 * c1;
        u32x4 w; w.x = pk2(r0[0], r0[1]); w.y = pk2(r0[2], r0[3]); w.z = pk2(r1[0], r1[1]); w.w = pk2(r1[2], r1[3]);
        *(u32x4*)(OA + (size_t)row * DM + lane * 8) = w;
    }
}

#define XB_TMO      128
#define XB_XCNT(j)  (256  + 64 * (j))
#define XB_XSUB(j)  (1280 + 64 * (j))
#define XB_XGEN(j)  (2304 + 64 * (j))
#define XB_TOP      3328
#define XB_TOPGEN   3392
#define XCD_BAR_WORDS 3456
#define XB_SPIN_CAP (1u << 18)

__device__ __forceinline__ unsigned xb_ld(unsigned* p)              { return __hip_atomic_load(p, __ATOMIC_RELAXED, __HIP_MEMORY_SCOPE_AGENT); }
__device__ __forceinline__ unsigned xb_add(unsigned* p, unsigned v) { return __hip_atomic_fetch_add(p, v, __ATOMIC_RELAXED, __HIP_MEMORY_SCOPE_AGENT); }
__device__ __forceinline__ unsigned xb_xcc_id() { return (unsigned)__builtin_amdgcn_s_getreg((3 << 11) | 20) & 0xFu; }
#define XB_SPIN(cond, bar) do { unsigned _sp = 0; while (cond) { __builtin_amdgcn_s_sleep(1); \
    if ((++_sp & 255u) == 0u) { if (xb_ld(&(bar)[XB_TMO])) break; if (_sp > XB_SPIN_CAP) { atomicAdd(&(bar)[XB_TMO], 1u); break; } } } } while (0)

struct XcdBarrier {
    unsigned* bar; unsigned x;
    volatile __attribute__((address_space(3))) unsigned* st;
};

__device__ __forceinline__ XcdBarrier xcd_barrier_post(unsigned* bar, volatile __attribute__((address_space(3))) unsigned* st) {
    XcdBarrier b; b.bar = bar; b.x = xb_xcc_id(); b.st = st;
    if (threadIdx.x == 0) (void)xb_add(&bar[XB_XCNT(b.x)], 1u);
    return b;
}
__device__ __forceinline__ void xcd_barrier_complete(unsigned* bar, unsigned x, unsigned& nloc, unsigned& nx) {
    const unsigned G = gridDim.x * gridDim.y * gridDim.z;
    unsigned sum, cnt, mine, sp = 0u;
    for (;;) {
        sum = 0u; cnt = 0u; mine = 0u;
#pragma unroll
        for (unsigned j = 0; j < 16; ++j) { const unsigned c = xb_ld(&bar[XB_XCNT(j)]); sum += c; cnt += (c > 0u) ? 1u : 0u; mine = (j == x) ? c : mine; }
        if (sum == G) break;
        __builtin_amdgcn_s_sleep(1);
        if ((++sp & 255u) == 0u) { if (xb_ld(&bar[XB_TMO])) break; if (sp > XB_SPIN_CAP) { atomicAdd(&bar[XB_TMO], 1u); break; } }
    }
    nloc = mine > 0u ? mine : 1u; nx = cnt > 0u ? cnt : 1u;
}

__device__ __forceinline__ void xcd_barrier(const XcdBarrier& b) {
    asm volatile("s_waitcnt vmcnt(0)" ::: "memory");
    __syncthreads();
    if (threadIdx.x == 0) {
        unsigned* bar = b.bar;
        __builtin_amdgcn_s_waitcnt(0);
        unsigned nloc = b.st[0], nx = b.st[1];
        if (nloc == 0u) { xcd_barrier_complete(bar, b.x, nloc, nx); b.st[0] = nloc; b.st[1] = nx; }
        const unsigned old = xb_add(&bar[XB_XSUB(b.x)], 1u);
        const unsigned gen = old / nloc;
        if (old + 1u == (gen + 1u) * nloc) {
            __builtin_amdgcn_fence(__ATOMIC_RELEASE, "agent");
            asm volatile("s_waitcnt vmcnt(0)" ::: "memory");
            const unsigned og = xb_add(&bar[XB_TOP], 1u);
            const unsigned tg = og / nx;
            if (og + 1u == (tg + 1u) * nx) xb_add(&bar[XB_TOPGEN], 1u);
            else XB_SPIN(xb_ld(&bar[XB_TOPGEN]) == tg, bar);
            __builtin_amdgcn_fence(__ATOMIC_ACQUIRE, "agent");
            xb_add(&bar[XB_XGEN(b.x)], 1u);
            asm volatile("s_waitcnt vmcnt(0)" ::: "memory");
        } else {
            XB_SPIN(xb_ld(&bar[XB_XGEN(b.x)]) == gen, bar);
            __builtin_amdgcn_fence(__ATOMIC_ACQUIRE, "agent");
            asm volatile("s_waitcnt vmcnt(0)" ::: "memory");
        }
    }
    __syncthreads();
}

__device__ __forceinline__ void zero_y_ctx(unsigned char* ws, int vcu, int G) {
    f32x4* y4 = (f32x4*)((float*)(ws + WS_MRG) + (size_t)SEQ * DM);
    for (int i = vcu * NTHR + otid(); i < CTXL * DM / 4; i += G * NTHR) y4[i] = (f32x4){0.f, 0.f, 0.f, 0.f};
}
constexpr int NPHASE = 22;
constexpr int CV_A = 2500, CV_B = 7000;
__global__ void __launch_bounds__(NTHR, 2) fwd(Args a) {
    extern __shared__ __attribute__((aligned(16))) unsigned char lds[];
    const int G = gridDim.x, bx = blockIdx.x;
    const int vcu = (G % 8 == 0) ? (bx % 8) * (G / 8) + bx / 8 : bx;
    unsigned char* ws = a.ws;
    const float* MOD = (const float*)(ws + WS_CTL + CTL_MOD);
#if MK_COOP
    cg::grid_group grid = cg::this_grid();
    volatile __attribute__((address_space(3))) unsigned* MISC = (volatile __attribute__((address_space(3))) unsigned*)((__attribute__((address_space(3))) unsigned char*)lds + (LDS_BYTES - 64));
    if (threadIdx.x < 2) MISC[threadIdx.x] = 0u;
    __syncthreads();
    const XcdBarrier xbar = xcd_barrier_post((unsigned*)(ws + WS_CTL) + CW_BAR, MISC);
#define SEAM(p) do { if (lo <= (p) && (p) + 1 < hi) { if ((p) == 0) grid.sync(); else xcd_barrier(xbar); } } while (0)
#else
#define SEAM(p) do { } while (0)
#endif
    const int lo = a.ph_lo, hi = a.ph_hi;
#ifndef PHMASK
#define PHMASK 0xffffffu
#endif
#define IN(p) (lo <= (p) && (p) < hi && ((PHMASK >> ((p) < 2 ? (p) : 2 + ((p) - 2) % 10)) & 1u))
    if (IN(0)) { phase_prologue(a, lds, vcu, G); } SEAM(0);
    if (IN(1)) { phase_rows<0>(a, vcu, G, MR, nullptr, nullptr, 0, a.in[I_NPRE_MIX], MOD, 0); } SEAM(1);
    {
        constexpr int l = 0; constexpr bool last = (l == 1); const int pb = 2 + l * 10;
        unsigned char* wb = ws + WS_W + (size_t)l * WPL;
        const float* modl = MOD + (size_t)l * 2 * NIN;
        const int Mrows = last ? SEQ : MR;
        if (IN(pb + 0)) {
            Gemm g{(const bf16_t*)(ws + WS_XN), (const bf16_t*)(wb + W_IN), DM, DM, DM}; StaticOrder S; S.init(MR, NIN - 512, G, bx);
            EpiIn E{(bf16_t*)(ws + WS_PL)}; gemm_phase((PG8_LAS unsigned char*)lds, g, S, E);
        } SEAM(pb + 0);
        if (IN(pb + 1)) {
            phase_small(a, lds, vcu, G, l, last);
            Gemm g{(const bf16_t*)(ws + WS_XN), (const bf16_t*)(wb + W_IN), DM, DM, DM}; ListOrder S{vcu - 132, 2 * (Mrows / 256), Mrows / 256, 46};
            EpiIn E{(bf16_t*)(ws + WS_PL)}; gemm_phase((PG8_LAS unsigned char*)lds, g, S, E);
        } SEAM(pb + 1);
        if (IN(pb + 2)) { phase_attn_a(a, lds, vcu, G, last); } SEAM(pb + 2);
        if (IN(pb + 3)) {
            phase_combine_a(a, vcu, G);
            Gemm g{(const bf16_t*)(ws + WS_DLT), (const bf16_t*)(wb + W_B), 512, 512, 512}; StaticOrder S; S.init(Mrows, 512, G, bx);
            EpiScale E{(bf16_t*)(ws + WS_OUTS) + 512, DM, a.in[I_BSCALE] + l * 512}; gemm_phase((PG8_LAS unsigned char*)lds, g, S, E);
        } SEAM(pb + 3);
        if (IN(pb + 4)) {
            Gemm g{(const bf16_t*)(ws + WS_OUTS), (const bf16_t*)(wb + W_BR), DM, DM, DM}; StaticOrder S; S.init(Mrows, DM, G, bx);
            EpiMerge E{(const bf16_t*)(ws + WS_PL), (bf16_t*)(ws + WS_MRGB)}; gemm_phase((PG8_LAS unsigned char*)lds, g, S, E);
        } SEAM(pb + 4);
        if (IN(pb + 5)) {
            Gemm g{(const bf16_t*)(ws + WS_MRGB), (const bf16_t*)(wb + W_O), DM, DM, DM}; StaticOrder S; S.init(SEQ, DM, G, bx);
            EpiF32 E{(float*)(ws + WS_MRG), DM}; gemm_phase((PG8_LAS unsigned char*)lds, g, S, E);
            { const int kq = bx >> 3;
              Gemm g2{(const bf16_t*)(ws + WS_MRGB) + kq * 512, (const bf16_t*)(wb + W_O) + kq * 512, DM, DM, 512}; CtxSplitOrder S2{bx};
              EpiF32 E2{(float*)(ws + WS_DLT) + (size_t)kq * CTXL * DM - (size_t)SEQ * DM, DM}; gemm_phase((PG8_LAS unsigned char*)lds, g2, S2, E2); }
            if (bx >= 32) convert_layer(a, lds, 1, (bx - 32) * NWAVE + (otid() >> 6), (G - 32) * NWAVE, 0, CV_A);
        } SEAM(pb + 5);
        if (IN(pb + 6)) { phase_rows<1>(a, vcu, G, Mrows, a.in[I_NPOST_MIX] + l * DM, modl, 2, a.in[I_NPRE_FFN] + l * DM, modl, 3, (const float*)(ws + WS_DLT)); } SEAM(pb + 6);
        if (IN(pb + 7)) {
            Gemm g{(const bf16_t*)(ws + WS_XN), (const bf16_t*)(wb + W_GU), DM, DM, DM}; StaticOrder S; S.init(Mrows, 2 * FF, G, bx);
            EpiSwiglu E{(bf16_t*)(ws + WS_H)}; gemm_phase((PG8_LAS unsigned char*)lds, g, S, E);
            if (bx >= 172) convert_layer(a, lds, 1, (bx - 172) * NWAVE + (otid() >> 6), (G - 172) * NWAVE, CV_A, CV_B);
        } SEAM(pb + 7);
        if (IN(pb + 8)) {
            Gemm g{(const bf16_t*)(ws + WS_H), (const bf16_t*)(wb + W_D), FF, FF, FF}; StaticOrder S; S.init(SEQ, DM, G, bx);
            EpiF32 E{(float*)(ws + WS_MRG), DM}; gemm_phase((PG8_LAS unsigned char*)lds, g, S, E);
            { const int kq = bx >> 3;
              Gemm g2{(const bf16_t*)(ws + WS_H) + kq * 1408, (const bf16_t*)(wb + W_D) + kq * 1408, FF, FF, 1408}; CtxSplitOrder S2{bx};
              EpiF32 E2{(float*)(ws + WS_DLT) + (size_t)kq * CTXL * DM - (size_t)SEQ * DM, DM}; gemm_phase((PG8_LAS unsigned char*)lds, g2, S2, E2); }
            if (bx >= 32) convert_layer(a, lds, 1, (bx - 32) * NWAVE + (otid() >> 6), (G - 32) * NWAVE, CV_B, 1 << 30);
        } SEAM(pb + 8);
        if (IN(pb + 9)) {
            if (!last) phase_rows<1>(a, vcu, G, MR, a.in[I_NPOST_FFN] + l * DM, modl, 5, a.in[I_NPRE_MIX] + (l + 1) * DM, MOD + (size_t)(l + 1) * 2 * NIN, 0, (const float*)(ws + WS_DLT));
            else phase_rows<2>(a, vcu, G, SEQ, a.in[I_NPOST_FFN] + l * DM, modl, 5, nullptr, nullptr, 0);
        }
        if (!last) SEAM(pb + 9);
        }
    {
        constexpr int l = 1; constexpr bool last = (l == 1); const int pb = 2 + l * 10;
        unsigned char* wb = ws + WS_W + (size_t)l * WPL;
        const float* modl = MOD + (size_t)l * 2 * NIN;
        const int Mrows = last ? SEQ : MR;
        if (IN(pb + 0)) {
            Gemm g{(const bf16_t*)(ws + WS_XN), (const bf16_t*)(wb + W_IN), DM, DM, DM}; StaticOrder S; S.init(MR, NIN - 512, G, bx);
            EpiIn E{(bf16_t*)(ws + WS_PL)}; gemm_phase((PG8_LAS unsigned char*)lds, g, S, E);
        } SEAM(pb + 0);
        if (IN(pb + 1)) {
            phase_small(a, lds, vcu, G, l, last);
            Gemm g{(const bf16_t*)(ws + WS_XN), (const bf16_t*)(wb + W_IN), DM, DM, DM}; ListOrder S{vcu - 132, 2 * (Mrows / 256), Mrows / 256, 46};
            EpiIn E{(bf16_t*)(ws + WS_PL)}; gemm_phase((PG8_LAS unsigned char*)lds, g, S, E);
        } SEAM(pb + 1);
        if (IN(pb + 2)) { phase_attn_a(a, lds, vcu, G, last); } SEAM(pb + 2);
        if (IN(pb + 3)) {
            phase_combine_a(a, vcu, G);
            Gemm g{(const bf16_t*)(ws + WS_DLT), (const bf16_t*)(wb + W_B), 512, 512, 512}; StaticOrder S; S.init(Mrows, 512, G, bx);
            EpiScale E{(bf16_t*)(ws + WS_OUTS) + 512, DM, a.in[I_BSCALE] + l * 512}; gemm_phase((PG8_LAS unsigned char*)lds, g, S, E);
        } SEAM(pb + 3);
        if (IN(pb + 4)) {
            Gemm g{(const bf16_t*)(ws + WS_OUTS), (const bf16_t*)(wb + W_BR), DM, DM, DM}; StaticOrder S; S.init(Mrows, DM, G, bx);
            EpiMerge E{(const bf16_t*)(ws + WS_PL), (bf16_t*)(ws + WS_MRGB)}; gemm_phase((PG8_LAS unsigned char*)lds, g, S, E);
        } SEAM(pb + 4);
        if (IN(pb + 5)) {
            Gemm g{(const bf16_t*)(ws + WS_MRGB), (const bf16_t*)(wb + W_O), DM, DM, DM}; StaticOrder S; S.init(Mrows, DM, G, bx);
            EpiF32 E{(float*)(ws + WS_MRG), DM}; gemm_phase((PG8_LAS unsigned char*)lds, g, S, E);
        } SEAM(pb + 5);
        if (IN(pb + 6)) { phase_rows<1>(a, vcu, G, Mrows, a.in[I_NPOST_MIX] + l * DM, modl, 2, a.in[I_NPRE_FFN] + l * DM, modl, 3); } SEAM(pb + 6);
        if (IN(pb + 7)) {
            Gemm g{(const bf16_t*)(ws + WS_XN), (const bf16_t*)(wb + W_GU), DM, DM, DM}; StaticOrder S; S.init(Mrows, 2 * FF, G, bx);
            EpiSwiglu E{(bf16_t*)(ws + WS_H)}; gemm_phase((PG8_LAS unsigned char*)lds, g, S, E);
        } SEAM(pb + 7);
        if (IN(pb + 8)) {
            Gemm g{(const bf16_t*)(ws + WS_H), (const bf16_t*)(wb + W_D), FF, FF, FF}; StaticOrder S; S.init(Mrows, DM, G, bx);
            EpiF32 E{(float*)(ws + WS_MRG), DM}; gemm_phase((PG8_LAS unsigned char*)lds, g, S, E);
        } SEAM(pb + 8);
        if (IN(pb + 9)) {
            if (!last) phase_rows<1>(a, vcu, G, MR, a.in[I_NPOST_FFN] + l * DM, modl, 5, a.in[I_NPRE_MIX] + (l + 1) * DM, MOD + (size_t)(l + 1) * 2 * NIN, 0);
            else phase_rows<2>(a, vcu, G, SEQ, a.in[I_NPOST_FFN] + l * DM, modl, 5, nullptr, nullptr, 0);
        }
        if (!last) SEAM(pb + 9);
        }
#undef IN
#undef SEAM
}

extern "C" void kernel_launch(void* const* d_in, const int* in_sizes, int n_in, void* d_out, int out_size, void* d_ws, size_t ws_size, hipStream_t stream) {
    static int grid = 0;
    if (grid == 0) {
        if (n_in != N_IN || out_size != SEQ * DM || ws_size < WS_END) { fprintf(stderr, "kernel_launch: unexpected shapes (n_in %d out %d ws %zu)\n", n_in, out_size, ws_size); grid = -1; return; }
        if (hipFuncSetAttribute((const void*)fwd, hipFuncAttributeMaxDynamicSharedMemorySize, LDS_BYTES) != hipSuccess) { fprintf(stderr, "kernel_launch: hipFuncSetAttribute failed\n"); grid = -1; return; }
        int dev = 0, cus = 0, per_cu = 0;
        hipGetDevice(&dev); hipDeviceGetAttribute(&cus, hipDeviceAttributeMultiprocessorCount, dev);
        hipOccupancyMaxActiveBlocksPerMultiprocessor(&per_cu, (const void*)fwd, NTHR, LDS_BYTES);
        if (per_cu < 1) { fprintf(stderr, "kernel_launch: occupancy query says %d blocks per CU\n", per_cu); per_cu = 1; }
        (void)hipGetLastError();
        grid = cus * per_cu;
        fprintf(stderr, "kernel_launch: grid %d (cus %d x %d)\n", grid, cus, per_cu);
    }
    if (grid < 0) return;
    hipMemsetAsync((char*)d_ws + WS_CTL, 0, CTL_BYTES, stream);
    Args a{};
    for (int i = 0; i < N_IN; ++i) a.in[i] = (const float*)d_in[i];
    a.out = (float*)d_out; a.ws = (unsigned char*)d_ws;
#if MK_COOP
    a.ph_lo = 0; a.ph_hi = NPHASE;
    void* params[] = {&a};
    hipError_t e = hipLaunchCooperativeKernel((const void*)fwd, dim3(grid), dim3(NTHR), params, LDS_BYTES, stream);
    if (e != hipSuccess) fprintf(stderr, "kernel_launch: cooperative launch failed: %s (grid %d)\n", hipGetErrorString(e), grid);
#else
    for (int p = 0; p < NPHASE; ++p) {
        a.ph_lo = p; a.ph_hi = p + 1;
        hipLaunchKernelGGL(fwd, dim3(grid), dim3(NTHR), LDS_BYTES, stream, a);
    }
#endif
}
```

```cpp
#include <hip/hip_runtime.h>
#include <hip/hip_cooperative_groups.h>
#include <cstdio>
#include <cstdint>
namespace cg = cooperative_groups;

#ifndef MK_COOP
#define MK_COOP 1
#endif

typedef unsigned short bf16_t;
typedef short bf16x8 __attribute__((ext_vector_type(8)));
typedef float f32x4 __attribute__((ext_vector_type(4)));
typedef unsigned u32x4 __attribute__((ext_vector_type(4)));
typedef unsigned u32x2 __attribute__((ext_vector_type(2)));

constexpr int DM = 2048, SEQ = 8192, CTXL = 256, MR = SEQ + CTXL, NIN = 12288, FF = 5632, HD = 128, GW = 64;
constexpr int A_Q0 = 0, A_K0 = 512, A_V0 = 768, B0 = 1024, C_U0 = 1536, C_V0 = 2048, D_Q0 = 2560, D_K0 = 3072, D_V0 = 3584, G0 = 4096;
constexpr float EPS = 1e-6f;
constexpr int NTHR = 512, NWAVE = 8;
constexpr int LDS_BYTES = 147456;

enum { I_X = 0, I_C, I_CTX, I_CCTX, I_ADAW, I_ADAB, I_NPRE_MIX, I_NPOST_MIX, I_NPRE_FFN, I_NPOST_FFN, I_WIN, I_AQN, I_AKN, I_BW, I_BSCALE,
       I_CNG, I_CNB, I_CWS, I_CBS, I_RPB, I_WBR, I_WO, I_WG, I_WU, I_WD, N_IN };

constexpr size_t MiB = 1u << 20;
constexpr size_t WS_CTL = 0, CTL_BYTES = 1 * MiB;
constexpr int CW_BAR = 4096;
constexpr size_t CTL_MOD = 256 * 1024;
constexpr size_t WS_W = 2 * MiB, WPL = 131 * MiB;
constexpr size_t W_IN = 0, W_BR = 48 * MiB, W_O = 56 * MiB, W_GU = 64 * MiB, W_D = 108 * MiB, W_B = 130 * MiB;
constexpr size_t WS_X = 264 * MiB;
constexpr size_t WS_XN = 330 * MiB;
constexpr size_t WS_PL = 363 * MiB;
constexpr size_t WS_H = WS_PL;
constexpr size_t WS_OUTS = 561 * MiB;
constexpr size_t WS_DLT = 594 * MiB;
constexpr size_t WS_MRG = 603 * MiB;
constexpr size_t WS_MRGB = 669 * MiB;
constexpr size_t WS_END = 702 * MiB;

struct Args { const float* in[N_IN]; float* out; unsigned char* ws; int ph_lo, ph_hi; };

__device__ __forceinline__ unsigned f2bf(float f) { unsigned u = __builtin_bit_cast(unsigned, f); return (u + 0x7fffu + ((u >> 16) & 1u)) >> 16; }
__device__ __forceinline__ unsigned pk2(float lo, float hi) { return f2bf(lo) | (f2bf(hi) << 16); }
__device__ __forceinline__ float bflo(unsigned w) { return __builtin_bit_cast(float, w << 16); }
__device__ __forceinline__ float bfhi(unsigned w) { return __builtin_bit_cast(float, w & 0xffff0000u); }
__device__ __forceinline__ float bf2f(bf16_t h) { return __builtin_bit_cast(float, (unsigned)h << 16); }
__device__ __forceinline__ float wave_sum(float v) {
#pragma unroll
    for (int o = 32; o >= 1; o >>= 1) v += __shfl_xor(v, o);
    return v;
}
__device__ __forceinline__ int otid() { int t = threadIdx.x; asm volatile("" : "+v"(t)); return t; }
constexpr float MOD_FX = 1099511627776.f;
__device__ __forceinline__ float fx2f(unsigned lo, unsigned hi) { return fmaf((float)(int)hi, 0.00390625f  , (float)lo * (1.0f / 1099511627776.f)); }
__device__ __forceinline__ f32x4 ldmod4(const long long* p) {
    const u32x4 a = *(const u32x4*)p, b = *(const u32x4*)(p + 2);
    return (f32x4){fx2f(a.x, a.y), fx2f(a.z, a.w), fx2f(b.x, b.y), fx2f(b.z, b.w)};
}
__device__ __forceinline__ float sigmoidf_(float x) { return __builtin_amdgcn_rcpf(1.f + __expf(-x)); }
__device__ __forceinline__ float siluf_(float x) { return x * __builtin_amdgcn_rcpf(1.f + __expf(-x)); }

struct Unit { int pm, pn; };
struct Gemm { const bf16_t* A; const bf16_t* Bt; int lda, ldb, K; };
constexpr int NXCD = 8, WGM = 8;
struct StaticOrder {
    int nM, nN, nwg, G, c;
    __device__ void init(int M, int N, int G_, int c_) { nM = M / 256; nN = N / 256; nwg = nM * nN; G = G_; c = c_; }
    __device__ bool next(int i, Unit& u) const {
        const long L = (long)i * G + c; if (L >= nwg) return false;
        int wgid = (int)L; { const int q = nwg / NXCD, r = nwg % NXCD, xcd = wgid % NXCD, off = wgid / NXCD; wgid = (xcd < r ? xcd * (q + 1) : r * (q + 1) + (xcd - r) * q) + off; }
        const int nig = WGM * nN, gid = wgid / nig, fm = gid * WGM, gsz = (nM - fm) < WGM ? (nM - fm) : WGM;
        u.pm = fm + ((wgid % nig) % gsz); u.pn = (wgid % nig) / gsz; return true;
    }
    __device__ __forceinline__ void a_ready(const Unit&) const {}
    __device__ __forceinline__ void done(const Unit&) const {}
};
struct ListOrder {
    int j, n, nM, pn0;
    __device__ bool next(int i, Unit& u) const { if (i > 0 || j < 0 || j >= n) return false; u.pm = j % nM; u.pn = pn0 + j / nM; return true; }
    __device__ __forceinline__ void a_ready(const Unit&) const {}
    __device__ __forceinline__ void done(const Unit&) const {}
};
struct CtxSplitOrder {
    int j;
    __device__ bool next(int i, Unit& u) const { if (i > 0 || j < 0 || j >= 32) return false; u.pm = 32; u.pn = j & 7; return true; }
    __device__ __forceinline__ void a_ready(const Unit&) const {}
    __device__ __forceinline__ void done(const Unit&) const {}
};
struct MergeOrder {
    StaticOrder base;
    __device__ bool next(int i, Unit& u) const { Unit t; if (!base.next(i >> 2, t)) return false; const int pass = i & 3; u.pm = pass * 33 + t.pm; u.pn = pass * 8 + t.pn; return true; }
    __device__ __forceinline__ void a_ready(const Unit&) const {}
    __device__ __forceinline__ void done(const Unit&) const {}
};

struct EpiIn {
    static constexpr bool PERM = true, AFTER_DRAIN = false, KHOOK = false;
    bf16_t* PL;
    __device__ __forceinline__ void operator()(const f32x4 (&acc)[2][2][4][2], const Unit& u, int wr, int wc, int fr, int fq) const {
        const bool gate = u.pn >= (G0 / 256);
#pragma unroll
        for (int ai = 0; ai < 2; ++ai)
#pragma unroll
            for (int m = 0; m < 4; ++m) {
                const int row = u.pm * 256 + ai * 128 + wr * 64 + m * 16 + fr;
#pragma unroll
                for (int bj = 0; bj < 2; ++bj) {
                    const int col = u.pn * 256 + bj * 128 + wc * 32 + 8 * fq;
                    f32x4 v0 = acc[ai][bj][m][0], v1 = acc[ai][bj][m][1];
                    if (gate) {
#pragma unroll
                        for (int e = 0; e < 4; ++e) { v0[e] = sigmoidf_(v0[e]); v1[e] = sigmoidf_(v1[e]); }
                    }
                    u32x4 w; w.x = pk2(v0[0], v0[1]); w.y = pk2(v0[2], v0[3]); w.z = pk2(v1[0], v1[1]); w.w = pk2(v1[2], v1[3]);
                    *(u32x4*)(PL + (size_t)row * NIN + col) = w;
                }
            }
    }
};
struct EpiScale {
    static constexpr bool PERM = true, AFTER_DRAIN = false, KHOOK = false;
    bf16_t* O; int ldc; const float* scale;
    __device__ __forceinline__ void operator()(const f32x4 (&acc)[2][2][4][2], const Unit& u, int wr, int wc, int fr, int fq) const {
#pragma unroll
        for (int bj = 0; bj < 2; ++bj) {
            const int col = u.pn * 256 + bj * 128 + wc * 32 + 8 * fq;
            const f32x4 s0 = *(const f32x4*)(scale + col), s1 = *(const f32x4*)(scale + col + 4);
#pragma unroll
            for (int ai = 0; ai < 2; ++ai)
#pragma unroll
                for (int m = 0; m < 4; ++m) {
                    const int row = u.pm * 256 + ai * 128 + wr * 64 + m * 16 + fr;
                    const f32x4 v0 = acc[ai][bj][m][0] * s0, v1 = acc[ai][bj][m][1] * s1;
                    u32x4 w; w.x = pk2(v0[0], v0[1]); w.y = pk2(v0[2], v0[3]); w.z = pk2(v1[0], v1[1]); w.w = pk2(v1[2], v1[3]);
                    *(u32x4*)(O + (size_t)row * ldc + col) = w;
                }
        }
    }
};
struct EpiMerge {
    static constexpr bool PERM = true, AFTER_DRAIN = false, KHOOK = true;
    const bf16_t* PL; bf16_t* MRGB;
    __device__ __forceinline__ void khook(f32x4 (&acc)[2][2][4][2], const Unit& u, int s, int wr, int wc, int fr, int fq) const {
#pragma unroll
        for (int ai = 0; ai < 2; ++ai) {
            size_t off = ((size_t)(u.pm * 256 + ai * 128 + wr * 64 + fr) * NIN + G0 + (s - 1) * DM + u.pn * 256 + wc * 32 + 8 * fq) * 2;
            asm volatile("" : "+v"(off));
            const char* gp = (const char*)PL + off;
            u32x4 ga[4][2], gb[4][2];
#pragma unroll
            for (int m = 0; m < 4; ++m)
#pragma unroll
                for (int bj = 0; bj < 2; ++bj) { const char* p = gp + (size_t)m * 16 * NIN * 2 + bj * 256; ga[m][bj] = *(const u32x4*)p; gb[m][bj] = *(const u32x4*)(p + DM * 2); }
            __builtin_amdgcn_sched_barrier(0);
#pragma unroll
            for (int m = 0; m < 4; ++m)
#pragma unroll
                for (int bj = 0; bj < 2; ++bj) {
                    const u32x4 a_ = ga[m][bj], b_ = gb[m][bj];
                    f32x4& v0 = acc[ai][bj][m][0]; f32x4& v1 = acc[ai][bj][m][1];
                    v0[0] *= bflo(a_.x) * __builtin_amdgcn_rcpf(fmaxf(bflo(b_.x), 1e-30f)); v0[1] *= bfhi(a_.x) * __builtin_amdgcn_rcpf(fmaxf(bfhi(b_.x), 1e-30f));
                    v0[2] *= bflo(a_.y) * __builtin_amdgcn_rcpf(fmaxf(bflo(b_.y), 1e-30f)); v0[3] *= bfhi(a_.y) * __builtin_amdgcn_rcpf(fmaxf(bfhi(b_.y), 1e-30f));
                    v1[0] *= bflo(a_.z) * __builtin_amdgcn_rcpf(fmaxf(bflo(b_.z), 1e-30f)); v1[1] *= bfhi(a_.z) * __builtin_amdgcn_rcpf(fmaxf(bfhi(b_.z), 1e-30f));
                    v1[2] *= bflo(a_.w) * __builtin_amdgcn_rcpf(fmaxf(bflo(b_.w), 1e-30f)); v1[3] *= bfhi(a_.w) * __builtin_amdgcn_rcpf(fmaxf(bfhi(b_.w), 1e-30f));
                }
            __builtin_amdgcn_sched_barrier(0);
        }
        asm volatile("s_waitcnt vmcnt(0)" ::: "memory");
    }
    __device__ __forceinline__ void operator()(const f32x4 (&acc)[2][2][4][2], const Unit& u, int wr, int wc, int fr, int fq) const {
#pragma unroll
        for (int ai = 0; ai < 2; ++ai) {
            size_t off = ((size_t)(u.pm * 256 + ai * 128 + wr * 64 + fr) * NIN + G0 + 3 * DM + u.pn * 256 + wc * 32 + 8 * fq) * 2;
            asm volatile("" : "+v"(off));
            const char* gp = (const char*)PL + off;
            u32x4 g3[4][2];
#pragma unroll
            for (int m = 0; m < 4; ++m)
#pragma unroll
                for (int bj = 0; bj < 2; ++bj) g3[m][bj] = *(const u32x4*)(gp + (size_t)m * 16 * NIN * 2 + bj * 256);
            __builtin_amdgcn_sched_barrier(0);
#pragma unroll
            for (int m = 0; m < 4; ++m) {
                const int row = u.pm * 256 + ai * 128 + wr * 64 + m * 16 + fr;
#pragma unroll
                for (int bj = 0; bj < 2; ++bj) {
                    const int col = u.pn * 256 + bj * 128 + wc * 32 + 8 * fq;
                    const u32x4 gw = g3[m][bj];
                    f32x4 v0 = acc[ai][bj][m][0], v1 = acc[ai][bj][m][1];
                    v0[0] *= bflo(gw.x); v0[1] *= bfhi(gw.x); v0[2] *= bflo(gw.y); v0[3] *= bfhi(gw.y);
                    v1[0] *= bflo(gw.z); v1[1] *= bfhi(gw.z); v1[2] *= bflo(gw.w); v1[3] *= bfhi(gw.w);
                    u32x4 w; w.x = pk2(v0[0], v0[1]); w.y = pk2(v0[2], v0[3]); w.z = pk2(v1[0], v1[1]); w.w = pk2(v1[2], v1[3]);
                    *(u32x4*)(MRGB + (size_t)row * DM + col) = w;
                }
            }
        }
    }
};
struct EpiF32 {
    static constexpr bool PERM = true, AFTER_DRAIN = false, KHOOK = false;
    float* Y; int ldc;
    __device__ __forceinline__ void operator()(const f32x4 (&acc)[2][2][4][2], const Unit& u, int wr, int wc, int fr, int fq) const {
#pragma unroll
        for (int ai = 0; ai < 2; ++ai)
#pragma unroll
            for (int m = 0; m < 4; ++m) {
                const int row = u.pm * 256 + ai * 128 + wr * 64 + m * 16 + fr;
#pragma unroll
                for (int bj = 0; bj < 2; ++bj) {
                    const int col = u.pn * 256 + bj * 128 + wc * 32 + 8 * fq;
                    float* yp = Y + (size_t)row * ldc + col;
                    *(f32x4*)yp = acc[ai][bj][m][0]; *(f32x4*)(yp + 4) = acc[ai][bj][m][1];
                }
            }
    }
};
struct EpiY {
    static constexpr bool PERM = true, AFTER_DRAIN = false, KHOOK = false;
    bf16_t* Y; int ldc;
    __device__ __forceinline__ void operator()(const f32x4 (&acc)[2][2][4][2], const Unit& u, int wr, int wc, int fr, int fq) const {
#pragma unroll
        for (int ai = 0; ai < 2; ++ai)
#pragma unroll
            for (int m = 0; m < 4; ++m) {
                const int row = u.pm * 256 + ai * 128 + wr * 64 + m * 16 + fr;
#pragma unroll
                for (int bj = 0; bj < 2; ++bj) {
                    const int col = u.pn * 256 + bj * 128 + wc * 32 + 8 * fq;
                    const f32x4 v0 = acc[ai][bj][m][0], v1 = acc[ai][bj][m][1];
                    u32x4 w; w.x = pk2(v0[0], v0[1]); w.y = pk2(v0[2], v0[3]); w.z = pk2(v1[0], v1[1]); w.w = pk2(v1[2], v1[3]);
                    *(u32x4*)(Y + (size_t)row * ldc + col) = w;
                }
            }
    }
};
struct EpiAtomicF32 {
    static constexpr bool PERM = true, AFTER_DRAIN = false, KHOOK = false;
    float* Y; int ldc;
    __device__ __forceinline__ void operator()(const f32x4 (&acc)[2][2][4][2], const Unit& u, int wr, int wc, int fr, int fq) const {
#pragma unroll
        for (int ai = 0; ai < 2; ++ai)
#pragma unroll
            for (int m = 0; m < 4; ++m) {
                const int row = u.pm * 256 + ai * 128 + wr * 64 + m * 16 + fr;
#pragma unroll
                for (int bj = 0; bj < 2; ++bj) {
                    float* yp = Y + (size_t)row * ldc + u.pn * 256 + bj * 128 + wc * 32 + 8 * fq;
#pragma unroll
                    for (int e = 0; e < 4; ++e) { unsafeAtomicAdd(yp + e, acc[ai][bj][m][0][e]); unsafeAtomicAdd(yp + 4 + e, acc[ai][bj][m][1][e]); }
                }
            }
    }
};
struct EpiSwiglu {
    static constexpr bool PERM = true, AFTER_DRAIN = false, KHOOK = false;
    bf16_t* H;
    __device__ __forceinline__ void operator()(const f32x4 (&acc)[2][2][4][2], const Unit& u, int wr, int wc, int fr, int fq) const {
#pragma unroll
        for (int ai = 0; ai < 2; ++ai)
#pragma unroll
            for (int m = 0; m < 4; ++m) {
                const int row = u.pm * 256 + ai * 128 + wr * 64 + m * 16 + fr;
                const int col = u.pn * 128 + wc * 32 + 8 * fq;
                f32x4 h0, h1;
#pragma unroll
                for (int e = 0; e < 4; ++e) { h0[e] = siluf_(acc[ai][0][m][0][e]) * acc[ai][1][m][0][e]; h1[e] = siluf_(acc[ai][0][m][1][e]) * acc[ai][1][m][1][e]; }
                u32x4 w; w.x = pk2(h0[0], h0[1]); w.y = pk2(h0[2], h0[3]); w.z = pk2(h1[0], h1[1]); w.w = pk2(h1[2], h1[3]);
                *(u32x4*)(H + (size_t)row * FF + col) = w;
            }
    }
};

#define PG8_LAS __attribute__((address_space(3)))
constexpr int BM = 256, BK = 64, HALF = 128, HTB = HALF * BK * 2, STAGE_BYTES = 8 * HTB;
__device__ __forceinline__ int lds_byte(int r, int c) { const int st = (r >> 4) * 2 + (c >> 5), rr = r & 15, cc = c & 31, ob = rr * 64 + cc * 2; return st * 1024 + (ob ^ (((ob >> 9) & 1) << 5)); }
__device__ __forceinline__ void stage_rc(int b, int& R, int& C) { const int st = b / 1024, sb = b % 1024, swz = sb ^ (((sb >> 9) & 1) << 5); R = (st >> 1) * 16 + swz / 64; C = (st & 1) * 32 + (swz % 64) / 2; }
__device__ __forceinline__ int perm32(int rho) { const int n = rho >> 4, i = rho & 15; return 8 * (i >> 2) + 4 * n + (i & 3); }
template <class Epi, class Sched, bool ALIGN_EPI = true, bool SP2 = true>
__device__ __forceinline__ void gemm_phase(PG8_LAS unsigned char* lds, const Gemm g, const Sched& S, const Epi& E) {
    const int tid = otid(), wid = __builtin_amdgcn_readfirstlane(tid >> 6), lane = tid & 63, wr = wid >> 2, wc = wid & 3, fr = lane & 15, fq = lane >> 4;
    const int K = g.K, nt = K / BK;
    unsigned voffA[2], voffB[2];
#pragma unroll
    for (int i = 0; i < 2; ++i) { int R, C; stage_rc(tid * 16 + i * 8192, R, C); const int Rb = Epi::PERM ? ((R & ~31) + perm32(R & 31)) : R;
        voffA[i] = (unsigned)(R * g.lda + C) * 2u; voffB[i] = (unsigned)(Rb * g.ldb + C) * 2u; }
    const size_t kstep = (size_t)(BK * 2);
    const size_t hstepA = (size_t)HALF * g.lda * 2, hstepB = (size_t)HALF * g.ldb * 2;
    const size_t tstepA = 2 * hstepA, tstepB = 2 * hstepB;
    const unsigned ldsw = (unsigned)wid * 1024u;
    const int aoff = lds_byte(wr * 64 + fr, fq * 8), boff = lds_byte(wc * 32 + fr, fq * 8);
#define PG8_SA(b, h) (((b) * 2 + (h)) * HTB)
#define PG8_SB(b, h) ((4 + (b) * 2 + (h)) * HTB)
#define PG8_STAGE(bufoff, gbase, voff) do { _Pragma("unroll") for (int _i = 0; _i < 2; ++_i) \
        __builtin_amdgcn_global_load_lds((const unsigned*)((const char*)(gbase) + (voff)[_i]), (PG8_LAS unsigned*)(lds + (bufoff) + ldsw + _i * 8192), 16, 0, 0); } while (0)
#define PG8_LDA(dst, b, h) do { _Pragma("unroll") for (int m = 0; m < 4; ++m) _Pragma("unroll") for (int k = 0; k < 2; ++k) dst[m][k] = *(const PG8_LAS bf16x8*)(lds + PG8_SA(b, h) + aoff + m * 2048 + k * 1024); } while (0)
#define PG8_LDB(dst, b, h) do { _Pragma("unroll") for (int n = 0; n < 2; ++n) _Pragma("unroll") for (int k = 0; k < 2; ++k) dst[n][k] = *(const PG8_LAS bf16x8*)(lds + PG8_SB(b, h) + boff + n * 2048 + k * 1024); } while (0)
#define PG8_MMA(ai, bj, At, Bt) do { __builtin_amdgcn_s_setprio(1); _Pragma("unroll") for (int m = 0; m < 4; ++m) _Pragma("unroll") for (int n = 0; n < 2; ++n) _Pragma("unroll") for (int k = 0; k < 2; ++k) \
        acc[ai][bj][m][n] = __builtin_amdgcn_mfma_f32_16x16x32_bf16(Bt[n][k], At[m][k], acc[ai][bj][m][n], 0, 0, 0); __builtin_amdgcn_s_setprio(0); } while (0)
#define PG8_WAIT_V(n) asm volatile("s_waitcnt vmcnt(" #n ")" ::: "memory")
#define PG8_WAIT_L(n) asm volatile("s_waitcnt lgkmcnt(" #n ")" ::: "memory")
#define PG8_BAR __builtin_amdgcn_s_barrier()
#define PG8_SCHED __builtin_amdgcn_sched_barrier(0)
    Unit cur, nxt; int ui = 0;
    if (!S.next(0, cur)) return;
    f32x4 acc[2][2][4][2];
#pragma unroll
    for (int a = 0; a < 2; ++a)
#pragma unroll
        for (int b = 0; b < 2; ++b)
#pragma unroll
            for (int m = 0; m < 4; ++m)
#pragma unroll
                for (int n = 0; n < 2; ++n) acc[a][b][m][n] = (f32x4){0.f, 0.f, 0.f, 0.f};
    bf16x8 At[4][2], B0[2][2], B1[2][2];
    const char* cA = (const char*)g.A + (size_t)cur.pm * tstepA; const char* cB = (const char*)g.Bt + (size_t)cur.pn * tstepB;
    S.a_ready(cur);
    if constexpr (SP2) {
        PG8_STAGE(PG8_SB(0, 0), cB, voffB); PG8_STAGE(PG8_SB(0, 1), cB + hstepB, voffB); PG8_STAGE(PG8_SA(0, 0), cA, voffA); PG8_STAGE(PG8_SA(0, 1), cA + hstepA, voffA);
        if (wr == 1) PG8_BAR;
        PG8_WAIT_V(2); PG8_BAR;
        PG8_STAGE(PG8_SB(1, 0), cB + kstep, voffB); PG8_STAGE(PG8_SA(1, 0), cA + kstep, voffA); PG8_STAGE(PG8_SB(1, 1), cB + hstepB + kstep, voffB);
        PG8_WAIT_V(6); PG8_BAR;
    } else {
        PG8_STAGE(PG8_SB(0, 0), cB, voffB); PG8_STAGE(PG8_SA(0, 0), cA, voffA); PG8_STAGE(PG8_SB(0, 1), cB + hstepB, voffB); PG8_STAGE(PG8_SA(0, 1), cA + hstepA, voffA);
        if (wr == 1) PG8_BAR;
        PG8_WAIT_V(4); PG8_BAR;
        PG8_STAGE(PG8_SB(1, 0), cB + kstep, voffB); PG8_STAGE(PG8_SA(1, 0), cA + kstep, voffA); PG8_STAGE(PG8_SB(1, 1), cB + hstepB + kstep, voffB);
        PG8_WAIT_V(6); PG8_BAR;
    }
    for (;;) {
        const bool has_next = S.next(ui + 1, nxt);
        const char* nA = has_next ? (const char*)g.A + (size_t)nxt.pm * tstepA : cA; const char* nB = has_next ? (const char*)g.Bt + (size_t)nxt.pn * tstepB : cB;
        for (int t = 0; t < nt; t += 2) {
            if constexpr (Epi::KHOOK) { if (t > 0 && (t & 7) == 0) E.khook(acc, cur, t >> 3, wr, wc, fr, fq); }
            const bool last = (t == nt - 2);
            const char* a1 = cA + (size_t)(t + 1) * kstep;
            const char* a2 = last ? nA : cA + (size_t)(t + 2) * kstep; const char* b2 = last ? nB : cB + (size_t)(t + 2) * kstep;
            const char* a3 = a2 + kstep; const char* b3 = b2 + kstep;
            if (last && has_next) S.a_ready(nxt);
            if constexpr (SP2) {
            PG8_LDB(B0, 0, 0); PG8_LDB(B1, 0, 1); PG8_SCHED; PG8_LDA(At, 0, 0); PG8_STAGE(PG8_SA(1, 1), a1 + hstepA, voffA);
            PG8_WAIT_V(8); PG8_WAIT_L(0); PG8_BAR; PG8_MMA(0, 0, At, B0); PG8_MMA(0, 1, At, B1); PG8_BAR; PG8_SCHED;
            PG8_LDA(At, 0, 1); PG8_STAGE(PG8_SB(0, 0), b2, voffB); PG8_STAGE(PG8_SB(0, 1), b2 + hstepB, voffB); PG8_STAGE(PG8_SA(0, 0), a2, voffA);
            PG8_WAIT_V(8); PG8_WAIT_L(0); PG8_BAR; PG8_MMA(1, 0, At, B0); PG8_MMA(1, 1, At, B1); PG8_BAR; PG8_SCHED;
            PG8_LDB(B0, 1, 0); PG8_LDB(B1, 1, 1); PG8_SCHED; PG8_LDA(At, 1, 0); PG8_STAGE(PG8_SA(0, 1), a2 + hstepA, voffA);
            PG8_WAIT_V(8); PG8_WAIT_L(0); PG8_BAR; PG8_MMA(0, 0, At, B0); PG8_MMA(0, 1, At, B1); PG8_BAR; PG8_SCHED;
            PG8_LDA(At, 1, 1); PG8_STAGE(PG8_SB(1, 0), b3, voffB); PG8_STAGE(PG8_SB(1, 1), b3 + hstepB, voffB); PG8_STAGE(PG8_SA(1, 0), a3, voffA);
            PG8_WAIT_V(8); PG8_WAIT_L(0); PG8_BAR; PG8_MMA(1, 0, At, B0); PG8_MMA(1, 1, At, B1); PG8_BAR; PG8_SCHED;
            } else {
            PG8_LDB(B0, 0, 0); PG8_SCHED; PG8_LDA(At, 0, 0); PG8_STAGE(PG8_SA(1, 1), a1 + hstepA, voffA);
            PG8_WAIT_L(8); PG8_BAR; PG8_WAIT_L(0); PG8_MMA(0, 0, At, B0); PG8_BAR; PG8_SCHED;
            PG8_LDB(B1, 0, 1); PG8_STAGE(PG8_SB(0, 0), b2, voffB);
            PG8_BAR; PG8_WAIT_L(0); PG8_MMA(0, 1, At, B1); PG8_BAR;
            PG8_LDA(At, 0, 1); PG8_STAGE(PG8_SA(0, 0), a2, voffA);
            PG8_BAR; PG8_WAIT_L(0); PG8_MMA(1, 0, At, B0); PG8_BAR; PG8_SCHED;
            PG8_STAGE(PG8_SB(0, 1), b2 + hstepB, voffB);
            PG8_WAIT_V(6); PG8_BAR; PG8_MMA(1, 1, At, B1); PG8_BAR;
            PG8_LDB(B0, 1, 0); PG8_SCHED; PG8_LDA(At, 1, 0); PG8_STAGE(PG8_SA(0, 1), a2 + hstepA, voffA);
            PG8_WAIT_L(8); PG8_BAR; PG8_WAIT_L(0); PG8_MMA(0, 0, At, B0); PG8_BAR; PG8_SCHED;
            PG8_LDB(B1, 1, 1); PG8_STAGE(PG8_SB(1, 0), b3, voffB);
            PG8_BAR; PG8_WAIT_L(0); PG8_MMA(0, 1, At, B1); PG8_BAR;
            PG8_LDA(At, 1, 1); PG8_STAGE(PG8_SA(1, 0), a3, voffA);
            PG8_BAR; PG8_WAIT_L(0); PG8_MMA(1, 0, At, B0); PG8_BAR; PG8_SCHED;
            PG8_STAGE(PG8_SB(1, 1), b3 + hstepB, voffB);
            PG8_WAIT_V(6); PG8_BAR; PG8_MMA(1, 1, At, B1); PG8_BAR;
            }
        }
        if constexpr (ALIGN_EPI) { if (wr == 0) PG8_BAR; }
        if constexpr (!Epi::AFTER_DRAIN) { E(acc, cur, wr, wc, fr, fq); S.done(cur); }
        if (!has_next) break;
#pragma unroll
        for (int a = 0; a < 2; ++a)
#pragma unroll
            for (int b = 0; b < 2; ++b)
#pragma unroll
                for (int m = 0; m < 4; ++m)
#pragma unroll
                    for (int n = 0; n < 2; ++n) acc[a][b][m][n] = (f32x4){0.f, 0.f, 0.f, 0.f};
        cur = nxt; cA = nA; cB = nB; ++ui;
        if constexpr (ALIGN_EPI) { if (wr == 1) PG8_BAR; }
    }
    PG8_WAIT_V(0);
    if constexpr (!ALIGN_EPI) { if (wr == 0) PG8_BAR; }
    PG8_BAR;
    if constexpr (Epi::AFTER_DRAIN) { E.fused(acc, cur, wr, wc, fr, fq, lds, wid, lane); S.done(cur); }
#undef PG8_SA
#undef PG8_SB
#undef PG8_STAGE
#undef PG8_LDA
#undef PG8_LDB
#undef PG8_MMA
#undef PG8_WAIT_V
#undef PG8_WAIT_L
#undef PG8_BAR
#undef PG8_SCHED
}

__device__ __forceinline__ void tr_item(const float* src, int ldn, int k0, int n0, bf16_t* dst, int dld, int drow0, int dk0, float* scr, int lane) {
    const float* sp = src + (size_t)k0 * ldn + n0 + lane;
    float t[64];
#pragma unroll
    for (int i = 0; i < 64; ++i) t[i] = __builtin_nontemporal_load(sp + (size_t)i * ldn);
#pragma unroll
    for (int i = 0; i < 64; ++i) scr[i * 65 + lane] = t[i];
    __builtin_amdgcn_s_waitcnt(0); asm volatile("" ::: "memory");
    const int c = lane & 7;
#pragma unroll
    for (int j = 0; j < 8; ++j) {
        const int n = (lane >> 3) + 8 * j; const float* s = scr + (8 * c) * 65 + n;
        u32x4 o; o.x = pk2(s[0], s[65]); o.y = pk2(s[2 * 65], s[3 * 65]); o.z = pk2(s[4 * 65], s[5 * 65]); o.w = pk2(s[6 * 65], s[7 * 65]);
        *(u32x4*)(dst + (size_t)(drow0 + n) * dld + dk0 + 8 * c) = o;
    }
    __builtin_amdgcn_s_waitcnt(0); asm volatile("" ::: "memory");
}

__device__ __forceinline__ void convert_layer(const Args& a, unsigned char* lds, int l, int widx, int nw, int it_lo = 0, int it_hi = 1 << 30) {
    const int tid = otid(), wave = tid >> 6, lane = tid & 63;
    float* scr = (float*)(lds + wave * 16640);
    constexpr int I_IN = 32 * 192, I_BR = 4 * 8 * 32, I_O = 32 * 32, I_G = 32 * 88, I_D = 88 * 32, I_B = 16;
    constexpr int PLI = I_IN + I_BR + I_O + 2 * I_G + I_D + I_B;
    unsigned char* wb = a.ws + WS_W + (size_t)l * WPL;
    if (it_hi > PLI) it_hi = PLI;
    for (int it = it_lo + widx; it < it_hi; it += nw) {
        int r = it;
        if (r < I_IN) { const int kb = r / 192, nb = r % 192; tr_item(a.in[I_WIN] + (size_t)l * DM * NIN, NIN, kb * 64, nb * 64, (bf16_t*)(wb + W_IN), DM, nb * 64, kb * 64, scr, lane); continue; } r -= I_IN;
        if (r < I_BR) { const int i = r >> 8, rr = r & 255, kb = rr >> 5, nb = rr & 31;
            tr_item(a.in[I_WBR] + (size_t)(l * 4 + i) * 512 * DM, DM, kb * 64, nb * 64, (bf16_t*)(wb + W_BR), DM, nb * 64, i * 512 + kb * 64, scr, lane); continue; } r -= I_BR;
        if (r < I_O) { const int kb = r >> 5, nb = r & 31; tr_item(a.in[I_WO] + (size_t)l * DM * DM, DM, kb * 64, nb * 64, (bf16_t*)(wb + W_O), DM, nb * 64, kb * 64, scr, lane); continue; } r -= I_O;
        if (r < I_G) { const int kb = r / 88, nb = r % 88, n0 = nb * 64; tr_item(a.in[I_WG] + (size_t)l * DM * FF, FF, kb * 64, n0, (bf16_t*)(wb + W_GU), DM, (n0 >> 7) * 256 + (n0 & 127), kb * 64, scr, lane); continue; } r -= I_G;
        if (r < I_G) { const int kb = r / 88, nb = r % 88, n0 = nb * 64; tr_item(a.in[I_WU] + (size_t)l * DM * FF, FF, kb * 64, n0, (bf16_t*)(wb + W_GU), DM, (n0 >> 7) * 256 + 128 + (n0 & 127), kb * 64, scr, lane); continue; } r -= I_G;
        if (r < I_D) { const int kb = r >> 5, nb = r & 31; tr_item(a.in[I_WD] + (size_t)l * FF * DM, DM, kb * 64, nb * 64, (bf16_t*)(wb + W_D), FF, nb * 64, kb * 64, scr, lane); continue; } r -= I_D;
        { const int g = r >> 2, kb = (r >> 1) & 1, nb = r & 1;
          tr_item(a.in[I_BW] + (size_t)(l * 4 + g) * 128 * 128, 128, kb * 64, nb * 64, (bf16_t*)(wb + W_B), 512, g * 128 + nb * 64, g * 128 + kb * 64, scr, lane); }
    }
}
__device__ __forceinline__ void phase_prologue(const Args& a, unsigned char* lds, int vcu, int G) {
    const int tid = otid(), wave = tid >> 6;
    convert_layer(a, lds, 0, vcu * NWAVE + wave, G * NWAVE);
    for (int i = vcu * NTHR + tid; i < 2 * 32768; i += G * NTHR) {
        const int l = i >> 15, j = i & 32767, n = j >> 6, kc = j & 63;
        if ((n >> 7) != (kc >> 4)) *(u32x4*)((bf16_t*)(a.ws + WS_W + (size_t)l * WPL + W_B) + (size_t)n * 512 + kc * 8) = (u32x4){0u, 0u, 0u, 0u};
    }
    unsigned long long* MODI = (unsigned long long*)(a.ws + WS_CTL + CTL_MOD);
    for (int it = vcu; it < 768; it += G) {
        const int l = it / 384, r = it % 384, cb = r >> 6, kc = r & 63;
        const int col = cb * 2048 + tid * 4;
        f32x4 al = {0.f, 0.f, 0.f, 0.f}, ac = {0.f, 0.f, 0.f, 0.f};
        const float* wp = a.in[I_ADAW] + ((size_t)l * DM + kc * 32) * NIN + col;
#pragma unroll 8
        for (int k = 0; k < 32; ++k) {
            const float sl = siluf_(a.in[I_C][kc * 32 + k]), sc = siluf_(a.in[I_CCTX][kc * 32 + k]);
            const f32x4 w = *(const f32x4*)(wp + (size_t)k * NIN);
            al += sl * w; ac += sc * w;
        }
        if (kc == 0) { const f32x4 b = *(const f32x4*)(a.in[I_ADAB] + (size_t)l * NIN + col); al += b; ac += b; }
        unsigned long long* ml = MODI + (size_t)(l * 2 + 0) * NIN + col; unsigned long long* mc = MODI + (size_t)(l * 2 + 1) * NIN + col;
#pragma unroll
        for (int e = 0; e < 4; ++e) { atomicAdd(ml + e, (unsigned long long)__float2ll_rn(al[e] * MOD_FX)); atomicAdd(mc + e, (unsigned long long)__float2ll_rn(ac[e] * MOD_FX)); }
    }
}

template <int MODE, bool XIN = false>
__device__ __forceinline__ void phase_rows(const Args& a, int vcu, int G, int nrows, const float* gpost, const long long* modcur, int gate_idx,
                                           const float* gnext, const long long* modnext, int sh_idx, const float* ypart = nullptr) {
    const int tid = otid(), wave = tid >> 6, lane = tid & 63;
    const int gw = vcu * NWAVE + wave, NGW = G * NWAVE;
    float* X = (float*)(a.ws + WS_X); const bf16_t* Y = (const bf16_t*)(a.ws + WS_MRG); bf16_t* XN = (bf16_t*)(a.ws + WS_XN);
#define ROWS_LOAD(r) do { const int ic_ = (r) >= SEQ ? 1 : 0; \
        const float* xs_ = (MODE == 0 || XIN) ? (ic_ ? a.in[I_CTX] + (size_t)((r) - SEQ) * DM : a.in[I_X] + (size_t)(r) * DM) : X + (size_t)(r) * DM; \
        _Pragma("unroll") for (int j = 0; j < 8; ++j) nx[j] = *(const f32x4*)(xs_ + 4 * lane + 256 * j); \
        if (MODE != 0) { _Pragma("unroll") for (int j = 0; j < 8; ++j) ny[j] = *(const u32x2*)(Y + (size_t)(r) * DM + 4 * lane + 256 * j); } } while (0)
    int row = gw;
    f32x4 c1[8], s0v[8]; int cur_ctx = -1;
    for (; row < nrows; row += NGW) {
        const int isctx = row >= SEQ ? 1 : 0;
        if (isctx != cur_ctx) { cur_ctx = isctx;
            if (MODE != 2) { const long long* sh = modnext + (size_t)isctx * NIN + sh_idx * DM; const long long* sc = sh + DM;
#pragma unroll
                for (int j = 0; j < 8; ++j) { const int col = 4 * lane + 256 * j; c1[j] = *(const f32x4*)(gnext + col) * (1.f + ldmod4(sc + col)); s0v[j] = ldmod4(sh + col); } }
        }
        f32x4 nx[8]; u32x2 ny[8];
        ROWS_LOAD(row);
        f32x4 (&x)[8] = nx; u32x2 (&yb)[8] = ny;
        if (MODE != 0) {
            f32x4 y[8]; float ss = 0.f;
#pragma unroll
            for (int j = 0; j < 8; ++j) {
                if (ypart && isctx) { const float* yp = ypart + (size_t)(row - SEQ) * DM + 4 * lane + 256 * j;
                    y[j] = (*(const f32x4*)yp + *(const f32x4*)(yp + (size_t)CTXL * DM)) + (*(const f32x4*)(yp + (size_t)2 * CTXL * DM) + *(const f32x4*)(yp + (size_t)3 * CTXL * DM)); }
                else y[j] = (f32x4){bflo(yb[j].x), bfhi(yb[j].x), bflo(yb[j].y), bfhi(yb[j].y)};
                ss += (y[j][0] * y[j][0] + y[j][1] * y[j][1]) + (y[j][2] * y[j][2] + y[j][3] * y[j][3]); }
            const float rstd = 1.0f / sqrtf(wave_sum(ss) * (1.f / DM) + EPS);
            const long long* gate = modcur + (size_t)isctx * NIN + gate_idx * DM;
#pragma unroll
            for (int j = 0; j < 8; ++j) { const int col = 4 * lane + 256 * j; x[j] += (ldmod4(gate + col) * *(const f32x4*)(gpost + col)) * (y[j] * rstd); }
        }
        if (MODE == 2) {
#pragma unroll
            for (int j = 0; j < 8; ++j) *(f32x4*)(a.out + (size_t)row * DM + 4 * lane + 256 * j) = x[j];
            continue;
        }
        float ss = 0.f;
#pragma unroll
        for (int j = 0; j < 8; ++j) { if (MODE != 0) *(f32x4*)(X + (size_t)row * DM + 4 * lane + 256 * j) = x[j];
            ss += (x[j][0] * x[j][0] + x[j][1] * x[j][1]) + (x[j][2] * x[j][2] + x[j][3] * x[j][3]); }
        const float rstd = 1.0f / sqrtf(wave_sum(ss) * (1.f / DM) + EPS);
#pragma unroll
        for (int j = 0; j < 8; ++j) { const int col = 4 * lane + 256 * j;
            const f32x4 h = (x[j] * rstd) * c1[j] + s0v[j];
            u32x2 w; w.x = pk2(h[0], h[1]); w.y = pk2(h[2], h[3]); *(u32x2*)(XN + (size_t)row * DM + col) = w; }
    }
#undef ROWS_LOAD
}

__device__ __forceinline__ void qk_prep_row(const Args& a, int layer, int row, int lane) {
    bf16_t* p = (bf16_t*)(a.ws + WS_PL) + (size_t)row * NIN;
    const int ax = lane >> 5, f = lane & 31, d1 = ax * 64 + f, d2 = d1 + 32;
    float cs = 1.f, sn = 0.f;
    if (row < SEQ) { const float pos = (float)(ax == 0 ? (row >> 6) : (row & 63)); const float inv = exp2f(-(float)f * (13.287712379549449f / 32.f)); const float ang = pos * inv; cs = cosf(ang); sn = sinf(ang); }
#pragma unroll
    for (int h = 0; h < 6; ++h) {
        const float* gn = (h < 4 ? a.in[I_AQN] : a.in[I_AKN]) + layer * HD;
        bf16_t* hp = p + h * HD;
        float x1 = bf2f(hp[d1]), x2 = bf2f(hp[d2]);
        const float rstd = 1.0f / sqrtf(wave_sum(x1 * x1 + x2 * x2) * (1.f / HD) + EPS);
        x1 = x1 * rstd * gn[d1]; x2 = x2 * rstd * gn[d2];
        hp[d1] = (bf16_t)f2bf(x1 * cs - x2 * sn); hp[d2] = (bf16_t)f2bf(x2 * cs + x1 * sn);
    }
}
__device__ __forceinline__ void dlt_row(const Args& a, int row, int lane) {
    const bf16_t* PL = (const bf16_t*)(a.ws + WS_PL); bf16_t* DLT = (bf16_t*)(a.ws + WS_DLT);
    const int base = row < SEQ ? 0 : SEQ, n = row < SEQ ? SEQ : CTXL, t = row - base, half = 1 << (lane >> 4);
    const int lo = max(t - half, 0), hi = min(t + half, n);
    float s[8];
#pragma unroll
    for (int e = 0; e < 8; ++e) s[e] = 0.f;
    u32x4 w[16];
#pragma unroll
    for (int i = 0; i < 16; ++i) { const int r = min(max(t - 8 + i, 0), n - 1); w[i] = *(const u32x4*)(PL + (size_t)(base + r) * NIN + B0 + lane * 8); }
#pragma unroll
    for (int i = 0; i < 16; ++i) { const int r = t - 8 + i; const float m = (r >= lo && r < hi) ? 1.f : 0.f;
        s[0] += m * bflo(w[i].x); s[1] += m * bfhi(w[i].x); s[2] += m * bflo(w[i].y); s[3] += m * bfhi(w[i].y); s[4] += m * bflo(w[i].z); s[5] += m * bfhi(w[i].z); s[6] += m * bflo(w[i].w); s[7] += m * bfhi(w[i].w); }
    const float inv = 1.f / (float)(hi - lo);
    const u32x4 c = w[8];
    u32x4 o; o.x = pk2(s[0] * inv - bflo(c.x), s[1] * inv - bfhi(c.x)); o.y = pk2(s[2] * inv - bflo(c.y), s[3] * inv - bfhi(c.y));
    o.z = pk2(s[4] * inv - bflo(c.z), s[5] * inv - bfhi(c.z)); o.w = pk2(s[6] * inv - bflo(c.w), s[7] * inv - bfhi(c.w));
    *(u32x4*)(DLT + (size_t)row * 512 + lane * 8) = o;
}
constexpr int CP = 136;
__device__ __forceinline__ void cmix_unit(const Args& a, int layer, int unit, unsigned char* lds) {
    const int tid = otid(), wave = tid >> 6, lane = tid & 63, chunk = unit >> 2, g = unit & 3;
    const bf16_t* PL = (const bf16_t*)(a.ws + WS_PL); bf16_t* OUT = (bf16_t*)(a.ws + WS_OUTS) + 2 * 512;
    bf16_t* vT = (bf16_t*)lds;
    bf16_t* wsL = (bf16_t*)(lds + 128 * CP * 2);
    float* st = (float*)(lds + 2 * 128 * CP * 2);
    const int t0 = chunk * 128;
    for (int i = 0; i < 16; ++i) {
        const int q = wave * 16 + i;
        const u32x4 w = *(const u32x4*)(PL + (size_t)(t0 + q) * NIN + C_V0 + lane * 8);
        float x[8] = {bflo(w.x), bfhi(w.x), bflo(w.y), bfhi(w.y), bflo(w.z), bfhi(w.z), bflo(w.w), bfhi(w.w)};
        float s = 0.f;
#pragma unroll
        for (int e = 0; e < 8; ++e) s += x[e];
        const float mean = wave_sum(s) * (1.f / 512.f); float q2 = 0.f;
#pragma unroll
        for (int e = 0; e < 8; ++e) { const float d = x[e] - mean; q2 += d * d; }
        const float rstd = 1.0f / sqrtf(wave_sum(q2) * (1.f / 512.f) + EPS);
        if (lane == 0) { st[2 * q] = mean; st[2 * q + 1] = rstd; }
    }
    __syncthreads();
    {
        const int q = tid & 127, cb = tid >> 7; const float mean = st[2 * q], rstd = st[2 * q + 1];
        const float* lg = a.in[I_CNG] + layer * 512 + g * 128 + cb * 32; const float* lb = a.in[I_CNB] + layer * 512 + g * 128 + cb * 32;
        const bf16_t* vp = PL + (size_t)(t0 + q) * NIN + C_V0 + g * 128 + cb * 32;
#pragma unroll
        for (int j = 0; j < 4; ++j) { const u32x4 w = *(const u32x4*)(vp + j * 8);
            const float x[8] = {bflo(w.x), bfhi(w.x), bflo(w.y), bfhi(w.y), bflo(w.z), bfhi(w.z), bflo(w.w), bfhi(w.w)};
#pragma unroll
            for (int e = 0; e < 8; ++e) { const int c = j * 8 + e; vT[(cb * 32 + c) * CP + q] = (bf16_t)f2bf((x[e] - mean) * rstd * lg[c] + lb[c]); } }
        const int p = tid >> 2, qb = (tid & 3) * 32; const float* wp = a.in[I_CWS] + ((size_t)(layer * 4 + g) * 128 + p) * 128 + qb;
#pragma unroll
        for (int j = 0; j < 8; ++j) { const f32x4 w = *(const f32x4*)(wp + j * 4); u32x2 o; o.x = pk2(w[0], w[1]); o.y = pk2(w[2], w[3]); *(u32x2*)(wsL + p * CP + qb + j * 4) = o; }
    }
    __syncthreads();
    {
        const int fr = lane & 15, fq = lane >> 4;
        f32x4 acc[8];
#pragma unroll
        for (int nb = 0; nb < 8; ++nb) acc[nb] = (f32x4){0.f, 0.f, 0.f, 0.f};
#pragma unroll
        for (int ks = 0; ks < 4; ++ks) {
            const bf16x8 wf = *(const bf16x8*)(wsL + (wave * 16 + fr) * CP + ks * 32 + fq * 8);
#pragma unroll
            for (int nb = 0; nb < 8; ++nb) { const bf16x8 vf = *(const bf16x8*)(vT + (nb * 16 + fr) * CP + ks * 32 + fq * 8);
                acc[nb] = __builtin_amdgcn_mfma_f32_16x16x32_bf16(vf, wf, acc[nb], 0, 0, 0); }
        }
        const int p = wave * 16 + fr; const float bs = a.in[I_CBS][(layer * 4 + g) * 128 + p];
        const bf16_t* up = PL + (size_t)(t0 + p) * NIN + C_U0 + g * 128; bf16_t* op = OUT + (size_t)(t0 + p) * DM + g * 128;
#pragma unroll
        for (int nb = 0; nb < 8; ++nb) { const int c = nb * 16 + 4 * fq; const u32x2 uw = *(const u32x2*)(up + c);
            u32x2 o; o.x = pk2((acc[nb][0] + bs) * bflo(uw.x), (acc[nb][1] + bs) * bfhi(uw.x)); o.y = pk2((acc[nb][2] + bs) * bflo(uw.y), (acc[nb][3] + bs) * bfhi(uw.y));
            *(u32x2*)(op + c) = o; }
    }
    __syncthreads();
}

template <int MODE>
__device__ __forceinline__ void attn_simple_item(const bf16_t* PL, int qcol, int kcol, int vcol, bf16_t* O, int qrow, int h, int kvh, int kbeg, int kend, const float* rpb, int lane) {
    constexpr float C = 0.088388347648318440f * 1.4426950408889634f;
    const int part = lane & 3;
    float q[32], o[32];
    { const bf16_t* qp = PL + (size_t)qrow * NIN + qcol + h * HD + part * 32;
#pragma unroll
      for (int j = 0; j < 4; ++j) { const u32x4 w = *(const u32x4*)(qp + j * 8);
          q[j * 8 + 0] = bflo(w.x) * C; q[j * 8 + 1] = bfhi(w.x) * C; q[j * 8 + 2] = bflo(w.y) * C; q[j * 8 + 3] = bfhi(w.y) * C;
          q[j * 8 + 4] = bflo(w.z) * C; q[j * 8 + 5] = bfhi(w.z) * C; q[j * 8 + 6] = bflo(w.w) * C; q[j * 8 + 7] = bfhi(w.w) * C; } }
#pragma unroll
    for (int d = 0; d < 32; ++d) o[d] = 0.f;
    float mrun = -1e30f, l = 0.f;
    const int r = qrow >> 6, c = qrow & 63, r0 = min(max(r - 4, 0), 120), c0 = min(max(c - 8, 0), 48);
    const int nk = MODE == 0 ? (kend - kbeg) : 384;
    for (int idx = 0; idx < nk; ++idx) {
        int krow; float bias = 0.f;
        if (MODE == 0) krow = kbeg + idx;
        else if (idx < 128) { const int i = idx >> 4, j = idx & 15; krow = (r0 + i) * GW + c0 + j; bias = rpb[(h * 15 + (r0 + i - r + 7)) * 31 + (c0 + j - c + 15)] * 1.4426950408889634f; }
        else krow = SEQ + idx - 128;
        const bf16_t* kp = PL + (size_t)krow * NIN + kcol + kvh * HD + part * 32;
        float s = 0.f;
#pragma unroll
        for (int j = 0; j < 4; ++j) { const u32x4 w = *(const u32x4*)(kp + j * 8);
            s += q[j * 8 + 0] * bflo(w.x) + q[j * 8 + 1] * bfhi(w.x) + q[j * 8 + 2] * bflo(w.y) + q[j * 8 + 3] * bfhi(w.y)
               + q[j * 8 + 4] * bflo(w.z) + q[j * 8 + 5] * bfhi(w.z) + q[j * 8 + 6] * bflo(w.w) + q[j * 8 + 7] * bfhi(w.w); }
        s += __shfl_xor(s, 1); s += __shfl_xor(s, 2);
        s += bias;
        const float mn = fmaxf(mrun, s), alpha = exp2f(mrun - mn), p = exp2f(s - mn);
        l = l * alpha + p; mrun = mn;
        const bf16_t* vp = PL + (size_t)krow * NIN + vcol + kvh * HD + part * 32;
#pragma unroll
        for (int j = 0; j < 4; ++j) { const u32x4 w = *(const u32x4*)(vp + j * 8);
            o[j * 8 + 0] = o[j * 8 + 0] * alpha + p * bflo(w.x); o[j * 8 + 1] = o[j * 8 + 1] * alpha + p * bfhi(w.x);
            o[j * 8 + 2] = o[j * 8 + 2] * alpha + p * bflo(w.y); o[j * 8 + 3] = o[j * 8 + 3] * alpha + p * bfhi(w.y);
            o[j * 8 + 4] = o[j * 8 + 4] * alpha + p * bflo(w.z); o[j * 8 + 5] = o[j * 8 + 5] * alpha + p * bfhi(w.z);
            o[j * 8 + 6] = o[j * 8 + 6] * alpha + p * bflo(w.w); o[j * 8 + 7] = o[j * 8 + 7] * alpha + p * bfhi(w.w); }
    }
    const float il = 1.f / l;
    bf16_t* op = O + (size_t)qrow * 512 + h * HD + part * 32;
#pragma unroll
    for (int j = 0; j < 4; ++j) { u32x4 w; w.x = pk2(o[j * 8 + 0] * il, o[j * 8 + 1] * il); w.y = pk2(o[j * 8 + 2] * il, o[j * 8 + 3] * il);
        w.z = pk2(o[j * 8 + 4] * il, o[j * 8 + 5] * il); w.w = pk2(o[j * 8 + 6] * il, o[j * 8 + 7] * il); *(u32x4*)(op + j * 8) = w; }
}


namespace att {
using s16x4 = __attribute__((ext_vector_type(4))) short;
using f32x16 = __attribute__((ext_vector_type(16))) float;
constexpr int KVBLK = 64;
constexpr float SCALE = 0.088388347648318440f, THR = 8.f;
constexpr int SHM_V = KVBLK * HD * 2, SHM_K = KVBLK * HD * 2, SHM_ATTN = 2 * SHM_V + 2 * SHM_K + NWAVE * 64 * 4;
#define KSWZ(row, colB) ((row) * 256 + ((colB) ^ (((row) & 7) << 4)))
#define SBAR() __builtin_amdgcn_sched_barrier(0)
__device__ __forceinline__ int crow(int r, int hi) { return (r & 3) + 8 * (r >> 2) + 4 * hi; }
__device__ __forceinline__ unsigned cvtpk(float lo, float hi) { unsigned r; asm volatile("v_cvt_pk_bf16_f32 %0, %1, %2" : "=v"(r) : "v"(lo), "v"(hi)); return r; }
__device__ __forceinline__ void partialSM(f32x16& p0, f32x16& p1, float& m_reg, float& mn, float& alpha) {
  constexpr float C = SCALE * 1.4426950408889634f;
  float pmax = p0[0];
#pragma unroll
  for (int r = 1; r < 16; ++r) pmax = fmaxf(pmax, p0[r]);
#pragma unroll
  for (int r = 0; r < 16; ++r) pmax = fmaxf(pmax, p1[r]);
  { auto rr = __builtin_amdgcn_permlane32_swap(__float_as_uint(pmax), __float_as_uint(pmax), false, false);
    pmax = fmaxf(__uint_as_float(rr[0]), __uint_as_float(rr[1])); }
  if (__builtin_expect(__all(pmax - m_reg <= THR / SCALE), 1)) { mn = m_reg; alpha = 1.f; }
  else { mn = fmaxf(m_reg, pmax); alpha = __builtin_amdgcn_exp2f((m_reg - mn) * C); m_reg = mn; }
  float mnC = -mn * C;
#pragma unroll
  for (int r = 0; r < 16; ++r) p0[r] = fmaf(p0[r], C, mnC);
#pragma unroll
  for (int r = 0; r < 16; ++r) p1[r] = fmaf(p1[r], C, mnC);
#pragma unroll
  for (int r = 0; r < 16; ++r) p0[r] = __builtin_amdgcn_exp2f(p0[r]);
}
__device__ __forceinline__ void finishSM(f32x16& p0, f32x16& p1, float alpha, float& l_reg, bf16x8& pa0, bf16x8& pa1, bf16x8& pa2, bf16x8& pa3) {
#pragma unroll
  for (int r = 0; r < 16; ++r) p1[r] = __builtin_amdgcn_exp2f(p1[r]);
  float ps = 0;
#pragma unroll
  for (int r = 0; r < 16; ++r) ps += p0[r];
#pragma unroll
  for (int r = 0; r < 16; ++r) ps += p1[r];
  { auto rr = __builtin_amdgcn_permlane32_swap(__float_as_uint(ps), __float_as_uint(ps), false, false);
    ps = __uint_as_float(rr[0]) + __uint_as_float(rr[1]); }
  l_reg = l_reg * alpha + ps;
#define PK4(P, BASE, OUT) do { unsigned a0 = cvtpk(P[BASE + 0], P[BASE + 1]), a1 = cvtpk(P[BASE + 2], P[BASE + 3]);   \
    unsigned b0 = cvtpk(P[BASE + 4], P[BASE + 5]), b1 = cvtpk(P[BASE + 6], P[BASE + 7]);                              \
    auto r0 = __builtin_amdgcn_permlane32_swap(a0, b0, false, false); auto r1 = __builtin_amdgcn_permlane32_swap(a1, b1, false, false); \
    u32x4 w = {r0[0], r1[0], r0[1], r1[1]}; OUT = *reinterpret_cast<bf16x8*>(&w); } while (0)
  PK4(p0, 0, pa0); PK4(p0, 8, pa1); PK4(p1, 0, pa2); PK4(p1, 8, pa3);
#undef PK4
}
__device__ __forceinline__ void qkt(f32x16& p0, f32x16& p1, const char* Ks, const bf16x8* qr, int r32, int hi) {
  p0 = f32x16{}; p1 = f32x16{};
#pragma unroll
  for (int d0 = 0; d0 < 8; ++d0) { int cb = (d0 * 16 + hi * 8) * 2;
    bf16x8 b0 = *reinterpret_cast<const bf16x8*>(Ks + KSWZ(r32, cb));
    bf16x8 b1 = *reinterpret_cast<const bf16x8*>(Ks + KSWZ(32 + r32, cb));
    p0 = __builtin_amdgcn_mfma_f32_32x32x16_bf16(b0, qr[d0], p0, 0, 0, 0);
    p1 = __builtin_amdgcn_mfma_f32_32x32x16_bf16(b1, qr[d0], p1, 0, 0, 0); }
}
__device__ __forceinline__ int v_st(int k, int c) { const int kk = (k & ~0xC) | ((k & 4) << 1) | ((k & 8) >> 1); return ((kk >> 3) * 4 + (c >> 5)) * 512 + ((kk & 7) * 32 + (c & 31)) * 2; }
__device__ __forceinline__ int v_rd_base(int lane) { return ((lane & 3) << 3) | (((lane >> 2) & 3) << 6) | (((lane >> 4) & 1) << 5) | (((lane >> 5) & 1) << 8); }
constexpr int v_rd_off(int d0, int ks, int half) { return d0 * 512 + ks * 4096 + half * 2048; }
template <int OFF> __device__ __forceinline__ s16x4 tr_read(int vb) {
  s16x4 r; asm volatile("ds_read_b64_tr_b16 %0, %1 offset:%2" : "=&v"(r) : "v"(vb), "i"(OFF) : "memory"); return r;
}
template <int D0> __device__ __forceinline__ void pv_one(f32x16& od, int vb, bf16x8 pa0, bf16x8 pa1, bf16x8 pa2, bf16x8 pa3) {
  const s16x4 l0 = tr_read<v_rd_off(D0, 0, 0)>(vb), h0 = tr_read<v_rd_off(D0, 0, 1)>(vb), l1 = tr_read<v_rd_off(D0, 1, 0)>(vb), h1 = tr_read<v_rd_off(D0, 1, 1)>(vb);
  const s16x4 l2 = tr_read<v_rd_off(D0, 2, 0)>(vb), h2 = tr_read<v_rd_off(D0, 2, 1)>(vb), l3 = tr_read<v_rd_off(D0, 3, 0)>(vb), h3 = tr_read<v_rd_off(D0, 3, 1)>(vb);
  asm volatile("s_waitcnt lgkmcnt(0)" ::: "memory"); SBAR();
#define PK(L, H) (bf16x8){L[0], L[1], L[2], L[3], H[0], H[1], H[2], H[3]}
  od = __builtin_amdgcn_mfma_f32_32x32x16_bf16(pa0, PK(l0, h0), od, 0, 0, 0);
  od = __builtin_amdgcn_mfma_f32_32x32x16_bf16(pa1, PK(l1, h1), od, 0, 0, 0);
  od = __builtin_amdgcn_mfma_f32_32x32x16_bf16(pa2, PK(l2, h2), od, 0, 0, 0);
  od = __builtin_amdgcn_mfma_f32_32x32x16_bf16(pa3, PK(l3, h3), od, 0, 0, 0);
#undef PK
}
__device__ __forceinline__ void pv_d0(f32x16* o, int vb, bf16x8 pa0, bf16x8 pa1, bf16x8 pa2, bf16x8 pa3) {
  pv_one<0>(o[0], vb, pa0, pa1, pa2, pa3); pv_one<1>(o[1], vb, pa0, pa1, pa2, pa3); pv_one<2>(o[2], vb, pa0, pa1, pa2, pa3); pv_one<3>(o[3], vb, pa0, pa1, pa2, pa3);
}
__device__ __forceinline__ void na_hook(f32x16& p0, f32x16& p1, int kr, int qr, int qc, int hi, const float* rpbh) {
  const int r0 = min(max(qr - 4, 0), 120), c0 = min(max(qc - 8, 0), 48);
  if (kr < r0 || kr >= r0 + 8) {
#pragma unroll
    for (int r = 0; r < 16; ++r) { p0[r] = -1e30f; p1[r] = -1e30f; }
  } else {
    const float* bp = rpbh + (kr - qr + 7) * 31 + 15 - qc;
#pragma unroll
    for (int r = 0; r < 16; ++r) {
      const int kc0 = crow(r, hi), kc1 = 32 + kc0;
      const bool v0 = (unsigned)(kc0 - c0) < 16u, v1 = (unsigned)(kc1 - c0) < 16u;
      const float b0 = v0 ? bp[kc0] : 0.f, b1 = v1 ? bp[kc1] : 0.f;
      p0[r] = v0 ? fmaf(b0, 1.f / SCALE, p0[r]) : -1e30f;
      p1[r] = v1 ? fmaf(b1, 1.f / SCALE, p1[r]) : -1e30f;
      if ((r & 3) == 3) SBAR();
    }
  }
}
template <int MODE, bool DIRECT>
__device__ __forceinline__ void attn_unit(const bf16_t* __restrict__ PL, int qrow0, int qcol, int kcol, int vcol, int NT, int base0, int n0, int base1,
                                          const float* rpbh, bf16_t* Obf, float* Opart, float* LSE, char* lds) {
  const int tid = otid(), wid = tid >> 6, lane = tid & 63, r32 = lane & 31, hi = lane >> 5;
  char* V_lds = lds; char* K_lds = lds + 2 * SHM_V;
  float* wsf = (float*)(lds + 2 * SHM_V + 2 * SHM_K) + wid * 64; float* li_l = wsf; float* al_l = wsf + 32;
  float m_reg = -1e30f, l_reg = 0; f32x16 o[4] = {}; bf16x8 qr[8];
  const bf16_t* Qw = PL + (size_t)(qrow0 + wid * 32 + r32) * NIN + qcol + hi * 8;
#pragma unroll
  for (int d0 = 0; d0 < 8; ++d0) qr[d0] = *reinterpret_cast<const bf16x8*>(Qw + d0 * 16);
  const int qgr = __builtin_amdgcn_readfirstlane((qrow0 + wid * 32) >> 6);
  const int sr = tid >> 4, sc = (tid & 15) * 8, vst0 = v_st(sr, sc), vst1 = v_st(32 + sr, sc);
  const int vb0 = (int)(uintptr_t)V_lds + v_rd_base(lane);
  const bf16_t* Kg = PL + (size_t)sr * NIN + kcol + sc; const bf16_t* Vg = PL + (size_t)sr * NIN + vcol + sc;
  constexpr int SD = 1;
  struct { bf16x8 vs0, vs1, ks0, ks1; } sr_[SD];
#define KROW(j) ((j) < n0 ? base0 + 64 * (j) : base1 + 64 * ((j) - n0))
#define SLOAD(i, j) do { const size_t ko_ = (size_t)KROW(j) * NIN; sr_[i].vs0 = *reinterpret_cast<const bf16x8*>(Vg + ko_); sr_[i].vs1 = *reinterpret_cast<const bf16x8*>(Vg + ko_ + (size_t)32 * NIN); \
    sr_[i].ks0 = *reinterpret_cast<const bf16x8*>(Kg + ko_); sr_[i].ks1 = *reinterpret_cast<const bf16x8*>(Kg + ko_ + (size_t)32 * NIN); } while (0)
#define SWRITE(b, i) do { *(bf16x8*)(V_lds + (b) * SHM_V + vst0) = sr_[i].vs0;          \
    *(bf16x8*)(V_lds + (b) * SHM_V + vst1) = sr_[i].vs1; int kc = sc * 2;               \
    *(bf16x8*)(K_lds + (b) * SHM_K + KSWZ(sr, kc)) = sr_[i].ks0;                       \
    *(bf16x8*)(K_lds + (b) * SHM_K + KSWZ(32 + sr, kc)) = sr_[i].ks1; } while (0)
#define SWAIT() do { if constexpr (SD == 2) asm volatile("s_waitcnt vmcnt(4)" ::: "memory"); else asm volatile("s_waitcnt vmcnt(0)" ::: "memory"); } while (0)
#define RESC(a) do { if (__any((a) < 1.f)) { if (hi == 0) al_l[r32] = (a); asm volatile("s_waitcnt lgkmcnt(0)" ::: "memory"); \
    _Pragma("unroll") for (int d = 0; d < 4; ++d) _Pragma("unroll") for (int r = 0; r < 16; ++r) o[d][r] *= al_l[crow(r, hi)]; } } while (0)
#define HOOK(P0, P1, j) do { if (MODE == 1) { if ((j) >= n0) na_hook(P0, P1, (base1 >> 6) + (j) - n0, qgr, ((wid & 1) << 5) + r32, hi, rpbh); } } while (0)
  f32x16 pA0, pA1, pB0, pB1; float mnA, mnB, alA, alB; bf16x8 pa0, pa1, pa2, pa3;
  constexpr int SE = 0, SO = SD - 1;
  SLOAD(SE, 0); asm volatile("s_waitcnt vmcnt(0)" ::: "memory"); SWRITE(0, SE); __syncthreads();
  qkt(pA0, pA1, K_lds, qr, r32, hi); HOOK(pA0, pA1, 0); partialSM(pA0, pA1, m_reg, mnA, alA);
  SLOAD(SO, 1); if constexpr (SD == 2) { if (2 < NT) SLOAD(SE, 2); }
  SWAIT(); SWRITE(1, SO); __syncthreads();
  for (int j = 1; j + 1 < NT; j += 2) {
    SBAR(); qkt(pB0, pB1, K_lds + SHM_K, qr, r32, hi); HOOK(pB0, pB1, j);
    finishSM(pA0, pA1, alA, l_reg, pa0, pa1, pa2, pa3); SBAR();
    SLOAD(SO, j + SD); SBAR();
    pv_d0(o, vb0, pa0, pa1, pa2, pa3); partialSM(pB0, pB1, m_reg, mnB, alB);
    __syncthreads(); SWAIT(); SWRITE(0, SE);
    RESC(alB); __syncthreads();
    SBAR(); qkt(pA0, pA1, K_lds, qr, r32, hi); HOOK(pA0, pA1, j + 1);
    finishSM(pB0, pB1, alB, l_reg, pa0, pa1, pa2, pa3); SBAR();
    if (SD == 1 || j + 3 < NT) SLOAD(SE, j + 1 + SD); SBAR();
    pv_d0(o, vb0 + SHM_V, pa0, pa1, pa2, pa3); partialSM(pA0, pA1, m_reg, mnA, alA);
    __syncthreads(); SWAIT(); SWRITE(1, SO);
    RESC(alA); __syncthreads();
  }
  SBAR(); qkt(pB0, pB1, K_lds + SHM_K, qr, r32, hi); HOOK(pB0, pB1, NT - 1);
  finishSM(pA0, pA1, alA, l_reg, pa0, pa1, pa2, pa3); SBAR();
  pv_d0(o, vb0, pa0, pa1, pa2, pa3); partialSM(pB0, pB1, m_reg, mnB, alB);
  __syncthreads(); RESC(alB);
  finishSM(pB0, pB1, alB, l_reg, pa0, pa1, pa2, pa3); SBAR();
  pv_d0(o, vb0 + SHM_V, pa0, pa1, pa2, pa3);
  if (hi == 0) li_l[r32] = l_reg; asm volatile("s_waitcnt lgkmcnt(0)" ::: "memory");
  float rli[16];
#pragma unroll
  for (int r = 0; r < 16; ++r) rli[r] = __builtin_amdgcn_rcpf(li_l[crow(r, hi)]);
  if (DIRECT) {
    bf16_t* Ow = Obf + (size_t)(wid * 32) * DM;
#pragma unroll
    for (int r = 0; r < 16; ++r) { const int orow = crow(r, hi);
#pragma unroll
      for (int d0 = 0; d0 < 4; ++d0) Ow[(size_t)orow * DM + d0 * 32 + r32] = (bf16_t)f2bf(o[d0][r] * rli[r]); }
  } else {
    float* Ow = Opart + (size_t)(wid * 32) * 512;
#pragma unroll
    for (int r = 0; r < 16; ++r) { const int orow = crow(r, hi);
#pragma unroll
      for (int d0 = 0; d0 < 4; ++d0) Ow[(size_t)orow * 512 + d0 * 32 + r32] = o[d0][r] * rli[r]; }
    if (hi == 0) LSE[(size_t)(wid * 32 + r32) * 4] = m_reg * (SCALE * 1.4426950408889634f) + log2f(l_reg);
  }
  __syncthreads();
#undef KROW
#undef SLOAD
#undef SWRITE
#undef SWAIT
#undef RESC
#undef HOOK
}
__device__ __forceinline__ void attn_unit_na(const bf16_t* __restrict__ PL, int qrow0, int qcol, int kcol, int vcol, int R0, const float* rpbh, bf16_t* Obf, char* lds) {
  const int tid = otid(), wid = tid >> 6, lane = tid & 63, r32 = lane & 31, hi = lane >> 5;
  constexpr int NT = 16, n0 = 4;
  char* V_lds = lds; char* K_lds = lds + 2 * SHM_V;
  float* wsf = (float*)(lds + 2 * SHM_V + 2 * SHM_K) + wid * 64; float* li_l = wsf; float* al_l = wsf + 32;
  float m_reg = -1e30f, l_reg = 0; f32x16 o[4] = {}; bf16x8 qr[8];
  const bf16_t* Qw = PL + (size_t)(qrow0 + wid * 32 + r32) * NIN + qcol + hi * 8;
#pragma unroll
  for (int d0 = 0; d0 < 8; ++d0) qr[d0] = *reinterpret_cast<const bf16x8*>(Qw + d0 * 16);
  const int qgr = (qrow0 + wid * 32) >> 6, qgc = ((wid & 1) << 5) + r32;
  const int sr = tid >> 4, sc = (tid & 15) * 8, vst0 = v_st(sr, sc), vst1 = v_st(32 + sr, sc);
  const int vb0 = (int)(uintptr_t)V_lds + v_rd_base(lane);
  const bf16_t* Kg = PL + (size_t)sr * NIN + kcol + sc; const bf16_t* Vg = PL + (size_t)sr * NIN + vcol + sc;
  bf16x8 vs0, vs1, ks0, ks1;
#define KROW(j) ((j) < n0 ? SEQ + 64 * (j) : (R0 + (j) - n0) * 64)
#define SLOAD(j) do { const size_t ko_ = (size_t)KROW(j) * NIN; vs0 = *reinterpret_cast<const bf16x8*>(Vg + ko_); vs1 = *reinterpret_cast<const bf16x8*>(Vg + ko_ + (size_t)32 * NIN); \
    ks0 = *reinterpret_cast<const bf16x8*>(Kg + ko_); ks1 = *reinterpret_cast<const bf16x8*>(Kg + ko_ + (size_t)32 * NIN); } while (0)
  SLOAD(0);
  for (int j = 0; j < NT; ++j) {
    asm volatile("s_waitcnt vmcnt(0)" ::: "memory");
    *(bf16x8*)(V_lds + vst0) = vs0; *(bf16x8*)(V_lds + vst1) = vs1;
    *(bf16x8*)(K_lds + KSWZ(sr, sc * 2)) = ks0; *(bf16x8*)(K_lds + KSWZ(32 + sr, sc * 2)) = ks1;
    __syncthreads();
    if (j + 1 < NT) SLOAD(j + 1);
    f32x16 p0, p1; float mn, al; bf16x8 pa0, pa1, pa2, pa3;
    qkt(p0, p1, K_lds, qr, r32, hi);
    if (j >= n0) na_hook(p0, p1, R0 + j - n0, qgr, qgc, hi, rpbh);
    partialSM(p0, p1, m_reg, mn, al);
    if (__any(al < 1.f)) { if (hi == 0) al_l[r32] = al; asm volatile("s_waitcnt lgkmcnt(0)" ::: "memory");
#pragma unroll
      for (int d = 0; d < 4; ++d)
#pragma unroll
        for (int r = 0; r < 16; ++r) o[d][r] *= al_l[crow(r, hi)]; }
    finishSM(p0, p1, al, l_reg, pa0, pa1, pa2, pa3); SBAR();
    pv_d0(o, vb0, pa0, pa1, pa2, pa3);
    __syncthreads();
  }
  if (hi == 0) li_l[r32] = l_reg; asm volatile("s_waitcnt lgkmcnt(0)" ::: "memory");
  bf16_t* Ow = Obf + (size_t)(wid * 32) * DM;
#pragma unroll
  for (int r = 0; r < 16; ++r) { const int orow = crow(r, hi); const float rl = __builtin_amdgcn_rcpf(li_l[orow]);
#pragma unroll
    for (int d0 = 0; d0 < 4; ++d0) Ow[(size_t)orow * DM + d0 * 32 + r32] = (bf16_t)f2bf(o[d0][r] * rl); }
  __syncthreads();
#undef KROW
#undef SLOAD
}
}

__device__ __forceinline__ void phase_small(const Args& a, unsigned char* lds, int vcu, int G, int layer, bool last) {
    const int tid = otid(), wave = tid >> 6, lane = tid & 63;
    const int gw = vcu * NWAVE + wave, NGW = G * NWAVE;
    const int nrows = last ? SEQ : MR;
    for (int row = gw; row < MR; row += NGW) qk_prep_row(a, layer, row, lane);
    for (int row = gw; row < nrows; row += NGW) dlt_row(a, row, lane);
    const int nunits = (nrows / 128) * 4;
    for (int u = G - 1 - vcu; u < nunits; u += G) cmix_unit(a, layer, u, lds);
    const bf16_t* PL = (const bf16_t*)(a.ws + WS_PL); bf16_t* OD = (bf16_t*)(a.ws + WS_OUTS) + 3 * 512;
    const float* rpb = a.in[I_RPB] + layer * 4 * 15 * 31;
    const int nu = 128 + (last ? 0 : 4);
    for (int u = vcu; u < nu; u += G) {
        if (u < 128) { const int h = u & 3, i = u >> 2, R0 = min(max(4 * i - 4, 0), 120);
            att::attn_unit_na(PL, i * 256, D_Q0 + h * HD, D_K0 + h * HD, D_V0 + h * HD, R0, rpb + h * 465, OD + (size_t)(i * 256) * DM + h * HD, (char*)lds); }
        else { const int h = u - 128;
            att::attn_unit<0, true>(PL, SEQ, D_Q0 + h * HD, D_K0 + h * HD, D_V0 + h * HD, 4, SEQ, 4, 0, nullptr, OD + (size_t)SEQ * DM + h * HD, nullptr, nullptr, (char*)lds); }
    }
}
constexpr size_t OPART_LSE = (size_t)2 * SEQ * 512 * 4;
__device__ __forceinline__ void phase_attn_a(const Args& a, unsigned char* lds, int vcu, int G, bool last) {
    const bf16_t* PL = (const bf16_t*)(a.ws + WS_PL); bf16_t* OA = (bf16_t*)(a.ws + WS_OUTS);
    float* Opart = (float*)(a.ws + WS_MRG); float* LSE = (float*)(a.ws + WS_MRG + OPART_LSE);
    const int nu = 256 + (last ? 0 : 4);
    for (int u = vcu; u < nu; u += G) {
        if (u < 256) { const int half = u >> 7, h = (u >> 5) & 3, qb = u & 31, kvh = h >> 1;
            att::attn_unit<0, false>(PL, qb * 256, A_Q0 + h * HD, A_K0 + kvh * HD, A_V0 + kvh * HD, 66, half * 4224, 66, 0, nullptr, nullptr,
                                     Opart + ((size_t)half * SEQ + qb * 256) * 512 + h * HD, LSE + ((size_t)half * SEQ + qb * 256) * 4 + h, (char*)lds); }
        else { const int h = u - 256, kvh = h >> 1;
            att::attn_unit<0, true>(PL, SEQ, A_Q0 + h * HD, A_K0 + kvh * HD, A_V0 + kvh * HD, 4, SEQ, 4, 0, nullptr, OA + (size_t)SEQ * DM + h * HD, nullptr, nullptr, (char*)lds); }
    }
}
__device__ __forceinline__ void phase_combine_a(const Args& a, int vcu, int G) {
    const int tid = otid(), wave = tid >> 6, lane = tid & 63;
    const int gw = vcu * NWAVE + wave, NGW = G * NWAVE;
    const float* Opart = (const float*)(a.ws + WS_MRG); const float* LSE = (const float*)(a.ws + WS_MRG + OPART_LSE); bf16_t* OA = (bf16_t*)(a.ws + WS_OUTS);
    for (int row = gw; row < SEQ; row += NGW) {
        const float l0 = LSE[(size_t)row * 4 + (lane >> 4)], l1 = LSE[((size_t)SEQ + row) * 4 + (lane >> 4)];
        const float mx = fmaxf(l0, l1), w0 = exp2f(l0 - mx), w1 = exp2f(l1 - mx), inv = 1.f / (w0 + w1), c0 = w0 * inv, c1 = w1 * inv;
        const float* p0 = Opart + (size_t)row * 512 + lane * 8; const float* p1 = p0 + (size_t)SEQ * 512;
        const f32x4 a0 = *(const f32x4*)p0, a1 = *(const f32x4*)(p0 + 4), b0 = *(const f32x4*)p1, b1 = *(const f32x4*)(p1 + 4);
        const f32x4 r0 = a0 * c0 + b0 * c1, r1 = a1 * c0 + b1 * c1;
        u32x4 w; w.x = pk2(r0[0], r0[1]); w.y = pk2(r0[2], r0[3]); w.z = pk2(r1[0], r1[1]); w.w = pk2(r1[2], r1[3]);
        *(u32x4*)(OA + (size_t)row * DM + lane * 8) = w;
    }
}

#define XB_TMO      128
#define XB_XCNT(j)  (256  + 64 * (j))
#define XB_XSUB(j)  (1280 + 64 * (j))
#define XB_XGEN(j)  (2304 + 64 * (j))
#define XB_TOP      3328
#define XB_TOPGEN   3392
#define XCD_BAR_WORDS 3456
#define XB_SPIN_CAP (1u << 18)

__device__ __forceinline__ unsigned xb_ld(unsigned* p)              { return __hip_atomic_load(p, __ATOMIC_RELAXED, __HIP_MEMORY_SCOPE_AGENT); }
__device__ __forceinline__ unsigned xb_add(unsigned* p, unsigned v) { return __hip_atomic_fetch_add(p, v, __ATOMIC_RELAXED, __HIP_MEMORY_SCOPE_AGENT); }
__device__ __forceinline__ unsigned xb_xcc_id() { return (unsigned)__builtin_amdgcn_s_getreg((3 << 11) | 20) & 0xFu; }
#define XB_SPIN(cond, bar) do { unsigned _sp = 0; while (cond) { __builtin_amdgcn_s_sleep(1); \
    if ((++_sp & 255u) == 0u) { if (xb_ld(&(bar)[XB_TMO])) break; if (_sp > XB_SPIN_CAP) { atomicAdd(&(bar)[XB_TMO], 1u); break; } } } } while (0)

struct XcdBarrier {
    unsigned* bar; unsigned x;
    volatile __attribute__((address_space(3))) unsigned* st;
};

__device__ __forceinline__ XcdBarrier xcd_barrier_post(unsigned* bar, volatile __attribute__((address_space(3))) unsigned* st) {
    XcdBarrier b; b.bar = bar; b.x = xb_xcc_id(); b.st = st;
    if (threadIdx.x == 0) (void)xb_add(&bar[XB_XCNT(b.x)], 1u);
    return b;
}
__device__ __forceinline__ void xcd_barrier_complete(unsigned* bar, unsigned x, unsigned& nloc, unsigned& nx) {
    const unsigned G = gridDim.x * gridDim.y * gridDim.z;
    unsigned sum, cnt, mine, sp = 0u;
    for (;;) {
        sum = 0u; cnt = 0u; mine = 0u;
#pragma unroll
        for (unsigned j = 0; j < 16; ++j) { const unsigned c = xb_ld(&bar[XB_XCNT(j)]); sum += c; cnt += (c > 0u) ? 1u : 0u; mine = (j == x) ? c : mine; }
        if (sum == G) break;
        __builtin_amdgcn_s_sleep(1);
        if ((++sp & 255u) == 0u) { if (xb_ld(&bar[XB_TMO])) break; if (sp > XB_SPIN_CAP) { atomicAdd(&bar[XB_TMO], 1u); break; } }
    }
    nloc = mine > 0u ? mine : 1u; nx = cnt > 0u ? cnt : 1u;
}

__device__ __forceinline__ void xcd_barrier(const XcdBarrier& b) {
    asm volatile("s_waitcnt vmcnt(0)" ::: "memory");
    __syncthreads();
    if (threadIdx.x == 0) {
        unsigned* bar = b.bar;
        __builtin_amdgcn_s_waitcnt(0);
        unsigned nloc = b.st[0], nx = b.st[1];
        if (nloc == 0u) { xcd_barrier_complete(bar, b.x, nloc, nx); b.st[0] = nloc; b.st[1] = nx; }
        const unsigned old = xb_add(&bar[XB_XSUB(b.x)], 1u);
        const unsigned gen = old / nloc;
        if (old + 1u == (gen + 1u) * nloc) {
            __builtin_amdgcn_fence(__ATOMIC_RELEASE, "agent");
            asm volatile("s_waitcnt vmcnt(0)" ::: "memory");
            const unsigned og = xb_add(&bar[XB_TOP], 1u);
            const unsigned tg = og / nx;
            if (og + 1u == (tg + 1u) * nx) xb_add(&bar[XB_TOPGEN], 1u);
            else XB_SPIN(xb_ld(&bar[XB_TOPGEN]) == tg, bar);
            __builtin_amdgcn_fence(__ATOMIC_ACQUIRE, "agent");
            xb_add(&bar[XB_XGEN(b.x)], 1u);
            asm volatile("s_waitcnt vmcnt(0)" ::: "memory");
        } else {
            XB_SPIN(xb_ld(&bar[XB_XGEN(b.x)]) == gen, bar);
            __builtin_amdgcn_fence(__ATOMIC_ACQUIRE, "agent");
            asm volatile("s_waitcnt vmcnt(0)" ::: "memory");
        }
    }
    __syncthreads();
}

__device__ __forceinline__ void zero_y_ctx(unsigned char* ws, int vcu, int G) {
    f32x4* y4 = (f32x4*)((float*)(ws + WS_MRG) + (size_t)SEQ * DM);
    for (int i = vcu * NTHR + otid(); i < CTXL * DM / 4; i += G * NTHR) y4[i] = (f32x4){0.f, 0.f, 0.f, 0.f};
}
constexpr int NPHASE = 22;
constexpr int CV_A = 2500, CV_B = 7000;
__global__ void __launch_bounds__(NTHR, 2) fwd(Args a) {
    extern __shared__ __attribute__((aligned(16))) unsigned char lds[];
    const int G = gridDim.x, bx = blockIdx.x;
    const int vcu = (G % 8 == 0) ? (bx % 8) * (G / 8) + bx / 8 : bx;
    unsigned char* ws = a.ws;
    const long long* MOD = (const long long*)(ws + WS_CTL + CTL_MOD);
#if MK_COOP
    cg::grid_group grid = cg::this_grid();
    volatile __attribute__((address_space(3))) unsigned* MISC = (volatile __attribute__((address_space(3))) unsigned*)((__attribute__((address_space(3))) unsigned char*)lds + (LDS_BYTES - 64));
    if (threadIdx.x < 2) MISC[threadIdx.x] = 0u;
    __syncthreads();
    const XcdBarrier xbar = xcd_barrier_post((unsigned*)(ws + WS_CTL) + CW_BAR, MISC);
#define SEAM(p) do { if (lo <= (p) && (p) + 1 < hi) { if ((p) == 0) grid.sync(); else xcd_barrier(xbar); } } while (0)
#else
#define SEAM(p) do { } while (0)
#endif
    const int lo = a.ph_lo, hi = a.ph_hi;
#ifndef PHMASK
#define PHMASK 0xffffffu
#endif
#define IN(p) (lo <= (p) && (p) < hi && ((PHMASK >> ((p) < 2 ? (p) : 2 + ((p) - 2) % 10)) & 1u))
    if (IN(0)) { phase_prologue(a, lds, vcu, G); } SEAM(0);
    if (IN(1)) { phase_rows<0>(a, vcu, G, MR, nullptr, nullptr, 0, a.in[I_NPRE_MIX], MOD, 0); } SEAM(1);
    {
        constexpr int l = 0; constexpr bool last = (l == 1); const int pb = 2 + l * 10;
        unsigned char* wb = ws + WS_W + (size_t)l * WPL;
        const long long* modl = MOD + (size_t)l * 2 * NIN;
        const int Mrows = last ? SEQ : MR;
        if (IN(pb + 0)) {
            Gemm g{(const bf16_t*)(ws + WS_XN), (const bf16_t*)(wb + W_IN), DM, DM, DM}; StaticOrder S; S.init(MR, NIN - 512, G, bx);
            EpiIn E{(bf16_t*)(ws + WS_PL)}; gemm_phase((PG8_LAS unsigned char*)lds, g, S, E);
        } SEAM(pb + 0);
        if (IN(pb + 1)) {
            phase_small(a, lds, vcu, G, l, last);
            Gemm g{(const bf16_t*)(ws + WS_XN), (const bf16_t*)(wb + W_IN), DM, DM, DM}; ListOrder S{vcu - 132, 2 * (Mrows / 256), Mrows / 256, 46};
            EpiIn E{(bf16_t*)(ws + WS_PL)}; gemm_phase((PG8_LAS unsigned char*)lds, g, S, E);
        } SEAM(pb + 1);
        if (IN(pb + 2)) { phase_attn_a(a, lds, vcu, G, last); } SEAM(pb + 2);
        if (IN(pb + 3)) {
            phase_combine_a(a, vcu, G);
            Gemm g{(const bf16_t*)(ws + WS_DLT), (const bf16_t*)(wb + W_B), 512, 512, 512}; StaticOrder S; S.init(Mrows, 512, G, bx);
            EpiScale E{(bf16_t*)(ws + WS_OUTS) + 512, DM, a.in[I_BSCALE] + l * 512}; gemm_phase((PG8_LAS unsigned char*)lds, g, S, E);
        } SEAM(pb + 3);
        if (IN(pb + 4)) {
            Gemm g{(const bf16_t*)(ws + WS_OUTS), (const bf16_t*)(wb + W_BR), DM, DM, DM}; StaticOrder S; S.init(Mrows, DM, G, bx);
            EpiMerge E{(const bf16_t*)(ws + WS_PL), (bf16_t*)(ws + WS_MRGB)}; gemm_phase((PG8_LAS unsigned char*)lds, g, S, E);
        } SEAM(pb + 4);
        if (IN(pb + 5)) {
            Gemm g{(const bf16_t*)(ws + WS_MRGB), (const bf16_t*)(wb + W_O), DM, DM, DM}; StaticOrder S; S.init(SEQ, DM, G, bx);
            EpiY E{(bf16_t*)(ws + WS_MRG), DM}; gemm_phase((PG8_LAS unsigned char*)lds, g, S, E);
            { const int kq = bx >> 3;
              Gemm g2{(const bf16_t*)(ws + WS_MRGB) + kq * 512, (const bf16_t*)(wb + W_O) + kq * 512, DM, DM, 512}; CtxSplitOrder S2{bx};
              EpiF32 E2{(float*)(ws + WS_DLT) + (size_t)kq * CTXL * DM - (size_t)SEQ * DM, DM}; gemm_phase((PG8_LAS unsigned char*)lds, g2, S2, E2); }
            if (bx >= 32) convert_layer(a, lds, 1, (bx - 32) * NWAVE + (otid() >> 6), (G - 32) * NWAVE, 0, CV_A);
        } SEAM(pb + 5);
        if (IN(pb + 6)) { phase_rows<1, true>(a, vcu, G, Mrows, a.in[I_NPOST_MIX] + l * DM, modl, 2, a.in[I_NPRE_FFN] + l * DM, modl, 3, (const float*)(ws + WS_DLT)); } SEAM(pb + 6);
        if (IN(pb + 7)) {
            Gemm g{(const bf16_t*)(ws + WS_XN), (const bf16_t*)(wb + W_GU), DM, DM, DM}; StaticOrder S; S.init(Mrows, 2 * FF, G, bx);
            EpiSwiglu E{(bf16_t*)(ws + WS_H)}; gemm_phase((PG8_LAS unsigned char*)lds, g, S, E);
            if (bx >= 172) convert_layer(a, lds, 1, (bx - 172) * NWAVE + (otid() >> 6), (G - 172) * NWAVE, CV_A, CV_B);
        } SEAM(pb + 7);
        if (IN(pb + 8)) {
            Gemm g{(const bf16_t*)(ws + WS_H), (const bf16_t*)(wb + W_D), FF, FF, FF}; StaticOrder S; S.init(SEQ, DM, G, bx);
            EpiY E{(bf16_t*)(ws + WS_MRG), DM}; gemm_phase((PG8_LAS unsigned char*)lds, g, S, E);
            { const int kq = bx >> 3;
              Gemm g2{(const bf16_t*)(ws + WS_H) + kq * 1408, (const bf16_t*)(wb + W_D) + kq * 1408, FF, FF, 1408}; CtxSplitOrder S2{bx};
              EpiF32 E2{(float*)(ws + WS_DLT) + (size_t)kq * CTXL * DM - (size_t)SEQ * DM, DM}; gemm_phase((PG8_LAS unsigned char*)lds, g2, S2, E2); }
            if (bx >= 32) convert_layer(a, lds, 1, (bx - 32) * NWAVE + (otid() >> 6), (G - 32) * NWAVE, CV_B, 1 << 30);
        } SEAM(pb + 8);
        if (IN(pb + 9)) {
            if (!last) phase_rows<1>(a, vcu, G, MR, a.in[I_NPOST_FFN] + l * DM, modl, 5, a.in[I_NPRE_MIX] + (l + 1) * DM, MOD + (size_t)(l + 1) * 2 * NIN, 0, (const float*)(ws + WS_DLT));
            else phase_rows<2>(a, vcu, G, SEQ, a.in[I_NPOST_FFN] + l * DM, modl, 5, nullptr, nullptr, 0);
        }
        if (!last) SEAM(pb + 9);
        }
    {
        constexpr int l = 1; constexpr bool last = (l == 1); const int pb = 2 + l * 10;
        unsigned char* wb = ws + WS_W + (size_t)l * WPL;
        const long long* modl = MOD + (size_t)l * 2 * NIN;
        const int Mrows = last ? SEQ : MR;
        if (IN(pb + 0)) {
            Gemm g{(const bf16_t*)(ws + WS_XN), (const bf16_t*)(wb + W_IN), DM, DM, DM}; StaticOrder S; S.init(MR, NIN - 512, G, bx);
            EpiIn E{(bf16_t*)(ws + WS_PL)}; gemm_phase((PG8_LAS unsigned char*)lds, g, S, E);
        } SEAM(pb + 0);
        if (IN(pb + 1)) {
            phase_small(a, lds, vcu, G, l, last);
            Gemm g{(const bf16_t*)(ws + WS_XN), (const bf16_t*)(wb + W_IN), DM, DM, DM}; ListOrder S{vcu - 132, 2 * (Mrows / 256), Mrows / 256, 46};
            EpiIn E{(bf16_t*)(ws + WS_PL)}; gemm_phase((PG8_LAS unsigned char*)lds, g, S, E);
        } SEAM(pb + 1);
        if (IN(pb + 2)) { phase_attn_a(a, lds, vcu, G, last); } SEAM(pb + 2);
        if (IN(pb + 3)) {
            phase_combine_a(a, vcu, G);
            Gemm g{(const bf16_t*)(ws + WS_DLT), (const bf16_t*)(wb + W_B), 512, 512, 512}; StaticOrder S; S.init(Mrows, 512, G, bx);
            EpiScale E{(bf16_t*)(ws + WS_OUTS) + 512, DM, a.in[I_BSCALE] + l * 512}; gemm_phase((PG8_LAS unsigned char*)lds, g, S, E);
        } SEAM(pb + 3);
        if (IN(pb + 4)) {
            Gemm g{(const bf16_t*)(ws + WS_OUTS), (const bf16_t*)(wb + W_BR), DM, DM, DM}; StaticOrder S; S.init(Mrows, DM, G, bx);
            EpiMerge E{(const bf16_t*)(ws + WS_PL), (bf16_t*)(ws + WS_MRGB)}; gemm_phase((PG8_LAS unsigned char*)lds, g, S, E);
        } SEAM(pb + 4);
        if (IN(pb + 5)) {
            Gemm g{(const bf16_t*)(ws + WS_MRGB), (const bf16_t*)(wb + W_O), DM, DM, DM}; StaticOrder S; S.init(Mrows, DM, G, bx);
            EpiY E{(bf16_t*)(ws + WS_MRG), DM}; gemm_phase((PG8_LAS unsigned char*)lds, g, S, E);
        } SEAM(pb + 5);
        if (IN(pb + 6)) { phase_rows<1>(a, vcu, G, Mrows, a.in[I_NPOST_MIX] + l * DM, modl, 2, a.in[I_NPRE_FFN] + l * DM, modl, 3); } SEAM(pb + 6);
        if (IN(pb + 7)) {
            Gemm g{(const bf16_t*)(ws + WS_XN), (const bf16_t*)(wb + W_GU), DM, DM, DM}; StaticOrder S; S.init(Mrows, 2 * FF, G, bx);
            EpiSwiglu E{(bf16_t*)(ws + WS_H)}; gemm_phase((PG8_LAS unsigned char*)lds, g, S, E);
        } SEAM(pb + 7);
        if (IN(pb + 8)) {
            Gemm g{(const bf16_t*)(ws + WS_H), (const bf16_t*)(wb + W_D), FF, FF, FF}; StaticOrder S; S.init(Mrows, DM, G, bx);
            EpiY E{(bf16_t*)(ws + WS_MRG), DM}; gemm_phase((PG8_LAS unsigned char*)lds, g, S, E);
        } SEAM(pb + 8);
        if (IN(pb + 9)) {
            if (!last) phase_rows<1>(a, vcu, G, MR, a.in[I_NPOST_FFN] + l * DM, modl, 5, a.in[I_NPRE_MIX] + (l + 1) * DM, MOD + (size_t)(l + 1) * 2 * NIN, 0);
            else phase_rows<2>(a, vcu, G, SEQ, a.in[I_NPOST_FFN] + l * DM, modl, 5, nullptr, nullptr, 0);
        }
        if (!last) SEAM(pb + 9);
        }
#undef IN
#undef SEAM
}

extern "C" void kernel_launch(void* const* d_in, const int* in_sizes, int n_in, void* d_out, int out_size, void* d_ws, size_t ws_size, hipStream_t stream) {
    static int grid = 0;
    if (grid == 0) {
        if (n_in != N_IN || out_size != SEQ * DM || ws_size < WS_END) { fprintf(stderr, "kernel_launch: unexpected shapes (n_in %d out %d ws %zu)\n", n_in, out_size, ws_size); grid = -1; return; }
        if (hipFuncSetAttribute((const void*)fwd, hipFuncAttributeMaxDynamicSharedMemorySize, LDS_BYTES) != hipSuccess) { fprintf(stderr, "kernel_launch: hipFuncSetAttribute failed\n"); grid = -1; return; }
        int dev = 0, cus = 0, per_cu = 0;
        hipGetDevice(&dev); hipDeviceGetAttribute(&cus, hipDeviceAttributeMultiprocessorCount, dev);
        hipOccupancyMaxActiveBlocksPerMultiprocessor(&per_cu, (const void*)fwd, NTHR, LDS_BYTES);
        if (per_cu < 1) { fprintf(stderr, "kernel_launch: occupancy query says %d blocks per CU\n", per_cu); per_cu = 1; }
        (void)hipGetLastError();
        grid = cus * per_cu;
        fprintf(stderr, "kernel_launch: grid %d (cus %d x %d)\n", grid, cus, per_cu);
    }
    if (grid < 0) return;
    hipMemsetAsync((char*)d_ws + WS_CTL, 0, CTL_BYTES, stream);
    Args a{};
    for (int i = 0; i < N_IN; ++i) a.in[i] = (const float*)d_in[i];
    a.out = (float*)d_out; a.ws = (unsigned char*)d_ws;
#if MK_COOP
    a.ph_lo = 0; a.ph_hi = NPHASE;
    void* params[] = {&a};
    hipError_t e = hipLaunchCooperativeKernel((const void*)fwd, dim3(grid), dim3(NTHR), params, LDS_BYTES, stream);
    if (e != hipSuccess) fprintf(stderr, "kernel_launch: cooperative launch failed: %s (grid %d)\n", hipGetErrorString(e), grid);
#else
    for (int p = 0; p < NPHASE; ++p) {
        a.ph_lo = p; a.ph_hi = p + 1;
        hipLaunchKernelGGL(fwd, dim3(grid), dim3(NTHR), LDS_BYTES, stream, a);
    }
#endif
}
```
